# Optimizing an MI355X kernel written in HIP

```python
import jax, jax.numpy as jnp
from jax import lax
import numpy as np

D_MODEL = 1024
BATCH = 4
SEQ = 4096
DEPTH = 1

ML_HEADS = 4
ML_DQK = 128
ML_DV = 256
CONV_K = 4
RET_HEADS = 4
RET_DQK = 128
RET_DV = 256
ROPE_BASE = 10000.0
CHUNK = 128
N_EXPERTS = 32
TOP_K = 4
D_EXPERT = D_MODEL
SWIGLU_LIMIT = 7.0
SWIGLU_ALPHA = 1.702
EXPERT_BLOCK = 256
EPS = 1e-5

ML_QK_W = ML_HEADS * ML_DQK
ML_V_W = ML_HEADS * ML_DV
RET_QK_W = RET_HEADS * RET_DQK
RET_V_W = RET_HEADS * RET_DV
IN_SIZES = (2 * ML_QK_W, ML_V_W, ML_V_W, 2 * ML_HEADS, RET_QK_W, RET_QK_W, RET_V_W, RET_V_W, D_MODEL, D_MODEL)
D_IN = sum(IN_SIZES)

kernel_name = "hybrid_mlstm_retention_moe_adaln"


def rmsnorm(x, g):
    xf = x.astype(jnp.float32)
    y = xf * lax.rsqrt(jnp.mean(xf * xf, axis=-1, keepdims=True) + EPS)
    return (y * g.astype(jnp.float32)).astype(x.dtype)


def head_layernorm(h, n_heads, g):
    B, S, W = h.shape
    hf = h.astype(jnp.float32).reshape(B, S, n_heads, W // n_heads)
    mu = jnp.mean(hf, axis=-1, keepdims=True)
    var = jnp.mean(jnp.square(hf - mu), axis=-1, keepdims=True)
    y = ((hf - mu) * lax.rsqrt(var + EPS)).reshape(B, S, W)
    return (y * g.astype(jnp.float32)).astype(h.dtype)


def causal_dwconv(x, w, b):
    C = x.shape[-1]
    y = lax.conv_general_dilated(x, w[:, None, :].astype(x.dtype), window_strides=(1,), padding=((CONV_K - 1, 0),),
                                 dimension_numbers=('NWC', 'WIO', 'NWC'), feature_group_count=C)
    return y + b.astype(x.dtype)


def rotary(x, positions):
    half = x.shape[-1] // 2
    inv = ROPE_BASE ** (-jnp.arange(half, dtype=jnp.float32) / half)
    ang = positions.astype(jnp.float32)[..., None] * inv
    cos = jnp.cos(ang)[:, :, None, :]
    sin = jnp.sin(ang)[:, :, None, :]
    xf = x.astype(jnp.float32)
    x1, x2 = xf[..., :half], xf[..., half:]
    return jnp.concatenate([x1 * cos - x2 * sin, x2 * cos + x1 * sin], axis=-1).astype(x.dtype)


def to_chunks(t, n_heads):
    B, S, _ = t.shape
    return t.reshape(B, S // CHUNK, CHUNK, n_heads, -1).transpose(0, 3, 1, 2, 4)


def gate_chunks(t):
    B, S, H = t.shape
    return t.reshape(B, S // CHUNK, CHUNK, H).transpose(0, 3, 1, 2)


def from_chunks(t):
    B, H, NC, L, d = t.shape
    return t.transpose(0, 2, 3, 1, 4).reshape(B, NC * L, H * d)


def mlstm_chunkwise(q, k, v, i_pre, f_pre):
    L = q.shape[-2]
    dk = q.shape[-1]
    q = q.astype(jnp.float32) * (dk ** -0.5)
    k = k.astype(jnp.float32)
    v = v.astype(jnp.float32)
    a = jnp.cumsum(jax.nn.log_sigmoid(f_pre), axis=-1)
    A = a[..., -1]
    causal = jnp.tril(jnp.ones((L, L), dtype=bool))
    d_log = jnp.where(causal, a[..., :, None] - a[..., None, :] + i_pre[..., None, :], -jnp.inf)
    m_intra = jnp.max(d_log, axis=-1)
    w_state = A[..., None] - a + i_pre
    m_loc = jnp.max(w_state, axis=-1)
    ws = jnp.exp(w_state - m_loc[..., None])
    c_loc = jnp.einsum('bhcl,bhclk,bhclv->bhckv', ws, k, v)
    n_loc = jnp.einsum('bhcl,bhclk->bhck', ws, k)

    def step(carry, inp):
        c_st, n_st, m_st = carry
        a_c, m_l, c_l, n_l = inp
        m_new = jnp.maximum(a_c + m_st, m_l)
        s_prev = jnp.exp(a_c + m_st - m_new)
        s_loc = jnp.exp(m_l - m_new)
        c_new = s_prev[..., None, None] * c_st + s_loc[..., None, None] * c_l
        n_new = s_prev[..., None] * n_st + s_loc[..., None] * n_l
        return (c_new, n_new, m_new), (c_st, n_st, m_st)

    B, H = q.shape[0], q.shape[1]
    init = (jnp.zeros((B, H, dk, v.shape[-1]), jnp.float32), jnp.zeros((B, H, dk), jnp.float32), jnp.zeros((B, H), jnp.float32))
    xs = (jnp.moveaxis(A, 2, 0), jnp.moveaxis(m_loc, 2, 0), jnp.moveaxis(c_loc, 2, 0), jnp.moveaxis(n_loc, 2, 0))
    _, (c_prev, n_prev, m_prev) = lax.scan(step, init, xs)
    c_prev = jnp.moveaxis(c_prev, 0, 2)
    n_prev = jnp.moveaxis(n_prev, 0, 2)
    m_prev = jnp.moveaxis(m_prev, 0, 2)

    inter_log = a + m_prev[..., None]
    m_t = jnp.maximum(inter_log, m_intra)
    p = jnp.exp(d_log - m_t[..., None]) * jnp.einsum('bhcjk,bhcsk->bhcjs', q, k)
    inter_scale = jnp.exp(inter_log - m_t)
    num = jnp.einsum('bhcjs,bhcsv->bhcjv', p, v) + inter_scale[..., None] * jnp.einsum('bhcjk,bhckv->bhcjv', q, c_prev)
    den = jnp.sum(p, axis=-1) + inter_scale * jnp.einsum('bhcjk,bhck->bhcj', q, n_prev)
    return num / jnp.maximum(jnp.abs(den), jnp.exp(-m_t))[..., None]


def retention_chunkwise(q, k, v):
    H, L = q.shape[1], q.shape[-2]
    log_gamma = jnp.log(1.0 - 2.0 ** (-5.0 - jnp.arange(H, dtype=jnp.float32)))
    q = q.astype(jnp.float32)
    k = k.astype(jnp.float32) * (k.shape[-1] ** -0.5)
    v = v.astype(jnp.float32)
    pos = jnp.arange(L, dtype=jnp.float32)
    rel = pos[:, None] - pos[None, :]
    decay = jnp.where(rel >= 0, jnp.exp(log_gamma[:, None, None] * jnp.maximum(rel, 0.0)), 0.0)
    scores = jnp.einsum('bhcjk,bhcsk->bhcjs', q, k) * decay[None, :, None]
    intra = jnp.einsum('bhcjs,bhcsv->bhcjv', scores, v)
    k_decay = jnp.exp(log_gamma[:, None] * (L - 1 - pos))
    r_loc = jnp.einsum('bhcsk,hs,bhcsv->bhckv', k, k_decay, v)
    g_chunk = jnp.exp(log_gamma * L)[None, :, None, None]

    def step(r, r_l):
        return g_chunk * r + r_l, r

    init = jnp.zeros((q.shape[0], H, q.shape[-1], v.shape[-1]), jnp.float32)
    _, r_prev = lax.scan(step, init, jnp.moveaxis(r_loc, 2, 0))
    r_prev = jnp.moveaxis(r_prev, 0, 2)
    q_decay = jnp.exp(log_gamma[:, None] * (pos + 1.0))
    inter = jnp.einsum('bhcjk,bhckv->bhcjv', q, r_prev) * q_decay[None, :, None, :, None]
    return intra + inter


def mixer(xm, positions, w_in, conv_w, conv_b, b_if, ml_norm_g, ret_norm_g, w_branch_ml, w_branch_ret, w_out):
    B, S, _ = xm.shape
    split_idx = np.cumsum(IN_SIZES)[:-1].tolist()
    proj = xm @ w_in
    ml_qk, ml_v, ml_o, ml_if, ret_q, ret_k, ret_v, ret_g, gate_ml, gate_ret = jnp.split(proj, split_idx, axis=-1)

    ml_qk = jax.nn.silu(causal_dwconv(ml_qk, conv_w, conv_b))
    ml_q, ml_k = ml_qk[..., :ML_QK_W], ml_qk[..., ML_QK_W:]
    if_pre = (ml_if + b_if).astype(jnp.float32)
    h_ml = mlstm_chunkwise(to_chunks(ml_q, ML_HEADS), to_chunks(ml_k, ML_HEADS), to_chunks(ml_v, ML_HEADS),
                           gate_chunks(if_pre[..., :ML_HEADS]), gate_chunks(if_pre[..., ML_HEADS:]))
    h_ml = from_chunks(h_ml).astype(xm.dtype)
    h_ml = jax.nn.sigmoid(ml_o) * head_layernorm(h_ml, ML_HEADS, ml_norm_g)

    ret_q = rotary(ret_q.reshape(B, S, RET_HEADS, RET_DQK), positions).reshape(B, S, RET_QK_W)
    ret_k = rotary(ret_k.reshape(B, S, RET_HEADS, RET_DQK), positions).reshape(B, S, RET_QK_W)
    h_ret = retention_chunkwise(to_chunks(ret_q, RET_HEADS), to_chunks(ret_k, RET_HEADS), to_chunks(ret_v, RET_HEADS))
    h_ret = from_chunks(h_ret).astype(xm.dtype)
    h_ret = jax.nn.silu(ret_g) * head_layernorm(h_ret, RET_HEADS, ret_norm_g)

    y = jax.nn.sigmoid(gate_ml) * (h_ml @ w_branch_ml) + jax.nn.sigmoid(gate_ret) * (h_ret @ w_branch_ret)
    return y @ w_out


def clamped_swiglu(gu):
    x_glu = jnp.minimum(gu[..., ::2], SWIGLU_LIMIT)
    x_lin = jnp.clip(gu[..., 1::2], -SWIGLU_LIMIT, SWIGLU_LIMIT)
    return x_glu * jax.nn.sigmoid(SWIGLU_ALPHA * x_glu) * (x_lin + 1.0)


def moe(xm, w_router, b_router, w_gate_up, b_gate_up, w_down, b_down):
    B, S, D = xm.shape
    T = B * S
    xt = xm.reshape(T, D)
    logits = (xt @ w_router + b_router).astype(jnp.float32)
    top_val, top_idx = lax.top_k(logits, TOP_K)
    top_w = jax.nn.softmax(top_val, axis=-1)
    n_assign = T * TOP_K
    n_blocks = -(-n_assign // EXPERT_BLOCK) + N_EXPERTS
    n_slots = n_blocks * EXPERT_BLOCK
    e_flat = top_idx.reshape(n_assign)
    tok_flat = jnp.arange(n_assign, dtype=jnp.int32) // TOP_K
    w_flat = top_w.reshape(n_assign)
    counts = jnp.bincount(e_flat, length=N_EXPERTS)
    group_start = jnp.cumsum(counts) - counts
    blocks_per_e = (counts + EXPERT_BLOCK - 1) // EXPERT_BLOCK
    block_end = jnp.cumsum(blocks_per_e)
    pad_start = (block_end - blocks_per_e) * EXPERT_BLOCK
    order = jnp.argsort(e_flat)
    e_sorted = e_flat[order]
    rank = jnp.arange(n_assign, dtype=jnp.int32) - group_start[e_sorted]
    dest = pad_start[e_sorted] + rank
    slot_tok = jnp.full((n_slots,), T, jnp.int32).at[dest].set(tok_flat[order])
    slot_w = jnp.zeros((n_slots,), jnp.float32).at[dest].set(w_flat[order])
    block_expert = jnp.minimum(jnp.searchsorted(block_end, jnp.arange(n_blocks), side='right'), N_EXPERTS - 1)
    x_pad = jnp.concatenate([xt, jnp.zeros((1, D), xt.dtype)], axis=0)
    x_blocks = x_pad[slot_tok].reshape(n_blocks, EXPERT_BLOCK, D)

    def expert_block(args):
        xb, e = args
        gu = xb @ w_gate_up[e] + b_gate_up[e]
        return clamped_swiglu(gu) @ w_down[e] + b_down[e]

    y_blocks = lax.map(expert_block, (x_blocks, block_expert))
    y_slots = y_blocks.reshape(n_slots, D) * slot_w[:, None].astype(y_blocks.dtype)
    y = jax.ops.segment_sum(y_slots, slot_tok, num_segments=T + 1)[:T]
    return y.reshape(B, S, D)


def setup_inputs(seed: int = 0) -> dict:
    key = jax.random.key(seed)
    ks = jax.random.split(key, 24)
    D, L, E, F = D_MODEL, DEPTH, N_EXPERTS, D_EXPERT
    nrm = lambda k, shape, s: jax.random.normal(k, shape, jnp.float32) * s
    x = nrm(ks[0], (BATCH, SEQ, D), 1.0)
    c = nrm(ks[1], (BATCH, D), 1.0)
    offsets = jax.random.randint(ks[2], (BATCH, 1), 0, 1024, dtype=jnp.int32)
    positions = offsets + jnp.arange(SEQ, dtype=jnp.int32)[None, :]
    b_i = -1.0 + nrm(ks[8], (L, ML_HEADS), 0.1)
    b_f = jnp.linspace(3.0, 6.0, ML_HEADS, dtype=jnp.float32)[None, :] + nrm(ks[9], (L, ML_HEADS), 0.1)
    return {
        "x": x,
        "c": c,
        "positions": positions,
        "w_ada": nrm(ks[3], (L, D, 6 * D), 0.5 * D ** -0.5),
        "b_ada": nrm(ks[4], (L, 6 * D), 0.02),
        "norm_mix_g": 1.0 + nrm(ks[5], (L, D), 0.02),
        "w_in": nrm(ks[6], (L, D, D_IN), D ** -0.5),
        "conv_w": nrm(ks[7], (L, CONV_K, 2 * ML_QK_W), CONV_K ** -0.5),
        "conv_b": nrm(ks[10], (L, 2 * ML_QK_W), 0.02),
        "b_if": jnp.concatenate([b_i, b_f], axis=-1),
        "ml_norm_g": 1.0 + nrm(ks[11], (L, ML_V_W), 0.02),
        "ret_norm_g": 1.0 + nrm(ks[12], (L, RET_V_W), 0.02),
        "w_branch_ml": nrm(ks[13], (L, ML_V_W, D), ML_V_W ** -0.5),
        "w_branch_ret": nrm(ks[14], (L, RET_V_W, D), RET_V_W ** -0.5),
        "w_out": nrm(ks[15], (L, D, D), D ** -0.5),
        "norm_ffn_g": 1.0 + nrm(ks[16], (L, D), 0.02),
        "w_router": nrm(ks[17], (L, D, E), D ** -0.5),
        "b_router": nrm(ks[18], (L, E), 0.01),
        "w_gate_up": nrm(ks[19], (L, E, D, 2 * F), D ** -0.5),
        "b_gate_up": nrm(ks[20], (L, E, 2 * F), 0.02),
        "w_down": nrm(ks[21], (L, E, F, D), F ** -0.5),
        "b_down": nrm(ks[22], (L, E, D), 0.02),
        "norm_final_g": 1.0 + nrm(ks[23], (D,), 0.02),
    }


def reference(x, c, positions, w_ada, b_ada, norm_mix_g, w_in, conv_w, conv_b, b_if, ml_norm_g, ret_norm_g,
              w_branch_ml, w_branch_ret, w_out, norm_ffn_g, w_router, b_router, w_gate_up, b_gate_up, w_down, b_down,
              norm_final_g):
    c_act = jax.nn.silu(c)
    for l in range(DEPTH):
        mod = c_act @ w_ada[l] + b_ada[l]
        shift_m, scale_m, gate_m, shift_f, scale_f, gate_f = jnp.split(mod[:, None, :], 6, axis=-1)
        h = rmsnorm(x, norm_mix_g[l]) * (1.0 + scale_m) + shift_m
        x = x + gate_m * mixer(h, positions, w_in[l], conv_w[l], conv_b[l], b_if[l], ml_norm_g[l], ret_norm_g[l],
                               w_branch_ml[l], w_branch_ret[l], w_out[l])
        h = rmsnorm(x, norm_ffn_g[l]) * (1.0 + scale_f) + shift_f
        x = x + gate_f * moe(h, w_router[l], b_router[l], w_gate_up[l], b_gate_up[l], w_down[l], b_down[l])
    return rmsnorm(x, norm_final_g)
```

```cpp
#include <hip/hip_runtime.h>
#include <cstdio>
#include <cstdint>

#define DI __device__ __forceinline__
#define LAS __attribute__((address_space(3)))
typedef unsigned short bf16;
typedef float f32x4 __attribute__((ext_vector_type(4)));
typedef unsigned u32x4 __attribute__((ext_vector_type(4)));
typedef unsigned u32x2 __attribute__((ext_vector_type(2)));

constexpr int D = 1024, NB = 4, SEQ = 4096, T = NB * SEQ;
constexpr int DIN = 8200, CH = 128, NCH = SEQ / CH;
constexpr int NE = 32, TOPK = 4, NSLOT_BLK = 288, NSLOTS = NSLOT_BLK * 256;
constexpr float EPS = 1e-5f;
constexpr int NTHR = 512, NWAVES = 8;

constexpr size_t MiB = 1u << 20;
constexpr size_t WS_CTL   = 0;
constexpr size_t WS_MOD   = 1 * MiB;
constexpr size_t WS_IFG   = 2 * MiB;
constexpr size_t WS_COS   = 3 * MiB;
constexpr size_t WS_SIN   = 7 * MiB;
constexpr size_t WS_ROUTE = 11 * MiB;
constexpr size_t WS_SMALL = 14 * MiB;
constexpr size_t WS_H1    = 16 * MiB;
constexpr size_t WS_X1    = 50 * MiB;
constexpr size_t WS_TMP   = 114 * MiB;
constexpr size_t WS_B     = 178 * MiB;
constexpr size_t WS_QKRAW = WS_B;
constexpr size_t WS_QC    = WS_B + 32 * MiB;
constexpr size_t WS_MLV   = WS_B + 64 * MiB;
constexpr size_t WS_MLO   = WS_B + 96 * MiB;
constexpr size_t WS_RETQ  = WS_B + 128 * MiB;
constexpr size_t WS_RETK  = WS_B + 144 * MiB;
constexpr size_t WS_RETV  = WS_B + 160 * MiB;
constexpr size_t WS_RETG  = WS_B + 192 * MiB;
constexpr size_t WS_GML   = WS_B + 224 * MiB;
constexpr size_t WS_GRET  = WS_B + 256 * MiB;
constexpr size_t WS_CLOC  = WS_B + 288 * MiB;
constexpr size_t WS_CPREV = WS_B + 352 * MiB;
constexpr size_t WS_HML   = WS_B + 416 * MiB;
constexpr size_t WS_HRET  = WS_B + 448 * MiB;
constexpr size_t WS_B_END = WS_B + 480 * MiB;
constexpr size_t WS_ACT   = WS_B;
constexpr size_t WS_YS    = WS_B + 160 * MiB;
constexpr size_t WS_END   = WS_B_END;
static_assert(WS_YS + (size_t)NSLOTS * 2048 <= WS_B_END, "ws map");

constexpr int CW_CNT = 64;
constexpr int CW_NBLK = 128;
constexpr int CW_BLKE = 192;
constexpr size_t RT_TOPI = 0;
constexpr size_t RT_TOPW = 256 * 1024;
constexpr size_t RT_RANK = 512 * 1024;
constexpr size_t RT_ASLOT = 768 * 1024;
constexpr size_t RT_SLOTTOK = 1024 * 1024;
constexpr size_t RT_SLOTW = 1024 * 1024 + 512 * 1024;
constexpr size_t SM_NLOC = 0;
constexpr size_t SM_NPREV = 256 * 1024;
constexpr size_t SM_MLOC = 512 * 1024;
constexpr size_t SM_ACH = 512 * 1024 + 4096;
constexpr size_t SM_MPREV = 512 * 1024 + 8192;

constexpr int LDS_BYTES = 147456;

DI float bf2f(bf16 v) { return __uint_as_float(((unsigned)v) << 16); }
DI unsigned f2bf(float f) { unsigned u = __float_as_uint(f); return (u + 0x7fffu + ((u >> 16) & 1u)) >> 16; }
DI unsigned pk2(float lo, float hi) { return f2bf(lo) | (f2bf(hi) << 16); }
DI float wave_sum(float v) {
#pragma unroll
    for (int o = 1; o < 64; o <<= 1) v += __shfl_xor(v, o);
    return v;
}
DI float sigmoidf_(float x) { return 1.0f / (1.0f + __expf(-x)); }
DI float siluf_(float x) { return x / (1.0f + __expf(-x)); }
DI float logsigmoidf_(float x) { return fminf(x, 0.f) - log1pf(__expf(-fabsf(x))); }
DI void unpack8(const u32x4 w, float (&f)[8]) {
    f[0] = __uint_as_float(w.x << 16); f[1] = __uint_as_float(w.x & 0xffff0000u);
    f[2] = __uint_as_float(w.y << 16); f[3] = __uint_as_float(w.y & 0xffff0000u);
    f[4] = __uint_as_float(w.z << 16); f[5] = __uint_as_float(w.z & 0xffff0000u);
    f[6] = __uint_as_float(w.w << 16); f[7] = __uint_as_float(w.w & 0xffff0000u);
}
DI u32x4 pack8(const float (&f)[8]) { u32x4 w; w.x = pk2(f[0], f[1]); w.y = pk2(f[2], f[3]); w.z = pk2(f[4], f[5]); w.w = pk2(f[6], f[7]); return w; }

struct Args { const void* in[23]; float* out; unsigned char* ws; int ph_lo, ph_hi; };

struct Ctx {
    LAS unsigned char* lds;
    int tid, lane, wave, G, bid;
    const float *x, *c, *w_ada, *b_ada, *norm_mix_g, *w_in, *conv_w, *conv_b, *b_if, *ml_norm_g, *ret_norm_g;
    const float *w_bml, *w_bret, *w_out, *norm_ffn_g, *w_router, *b_router, *w_gu, *b_gu, *w_dn, *b_dn, *norm_final_g;
    const int* positions;
    float* out; unsigned char* ws;
};

template <class AF, class BF, class EF>
DI void naive_gemm_tile(Ctx& C, int tm, int tn, int K, int ldb, const AF& af, const BF& bf, const EF& ef) {
    LAS float* As = (LAS float*)C.lds;
    LAS float* Bs = As + 16 * 132;
    const int t = C.tid, ty = t >> 5, tx = t & 31;
    float acc[8][4];
#pragma unroll
    for (int i = 0; i < 8; ++i)
#pragma unroll
        for (int j = 0; j < 4; ++j) acc[i][j] = 0.f;
    const int ar = t >> 2, ak = (t & 3) * 4;
    const bf16* arow = af.row(tm, ar);
    const int bk = t >> 5, bn = (t & 31) * 4;
    const float* bbase = bf.ptr(tm, tn) + bn;
    for (int k0 = 0; k0 < K; k0 += 16) {
        const u32x2 av = *(const u32x2*)(arow + k0 + ak);
        const f32x4 bv = *(const f32x4*)(bbase + (size_t)(k0 + bk) * ldb);
        __syncthreads();
        As[(ak + 0) * 132 + ar] = __uint_as_float(av.x << 16); As[(ak + 1) * 132 + ar] = __uint_as_float(av.x & 0xffff0000u);
        As[(ak + 2) * 132 + ar] = __uint_as_float(av.y << 16); As[(ak + 3) * 132 + ar] = __uint_as_float(av.y & 0xffff0000u);
        *(LAS f32x4*)(Bs + bk * 132 + bn) = bv;
        __syncthreads();
#pragma unroll 4
        for (int kk = 0; kk < 16; ++kk) {
            const f32x4 a0 = *(const LAS f32x4*)(As + kk * 132 + ty * 8), a1 = *(const LAS f32x4*)(As + kk * 132 + ty * 8 + 4);
            const f32x4 b = *(const LAS f32x4*)(Bs + kk * 132 + tx * 4);
            const float a[8] = {a0.x, a0.y, a0.z, a0.w, a1.x, a1.y, a1.z, a1.w};
#pragma unroll
            for (int i = 0; i < 8; ++i) { acc[i][0] += a[i] * b.x; acc[i][1] += a[i] * b.y; acc[i][2] += a[i] * b.z; acc[i][3] += a[i] * b.w; }
        }
    }
#pragma unroll
    for (int i = 0; i < 8; ++i) { ef.put(tm, tn, ty * 8 + i, tx * 4, acc[i]); asm volatile("" ::: "memory"); }
    __syncthreads();
}

DI void phase_mod(Ctx& C) {
    LAS float* red = (LAS float*)C.lds;
    float* mod = (float*)(C.ws + WS_MOD);
    for (int g = C.bid; g < 256; g += C.G) {
        const int n0 = g * 24, t = C.tid;
        if (t < 504) {
            const int col = t % 24, kg = t / 24;
            float a0 = 0.f, a1 = 0.f, a2 = 0.f, a3 = 0.f;
            for (int k = kg; k < D; k += 21) {
                const float w = C.w_ada[(size_t)k * 6144 + n0 + col];
                a0 += siluf_(C.c[k]) * w; a1 += siluf_(C.c[D + k]) * w; a2 += siluf_(C.c[2 * D + k]) * w; a3 += siluf_(C.c[3 * D + k]) * w;
            }
            red[(kg * 24 + col) * 4 + 0] = a0; red[(kg * 24 + col) * 4 + 1] = a1; red[(kg * 24 + col) * 4 + 2] = a2; red[(kg * 24 + col) * 4 + 3] = a3;
        }
        __syncthreads();
        if (t < 96) {
            const int col = t % 24, b = t / 24; float s = 0.f;
            for (int kg = 0; kg < 21; ++kg) s += red[(kg * 24 + col) * 4 + b];
            mod[b * 6144 + n0 + col] = s + C.b_ada[n0 + col];
        }
        __syncthreads();
    }
}

DI void phase_norm1(Ctx& C) {
    const float* mod = (const float*)(C.ws + WS_MOD);
    bf16* H1 = (bf16*)(C.ws + WS_H1);
    float* IFG = (float*)(C.ws + WS_IFG);
    const int lane = C.lane, gw = C.bid * NWAVES + C.wave, NGW = C.G * NWAVES;
    float wif[4][4][8];
#pragma unroll
    for (int j = 0; j < 4; ++j)
#pragma unroll
        for (int i = 0; i < 4; ++i) {
            const float* wp = C.w_in + (size_t)(4 * (lane + 64 * j) + i) * DIN + 3072;
#pragma unroll
            for (int e = 0; e < 8; ++e) wif[j][i][e] = wp[e];
        }
    for (int m = gw; m < T; m += NGW) {
        const int b = m / SEQ;
        const f32x4* xr = (const f32x4*)(C.x + (size_t)m * D) + lane;
        f32x4 v[4]; float ss = 0.f;
#pragma unroll
        for (int j = 0; j < 4; ++j) { v[j] = xr[64 * j]; ss += (v[j].x * v[j].x + v[j].y * v[j].y) + (v[j].z * v[j].z + v[j].w * v[j].w); }
        const float rstd = 1.0f / sqrtf(wave_sum(ss) * (1.0f / D) + EPS);
        float p[8];
#pragma unroll
        for (int e = 0; e < 8; ++e) p[e] = 0.f;
        u32x2* o8 = (u32x2*)(H1 + (size_t)m * D) + lane;
#pragma unroll
        for (int j = 0; j < 4; ++j) {
            const int col = 4 * (lane + 64 * j);
            const f32x4 g = *(const f32x4*)(C.norm_mix_g + col), sh = *(const f32x4*)(mod + b * 6144 + col), sc = *(const f32x4*)(mod + b * 6144 + 1024 + col);
            f32x4 h = (v[j] * rstd * g) * (sc + 1.0f) + sh;
            u32x2 w; w.x = pk2(h.x, h.y); w.y = pk2(h.z, h.w); o8[64 * j] = w;
            const float hh[4] = {h.x, h.y, h.z, h.w};
#pragma unroll
            for (int i = 0; i < 4; ++i)
#pragma unroll
                for (int e = 0; e < 8; ++e) p[e] += hh[i] * wif[j][i][e];
        }
#pragma unroll
        for (int e = 0; e < 8; ++e) p[e] = wave_sum(p[e]);
        if (lane < 8) { float r = p[0];
#pragma unroll
            for (int e = 1; e < 8; ++e) r = (lane == e) ? p[e] : r;
            IFG[(size_t)m * 8 + lane] = r + C.b_if[lane]; }
    }
    float* COS = (float*)(C.ws + WS_COS); float* SIN = (float*)(C.ws + WS_SIN);
    for (int idx = C.bid * NTHR + C.tid; idx < T * 64; idx += C.G * NTHR) {
        const int t = idx >> 6, i = idx & 63;
        const float inv = (float)exp(-(double)i * (9.210340371976184 / 64.0));
        const double ang = (double)C.positions[t] * (double)inv;
        const double kq = rint(ang * 0.6366197723675814);
        double r = fma(-kq, 1.5707963267948966, ang); r = fma(-kq, 6.123233995736766e-17, r);
        const float rf = (float)r; const float s = sinf(rf), c = cosf(rf);
        const int q = ((int)kq) & 3;
        const float cs = (q == 0) ? c : (q == 1) ? -s : (q == 2) ? -c : s;
        const float sn = (q == 0) ? s : (q == 1) ? c : (q == 2) ? -s : -c;
        COS[idx] = cs; SIN[idx] = sn;
    }
    if (C.bid == 0 && C.tid < 32) ((unsigned*)(C.ws + WS_CTL))[CW_CNT + C.tid] = 0u;
}

struct AF_rows { const bf16* base; int ld; DI const bf16* row(int tm, int r) const { return base + (size_t)(tm * 128 + r) * ld; } };
struct BF_inproj { const float* w; DI const float* ptr(int, int tn) const { return w + (tn < 24 ? tn * 128 : tn * 128 + 8); } };
struct EF_inproj { unsigned char* ws;
    DI void put(int tm, int tn, int r, int c, const float (&v)[4]) const {
        const int row = tm * 128 + r; const int seg = tn >> 3;
        bf16* dst; int ld = 1024, col = (tn & 7) * 128 + c; int act = 0;
        switch (seg) {
            case 0: dst = (bf16*)(ws + WS_QKRAW); break;
            case 1: dst = (bf16*)(ws + WS_MLV); break;
            case 2: dst = (bf16*)(ws + WS_MLO); act = 1; break;
            case 3: if ((tn & 7) < 4) dst = (bf16*)(ws + WS_RETQ); else { dst = (bf16*)(ws + WS_RETK); col -= 512; } ld = 512; break;
            case 4: dst = (bf16*)(ws + WS_RETV); break;
            case 5: dst = (bf16*)(ws + WS_RETG); act = 2; break;
            case 6: dst = (bf16*)(ws + WS_GML); act = 1; break;
            default: dst = (bf16*)(ws + WS_GRET); act = 1; break;
        }
        float o[4];
#pragma unroll
        for (int j = 0; j < 4; ++j) o[j] = act == 1 ? sigmoidf_(v[j]) : act == 2 ? siluf_(v[j]) : v[j];
        u32x2 w; w.x = pk2(o[0], o[1]); w.y = pk2(o[2], o[3]);
        *(u32x2*)(dst + (size_t)row * ld + col) = w;
    } };
DI void phase_inproj(Ctx& C) {
    AF_rows af{(const bf16*)(C.ws + WS_H1), D}; BF_inproj bf{C.w_in}; EF_inproj ef{C.ws};
    const int ntn = 64, nt = (T / 128) * ntn;
    for (int u = C.bid; u < nt; u += C.G) naive_gemm_tile(C, u / ntn, u % ntn, D, DIN, af, bf, ef);
}

DI void phase_conv_rope(Ctx& C) {
    const bf16* QKRAW = (const bf16*)(C.ws + WS_QKRAW); bf16* QC = (bf16*)(C.ws + WS_QC);
    for (int idx = C.bid * NTHR + C.tid; idx < T * 128; idx += C.G * NTHR) {
        const int t = idx >> 7, c0 = (idx & 127) * 8, s = t % SEQ;
        float acc[8];
#pragma unroll
        for (int e = 0; e < 8; ++e) acc[e] = C.conv_b[c0 + e];
#pragma unroll
        for (int j = 0; j < 4; ++j) {
            if (s - 3 + j >= 0) {
                float f[8]; unpack8(*(const u32x4*)(QKRAW + (size_t)(t - 3 + j) * D + c0), f);
#pragma unroll
                for (int e = 0; e < 8; ++e) acc[e] += f[e] * C.conv_w[j * D + c0 + e];
            }
        }
        const float sc = (c0 < 512) ? 0.08838834764831845f : 1.0f;
#pragma unroll
        for (int e = 0; e < 8; ++e) acc[e] = siluf_(acc[e]) * sc;
        *(u32x4*)(QC + (size_t)t * D + c0) = pack8(acc);
    }
    const float* COS = (const float*)(C.ws + WS_COS); const float* SIN = (const float*)(C.ws + WS_SIN);
    for (int idx = C.bid * NTHR + C.tid; idx < T * 64; idx += C.G * NTHR) {
        const int t = idx >> 6, r = idx & 63, which = r >> 5, h = (r >> 3) & 3, i0 = (r & 7) * 8;
        bf16* base = (bf16*)(C.ws + (which ? WS_RETK : WS_RETQ)) + (size_t)t * 512 + h * 128;
        float x1[8], x2[8], o1[8], o2[8]; unpack8(*(const u32x4*)(base + i0), x1); unpack8(*(const u32x4*)(base + 64 + i0), x2);
        const float sc = which ? 0.08838834764831845f : 1.0f;
#pragma unroll
        for (int e = 0; e < 8; ++e) { const float cs = COS[t * 64 + i0 + e], sn = SIN[t * 64 + i0 + e]; o1[e] = (x1[e] * cs - x2[e] * sn) * sc; o2[e] = (x2[e] * cs + x1[e] * sn) * sc; }
        *(u32x4*)(base + i0) = pack8(o1); *(u32x4*)(base + 64 + i0) = pack8(o2);
    }
}

DI float ret_lg(int h) { return logf(1.0f - exp2f(-5.0f - (float)h)); }

DI void phase_local(Ctx& C) {
    LAS float* lf = (LAS float*)C.lds; LAS float* a = lf + 128; LAS float* ws = a + 128; LAS float* red = ws + 128;
    const float* IFG = (const float*)(C.ws + WS_IFG);
    bf16* CLOC = (bf16*)(C.ws + WS_CLOC);
    float* NLOC = (float*)(C.ws + WS_SMALL + SM_NLOC); float* MLOC = (float*)(C.ws + WS_SMALL + SM_MLOC); float* ACH = (float*)(C.ws + WS_SMALL + SM_ACH);
    const int t = C.tid;
    for (int u = C.bid; u < 1024; u += C.G) {
        const int mixer = u >> 9, bh = (u >> 5) & 15, ch = u & 31, b = bh >> 2, h = bh & 3, t0 = b * SEQ + ch * CH;
        const bf16 *Kp, *Vp; int ldk;
        if (mixer == 0) {
            if (t < 128) lf[t] = logsigmoidf_(IFG[(size_t)(t0 + t) * 8 + 4 + h]);
            __syncthreads();
            if (t < 128) { float s = 0.f; for (int j = 0; j <= t; ++j) s += lf[j]; a[t] = s; }
            __syncthreads();
            const float A = a[127];
            if (t < 128) ws[t] = A - a[t] + IFG[(size_t)(t0 + t) * 8 + h];
            __syncthreads();
            float mloc = -3.0e38f; for (int j = 0; j < 128; ++j) mloc = fmaxf(mloc, ws[j]);
            __syncthreads();
            if (t < 128) ws[t] = __expf(ws[t] - mloc);
            if (t == 0) { MLOC[bh * 32 + ch] = mloc; ACH[bh * 32 + ch] = A; }
            __syncthreads();
            Kp = (const bf16*)(C.ws + WS_QC) + (size_t)t0 * D + 512 + h * 128; ldk = D;
            Vp = (const bf16*)(C.ws + WS_MLV) + (size_t)t0 * D + h * 256;
        } else {
            const float lg = ret_lg(h);
            if (t < 128) ws[t] = __expf(lg * (float)(127 - t));
            __syncthreads();
            Kp = (const bf16*)(C.ws + WS_RETK) + (size_t)t0 * 512 + h * 128; ldk = 512;
            Vp = (const bf16*)(C.ws + WS_RETV) + (size_t)t0 * D + h * 256;
        }
        const int kh = t >> 8, v = t & 255;
        float acc[64];
#pragma unroll
        for (int i = 0; i < 64; ++i) acc[i] = 0.f;
        for (int s = 0; s < 128; ++s) {
            const float vv = ws[s] * bf2f(Vp[(size_t)s * D + v]);
            const bf16* kr = Kp + (size_t)s * ldk + kh * 64;
#pragma unroll
            for (int i8 = 0; i8 < 8; ++i8) { float f[8]; unpack8(*(const u32x4*)(kr + i8 * 8), f);
#pragma unroll
                for (int e = 0; e < 8; ++e) acc[i8 * 8 + e] += f[e] * vv; }
        }
        bf16* cl = CLOC + ((size_t)(mixer * 16 + bh) * 32 + ch) * 32768;
#pragma unroll
        for (int i = 0; i < 64; ++i) cl[(size_t)(kh * 64 + i) * 256 + v] = (bf16)f2bf(acc[i]);
        if (mixer == 0 && t < 128) { float s = 0.f; for (int j = 0; j < 128; ++j) s += ws[j] * bf2f(Kp[(size_t)j * ldk + t]); NLOC[(bh * 32 + ch) * 128 + t] = s; }
        __syncthreads();
    }
    (void)red;
}

DI void phase_scan(Ctx& C) {
    const bf16* CLOC = (const bf16*)(C.ws + WS_CLOC); bf16* CPREV = (bf16*)(C.ws + WS_CPREV);
    const float* NLOC = (const float*)(C.ws + WS_SMALL + SM_NLOC); float* NPREV = (float*)(C.ws + WS_SMALL + SM_NPREV);
    const float* MLOC = (const float*)(C.ws + WS_SMALL + SM_MLOC); const float* ACH = (const float*)(C.ws + WS_SMALL + SM_ACH); float* MPREV = (float*)(C.ws + WS_SMALL + SM_MPREV);
    for (int idx = C.bid * NTHR + C.tid; idx < 32 * 4096; idx += C.G * NTHR) {
        const int seq = idx >> 12, e8 = idx & 4095;
        float st[8];
#pragma unroll
        for (int e = 0; e < 8; ++e) st[e] = 0.f;
        if (seq < 16) {
            float m_st = 0.f; float nst[8];
#pragma unroll
            for (int e = 0; e < 8; ++e) nst[e] = 0.f;
            for (int ch = 0; ch < 32; ++ch) {
                const size_t o = ((size_t)seq * 32 + ch) * 32768 + (size_t)e8 * 8;
                *(u32x4*)(CPREV + o) = pack8(st);
                if (e8 < 16) { *(f32x4*)(NPREV + (seq * 32 + ch) * 128 + e8 * 8) = (f32x4){nst[0], nst[1], nst[2], nst[3]}; *(f32x4*)(NPREV + (seq * 32 + ch) * 128 + e8 * 8 + 4) = (f32x4){nst[4], nst[5], nst[6], nst[7]}; }
                if (e8 == 0) MPREV[seq * 32 + ch] = m_st;
                const float A = ACH[seq * 32 + ch], ml = MLOC[seq * 32 + ch];
                const float m_new = fmaxf(A + m_st, ml), sp = __expf(A + m_st - m_new), sl = __expf(ml - m_new);
                float f[8]; unpack8(*(const u32x4*)(CLOC + o), f);
#pragma unroll
                for (int e = 0; e < 8; ++e) st[e] = sp * st[e] + sl * f[e];
                if (e8 < 16) { const float* nl = NLOC + (seq * 32 + ch) * 128 + e8 * 8;
#pragma unroll
                    for (int e = 0; e < 8; ++e) nst[e] = sp * nst[e] + sl * nl[e]; }
                m_st = m_new;
            }
        } else {
            const float g = __expf(ret_lg(seq & 3) * 128.0f);
            for (int ch = 0; ch < 32; ++ch) {
                const size_t o = ((size_t)seq * 32 + ch) * 32768 + (size_t)e8 * 8;
                *(u32x4*)(CPREV + o) = pack8(st);
                float f[8]; unpack8(*(const u32x4*)(CLOC + o), f);
#pragma unroll
                for (int e = 0; e < 8; ++e) st[e] = g * st[e] + f[e];
            }
        }
    }
}

DI void phase_out(Ctx& C) {
    LAS float* av = (LAS float*)C.lds;
    LAS float* bv = av + 128;
    LAS float* mt = bv + 128;
    LAS float* isc = mt + 128;
    LAS float* den = isc + 128;
    LAS float* rs = den + 128;
    LAS float* P = rs + 1024;
    LAS float* Qs = P + 128 * 129;
    const float* IFG = (const float*)(C.ws + WS_IFG);
    const bf16* CPREV = (const bf16*)(C.ws + WS_CPREV);
    const float* NPREV = (const float*)(C.ws + WS_SMALL + SM_NPREV); const float* MPREV = (const float*)(C.ws + WS_SMALL + SM_MPREV);
    const int t = C.tid;
    for (int u = C.bid; u < 1024; u += C.G) {
        const int mixer = u >> 9, bh = (u >> 5) & 15, ch = u & 31, b = bh >> 2, h = bh & 3, t0 = b * SEQ + ch * CH;
        const bf16 *Qp, *Kp, *Vp; int ldq; const bf16* cp = CPREV + ((size_t)(mixer * 16 + bh) * 32 + ch) * 32768;
        float lg = 0.f;
        if (mixer == 0) {
            Qp = (const bf16*)(C.ws + WS_QC) + (size_t)t0 * D + h * 128; Kp = Qp + 512; ldq = D;
            Vp = (const bf16*)(C.ws + WS_MLV) + (size_t)t0 * D + h * 256;
            if (t < 128) mt[t] = logsigmoidf_(IFG[(size_t)(t0 + t) * 8 + 4 + h]);
            __syncthreads();
            if (t < 128) { float s = 0.f; for (int j = 0; j <= t; ++j) s += mt[j]; av[t] = s; bv[t] = IFG[(size_t)(t0 + t) * 8 + h] - s; }
            __syncthreads();
            if (t < 128) { float cm = -3.0e38f; for (int j = 0; j <= t; ++j) cm = fmaxf(cm, bv[j]);
                const float il = av[t] + MPREV[bh * 32 + ch], m = fmaxf(il, av[t] + cm); isc[t] = __expf(il - m); mt[t] = m; }
        } else {
            lg = ret_lg(h);
            Qp = (const bf16*)(C.ws + WS_RETQ) + (size_t)t0 * 512 + h * 128; Kp = (const bf16*)(C.ws + WS_RETK) + (size_t)t0 * 512 + h * 128; ldq = 512;
            Vp = (const bf16*)(C.ws + WS_RETV) + (size_t)t0 * D + h * 256;
            if (t < 128) isc[t] = __expf(lg * (float)(t + 1));
        }
        for (int e = t; e < 128 * 16; e += NTHR) { const int j = e >> 4, k8 = e & 15; float f[8]; unpack8(*(const u32x4*)(Qp + (size_t)j * ldq + k8 * 8), f);
#pragma unroll
            for (int i = 0; i < 8; ++i) Qs[j * 129 + k8 * 8 + i] = f[i]; }
        __syncthreads();
        for (int e = t; e < 128 * 128; e += NTHR) {
            const int j = e >> 7, s = e & 127; float p = 0.f;
            if (s <= j) {
                float d = 0.f;
#pragma unroll 4
                for (int k8 = 0; k8 < 16; ++k8) { float fk[8]; unpack8(*(const u32x4*)(Kp + (size_t)s * ldq + k8 * 8), fk);
#pragma unroll
                    for (int i = 0; i < 8; ++i) d += Qs[j * 129 + k8 * 8 + i] * fk[i]; }
                p = d * (mixer == 0 ? __expf(av[j] + bv[s] - mt[j]) : __expf(lg * (float)(j - s)));
            }
            P[j * 129 + s] = p;
        }
        __syncthreads();
        if (mixer == 0 && t < 128) { float s = 0.f; for (int i = 0; i < 128; ++i) s += P[t * 129 + i];
            float qn = 0.f; const float* np = NPREV + (bh * 32 + ch) * 128; for (int k = 0; k < 128; ++k) qn += Qs[t * 129 + k] * np[k];
            den[t] = fmaxf(fabsf(s + isc[t] * qn), __expf(-mt[t])); }
        __syncthreads();
        const float gain = (mixer == 0 ? C.ml_norm_g : C.ret_norm_g)[h * 256 + (t & 255)];
#pragma unroll 1
        for (int pass = 0; pass < 2; ++pass) {
            const int jh = t >> 8, v = t & 255, r0 = (pass * 2 + jh) * 32;
            float acc[32];
#pragma unroll
            for (int i = 0; i < 32; ++i) acc[i] = 0.f;
            const LAS float* qb = Qs + r0 * 129; const LAS float* pb = P + r0 * 129;
            for (int k = 0; k < 128; ++k) {
                const float cv = bf2f(cp[(size_t)k * 256 + v]);
#pragma unroll
                for (int i = 0; i < 32; ++i) acc[i] += qb[i * 129 + k] * cv;
            }
#pragma unroll
            for (int i = 0; i < 32; ++i) acc[i] *= isc[r0 + i];
            for (int s = 0; s < 128; ++s) {
                const float vv = bf2f(Vp[(size_t)s * D + v]);
#pragma unroll
                for (int i = 0; i < 32; ++i) acc[i] += pb[i * 129 + s] * vv;
            }
            if (mixer == 0) {
#pragma unroll
                for (int i = 0; i < 32; ++i) acc[i] = acc[i] / den[r0 + i];
            }
            const int wq = C.wave & 3;
#pragma unroll
            for (int i = 0; i < 32; ++i) { const float s1 = wave_sum(acc[i]); if (C.lane == 0) rs[wq * 128 + r0 + i] = s1; }
            __syncthreads();
#pragma unroll
            for (int i = 0; i < 32; ++i) { const int r = r0 + i; acc[i] -= (rs[r] + rs[128 + r] + rs[256 + r] + rs[384 + r]) * (1.0f / 256.0f); }
#pragma unroll
            for (int i = 0; i < 32; ++i) { const float s2 = wave_sum(acc[i] * acc[i]); if (C.lane == 0) rs[512 + wq * 128 + r0 + i] = s2; }
            __syncthreads();
            const bf16* gate = (const bf16*)(C.ws + (mixer == 0 ? WS_MLO : WS_RETG)) + (size_t)t0 * D + h * 256 + v;
            bf16* outp = (bf16*)(C.ws + (mixer == 0 ? WS_HML : WS_HRET)) + (size_t)t0 * D + h * 256 + v;
#pragma unroll
            for (int i = 0; i < 32; ++i) { const int r = r0 + i;
                const float var = (rs[512 + r] + rs[512 + 128 + r] + rs[512 + 256 + r] + rs[512 + 384 + r]) * (1.0f / 256.0f);
                const float y = acc[i] * (1.0f / sqrtf(var + EPS)) * gain * bf2f(gate[(size_t)r * D]);
                outp[(size_t)r * D] = (bf16)f2bf(y); }
            __syncthreads();
        }
    }
}

struct BF_plain { const float* w; DI const float* ptr(int, int tn) const { return w + tn * 128; } };
struct EF_f32 { float* dst; DI void put(int tm, int tn, int r, int c, const float (&v)[4]) const { *(f32x4*)(dst + (size_t)(tm * 128 + r) * D + tn * 128 + c) = (f32x4){v[0], v[1], v[2], v[3]}; } };
struct EF_merge { const float* t1; const bf16* g1; const bf16* g2; bf16* y;
    DI void put(int tm, int tn, int r, int c, const float (&v)[4]) const {
        const size_t o = (size_t)(tm * 128 + r) * D + tn * 128 + c; const f32x4 a = *(const f32x4*)(t1 + o);
        const u32x2 w1 = *(const u32x2*)(g1 + o), w2 = *(const u32x2*)(g2 + o);
        const float o0 = __uint_as_float(w1.x << 16) * a.x + __uint_as_float(w2.x << 16) * v[0], o1 = __uint_as_float(w1.x & 0xffff0000u) * a.y + __uint_as_float(w2.x & 0xffff0000u) * v[1];
        const float o2 = __uint_as_float(w1.y << 16) * a.z + __uint_as_float(w2.y << 16) * v[2], o3 = __uint_as_float(w1.y & 0xffff0000u) * a.w + __uint_as_float(w2.y & 0xffff0000u) * v[3];
        u32x2 w; w.x = pk2(o0, o1); w.y = pk2(o2, o3); *(u32x2*)(y + o) = w; } };
DI void phase_branch(Ctx& C) {
    AF_rows a1{(const bf16*)(C.ws + WS_HML), D}, a2{(const bf16*)(C.ws + WS_HRET), D}; BF_plain b1{C.w_bml}, b2{C.w_bret};
    EF_f32 e1{(float*)(C.ws + WS_TMP)}; EF_merge e2{(const float*)(C.ws + WS_TMP), (const bf16*)(C.ws + WS_GML), (const bf16*)(C.ws + WS_GRET), (bf16*)(C.ws + WS_H1)};
    const int nt = (T / 128) * 8;
    for (int u = C.bid; u < nt; u += C.G) { naive_gemm_tile(C, u / 8, u % 8, D, D, a1, b1, e1); naive_gemm_tile(C, u / 8, u % 8, D, D, a2, b2, e2); }
}
struct EF_resid { const float* x; const float* mod; float* x1;
    DI void put(int tm, int tn, int r, int c, const float (&v)[4]) const {
        const int row = tm * 128 + r, col = tn * 128 + c, b = row / SEQ; const size_t o = (size_t)row * D + col;
        const f32x4 xv = *(const f32x4*)(x + o), g = *(const f32x4*)(mod + b * 6144 + 2048 + col);
        *(f32x4*)(x1 + o) = xv + g * (f32x4){v[0], v[1], v[2], v[3]}; } };
DI void phase_outproj(Ctx& C) {
    AF_rows a{(const bf16*)(C.ws + WS_H1), D}; BF_plain b{C.w_out}; EF_resid e{C.x, (const float*)(C.ws + WS_MOD), (float*)(C.ws + WS_X1)};
    const int nt = (T / 128) * 8;
    for (int u = C.bid; u < nt; u += C.G) naive_gemm_tile(C, u / 8, u % 8, D, D, a, b, e);
}

DI void phase_norm2_route(Ctx& C) {
    LAS float* wr = (LAS float*)C.lds;
    LAS float* lg = wr + 32768;
    for (int i = C.tid; i < 32768 / 4; i += NTHR) *(LAS f32x4*)(wr + i * 4) = *(const f32x4*)(C.w_router + i * 4);
    __syncthreads();
    const float* mod = (const float*)(C.ws + WS_MOD); const float* X1 = (const float*)(C.ws + WS_X1);
    bf16* H2 = (bf16*)(C.ws + WS_H1);
    int* TOPI = (int*)(C.ws + WS_ROUTE + RT_TOPI); float* TOPW = (float*)(C.ws + WS_ROUTE + RT_TOPW); int* RANK = (int*)(C.ws + WS_ROUTE + RT_RANK);
    unsigned* CNT = (unsigned*)(C.ws + WS_CTL) + CW_CNT;
    const int lane = C.lane, gw = C.bid * NWAVES + C.wave, NGW = C.G * NWAVES;
    for (int m = gw; m < T; m += NGW) {
        const int b = m / SEQ;
        const f32x4* xr = (const f32x4*)(X1 + (size_t)m * D) + lane;
        f32x4 v[4]; float ss = 0.f;
#pragma unroll
        for (int j = 0; j < 4; ++j) { v[j] = xr[64 * j]; ss += (v[j].x * v[j].x + v[j].y * v[j].y) + (v[j].z * v[j].z + v[j].w * v[j].w); }
        const float rstd = 1.0f / sqrtf(wave_sum(ss) * (1.0f / D) + EPS);
        float acc[32];
#pragma unroll
        for (int e = 0; e < 32; ++e) acc[e] = 0.f;
        u32x2* o8 = (u32x2*)(H2 + (size_t)m * D) + lane;
#pragma unroll
        for (int j = 0; j < 4; ++j) {
            const int col = 4 * (lane + 64 * j);
            const f32x4 g = *(const f32x4*)(C.norm_ffn_g + col), sh = *(const f32x4*)(mod + b * 6144 + 3072 + col), sc = *(const f32x4*)(mod + b * 6144 + 4096 + col);
            const f32x4 h = (v[j] * rstd * g) * (sc + 1.0f) + sh;
            u32x2 w; w.x = pk2(h.x, h.y); w.y = pk2(h.z, h.w); o8[64 * j] = w;
            const float hh[4] = {h.x, h.y, h.z, h.w};
#pragma unroll
            for (int i = 0; i < 4; ++i) {
                const LAS f32x4* wp = (const LAS f32x4*)(wr + (col + i) * 32);
#pragma unroll
                for (int e4 = 0; e4 < 8; ++e4) { const f32x4 w4 = wp[e4]; acc[e4 * 4 + 0] += hh[i] * w4.x; acc[e4 * 4 + 1] += hh[i] * w4.y; acc[e4 * 4 + 2] += hh[i] * w4.z; acc[e4 * 4 + 3] += hh[i] * w4.w; }
                asm volatile("" ::: "memory");
            }
        }
#pragma unroll
        for (int e = 0; e < 32; ++e) acc[e] = wave_sum(acc[e]);
        float l[32];
#pragma unroll
        for (int e = 0; e < 32; ++e) l[e] = acc[e] + C.b_router[e];
        float tv[4]; int ti[4];
#pragma unroll
        for (int k = 0; k < 4; ++k) {
            float bvv = -3.0e38f; int bi = 0;
#pragma unroll
            for (int e = 0; e < 32; ++e) { const bool take = l[e] > bvv; bvv = take ? l[e] : bvv; bi = take ? e : bi; }
            tv[k] = bvv; ti[k] = bi;
#pragma unroll
            for (int e = 0; e < 32; ++e) l[e] = (e == bi) ? -3.0e38f : l[e];
        }
        const float e1 = __expf(tv[1] - tv[0]), e2 = __expf(tv[2] - tv[0]), e3 = __expf(tv[3] - tv[0]), inv = 1.0f / (1.0f + e1 + e2 + e3);
        if (lane < 4) {
            const int e = lane == 0 ? ti[0] : lane == 1 ? ti[1] : lane == 2 ? ti[2] : ti[3];
            const float w = (lane == 0 ? 1.0f : lane == 1 ? e1 : lane == 2 ? e2 : e3) * inv;
            TOPI[m * 4 + lane] = e; TOPW[m * 4 + lane] = w; RANK[m * 4 + lane] = (int)atomicAdd(CNT + e, 1u);
        }
    }
    (void)lg;
    int* SLOTTOK = (int*)(C.ws + WS_ROUTE + RT_SLOTTOK); float* SLOTW = (float*)(C.ws + WS_ROUTE + RT_SLOTW);
    for (int i = C.bid * NTHR + C.tid; i < NSLOTS; i += C.G * NTHR) { SLOTTOK[i] = T; SLOTW[i] = 0.f; }
    if (C.bid == 0) for (int i = C.tid; i < D / 2; i += NTHR) ((unsigned*)(H2 + (size_t)T * D))[i] = 0u;
    __syncthreads();
}

DI void phase_slots(Ctx& C) {
    LAS int* pstart = (LAS int*)C.lds;
    const unsigned* CNT = (const unsigned*)(C.ws + WS_CTL) + CW_CNT;
    unsigned* ctl = (unsigned*)(C.ws + WS_CTL);
    if (C.tid == 0) {
        int nb = 0;
        for (int e = 0; e < NE; ++e) { pstart[e] = nb * 256; const int bl = ((int)CNT[e] + 255) >> 8;
            if (C.bid == 0) for (int i = 0; i < bl; ++i) ctl[CW_BLKE + nb + i] = (unsigned)e;
            nb += bl; }
        if (C.bid == 0) ctl[CW_NBLK] = (unsigned)nb;
    }
    __syncthreads();
    const int* TOPI = (const int*)(C.ws + WS_ROUTE + RT_TOPI); const float* TOPW = (const float*)(C.ws + WS_ROUTE + RT_TOPW); const int* RANK = (const int*)(C.ws + WS_ROUTE + RT_RANK);
    int* ASLOT = (int*)(C.ws + WS_ROUTE + RT_ASLOT); int* SLOTTOK = (int*)(C.ws + WS_ROUTE + RT_SLOTTOK); float* SLOTW = (float*)(C.ws + WS_ROUTE + RT_SLOTW);
    for (int i = C.bid * NTHR + C.tid; i < T * 4; i += C.G * NTHR) {
        const int slot = pstart[TOPI[i]] + RANK[i];
        ASLOT[i] = slot; SLOTTOK[slot] = i >> 2; SLOTW[slot] = TOPW[i];
    }
    __syncthreads();
}

struct AF_gather { const bf16* base; const int* slottok; DI const bf16* row(int tm, int r) const { return base + (size_t)slottok[tm * 128 + r] * D; } };
struct BF_expert { const float* w; const unsigned* blke; size_t estride; DI const float* ptr(int tm, int tn) const { return w + (size_t)blke[tm >> 1] * estride + tn * 128; } };
struct EF_swiglu { const float* bias; const unsigned* blke; bf16* act;
    DI void put(int tm, int tn, int r, int c, const float (&v)[4]) const {
        const int e = (int)blke[tm >> 1]; const float* bp = bias + (size_t)e * 2048 + tn * 128 + c;
        float o[2];
#pragma unroll
        for (int j = 0; j < 2; ++j) { const float xg = fminf(v[2 * j] + bp[2 * j], 7.0f), xl = fminf(fmaxf(v[2 * j + 1] + bp[2 * j + 1], -7.0f), 7.0f); o[j] = xg * sigmoidf_(1.702f * xg) * (xl + 1.0f); }
        *(unsigned*)(act + (size_t)(tm * 128 + r) * D + (tn * 128 + c) / 2) = pk2(o[0], o[1]); } };
DI void phase_gateup(Ctx& C) {
    const unsigned* ctl = (const unsigned*)(C.ws + WS_CTL); const int nblk = (int)ctl[CW_NBLK];
    AF_gather a{(const bf16*)(C.ws + WS_H1), (const int*)(C.ws + WS_ROUTE + RT_SLOTTOK)}; BF_expert b{C.w_gu, ctl + CW_BLKE, (size_t)D * 2048};
    EF_swiglu e{C.b_gu, ctl + CW_BLKE, (bf16*)(C.ws + WS_ACT)};
    const int nt = nblk * 2 * 16;
    for (int u = C.bid; u < nt; u += C.G) naive_gemm_tile(C, u / 16, u % 16, D, 2048, a, b, e);
}
struct EF_down { const float* bias; const unsigned* blke; const float* slotw; bf16* ys;
    DI void put(int tm, int tn, int r, int c, const float (&v)[4]) const {
        const int e = (int)blke[tm >> 1], slot = tm * 128 + r; const float w = slotw[slot]; const float* bp = bias + (size_t)e * D + tn * 128 + c;
        u32x2 o; o.x = pk2((v[0] + bp[0]) * w, (v[1] + bp[1]) * w); o.y = pk2((v[2] + bp[2]) * w, (v[3] + bp[3]) * w);
        *(u32x2*)(ys + (size_t)slot * D + tn * 128 + c) = o; } };
DI void phase_down(Ctx& C) {
    const unsigned* ctl = (const unsigned*)(C.ws + WS_CTL); const int nblk = (int)ctl[CW_NBLK];
    AF_rows a{(const bf16*)(C.ws + WS_ACT), D}; BF_expert b{C.w_dn, ctl + CW_BLKE, (size_t)D * D};
    EF_down e{C.b_dn, ctl + CW_BLKE, (const float*)(C.ws + WS_ROUTE + RT_SLOTW), (bf16*)(C.ws + WS_YS)};
    const int nt = nblk * 2 * 8;
    for (int u = C.bid; u < nt; u += C.G) naive_gemm_tile(C, u / 8, u % 8, D, D, a, b, e);
}
DI void phase_final(Ctx& C) {
    const float* mod = (const float*)(C.ws + WS_MOD); const float* X1 = (const float*)(C.ws + WS_X1); const bf16* YS = (const bf16*)(C.ws + WS_YS);
    const int* ASLOT = (const int*)(C.ws + WS_ROUTE + RT_ASLOT);
    const int lane = C.lane, gw = C.bid * NWAVES + C.wave, NGW = C.G * NWAVES;
    for (int m = gw; m < T; m += NGW) {
        const int b = m / SEQ;
        const int s0 = ASLOT[m * 4 + 0], s1 = ASLOT[m * 4 + 1], s2 = ASLOT[m * 4 + 2], s3 = ASLOT[m * 4 + 3];
        f32x4 v[4]; float ss = 0.f;
#pragma unroll
        for (int j = 0; j < 4; ++j) {
            const int col = 4 * (lane + 64 * j);
            f32x4 y = (f32x4){0.f, 0.f, 0.f, 0.f};
            const int sl[4] = {s0, s1, s2, s3};
#pragma unroll
            for (int k = 0; k < 4; ++k) { const u32x2 w = *(const u32x2*)(YS + (size_t)sl[k] * D + col);
                y += (f32x4){__uint_as_float(w.x << 16), __uint_as_float(w.x & 0xffff0000u), __uint_as_float(w.y << 16), __uint_as_float(w.y & 0xffff0000u)}; }
            const f32x4 g = *(const f32x4*)(mod + b * 6144 + 5120 + col);
            v[j] = *(const f32x4*)(X1 + (size_t)m * D + col) + g * y;
            ss += (v[j].x * v[j].x + v[j].y * v[j].y) + (v[j].z * v[j].z + v[j].w * v[j].w);
        }
        const float rstd = 1.0f / sqrtf(wave_sum(ss) * (1.0f / D) + EPS);
#pragma unroll
        for (int j = 0; j < 4; ++j) { const int col = 4 * (lane + 64 * j); *(f32x4*)(C.out + (size_t)m * D + col) = v[j] * rstd * *(const f32x4*)(C.norm_final_g + col); }
    }
}

constexpr int NPHASES = 14;
__global__ void __launch_bounds__(NTHR, 2) fwd(Args a) {
    extern __shared__ __attribute__((aligned(16))) unsigned char lds[];
    Ctx C;
    C.lds = (LAS unsigned char*)lds; C.tid = threadIdx.x; C.lane = C.tid & 63; C.wave = __builtin_amdgcn_readfirstlane(C.tid >> 6); C.G = gridDim.x; C.bid = blockIdx.x;
    C.x = (const float*)a.in[0]; C.c = (const float*)a.in[1]; C.positions = (const int*)a.in[2]; C.w_ada = (const float*)a.in[3]; C.b_ada = (const float*)a.in[4];
    C.norm_mix_g = (const float*)a.in[5]; C.w_in = (const float*)a.in[6]; C.conv_w = (const float*)a.in[7]; C.conv_b = (const float*)a.in[8]; C.b_if = (const float*)a.in[9];
    C.ml_norm_g = (const float*)a.in[10]; C.ret_norm_g = (const float*)a.in[11]; C.w_bml = (const float*)a.in[12]; C.w_bret = (const float*)a.in[13]; C.w_out = (const float*)a.in[14];
    C.norm_ffn_g = (const float*)a.in[15]; C.w_router = (const float*)a.in[16]; C.b_router = (const float*)a.in[17]; C.w_gu = (const float*)a.in[18]; C.b_gu = (const float*)a.in[19];
    C.w_dn = (const float*)a.in[20]; C.b_dn = (const float*)a.in[21]; C.norm_final_g = (const float*)a.in[22];
    C.out = a.out; C.ws = a.ws;
    const int lo = a.ph_lo, hi = a.ph_hi;
#ifdef ONLY_PHASE
#define IN(k) ((k) == ONLY_PHASE && lo <= (k) && (k) < hi)
#else
#define IN(k) (lo <= (k) && (k) < hi)
#endif
    if (IN(0)) phase_mod(C);
    if (IN(1)) phase_norm1(C);
    if (IN(2)) phase_inproj(C);
    if (IN(3)) phase_conv_rope(C);
    if (IN(4)) phase_local(C);
    if (IN(5)) phase_scan(C);
    if (IN(6)) phase_out(C);
    if (IN(7)) phase_branch(C);
    if (IN(8)) phase_outproj(C);
    if (IN(9)) phase_norm2_route(C);
    if (IN(10)) phase_slots(C);
    if (IN(11)) phase_gateup(C);
    if (IN(12)) phase_down(C);
    if (IN(13)) phase_final(C);
#undef IN
}

extern "C" void kernel_launch(void* const* d_in, const int* in_sizes, int n_in, void* d_out, int out_size, void* d_ws, size_t ws_size, hipStream_t stream) {
    static int grid = 0;
    if (grid == 0) {
        if (n_in != 23 || out_size != T * D || ws_size < WS_END) { fprintf(stderr, "kernel_launch: unexpected shapes: n_in %d out %d ws %zu (need %zu)\n", n_in, out_size, ws_size, (size_t)WS_END); grid = -1; return; }
        int dev = 0, cus = 0;
        if (hipGetDevice(&dev) != hipSuccess || hipDeviceGetAttribute(&cus, hipDeviceAttributeMultiprocessorCount, dev) != hipSuccess) { grid = -1; return; }
        if (hipFuncSetAttribute((const void*)fwd, hipFuncAttributeMaxDynamicSharedMemorySize, LDS_BYTES) != hipSuccess) { fprintf(stderr, "kernel_launch: hipFuncSetAttribute failed\n"); grid = -1; return; }
        grid = cus > 0 ? cus : 256;
    }
    if (grid < 0) return;
    Args a{};
    for (int i = 0; i < 23; ++i) a.in[i] = d_in[i];
    a.out = (float*)d_out; a.ws = (unsigned char*)d_ws;
    for (int p = 0; p < NPHASES; ++p) {
        a.ph_lo = p; a.ph_hi = p + 1;
        hipLaunchKernelGGL(fwd, dim3(grid), dim3(NTHR), LDS_BYTES, stream, a);
    }
}
```

```cpp
#include <hip/hip_runtime.h>
#include <cstdio>
#include <cstdint>

#define DI __device__ __forceinline__
#define LAS __attribute__((address_space(3)))
typedef unsigned short bf16;
typedef float f32x4 __attribute__((ext_vector_type(4)));
typedef unsigned u32x4 __attribute__((ext_vector_type(4)));
typedef unsigned u32x2 __attribute__((ext_vector_type(2)));

constexpr int D = 1024, NB = 4, SEQ = 4096, T = NB * SEQ;
constexpr int DIN = 8200, CH = 128, NCH = SEQ / CH;
constexpr int NE = 32, TOPK = 4, NSLOT_BLK = 288, NSLOTS = NSLOT_BLK * 256;
constexpr float EPS = 1e-5f;
constexpr int NTHR = 512, NWAVES = 8;

constexpr size_t MiB = 1u << 20;
constexpr size_t WS_CTL   = 0;
constexpr size_t WS_MOD   = 1 * MiB;
constexpr size_t WS_IFG   = 2 * MiB;
constexpr size_t WS_COS   = 3 * MiB;
constexpr size_t WS_SIN   = 7 * MiB;
constexpr size_t WS_ROUTE = 11 * MiB;
constexpr size_t WS_SMALL = 14 * MiB;
constexpr size_t WS_H1    = 16 * MiB;
constexpr size_t WS_X1    = 50 * MiB;
constexpr size_t WS_TMP   = 114 * MiB;
constexpr size_t WS_B     = 178 * MiB;
constexpr size_t WS_QKRAW = WS_B;
constexpr size_t WS_QC    = WS_B + 32 * MiB;
constexpr size_t WS_MLV   = WS_B + 64 * MiB;
constexpr size_t WS_MLO   = WS_B + 96 * MiB;
constexpr size_t WS_RETQ  = WS_B + 128 * MiB;
constexpr size_t WS_RETK  = WS_B + 144 * MiB;
constexpr size_t WS_RETV  = WS_B + 160 * MiB;
constexpr size_t WS_RETG  = WS_B + 192 * MiB;
constexpr size_t WS_GML   = WS_B + 224 * MiB;
constexpr size_t WS_GRET  = WS_B + 256 * MiB;
constexpr size_t WS_CLOC  = WS_B + 288 * MiB;
constexpr size_t WS_CPREV = WS_B + 352 * MiB;
constexpr size_t WS_HML   = WS_B + 416 * MiB;
constexpr size_t WS_HRET  = WS_B + 448 * MiB;
constexpr size_t WS_B_END = WS_B + 480 * MiB;
constexpr size_t WS_ACT   = WS_B;
constexpr size_t WS_YS    = WS_B + 160 * MiB;
constexpr size_t WS_END   = WS_B_END;
static_assert(WS_YS + (size_t)NSLOTS * 2048 <= WS_B_END, "ws map");

constexpr int CW_CNT = 64;
constexpr int CW_NBLK = 128;
constexpr int CW_BLKE = 192;
constexpr int CW_BAR = 4096;
constexpr size_t CTL_ZERO_BYTES = 65536;
constexpr size_t RT_TOPI = 0;
constexpr size_t RT_TOPW = 256 * 1024;
constexpr size_t RT_RANK = 512 * 1024;
constexpr size_t RT_ASLOT = 768 * 1024;
constexpr size_t RT_SLOTTOK = 1024 * 1024;
constexpr size_t RT_SLOTW = 1024 * 1024 + 512 * 1024;
constexpr size_t SM_NLOC = 0;
constexpr size_t SM_NPREV = 256 * 1024;
constexpr size_t SM_MLOC = 512 * 1024;
constexpr size_t SM_ACH = 512 * 1024 + 4096;
constexpr size_t SM_MPREV = 512 * 1024 + 8192;

constexpr int LDS_BYTES = 147456;

DI float bf2f(bf16 v) { return __uint_as_float(((unsigned)v) << 16); }
DI unsigned f2bf(float f) { unsigned u = __float_as_uint(f); return (u + 0x7fffu + ((u >> 16) & 1u)) >> 16; }
DI unsigned pk2(float lo, float hi) { return f2bf(lo) | (f2bf(hi) << 16); }
DI float wave_sum(float v) {
#pragma unroll
    for (int o = 1; o < 64; o <<= 1) v += __shfl_xor(v, o);
    return v;
}
DI float sigmoidf_(float x) { return 1.0f / (1.0f + __expf(-x)); }
DI float siluf_(float x) { return x / (1.0f + __expf(-x)); }
DI float logsigmoidf_(float x) { return fminf(x, 0.f) - log1pf(__expf(-fabsf(x))); }
DI void unpack8(const u32x4 w, float (&f)[8]) {
    f[0] = __uint_as_float(w.x << 16); f[1] = __uint_as_float(w.x & 0xffff0000u);
    f[2] = __uint_as_float(w.y << 16); f[3] = __uint_as_float(w.y & 0xffff0000u);
    f[4] = __uint_as_float(w.z << 16); f[5] = __uint_as_float(w.z & 0xffff0000u);
    f[6] = __uint_as_float(w.w << 16); f[7] = __uint_as_float(w.w & 0xffff0000u);
}
DI u32x4 pack8(const float (&f)[8]) { u32x4 w; w.x = pk2(f[0], f[1]); w.y = pk2(f[2], f[3]); w.z = pk2(f[4], f[5]); w.w = pk2(f[6], f[7]); return w; }

struct Args { const void* in[23]; float* out; unsigned char* ws; int ph_lo, ph_hi; };

struct Ctx {
    LAS unsigned char* lds;
    int tid, lane, wave, G, bid;
    const float *x, *c, *w_ada, *b_ada, *norm_mix_g, *w_in, *conv_w, *conv_b, *b_if, *ml_norm_g, *ret_norm_g;
    const float *w_bml, *w_bret, *w_out, *norm_ffn_g, *w_router, *b_router, *w_gu, *b_gu, *w_dn, *b_dn, *norm_final_g;
    const int* positions;
    float* out; unsigned char* ws;
};

template <class AF, class BF, class EF>
DI void naive_gemm_tile(Ctx& C, int tm, int tn, int K, int ldb, const AF& af, const BF& bf, const EF& ef) {
    LAS float* As = (LAS float*)C.lds;
    LAS float* Bs = As + 16 * 132;
    const int t = C.tid, ty = t >> 5, tx = t & 31;
    float acc[8][4];
#pragma unroll
    for (int i = 0; i < 8; ++i)
#pragma unroll
        for (int j = 0; j < 4; ++j) acc[i][j] = 0.f;
    const int ar = t >> 2, ak = (t & 3) * 4;
    const bf16* arow = af.row(tm, ar);
    const int bk = t >> 5, bn = (t & 31) * 4;
    const float* bbase = bf.ptr(tm, tn) + bn;
    for (int k0 = 0; k0 < K; k0 += 16) {
        const u32x2 av = *(const u32x2*)(arow + k0 + ak);
        const f32x4 bv = *(const f32x4*)(bbase + (size_t)(k0 + bk) * ldb);
        __syncthreads();
        As[(ak + 0) * 132 + ar] = __uint_as_float(av.x << 16); As[(ak + 1) * 132 + ar] = __uint_as_float(av.x & 0xffff0000u);
        As[(ak + 2) * 132 + ar] = __uint_as_float(av.y << 16); As[(ak + 3) * 132 + ar] = __uint_as_float(av.y & 0xffff0000u);
        *(LAS f32x4*)(Bs + bk * 132 + bn) = bv;
        __syncthreads();
#pragma unroll 4
        for (int kk = 0; kk < 16; ++kk) {
            const f32x4 a0 = *(const LAS f32x4*)(As + kk * 132 + ty * 8), a1 = *(const LAS f32x4*)(As + kk * 132 + ty * 8 + 4);
            const f32x4 b = *(const LAS f32x4*)(Bs + kk * 132 + tx * 4);
            const float a[8] = {a0.x, a0.y, a0.z, a0.w, a1.x, a1.y, a1.z, a1.w};
#pragma unroll
            for (int i = 0; i < 8; ++i) { acc[i][0] += a[i] * b.x; acc[i][1] += a[i] * b.y; acc[i][2] += a[i] * b.z; acc[i][3] += a[i] * b.w; }
        }
    }
#pragma unroll
    for (int i = 0; i < 8; ++i) { ef.put(tm, tn, ty * 8 + i, tx * 4, acc[i]); asm volatile("" ::: "memory"); }
    __syncthreads();
}

DI void phase_mod(Ctx& C) {
    LAS float* red = (LAS float*)C.lds;
    float* mod = (float*)(C.ws + WS_MOD);
    for (int g = C.bid; g < 256; g += C.G) {
        const int n0 = g * 24, t = C.tid;
        if (t < 504) {
            const int col = t % 24, kg = t / 24;
            float a0 = 0.f, a1 = 0.f, a2 = 0.f, a3 = 0.f;
            for (int k = kg; k < D; k += 21) {
                const float w = C.w_ada[(size_t)k * 6144 + n0 + col];
                a0 += siluf_(C.c[k]) * w; a1 += siluf_(C.c[D + k]) * w; a2 += siluf_(C.c[2 * D + k]) * w; a3 += siluf_(C.c[3 * D + k]) * w;
            }
            red[(kg * 24 + col) * 4 + 0] = a0; red[(kg * 24 + col) * 4 + 1] = a1; red[(kg * 24 + col) * 4 + 2] = a2; red[(kg * 24 + col) * 4 + 3] = a3;
        }
        __syncthreads();
        if (t < 96) {
            const int col = t % 24, b = t / 24; float s = 0.f;
            for (int kg = 0; kg < 21; ++kg) s += red[(kg * 24 + col) * 4 + b];
            mod[b * 6144 + n0 + col] = s + C.b_ada[n0 + col];
        }
        __syncthreads();
    }
}

DI void phase_norm1(Ctx& C) {
    const float* mod = (const float*)(C.ws + WS_MOD);
    bf16* H1 = (bf16*)(C.ws + WS_H1);
    float* IFG = (float*)(C.ws + WS_IFG);
    const int lane = C.lane, gw = C.bid * NWAVES + C.wave, NGW = C.G * NWAVES;
    float wif[4][4][8];
#pragma unroll
    for (int j = 0; j < 4; ++j)
#pragma unroll
        for (int i = 0; i < 4; ++i) {
            const float* wp = C.w_in + (size_t)(4 * (lane + 64 * j) + i) * DIN + 3072;
#pragma unroll
            for (int e = 0; e < 8; ++e) wif[j][i][e] = wp[e];
        }
    for (int m = gw; m < T; m += NGW) {
        const int b = m / SEQ;
        const f32x4* xr = (const f32x4*)(C.x + (size_t)m * D) + lane;
        f32x4 v[4]; float ss = 0.f;
#pragma unroll
        for (int j = 0; j < 4; ++j) { v[j] = xr[64 * j]; ss += (v[j].x * v[j].x + v[j].y * v[j].y) + (v[j].z * v[j].z + v[j].w * v[j].w); }
        const float rstd = 1.0f / sqrtf(wave_sum(ss) * (1.0f / D) + EPS);
        float p[8];
#pragma unroll
        for (int e = 0; e < 8; ++e) p[e] = 0.f;
        u32x2* o8 = (u32x2*)(H1 + (size_t)m * D) + lane;
#pragma unroll
        for (int j = 0; j < 4; ++j) {
            const int col = 4 * (lane + 64 * j);
            const f32x4 g = *(const f32x4*)(C.norm_mix_g + col), sh = *(const f32x4*)(mod + b * 6144 + col), sc = *(const f32x4*)(mod + b * 6144 + 1024 + col);
            f32x4 h = (v[j] * rstd * g) * (sc + 1.0f) + sh;
            u32x2 w; w.x = pk2(h.x, h.y); w.y = pk2(h.z, h.w); o8[64 * j] = w;
            const float hh[4] = {h.x, h.y, h.z, h.w};
#pragma unroll
            for (int i = 0; i < 4; ++i)
#pragma unroll
                for (int e = 0; e < 8; ++e) p[e] += hh[i] * wif[j][i][e];
        }
#pragma unroll
        for (int e = 0; e < 8; ++e) p[e] = wave_sum(p[e]);
        if (lane < 8) { float r = p[0];
#pragma unroll
            for (int e = 1; e < 8; ++e) r = (lane == e) ? p[e] : r;
            IFG[(size_t)m * 8 + lane] = r + C.b_if[lane]; }
    }
    float* COS = (float*)(C.ws + WS_COS); float* SIN = (float*)(C.ws + WS_SIN);
    for (int idx = C.bid * NTHR + C.tid; idx < T * 64; idx += C.G * NTHR) {
        const int t = idx >> 6, i = idx & 63;
        const float inv = (float)exp(-(double)i * (9.210340371976184 / 64.0));
        const double ang = (double)C.positions[t] * (double)inv;
        const double kq = rint(ang * 0.6366197723675814);
        double r = fma(-kq, 1.5707963267948966, ang); r = fma(-kq, 6.123233995736766e-17, r);
        const float rf = (float)r; const float s = sinf(rf), c = cosf(rf);
        const int q = ((int)kq) & 3;
        const float cs = (q == 0) ? c : (q == 1) ? -s : (q == 2) ? -c : s;
        const float sn = (q == 0) ? s : (q == 1) ? c : (q == 2) ? -s : -c;
        COS[idx] = cs; SIN[idx] = sn;
    }
    if (C.bid == 0 && C.tid < 32) ((unsigned*)(C.ws + WS_CTL))[CW_CNT + C.tid] = 0u;
}

struct AF_rows { const bf16* base; int ld; DI const bf16* row(int tm, int r) const { return base + (size_t)(tm * 128 + r) * ld; } };
struct BF_inproj { const float* w; DI const float* ptr(int, int tn) const { return w + (tn < 24 ? tn * 128 : tn * 128 + 8); } };
struct EF_inproj { unsigned char* ws;
    DI void put(int tm, int tn, int r, int c, const float (&v)[4]) const {
        const int row = tm * 128 + r; const int seg = tn >> 3;
        bf16* dst; int ld = 1024, col = (tn & 7) * 128 + c; int act = 0;
        switch (seg) {
            case 0: dst = (bf16*)(ws + WS_QKRAW); break;
            case 1: dst = (bf16*)(ws + WS_MLV); break;
            case 2: dst = (bf16*)(ws + WS_MLO); act = 1; break;
            case 3: if ((tn & 7) < 4) dst = (bf16*)(ws + WS_RETQ); else { dst = (bf16*)(ws + WS_RETK); col -= 512; } ld = 512; break;
            case 4: dst = (bf16*)(ws + WS_RETV); break;
            case 5: dst = (bf16*)(ws + WS_RETG); act = 2; break;
            case 6: dst = (bf16*)(ws + WS_GML); act = 1; break;
            default: dst = (bf16*)(ws + WS_GRET); act = 1; break;
        }
        float o[4];
#pragma unroll
        for (int j = 0; j < 4; ++j) o[j] = act == 1 ? sigmoidf_(v[j]) : act == 2 ? siluf_(v[j]) : v[j];
        u32x2 w; w.x = pk2(o[0], o[1]); w.y = pk2(o[2], o[3]);
        *(u32x2*)(dst + (size_t)row * ld + col) = w;
    } };
DI void phase_inproj(Ctx& C) {
    AF_rows af{(const bf16*)(C.ws + WS_H1), D}; BF_inproj bf{C.w_in}; EF_inproj ef{C.ws};
    const int ntn = 64, nt = (T / 128) * ntn;
    for (int u = C.bid; u < nt; u += C.G) naive_gemm_tile(C, u / ntn, u % ntn, D, DIN, af, bf, ef);
}

DI void phase_conv_rope(Ctx& C) {
    const bf16* QKRAW = (const bf16*)(C.ws + WS_QKRAW); bf16* QC = (bf16*)(C.ws + WS_QC);
    for (int idx = C.bid * NTHR + C.tid; idx < T * 128; idx += C.G * NTHR) {
        const int t = idx >> 7, c0 = (idx & 127) * 8, s = t % SEQ;
        float acc[8];
#pragma unroll
        for (int e = 0; e < 8; ++e) acc[e] = C.conv_b[c0 + e];
#pragma unroll
        for (int j = 0; j < 4; ++j) {
            if (s - 3 + j >= 0) {
                float f[8]; unpack8(*(const u32x4*)(QKRAW + (size_t)(t - 3 + j) * D + c0), f);
#pragma unroll
                for (int e = 0; e < 8; ++e) acc[e] += f[e] * C.conv_w[j * D + c0 + e];
            }
        }
        const float sc = (c0 < 512) ? 0.08838834764831845f : 1.0f;
#pragma unroll
        for (int e = 0; e < 8; ++e) acc[e] = siluf_(acc[e]) * sc;
        *(u32x4*)(QC + (size_t)t * D + c0) = pack8(acc);
    }
    const float* COS = (const float*)(C.ws + WS_COS); const float* SIN = (const float*)(C.ws + WS_SIN);
    for (int idx = C.bid * NTHR + C.tid; idx < T * 64; idx += C.G * NTHR) {
        const int t = idx >> 6, r = idx & 63, which = r >> 5, h = (r >> 3) & 3, i0 = (r & 7) * 8;
        bf16* base = (bf16*)(C.ws + (which ? WS_RETK : WS_RETQ)) + (size_t)t * 512 + h * 128;
        float x1[8], x2[8], o1[8], o2[8]; unpack8(*(const u32x4*)(base + i0), x1); unpack8(*(const u32x4*)(base + 64 + i0), x2);
        const float sc = which ? 0.08838834764831845f : 1.0f;
#pragma unroll
        for (int e = 0; e < 8; ++e) { const float cs = COS[t * 64 + i0 + e], sn = SIN[t * 64 + i0 + e]; o1[e] = (x1[e] * cs - x2[e] * sn) * sc; o2[e] = (x2[e] * cs + x1[e] * sn) * sc; }
        *(u32x4*)(base + i0) = pack8(o1); *(u32x4*)(base + 64 + i0) = pack8(o2);
    }
}

DI float ret_lg(int h) { return logf(1.0f - exp2f(-5.0f - (float)h)); }

DI void phase_local(Ctx& C) {
    LAS float* lf = (LAS float*)C.lds; LAS float* a = lf + 128; LAS float* ws = a + 128; LAS float* red = ws + 128;
    const float* IFG = (const float*)(C.ws + WS_IFG);
    bf16* CLOC = (bf16*)(C.ws + WS_CLOC);
    float* NLOC = (float*)(C.ws + WS_SMALL + SM_NLOC); float* MLOC = (float*)(C.ws + WS_SMALL + SM_MLOC); float* ACH = (float*)(C.ws + WS_SMALL + SM_ACH);
    const int t = C.tid;
    for (int u = C.bid; u < 1024; u += C.G) {
        const int mixer = u >> 9, bh = (u >> 5) & 15, ch = u & 31, b = bh >> 2, h = bh & 3, t0 = b * SEQ + ch * CH;
        const bf16 *Kp, *Vp; int ldk;
        if (mixer == 0) {
            if (t < 128) lf[t] = logsigmoidf_(IFG[(size_t)(t0 + t) * 8 + 4 + h]);
            __syncthreads();
            if (t < 128) { float s = 0.f; for (int j = 0; j <= t; ++j) s += lf[j]; a[t] = s; }
            __syncthreads();
            const float A = a[127];
            if (t < 128) ws[t] = A - a[t] + IFG[(size_t)(t0 + t) * 8 + h];
            __syncthreads();
            float mloc = -3.0e38f; for (int j = 0; j < 128; ++j) mloc = fmaxf(mloc, ws[j]);
            __syncthreads();
            if (t < 128) ws[t] = __expf(ws[t] - mloc);
            if (t == 0) { MLOC[bh * 32 + ch] = mloc; ACH[bh * 32 + ch] = A; }
            __syncthreads();
            Kp = (const bf16*)(C.ws + WS_QC) + (size_t)t0 * D + 512 + h * 128; ldk = D;
            Vp = (const bf16*)(C.ws + WS_MLV) + (size_t)t0 * D + h * 256;
        } else {
            const float lg = ret_lg(h);
            if (t < 128) ws[t] = __expf(lg * (float)(127 - t));
            __syncthreads();
            Kp = (const bf16*)(C.ws + WS_RETK) + (size_t)t0 * 512 + h * 128; ldk = 512;
            Vp = (const bf16*)(C.ws + WS_RETV) + (size_t)t0 * D + h * 256;
        }
        const int kh = t >> 8, v = t & 255;
        float acc[64];
#pragma unroll
        for (int i = 0; i < 64; ++i) acc[i] = 0.f;
        for (int s = 0; s < 128; ++s) {
            const float vv = ws[s] * bf2f(Vp[(size_t)s * D + v]);
            const bf16* kr = Kp + (size_t)s * ldk + kh * 64;
#pragma unroll
            for (int i8 = 0; i8 < 8; ++i8) { float f[8]; unpack8(*(const u32x4*)(kr + i8 * 8), f);
#pragma unroll
                for (int e = 0; e < 8; ++e) acc[i8 * 8 + e] += f[e] * vv; }
        }
        bf16* cl = CLOC + ((size_t)(mixer * 16 + bh) * 32 + ch) * 32768;
#pragma unroll
        for (int i = 0; i < 64; ++i) cl[(size_t)(kh * 64 + i) * 256 + v] = (bf16)f2bf(acc[i]);
        if (mixer == 0 && t < 128) { float s = 0.f; for (int j = 0; j < 128; ++j) s += ws[j] * bf2f(Kp[(size_t)j * ldk + t]); NLOC[(bh * 32 + ch) * 128 + t] = s; }
        __syncthreads();
    }
    (void)red;
}

DI void phase_scan(Ctx& C) {
    const bf16* CLOC = (const bf16*)(C.ws + WS_CLOC); bf16* CPREV = (bf16*)(C.ws + WS_CPREV);
    const float* NLOC = (const float*)(C.ws + WS_SMALL + SM_NLOC); float* NPREV = (float*)(C.ws + WS_SMALL + SM_NPREV);
    const float* MLOC = (const float*)(C.ws + WS_SMALL + SM_MLOC); const float* ACH = (const float*)(C.ws + WS_SMALL + SM_ACH); float* MPREV = (float*)(C.ws + WS_SMALL + SM_MPREV);
    for (int idx = C.bid * NTHR + C.tid; idx < 32 * 4096; idx += C.G * NTHR) {
        const int seq = idx >> 12, e8 = idx & 4095;
        float st[8];
#pragma unroll
        for (int e = 0; e < 8; ++e) st[e] = 0.f;
        if (seq < 16) {
            float m_st = 0.f; float nst[8];
#pragma unroll
            for (int e = 0; e < 8; ++e) nst[e] = 0.f;
            for (int ch = 0; ch < 32; ++ch) {
                const size_t o = ((size_t)seq * 32 + ch) * 32768 + (size_t)e8 * 8;
                *(u32x4*)(CPREV + o) = pack8(st);
                if (e8 < 16) { *(f32x4*)(NPREV + (seq * 32 + ch) * 128 + e8 * 8) = (f32x4){nst[0], nst[1], nst[2], nst[3]}; *(f32x4*)(NPREV + (seq * 32 + ch) * 128 + e8 * 8 + 4) = (f32x4){nst[4], nst[5], nst[6], nst[7]}; }
                if (e8 == 0) MPREV[seq * 32 + ch] = m_st;
                const float A = ACH[seq * 32 + ch], ml = MLOC[seq * 32 + ch];
                const float m_new = fmaxf(A + m_st, ml), sp = __expf(A + m_st - m_new), sl = __expf(ml - m_new);
                float f[8]; unpack8(*(const u32x4*)(CLOC + o), f);
#pragma unroll
                for (int e = 0; e < 8; ++e) st[e] = sp * st[e] + sl * f[e];
                if (e8 < 16) { const float* nl = NLOC + (seq * 32 + ch) * 128 + e8 * 8;
#pragma unroll
                    for (int e = 0; e < 8; ++e) nst[e] = sp * nst[e] + sl * nl[e]; }
                m_st = m_new;
            }
        } else {
            const float g = __expf(ret_lg(seq & 3) * 128.0f);
            for (int ch = 0; ch < 32; ++ch) {
                const size_t o = ((size_t)seq * 32 + ch) * 32768 + (size_t)e8 * 8;
                *(u32x4*)(CPREV + o) = pack8(st);
                float f[8]; unpack8(*(const u32x4*)(CLOC + o), f);
#pragma unroll
                for (int e = 0; e < 8; ++e) st[e] = g * st[e] + f[e];
            }
        }
    }
}

DI void phase_out(Ctx& C) {
    LAS float* av = (LAS float*)C.lds;
    LAS float* bv = av + 128;
    LAS float* mt = bv + 128;
    LAS float* isc = mt + 128;
    LAS float* den = isc + 128;
    LAS float* rs = den + 128;
    LAS float* P = rs + 1024;
    LAS float* Qs = P + 128 * 129;
    const float* IFG = (const float*)(C.ws + WS_IFG);
    const bf16* CPREV = (const bf16*)(C.ws + WS_CPREV);
    const float* NPREV = (const float*)(C.ws + WS_SMALL + SM_NPREV); const float* MPREV = (const float*)(C.ws + WS_SMALL + SM_MPREV);
    const int t = C.tid;
    for (int u = C.bid; u < 1024; u += C.G) {
        const int mixer = u >> 9, bh = (u >> 5) & 15, ch = u & 31, b = bh >> 2, h = bh & 3, t0 = b * SEQ + ch * CH;
        const bf16 *Qp, *Kp, *Vp; int ldq; const bf16* cp = CPREV + ((size_t)(mixer * 16 + bh) * 32 + ch) * 32768;
        float lg = 0.f;
        if (mixer == 0) {
            Qp = (const bf16*)(C.ws + WS_QC) + (size_t)t0 * D + h * 128; Kp = Qp + 512; ldq = D;
            Vp = (const bf16*)(C.ws + WS_MLV) + (size_t)t0 * D + h * 256;
            if (t < 128) mt[t] = logsigmoidf_(IFG[(size_t)(t0 + t) * 8 + 4 + h]);
            __syncthreads();
            if (t < 128) { float s = 0.f; for (int j = 0; j <= t; ++j) s += mt[j]; av[t] = s; bv[t] = IFG[(size_t)(t0 + t) * 8 + h] - s; }
            __syncthreads();
            if (t < 128) { float cm = -3.0e38f; for (int j = 0; j <= t; ++j) cm = fmaxf(cm, bv[j]);
                const float il = av[t] + MPREV[bh * 32 + ch], m = fmaxf(il, av[t] + cm); isc[t] = __expf(il - m); mt[t] = m; }
        } else {
            lg = ret_lg(h);
            Qp = (const bf16*)(C.ws + WS_RETQ) + (size_t)t0 * 512 + h * 128; Kp = (const bf16*)(C.ws + WS_RETK) + (size_t)t0 * 512 + h * 128; ldq = 512;
            Vp = (const bf16*)(C.ws + WS_RETV) + (size_t)t0 * D + h * 256;
            if (t < 128) isc[t] = __expf(lg * (float)(t + 1));
        }
        for (int e = t; e < 128 * 16; e += NTHR) { const int j = e >> 4, k8 = e & 15; float f[8]; unpack8(*(const u32x4*)(Qp + (size_t)j * ldq + k8 * 8), f);
#pragma unroll
            for (int i = 0; i < 8; ++i) Qs[j * 129 + k8 * 8 + i] = f[i]; }
        __syncthreads();
        for (int e = t; e < 128 * 128; e += NTHR) {
            const int j = e >> 7, s = e & 127; float p = 0.f;
            if (s <= j) {
                float d = 0.f;
#pragma unroll 4
                for (int k8 = 0; k8 < 16; ++k8) { float fk[8]; unpack8(*(const u32x4*)(Kp + (size_t)s * ldq + k8 * 8), fk);
#pragma unroll
                    for (int i = 0; i < 8; ++i) d += Qs[j * 129 + k8 * 8 + i] * fk[i]; }
                p = d * (mixer == 0 ? __expf(av[j] + bv[s] - mt[j]) : __expf(lg * (float)(j - s)));
            }
            P[j * 129 + s] = p;
        }
        __syncthreads();
        if (mixer == 0 && t < 128) { float s = 0.f; for (int i = 0; i < 128; ++i) s += P[t * 129 + i];
            float qn = 0.f; const float* np = NPREV + (bh * 32 + ch) * 128; for (int k = 0; k < 128; ++k) qn += Qs[t * 129 + k] * np[k];
            den[t] = fmaxf(fabsf(s + isc[t] * qn), __expf(-mt[t])); }
        __syncthreads();
        const float gain = (mixer == 0 ? C.ml_norm_g : C.ret_norm_g)[h * 256 + (t & 255)];
#pragma unroll 1
        for (int pass = 0; pass < 2; ++pass) {
            const int jh = t >> 8, v = t & 255, r0 = (pass * 2 + jh) * 32;
            float acc[32];
#pragma unroll
            for (int i = 0; i < 32; ++i) acc[i] = 0.f;
            const LAS float* qb = Qs + r0 * 129; const LAS float* pb = P + r0 * 129;
            for (int k = 0; k < 128; ++k) {
                const float cv = bf2f(cp[(size_t)k * 256 + v]);
#pragma unroll
                for (int i = 0; i < 32; ++i) acc[i] += qb[i * 129 + k] * cv;
            }
#pragma unroll
            for (int i = 0; i < 32; ++i) acc[i] *= isc[r0 + i];
            for (int s = 0; s < 128; ++s) {
                const float vv = bf2f(Vp[(size_t)s * D + v]);
#pragma unroll
                for (int i = 0; i < 32; ++i) acc[i] += pb[i * 129 + s] * vv;
            }
            if (mixer == 0) {
#pragma unroll
                for (int i = 0; i < 32; ++i) acc[i] = acc[i] / den[r0 + i];
            }
            const int wq = C.wave & 3;
#pragma unroll
            for (int i = 0; i < 32; ++i) { const float s1 = wave_sum(acc[i]); if (C.lane == 0) rs[wq * 128 + r0 + i] = s1; }
            __syncthreads();
#pragma unroll
            for (int i = 0; i < 32; ++i) { const int r = r0 + i; acc[i] -= (rs[r] + rs[128 + r] + rs[256 + r] + rs[384 + r]) * (1.0f / 256.0f); }
#pragma unroll
            for (int i = 0; i < 32; ++i) { const float s2 = wave_sum(acc[i] * acc[i]); if (C.lane == 0) rs[512 + wq * 128 + r0 + i] = s2; }
            __syncthreads();
            const bf16* gate = (const bf16*)(C.ws + (mixer == 0 ? WS_MLO : WS_RETG)) + (size_t)t0 * D + h * 256 + v;
            bf16* outp = (bf16*)(C.ws + (mixer == 0 ? WS_HML : WS_HRET)) + (size_t)t0 * D + h * 256 + v;
#pragma unroll
            for (int i = 0; i < 32; ++i) { const int r = r0 + i;
                const float var = (rs[512 + r] + rs[512 + 128 + r] + rs[512 + 256 + r] + rs[512 + 384 + r]) * (1.0f / 256.0f);
                const float y = acc[i] * (1.0f / sqrtf(var + EPS)) * gain * bf2f(gate[(size_t)r * D]);
                outp[(size_t)r * D] = (bf16)f2bf(y); }
            __syncthreads();
        }
    }
}

struct BF_plain { const float* w; DI const float* ptr(int, int tn) const { return w + tn * 128; } };
struct EF_f32 { float* dst; DI void put(int tm, int tn, int r, int c, const float (&v)[4]) const { *(f32x4*)(dst + (size_t)(tm * 128 + r) * D + tn * 128 + c) = (f32x4){v[0], v[1], v[2], v[3]}; } };
struct EF_merge { const float* t1; const bf16* g1; const bf16* g2; bf16* y;
    DI void put(int tm, int tn, int r, int c, const float (&v)[4]) const {
        const size_t o = (size_t)(tm * 128 + r) * D + tn * 128 + c; const f32x4 a = *(const f32x4*)(t1 + o);
        const u32x2 w1 = *(const u32x2*)(g1 + o), w2 = *(const u32x2*)(g2 + o);
        const float o0 = __uint_as_float(w1.x << 16) * a.x + __uint_as_float(w2.x << 16) * v[0], o1 = __uint_as_float(w1.x & 0xffff0000u) * a.y + __uint_as_float(w2.x & 0xffff0000u) * v[1];
        const float o2 = __uint_as_float(w1.y << 16) * a.z + __uint_as_float(w2.y << 16) * v[2], o3 = __uint_as_float(w1.y & 0xffff0000u) * a.w + __uint_as_float(w2.y & 0xffff0000u) * v[3];
        u32x2 w; w.x = pk2(o0, o1); w.y = pk2(o2, o3); *(u32x2*)(y + o) = w; } };
DI void phase_branch(Ctx& C) {
    AF_rows a1{(const bf16*)(C.ws + WS_HML), D}, a2{(const bf16*)(C.ws + WS_HRET), D}; BF_plain b1{C.w_bml}, b2{C.w_bret};
    EF_f32 e1{(float*)(C.ws + WS_TMP)}; EF_merge e2{(const float*)(C.ws + WS_TMP), (const bf16*)(C.ws + WS_GML), (const bf16*)(C.ws + WS_GRET), (bf16*)(C.ws + WS_H1)};
    const int nt = (T / 128) * 8;
    for (int u = C.bid; u < nt; u += C.G) { naive_gemm_tile(C, u / 8, u % 8, D, D, a1, b1, e1); naive_gemm_tile(C, u / 8, u % 8, D, D, a2, b2, e2); }
}
struct EF_resid { const float* x; const float* mod; float* x1;
    DI void put(int tm, int tn, int r, int c, const float (&v)[4]) const {
        const int row = tm * 128 + r, col = tn * 128 + c, b = row / SEQ; const size_t o = (size_t)row * D + col;
        const f32x4 xv = *(const f32x4*)(x + o), g = *(const f32x4*)(mod + b * 6144 + 2048 + col);
        *(f32x4*)(x1 + o) = xv + g * (f32x4){v[0], v[1], v[2], v[3]}; } };
DI void phase_outproj(Ctx& C) {
    AF_rows a{(const bf16*)(C.ws + WS_H1), D}; BF_plain b{C.w_out}; EF_resid e{C.x, (const float*)(C.ws + WS_MOD), (float*)(C.ws + WS_X1)};
    const int nt = (T / 128) * 8;
    for (int u = C.bid; u < nt; u += C.G) naive_gemm_tile(C, u / 8, u % 8, D, D, a, b, e);
}

DI void phase_norm2_route(Ctx& C) {
    LAS float* wr = (LAS float*)C.lds;
    LAS float* lg = wr + 32768;
    for (int i = C.tid; i < 32768 / 4; i += NTHR) *(LAS f32x4*)(wr + i * 4) = *(const f32x4*)(C.w_router + i * 4);
    __syncthreads();
    const float* mod = (const float*)(C.ws + WS_MOD); const float* X1 = (const float*)(C.ws + WS_X1);
    bf16* H2 = (bf16*)(C.ws + WS_H1);
    int* TOPI = (int*)(C.ws + WS_ROUTE + RT_TOPI); float* TOPW = (float*)(C.ws + WS_ROUTE + RT_TOPW); int* RANK = (int*)(C.ws + WS_ROUTE + RT_RANK);
    unsigned* CNT = (unsigned*)(C.ws + WS_CTL) + CW_CNT;
    const int lane = C.lane, gw = C.bid * NWAVES + C.wave, NGW = C.G * NWAVES;
    for (int m = gw; m < T; m += NGW) {
        const int b = m / SEQ;
        const f32x4* xr = (const f32x4*)(X1 + (size_t)m * D) + lane;
        f32x4 v[4]; float ss = 0.f;
#pragma unroll
        for (int j = 0; j < 4; ++j) { v[j] = xr[64 * j]; ss += (v[j].x * v[j].x + v[j].y * v[j].y) + (v[j].z * v[j].z + v[j].w * v[j].w); }
        const float rstd = 1.0f / sqrtf(wave_sum(ss) * (1.0f / D) + EPS);
        float acc[32];
#pragma unroll
        for (int e = 0; e < 32; ++e) acc[e] = 0.f;
        u32x2* o8 = (u32x2*)(H2 + (size_t)m * D) + lane;
#pragma unroll
        for (int j = 0; j < 4; ++j) {
            const int col = 4 * (lane + 64 * j);
            const f32x4 g = *(const f32x4*)(C.norm_ffn_g + col), sh = *(const f32x4*)(mod + b * 6144 + 3072 + col), sc = *(const f32x4*)(mod + b * 6144 + 4096 + col);
            const f32x4 h = (v[j] * rstd * g) * (sc + 1.0f) + sh;
            u32x2 w; w.x = pk2(h.x, h.y); w.y = pk2(h.z, h.w); o8[64 * j] = w;
            const float hh[4] = {h.x, h.y, h.z, h.w};
#pragma unroll
            for (int i = 0; i < 4; ++i) {
                const LAS f32x4* wp = (const LAS f32x4*)(wr + (col + i) * 32);
#pragma unroll
                for (int e4 = 0; e4 < 8; ++e4) { const f32x4 w4 = wp[e4]; acc[e4 * 4 + 0] += hh[i] * w4.x; acc[e4 * 4 + 1] += hh[i] * w4.y; acc[e4 * 4 + 2] += hh[i] * w4.z; acc[e4 * 4 + 3] += hh[i] * w4.w; }
                asm volatile("" ::: "memory");
            }
        }
#pragma unroll
        for (int e = 0; e < 32; ++e) acc[e] = wave_sum(acc[e]);
        float l[32];
#pragma unroll
        for (int e = 0; e < 32; ++e) l[e] = acc[e] + C.b_router[e];
        float tv[4]; int ti[4];
#pragma unroll
        for (int k = 0; k < 4; ++k) {
            float bvv = -3.0e38f; int bi = 0;
#pragma unroll
            for (int e = 0; e < 32; ++e) { const bool take = l[e] > bvv; bvv = take ? l[e] : bvv; bi = take ? e : bi; }
            tv[k] = bvv; ti[k] = bi;
#pragma unroll
            for (int e = 0; e < 32; ++e) l[e] = (e == bi) ? -3.0e38f : l[e];
        }
        const float e1 = __expf(tv[1] - tv[0]), e2 = __expf(tv[2] - tv[0]), e3 = __expf(tv[3] - tv[0]), inv = 1.0f / (1.0f + e1 + e2 + e3);
        if (lane < 4) {
            const int e = lane == 0 ? ti[0] : lane == 1 ? ti[1] : lane == 2 ? ti[2] : ti[3];
            const float w = (lane == 0 ? 1.0f : lane == 1 ? e1 : lane == 2 ? e2 : e3) * inv;
            TOPI[m * 4 + lane] = e; TOPW[m * 4 + lane] = w; RANK[m * 4 + lane] = (int)atomicAdd(CNT + e, 1u);
        }
    }
    (void)lg;
    int* SLOTTOK = (int*)(C.ws + WS_ROUTE + RT_SLOTTOK); float* SLOTW = (float*)(C.ws + WS_ROUTE + RT_SLOTW);
    for (int i = C.bid * NTHR + C.tid; i < NSLOTS; i += C.G * NTHR) { SLOTTOK[i] = T; SLOTW[i] = 0.f; }
    if (C.bid == 0) for (int i = C.tid; i < D / 2; i += NTHR) ((unsigned*)(H2 + (size_t)T * D))[i] = 0u;
    __syncthreads();
}

DI void phase_slots(Ctx& C) {
    LAS int* pstart = (LAS int*)C.lds;
    unsigned* CNT = (unsigned*)(C.ws + WS_CTL) + CW_CNT;
    unsigned* ctl = (unsigned*)(C.ws + WS_CTL);
    if (C.tid == 0) {
        int nb = 0;
        for (int e = 0; e < NE; ++e) { pstart[e] = nb * 256; const int bl = ((int)__hip_atomic_load(CNT + e, __ATOMIC_RELAXED, __HIP_MEMORY_SCOPE_AGENT) + 255) >> 8;
            if (C.bid == 0) for (int i = 0; i < bl; ++i) ctl[CW_BLKE + nb + i] = (unsigned)e;
            nb += bl; }
        if (C.bid == 0) ctl[CW_NBLK] = (unsigned)nb;
    }
    __syncthreads();
    const int* TOPI = (const int*)(C.ws + WS_ROUTE + RT_TOPI); const float* TOPW = (const float*)(C.ws + WS_ROUTE + RT_TOPW); const int* RANK = (const int*)(C.ws + WS_ROUTE + RT_RANK);
    int* ASLOT = (int*)(C.ws + WS_ROUTE + RT_ASLOT); int* SLOTTOK = (int*)(C.ws + WS_ROUTE + RT_SLOTTOK); float* SLOTW = (float*)(C.ws + WS_ROUTE + RT_SLOTW);
    for (int i = C.bid * NTHR + C.tid; i < T * 4; i += C.G * NTHR) {
        const int slot = pstart[TOPI[i]] + RANK[i];
        ASLOT[i] = slot; SLOTTOK[slot] = i >> 2; SLOTW[slot] = TOPW[i];
    }
    __syncthreads();
}

struct AF_gather { const bf16* base; const int* slottok; DI const bf16* row(int tm, int r) const { return base + (size_t)slottok[tm * 128 + r] * D; } };
struct BF_expert { const float* w; const unsigned* blke; size_t estride; DI const float* ptr(int tm, int tn) const { return w + (size_t)blke[tm >> 1] * estride + tn * 128; } };
struct EF_swiglu { const float* bias; const unsigned* blke; bf16* act;
    DI void put(int tm, int tn, int r, int c, const float (&v)[4]) const {
        const int e = (int)blke[tm >> 1]; const float* bp = bias + (size_t)e * 2048 + tn * 128 + c;
        float o[2];
#pragma unroll
        for (int j = 0; j < 2; ++j) { const float xg = fminf(v[2 * j] + bp[2 * j], 7.0f), xl = fminf(fmaxf(v[2 * j + 1] + bp[2 * j + 1], -7.0f), 7.0f); o[j] = xg * sigmoidf_(1.702f * xg) * (xl + 1.0f); }
        *(unsigned*)(act + (size_t)(tm * 128 + r) * D + (tn * 128 + c) / 2) = pk2(o[0], o[1]); } };
DI void phase_gateup(Ctx& C) {
    const unsigned* ctl = (const unsigned*)(C.ws + WS_CTL); const int nblk = (int)ctl[CW_NBLK];
    AF_gather a{(const bf16*)(C.ws + WS_H1), (const int*)(C.ws + WS_ROUTE + RT_SLOTTOK)}; BF_expert b{C.w_gu, ctl + CW_BLKE, (size_t)D * 2048};
    EF_swiglu e{C.b_gu, ctl + CW_BLKE, (bf16*)(C.ws + WS_ACT)};
    const int nt = nblk * 2 * 16;
    for (int u = C.bid; u < nt; u += C.G) naive_gemm_tile(C, u / 16, u % 16, D, 2048, a, b, e);
}
struct EF_down { const float* bias; const unsigned* blke; const float* slotw; bf16* ys;
    DI void put(int tm, int tn, int r, int c, const float (&v)[4]) const {
        const int e = (int)blke[tm >> 1], slot = tm * 128 + r; const float w = slotw[slot]; const float* bp = bias + (size_t)e * D + tn * 128 + c;
        u32x2 o; o.x = pk2((v[0] + bp[0]) * w, (v[1] + bp[1]) * w); o.y = pk2((v[2] + bp[2]) * w, (v[3] + bp[3]) * w);
        *(u32x2*)(ys + (size_t)slot * D + tn * 128 + c) = o; } };
DI void phase_down(Ctx& C) {
    const unsigned* ctl = (const unsigned*)(C.ws + WS_CTL); const int nblk = (int)ctl[CW_NBLK];
    AF_rows a{(const bf16*)(C.ws + WS_ACT), D}; BF_expert b{C.w_dn, ctl + CW_BLKE, (size_t)D * D};
    EF_down e{C.b_dn, ctl + CW_BLKE, (const float*)(C.ws + WS_ROUTE + RT_SLOTW), (bf16*)(C.ws + WS_YS)};
    const int nt = nblk * 2 * 8;
    for (int u = C.bid; u < nt; u += C.G) naive_gemm_tile(C, u / 8, u % 8, D, D, a, b, e);
}
DI void phase_final(Ctx& C) {
    const float* mod = (const float*)(C.ws + WS_MOD); const float* X1 = (const float*)(C.ws + WS_X1); const bf16* YS = (const bf16*)(C.ws + WS_YS);
    const int* ASLOT = (const int*)(C.ws + WS_ROUTE + RT_ASLOT);
    const int lane = C.lane, gw = C.bid * NWAVES + C.wave, NGW = C.G * NWAVES;
    for (int m = gw; m < T; m += NGW) {
        const int b = m / SEQ;
        const int s0 = ASLOT[m * 4 + 0], s1 = ASLOT[m * 4 + 1], s2 = ASLOT[m * 4 + 2], s3 = ASLOT[m * 4 + 3];
        f32x4 v[4]; float ss = 0.f;
#pragma unroll
        for (int j = 0; j < 4; ++j) {
            const int col = 4 * (lane + 64 * j);
            f32x4 y = (f32x4){0.f, 0.f, 0.f, 0.f};
            const int sl[4] = {s0, s1, s2, s3};
#pragma unroll
            for (int k = 0; k < 4; ++k) { const u32x2 w = *(const u32x2*)(YS + (size_t)sl[k] * D + col);
                y += (f32x4){__uint_as_float(w.x << 16), __uint_as_float(w.x & 0xffff0000u), __uint_as_float(w.y << 16), __uint_as_float(w.y & 0xffff0000u)}; }
            const f32x4 g = *(const f32x4*)(mod + b * 6144 + 5120 + col);
            v[j] = *(const f32x4*)(X1 + (size_t)m * D + col) + g * y;
            ss += (v[j].x * v[j].x + v[j].y * v[j].y) + (v[j].z * v[j].z + v[j].w * v[j].w);
        }
        const float rstd = 1.0f / sqrtf(wave_sum(ss) * (1.0f / D) + EPS);
#pragma unroll
        for (int j = 0; j < 4; ++j) { const int col = 4 * (lane + 64 * j); *(f32x4*)(C.out + (size_t)m * D + col) = v[j] * rstd * *(const f32x4*)(C.norm_final_g + col); }
    }
}

#define XB_TMO      128
#define XB_XCNT(j)  (256  + 64 * (j))
#define XB_XSUB(j)  (1280 + 64 * (j))
#define XB_XGEN(j)  (2304 + 64 * (j))
#define XB_TOP      3328
#define XB_TOPGEN   3392
#define XCD_BAR_WORDS 3456
#define XB_SPIN_CAP (1u << 22)
DI unsigned xb_ld(unsigned* p)              { return __hip_atomic_load(p, __ATOMIC_RELAXED, __HIP_MEMORY_SCOPE_AGENT); }
DI unsigned xb_add(unsigned* p, unsigned v) { return __hip_atomic_fetch_add(p, v, __ATOMIC_RELAXED, __HIP_MEMORY_SCOPE_AGENT); }
DI unsigned xb_xcc_id() { return (unsigned)__builtin_amdgcn_s_getreg((3 << 11) | 20) & 0xFu; }
#define XB_SPIN(cond, bar) do { unsigned _sp = 0; while (cond) { __builtin_amdgcn_s_sleep(1); \
    if ((++_sp & 255u) == 0u) { if (xb_ld(&(bar)[XB_TMO])) break; if (_sp > XB_SPIN_CAP) { atomicAdd(&(bar)[XB_TMO], 1u); break; } } } } while (0)
struct XcdBarrier { unsigned* bar; unsigned x; volatile LAS unsigned* st; };
DI XcdBarrier xcd_barrier_post(unsigned* bar, volatile LAS unsigned* st) {
    XcdBarrier b; b.bar = bar; b.x = xb_xcc_id(); b.st = st;
    if (threadIdx.x == 0) (void)xb_add(&bar[XB_XCNT(b.x)], 1u);
    return b;
}
DI void xcd_barrier_complete(unsigned* bar, unsigned x, unsigned& nloc, unsigned& nx) {
    const unsigned G = gridDim.x * gridDim.y * gridDim.z;
    unsigned sum, cnt, mine, sp = 0u;
    for (;;) {
        sum = 0u; cnt = 0u; mine = 0u;
#pragma unroll
        for (unsigned j = 0; j < 16; ++j) { const unsigned c = xb_ld(&bar[XB_XCNT(j)]); sum += c; cnt += (c > 0u) ? 1u : 0u; mine = (j == x) ? c : mine; }
        if (sum == G) break;
        __builtin_amdgcn_s_sleep(1);
        if ((++sp & 255u) == 0u) { if (xb_ld(&bar[XB_TMO])) break; if (sp > XB_SPIN_CAP) { atomicAdd(&bar[XB_TMO], 1u); break; } }
    }
    nloc = mine > 0u ? mine : 1u; nx = cnt > 0u ? cnt : 1u;
}
DI void xcd_barrier(const XcdBarrier& b) {
    asm volatile("s_waitcnt vmcnt(0)" ::: "memory");
    __syncthreads();
    if (threadIdx.x == 0) {
        unsigned* bar = b.bar;
        __builtin_amdgcn_s_waitcnt(0);
        unsigned nloc = b.st[0], nx = b.st[1];
        if (nloc == 0u) { xcd_barrier_complete(bar, b.x, nloc, nx); b.st[0] = nloc; b.st[1] = nx; }
        const unsigned old = xb_add(&bar[XB_XSUB(b.x)], 1u);
        const unsigned gen = old / nloc;
        if (old + 1u == (gen + 1u) * nloc) {
            __builtin_amdgcn_fence(__ATOMIC_RELEASE, "agent");
            asm volatile("s_waitcnt vmcnt(0)" ::: "memory");
            const unsigned og = xb_add(&bar[XB_TOP], 1u);
            const unsigned tg = og / nx;
            if (og + 1u == (tg + 1u) * nx) xb_add(&bar[XB_TOPGEN], 1u);
            else XB_SPIN(xb_ld(&bar[XB_TOPGEN]) == tg, bar);
            __builtin_amdgcn_fence(__ATOMIC_ACQUIRE, "agent");
            xb_add(&bar[XB_XGEN(b.x)], 1u);
            asm volatile("s_waitcnt vmcnt(0)" ::: "memory");
        } else {
            XB_SPIN(xb_ld(&bar[XB_XGEN(b.x)]) == gen, bar);
            __builtin_amdgcn_fence(__ATOMIC_ACQUIRE, "agent");
            asm volatile("s_waitcnt vmcnt(0)" ::: "memory");
        }
    }
    __syncthreads();
}

constexpr int NPHASES = 14;
__global__ void __launch_bounds__(NTHR, 2) fwd(Args a) {
    extern __shared__ __attribute__((aligned(16))) unsigned char lds[];
    Ctx C;
    C.lds = (LAS unsigned char*)lds; C.tid = threadIdx.x; C.lane = C.tid & 63; C.wave = __builtin_amdgcn_readfirstlane(C.tid >> 6); C.G = gridDim.x; C.bid = blockIdx.x;
    C.x = (const float*)a.in[0]; C.c = (const float*)a.in[1]; C.positions = (const int*)a.in[2]; C.w_ada = (const float*)a.in[3]; C.b_ada = (const float*)a.in[4];
    C.norm_mix_g = (const float*)a.in[5]; C.w_in = (const float*)a.in[6]; C.conv_w = (const float*)a.in[7]; C.conv_b = (const float*)a.in[8]; C.b_if = (const float*)a.in[9];
    C.ml_norm_g = (const float*)a.in[10]; C.ret_norm_g = (const float*)a.in[11]; C.w_bml = (const float*)a.in[12]; C.w_bret = (const float*)a.in[13]; C.w_out = (const float*)a.in[14];
    C.norm_ffn_g = (const float*)a.in[15]; C.w_router = (const float*)a.in[16]; C.b_router = (const float*)a.in[17]; C.w_gu = (const float*)a.in[18]; C.b_gu = (const float*)a.in[19];
    C.w_dn = (const float*)a.in[20]; C.b_dn = (const float*)a.in[21]; C.norm_final_g = (const float*)a.in[22];
    C.out = a.out; C.ws = a.ws;
    const int lo = a.ph_lo, hi = a.ph_hi;
    volatile LAS unsigned* bst = (volatile LAS unsigned*)(C.lds + LDS_BYTES - 16);
    if (C.tid < 4) bst[C.tid] = 0u;
    __syncthreads();
    XcdBarrier bar; bar.bar = (unsigned*)(C.ws + WS_CTL) + CW_BAR; bar.x = 0; bar.st = bst;
    if (hi - lo > 1) bar = xcd_barrier_post((unsigned*)(C.ws + WS_CTL) + CW_BAR, bst);
#define SEAM(k) do { if (IN(k) && IN((k) + 1)) xcd_barrier(bar); } while (0)
#ifdef ONLY_PHASE
#define IN(k) ((k) == ONLY_PHASE && lo <= (k) && (k) < hi)
#else
#define IN(k) (lo <= (k) && (k) < hi)
#endif
    if (IN(0)) phase_mod(C); SEAM(0);
    if (IN(1)) phase_norm1(C); SEAM(1);
    if (IN(2)) phase_inproj(C); SEAM(2);
    if (IN(3)) phase_conv_rope(C); SEAM(3);
    if (IN(4)) phase_local(C); SEAM(4);
    if (IN(5)) phase_scan(C); SEAM(5);
    if (IN(6)) phase_out(C); SEAM(6);
    if (IN(7)) phase_branch(C); SEAM(7);
    if (IN(8)) phase_outproj(C); SEAM(8);
    if (IN(9)) phase_norm2_route(C); SEAM(9);
    if (IN(10)) phase_slots(C); SEAM(10);
    if (IN(11)) phase_gateup(C); SEAM(11);
    if (IN(12)) phase_down(C); SEAM(12);
    if (IN(13)) phase_final(C); SEAM(13);
#undef IN
}

extern "C" void kernel_launch(void* const* d_in, const int* in_sizes, int n_in, void* d_out, int out_size, void* d_ws, size_t ws_size, hipStream_t stream) {
    static int grid = 0;
    if (grid == 0) {
        if (n_in != 23 || out_size != T * D || ws_size < WS_END) { fprintf(stderr, "kernel_launch: unexpected shapes: n_in %d out %d ws %zu (need %zu)\n", n_in, out_size, ws_size, (size_t)WS_END); grid = -1; return; }
        int dev = 0, cus = 0;
        if (hipGetDevice(&dev) != hipSuccess || hipDeviceGetAttribute(&cus, hipDeviceAttributeMultiprocessorCount, dev) != hipSuccess) { grid = -1; return; }
        if (hipFuncSetAttribute((const void*)fwd, hipFuncAttributeMaxDynamicSharedMemorySize, LDS_BYTES) != hipSuccess) { fprintf(stderr, "kernel_launch: hipFuncSetAttribute failed\n"); grid = -1; return; }
        grid = cus > 0 ? cus : 256;
    }
    if (grid < 0) return;
    Args a{};
    for (int i = 0; i < 23; ++i) a.in[i] = d_in[i];
    a.out = (float*)d_out; a.ws = (unsigned char*)d_ws;
    (void)hipMemsetAsync((char*)d_ws + WS_CTL, 0, CTL_ZERO_BYTES, stream);
#ifdef MK_PER_PHASE
    for (int p = 0; p < NPHASES; ++p) { a.ph_lo = p; a.ph_hi = p + 1; hipLaunchKernelGGL(fwd, dim3(grid), dim3(NTHR), LDS_BYTES, stream, a); }
#else
    a.ph_lo = 0; a.ph_hi = NPHASES;
    hipLaunchKernelGGL(fwd, dim3(grid), dim3(NTHR), LDS_BYTES, stream, a);
#endif
}
```

```cpp
#include <hip/hip_runtime.h>
#include <cstdio>
#include <cstdint>

#ifndef OPT_INPROJ
#define OPT_INPROJ 1
#endif
#ifndef OPT_BRANCH
#define OPT_BRANCH 1
#endif
#ifndef OPT_OUT
#define OPT_OUT 1
#endif
#ifndef OPT_MOE
#define OPT_MOE 1
#endif
#define OPT_ANY (OPT_INPROJ || OPT_BRANCH || OPT_OUT || OPT_MOE)
#define DI __device__ __forceinline__
#define LAS __attribute__((address_space(3)))
typedef unsigned short bf16;
typedef float f32x4 __attribute__((ext_vector_type(4)));
typedef unsigned u32x4 __attribute__((ext_vector_type(4)));
typedef unsigned u32x2 __attribute__((ext_vector_type(2)));

constexpr int D = 1024, NB = 4, SEQ = 4096, T = NB * SEQ;
constexpr int DIN = 8200, CH = 128, NCH = SEQ / CH;
constexpr int NE = 32, TOPK = 4, NSLOT_BLK = 288, NSLOTS = NSLOT_BLK * 256;
constexpr float EPS = 1e-5f;
constexpr int NTHR = 512, NWAVES = 8;

constexpr size_t MiB = 1u << 20;
constexpr size_t WS_CTL   = 0;
constexpr size_t WS_MOD   = 1 * MiB;
constexpr size_t WS_IFG   = 2 * MiB;
constexpr size_t WS_COS   = 3 * MiB;
constexpr size_t WS_SIN   = 7 * MiB;
constexpr size_t WS_ROUTE = 11 * MiB;
constexpr size_t WS_SMALL = 14 * MiB;
constexpr size_t WS_H1    = 16 * MiB;
constexpr size_t WS_X1    = 50 * MiB;
constexpr size_t WS_TMP   = 114 * MiB;
constexpr size_t WS_B     = 178 * MiB;
constexpr size_t WS_QKRAW = WS_B;
constexpr size_t WS_QC    = WS_B + 32 * MiB;
constexpr size_t WS_MLV   = WS_B + 64 * MiB;
constexpr size_t WS_MLO   = WS_B + 96 * MiB;
constexpr size_t WS_RETQ  = WS_B + 128 * MiB;
constexpr size_t WS_RETK  = WS_B + 144 * MiB;
constexpr size_t WS_RETV  = WS_B + 160 * MiB;
constexpr size_t WS_RETG  = WS_B + 192 * MiB;
constexpr size_t WS_GML   = WS_B + 224 * MiB;
constexpr size_t WS_GRET  = WS_B + 256 * MiB;
constexpr size_t WS_CLOC  = WS_B + 288 * MiB;
constexpr size_t WS_CPREV = WS_B + 352 * MiB;
constexpr size_t WS_HML   = WS_B + 416 * MiB;
constexpr size_t WS_HRET  = WS_B + 448 * MiB;
constexpr size_t WS_B_END = WS_B + 480 * MiB;
constexpr size_t WS_ACT   = WS_B;
constexpr size_t WS_YS    = WS_B + 160 * MiB;
constexpr size_t WS_WT_IN = WS_B_END;
constexpr size_t WS_WT_BR = WS_WT_IN + 16 * MiB;
constexpr size_t WS_WT_OUT = WS_WT_BR + 4 * MiB;
constexpr size_t WS_WT_GU = WS_WT_OUT + 2 * MiB;
constexpr size_t WS_WT_DN = WS_WT_GU + 128 * MiB;
constexpr size_t WS_END   = WS_WT_DN + 64 * MiB;
static_assert(WS_YS + (size_t)NSLOTS * 2048 <= WS_B_END, "ws map");

constexpr int CW_CNT = 64;
constexpr int CW_NBLK = 128;
constexpr int CW_BLKE = 192;
constexpr int CW_BAR = 4096;
constexpr size_t CTL_ZERO_BYTES = 65536;
constexpr size_t RT_TOPI = 0;
constexpr size_t RT_TOPW = 256 * 1024;
constexpr size_t RT_RANK = 512 * 1024;
constexpr size_t RT_ASLOT = 768 * 1024;
constexpr size_t RT_SLOTTOK = 1024 * 1024;
constexpr size_t RT_SLOTW = 1024 * 1024 + 512 * 1024;
constexpr size_t SM_NLOC = 0;
constexpr size_t SM_NPREV = 256 * 1024;
constexpr size_t SM_MLOC = 512 * 1024;
constexpr size_t SM_ACH = 512 * 1024 + 4096;
constexpr size_t SM_MPREV = 512 * 1024 + 8192;

constexpr int LDS_BYTES = 147456;

DI float bf2f(bf16 v) { return __uint_as_float(((unsigned)v) << 16); }
DI unsigned f2bf(float f) { unsigned u = __float_as_uint(f); return (u + 0x7fffu + ((u >> 16) & 1u)) >> 16; }
DI unsigned pk2(float lo, float hi) { return f2bf(lo) | (f2bf(hi) << 16); }
DI float wave_sum(float v) {
#pragma unroll
    for (int o = 1; o < 64; o <<= 1) v += __shfl_xor(v, o);
    return v;
}
DI float sigmoidf_(float x) { return 1.0f / (1.0f + __expf(-x)); }
DI float siluf_(float x) { return x / (1.0f + __expf(-x)); }
DI float logsigmoidf_(float x) { return fminf(x, 0.f) - log1pf(__expf(-fabsf(x))); }
DI void unpack8(const u32x4 w, float (&f)[8]) {
    f[0] = __uint_as_float(w.x << 16); f[1] = __uint_as_float(w.x & 0xffff0000u);
    f[2] = __uint_as_float(w.y << 16); f[3] = __uint_as_float(w.y & 0xffff0000u);
    f[4] = __uint_as_float(w.z << 16); f[5] = __uint_as_float(w.z & 0xffff0000u);
    f[6] = __uint_as_float(w.w << 16); f[7] = __uint_as_float(w.w & 0xffff0000u);
}
DI u32x4 pack8(const float (&f)[8]) { u32x4 w; w.x = pk2(f[0], f[1]); w.y = pk2(f[2], f[3]); w.z = pk2(f[4], f[5]); w.w = pk2(f[6], f[7]); return w; }

struct Args { const void* in[23]; float* out; unsigned char* ws; int ph_lo, ph_hi; };

struct Ctx {
    LAS unsigned char* lds;
    int tid, lane, wave, G, bid;
    const float *x, *c, *w_ada, *b_ada, *norm_mix_g, *w_in, *conv_w, *conv_b, *b_if, *ml_norm_g, *ret_norm_g;
    const float *w_bml, *w_bret, *w_out, *norm_ffn_g, *w_router, *b_router, *w_gu, *b_gu, *w_dn, *b_dn, *norm_final_g;
    const int* positions;
    float* out; unsigned char* ws;
};

template <class AF, class BF, class EF>
DI void naive_gemm_tile(Ctx& C, int tm, int tn, int K, int ldb, const AF& af, const BF& bf, const EF& ef) {
    LAS float* As = (LAS float*)C.lds;
    LAS float* Bs = As + 16 * 132;
    const int t = C.tid, ty = t >> 5, tx = t & 31;
    float acc[8][4];
#pragma unroll
    for (int i = 0; i < 8; ++i)
#pragma unroll
        for (int j = 0; j < 4; ++j) acc[i][j] = 0.f;
    const int ar = t >> 2, ak = (t & 3) * 4;
    const bf16* arow = af.row(tm, ar);
    const int bk = t >> 5, bn = (t & 31) * 4;
    const float* bbase = bf.ptr(tm, tn) + bn;
    for (int k0 = 0; k0 < K; k0 += 16) {
        const u32x2 av = *(const u32x2*)(arow + k0 + ak);
        const f32x4 bv = *(const f32x4*)(bbase + (size_t)(k0 + bk) * ldb);
        __syncthreads();
        As[(ak + 0) * 132 + ar] = __uint_as_float(av.x << 16); As[(ak + 1) * 132 + ar] = __uint_as_float(av.x & 0xffff0000u);
        As[(ak + 2) * 132 + ar] = __uint_as_float(av.y << 16); As[(ak + 3) * 132 + ar] = __uint_as_float(av.y & 0xffff0000u);
        *(LAS f32x4*)(Bs + bk * 132 + bn) = bv;
        __syncthreads();
#pragma unroll 4
        for (int kk = 0; kk < 16; ++kk) {
            const f32x4 a0 = *(const LAS f32x4*)(As + kk * 132 + ty * 8), a1 = *(const LAS f32x4*)(As + kk * 132 + ty * 8 + 4);
            const f32x4 b = *(const LAS f32x4*)(Bs + kk * 132 + tx * 4);
            const float a[8] = {a0.x, a0.y, a0.z, a0.w, a1.x, a1.y, a1.z, a1.w};
#pragma unroll
            for (int i = 0; i < 8; ++i) { acc[i][0] += a[i] * b.x; acc[i][1] += a[i] * b.y; acc[i][2] += a[i] * b.z; acc[i][3] += a[i] * b.w; }
        }
    }
#pragma unroll
    for (int i = 0; i < 8; ++i) { ef.put(tm, tn, ty * 8 + i, tx * 4, acc[i]); asm volatile("" ::: "memory"); }
    __syncthreads();
}

DI void phase_mod(Ctx& C) {
    LAS float* red = (LAS float*)C.lds;
    float* mod = (float*)(C.ws + WS_MOD);
    for (int g = C.bid; g < 256; g += C.G) {
        const int n0 = g * 24, t = C.tid;
        if (t < 504) {
            const int col = t % 24, kg = t / 24;
            float a0 = 0.f, a1 = 0.f, a2 = 0.f, a3 = 0.f;
            for (int k = kg; k < D; k += 21) {
                const float w = C.w_ada[(size_t)k * 6144 + n0 + col];
                a0 += siluf_(C.c[k]) * w; a1 += siluf_(C.c[D + k]) * w; a2 += siluf_(C.c[2 * D + k]) * w; a3 += siluf_(C.c[3 * D + k]) * w;
            }
            red[(kg * 24 + col) * 4 + 0] = a0; red[(kg * 24 + col) * 4 + 1] = a1; red[(kg * 24 + col) * 4 + 2] = a2; red[(kg * 24 + col) * 4 + 3] = a3;
        }
        __syncthreads();
        if (t < 96) {
            const int col = t % 24, b = t / 24; float s = 0.f;
            for (int kg = 0; kg < 21; ++kg) s += red[(kg * 24 + col) * 4 + b];
            mod[b * 6144 + n0 + col] = s + C.b_ada[n0 + col];
        }
        __syncthreads();
    }
}

DI void phase_norm1(Ctx& C) {
    const float* mod = (const float*)(C.ws + WS_MOD);
    bf16* H1 = (bf16*)(C.ws + WS_H1);
    float* IFG = (float*)(C.ws + WS_IFG);
    const int lane = C.lane, gw = C.bid * NWAVES + C.wave, NGW = C.G * NWAVES;
    float wif[4][4][8];
#pragma unroll
    for (int j = 0; j < 4; ++j)
#pragma unroll
        for (int i = 0; i < 4; ++i) {
            const float* wp = C.w_in + (size_t)(4 * (lane + 64 * j) + i) * DIN + 3072;
#pragma unroll
            for (int e = 0; e < 8; ++e) wif[j][i][e] = wp[e];
        }
    for (int m = gw; m < T; m += NGW) {
        const int b = m / SEQ;
        const f32x4* xr = (const f32x4*)(C.x + (size_t)m * D) + lane;
        f32x4 v[4]; float ss = 0.f;
#pragma unroll
        for (int j = 0; j < 4; ++j) { v[j] = xr[64 * j]; ss += (v[j].x * v[j].x + v[j].y * v[j].y) + (v[j].z * v[j].z + v[j].w * v[j].w); }
        const float rstd = 1.0f / sqrtf(wave_sum(ss) * (1.0f / D) + EPS);
        float p[8];
#pragma unroll
        for (int e = 0; e < 8; ++e) p[e] = 0.f;
        u32x2* o8 = (u32x2*)(H1 + (size_t)m * D) + lane;
#pragma unroll
        for (int j = 0; j < 4; ++j) {
            const int col = 4 * (lane + 64 * j);
            const f32x4 g = *(const f32x4*)(C.norm_mix_g + col), sh = *(const f32x4*)(mod + b * 6144 + col), sc = *(const f32x4*)(mod + b * 6144 + 1024 + col);
            f32x4 h = (v[j] * rstd * g) * (sc + 1.0f) + sh;
            u32x2 w; w.x = pk2(h.x, h.y); w.y = pk2(h.z, h.w); o8[64 * j] = w;
            const float hh[4] = {h.x, h.y, h.z, h.w};
#pragma unroll
            for (int i = 0; i < 4; ++i)
#pragma unroll
                for (int e = 0; e < 8; ++e) p[e] += hh[i] * wif[j][i][e];
        }
#pragma unroll
        for (int e = 0; e < 8; ++e) p[e] = wave_sum(p[e]);
        if (lane < 8) { float r = p[0];
#pragma unroll
            for (int e = 1; e < 8; ++e) r = (lane == e) ? p[e] : r;
            IFG[(size_t)m * 8 + lane] = r + C.b_if[lane]; }
    }
    float* COS = (float*)(C.ws + WS_COS); float* SIN = (float*)(C.ws + WS_SIN);
    for (int idx = C.bid * NTHR + C.tid; idx < T * 64; idx += C.G * NTHR) {
        const int t = idx >> 6, i = idx & 63;
        const float inv = (float)exp(-(double)i * (9.210340371976184 / 64.0));
        const double ang = (double)C.positions[t] * (double)inv;
        const double kq = rint(ang * 0.6366197723675814);
        double r = fma(-kq, 1.5707963267948966, ang); r = fma(-kq, 6.123233995736766e-17, r);
        const float rf = (float)r; const float s = sinf(rf), c = cosf(rf);
        const int q = ((int)kq) & 3;
        const float cs = (q == 0) ? c : (q == 1) ? -s : (q == 2) ? -c : s;
        const float sn = (q == 0) ? s : (q == 1) ? c : (q == 2) ? -s : -c;
        COS[idx] = cs; SIN[idx] = sn;
    }
    if (C.bid == 0 && C.tid < 32) ((unsigned*)(C.ws + WS_CTL))[CW_CNT + C.tid] = 0u;
}

struct AF_rows { const bf16* base; int ld; DI const bf16* row(int tm, int r) const { return base + (size_t)(tm * 128 + r) * ld; } };
struct BF_inproj { const float* w; DI const float* ptr(int, int tn) const { return w + (tn < 24 ? tn * 128 : tn * 128 + 8); } };
struct EF_inproj { unsigned char* ws;
    DI void put(int tm, int tn, int r, int c, const float (&v)[4]) const {
        const int row = tm * 128 + r; const int seg = tn >> 3;
        bf16* dst; int ld = 1024, col = (tn & 7) * 128 + c; int act = 0;
        switch (seg) {
            case 0: dst = (bf16*)(ws + WS_QKRAW); break;
            case 1: dst = (bf16*)(ws + WS_MLV); break;
            case 2: dst = (bf16*)(ws + WS_MLO); act = 1; break;
            case 3: if ((tn & 7) < 4) dst = (bf16*)(ws + WS_RETQ); else { dst = (bf16*)(ws + WS_RETK); col -= 512; } ld = 512; break;
            case 4: dst = (bf16*)(ws + WS_RETV); break;
            case 5: dst = (bf16*)(ws + WS_RETG); act = 2; break;
            case 6: dst = (bf16*)(ws + WS_GML); act = 1; break;
            default: dst = (bf16*)(ws + WS_GRET); act = 1; break;
        }
        float o[4];
#pragma unroll
        for (int j = 0; j < 4; ++j) o[j] = act == 1 ? sigmoidf_(v[j]) : act == 2 ? siluf_(v[j]) : v[j];
        u32x2 w; w.x = pk2(o[0], o[1]); w.y = pk2(o[2], o[3]);
        *(u32x2*)(dst + (size_t)row * ld + col) = w;
    } };
DI void phase_inproj(Ctx& C) {
    AF_rows af{(const bf16*)(C.ws + WS_H1), D}; BF_inproj bf{C.w_in}; EF_inproj ef{C.ws};
    const int ntn = 64, nt = (T / 128) * ntn;
    for (int u = C.bid; u < nt; u += C.G) naive_gemm_tile(C, u / ntn, u % ntn, D, DIN, af, bf, ef);
}

DI void phase_conv_rope(Ctx& C) {
    const bf16* QKRAW = (const bf16*)(C.ws + WS_QKRAW); bf16* QC = (bf16*)(C.ws + WS_QC);
    for (int idx = C.bid * NTHR + C.tid; idx < T * 128; idx += C.G * NTHR) {
        const int t = idx >> 7, c0 = (idx & 127) * 8, s = t % SEQ;
        float acc[8];
#pragma unroll
        for (int e = 0; e < 8; ++e) acc[e] = C.conv_b[c0 + e];
#pragma unroll
        for (int j = 0; j < 4; ++j) {
            if (s - 3 + j >= 0) {
                float f[8]; unpack8(*(const u32x4*)(QKRAW + (size_t)(t - 3 + j) * D + c0), f);
#pragma unroll
                for (int e = 0; e < 8; ++e) acc[e] += f[e] * C.conv_w[j * D + c0 + e];
            }
        }
        const float sc = (c0 < 512) ? 0.08838834764831845f : 1.0f;
#pragma unroll
        for (int e = 0; e < 8; ++e) acc[e] = siluf_(acc[e]) * sc;
        *(u32x4*)(QC + (size_t)t * D + c0) = pack8(acc);
    }
#if !OPT_INPROJ
    const float* COS = (const float*)(C.ws + WS_COS); const float* SIN = (const float*)(C.ws + WS_SIN);
    for (int idx = C.bid * NTHR + C.tid; idx < T * 64; idx += C.G * NTHR) {
        const int t = idx >> 6, r = idx & 63, which = r >> 5, h = (r >> 3) & 3, i0 = (r & 7) * 8;
        bf16* base = (bf16*)(C.ws + (which ? WS_RETK : WS_RETQ)) + (size_t)t * 512 + h * 128;
        float x1[8], x2[8], o1[8], o2[8]; unpack8(*(const u32x4*)(base + i0), x1); unpack8(*(const u32x4*)(base + 64 + i0), x2);
        const float sc = which ? 0.08838834764831845f : 1.0f;
#pragma unroll
        for (int e = 0; e < 8; ++e) { const float cs = COS[t * 64 + i0 + e], sn = SIN[t * 64 + i0 + e]; o1[e] = (x1[e] * cs - x2[e] * sn) * sc; o2[e] = (x2[e] * cs + x1[e] * sn) * sc; }
        *(u32x4*)(base + i0) = pack8(o1); *(u32x4*)(base + 64 + i0) = pack8(o2);
    }
#endif
}

DI float ret_lg(int h) { return logf(1.0f - exp2f(-5.0f - (float)h)); }

DI void phase_local(Ctx& C) {
    LAS float* lf = (LAS float*)C.lds; LAS float* a = lf + 128; LAS float* ws = a + 128; LAS float* red = ws + 128;
    const float* IFG = (const float*)(C.ws + WS_IFG);
    bf16* CLOC = (bf16*)(C.ws + WS_CLOC);
    float* NLOC = (float*)(C.ws + WS_SMALL + SM_NLOC); float* MLOC = (float*)(C.ws + WS_SMALL + SM_MLOC); float* ACH = (float*)(C.ws + WS_SMALL + SM_ACH);
    const int t = C.tid;
    for (int u = C.bid; u < 1024; u += C.G) {
        const int mixer = u >> 9, bh = (u >> 5) & 15, ch = u & 31, b = bh >> 2, h = bh & 3, t0 = b * SEQ + ch * CH;
        const bf16 *Kp, *Vp; int ldk;
        if (mixer == 0) {
            if (t < 128) lf[t] = logsigmoidf_(IFG[(size_t)(t0 + t) * 8 + 4 + h]);
            __syncthreads();
            if (t < 128) { float s = 0.f; for (int j = 0; j <= t; ++j) s += lf[j]; a[t] = s; }
            __syncthreads();
            const float A = a[127];
            if (t < 128) ws[t] = A - a[t] + IFG[(size_t)(t0 + t) * 8 + h];
            __syncthreads();
            float mloc = -3.0e38f; for (int j = 0; j < 128; ++j) mloc = fmaxf(mloc, ws[j]);
            __syncthreads();
            if (t < 128) ws[t] = __expf(ws[t] - mloc);
            if (t == 0) { MLOC[bh * 32 + ch] = mloc; ACH[bh * 32 + ch] = A; }
            __syncthreads();
            Kp = (const bf16*)(C.ws + WS_QC) + (size_t)t0 * D + 512 + h * 128; ldk = D;
            Vp = (const bf16*)(C.ws + WS_MLV) + (size_t)t0 * D + h * 256;
        } else {
            const float lg = ret_lg(h);
            if (t < 128) ws[t] = __expf(lg * (float)(127 - t));
            __syncthreads();
            Kp = (const bf16*)(C.ws + WS_RETK) + (size_t)t0 * 512 + h * 128; ldk = 512;
            Vp = (const bf16*)(C.ws + WS_RETV) + (size_t)t0 * D + h * 256;
        }
        const int kh = t >> 8, v = t & 255;
        float acc[64];
#pragma unroll
        for (int i = 0; i < 64; ++i) acc[i] = 0.f;
        for (int s = 0; s < 128; ++s) {
            const float vv = ws[s] * bf2f(Vp[(size_t)s * D + v]);
            const bf16* kr = Kp + (size_t)s * ldk + kh * 64;
#pragma unroll
            for (int i8 = 0; i8 < 8; ++i8) { float f[8]; unpack8(*(const u32x4*)(kr + i8 * 8), f);
#pragma unroll
                for (int e = 0; e < 8; ++e) acc[i8 * 8 + e] += f[e] * vv; }
        }
        bf16* cl = CLOC + ((size_t)(mixer * 16 + bh) * 32 + ch) * 32768;
#pragma unroll
        for (int i = 0; i < 64; ++i) cl[(size_t)(kh * 64 + i) * 256 + v] = (bf16)f2bf(acc[i]);
        if (mixer == 0 && t < 128) { float s = 0.f; for (int j = 0; j < 128; ++j) s += ws[j] * bf2f(Kp[(size_t)j * ldk + t]); NLOC[(bh * 32 + ch) * 128 + t] = s; }
        __syncthreads();
    }
    (void)red;
}

DI void phase_scan(Ctx& C) {
    const bf16* CLOC = (const bf16*)(C.ws + WS_CLOC); bf16* CPREV = (bf16*)(C.ws + WS_CPREV);
    const float* NLOC = (const float*)(C.ws + WS_SMALL + SM_NLOC); float* NPREV = (float*)(C.ws + WS_SMALL + SM_NPREV);
    const float* MLOC = (const float*)(C.ws + WS_SMALL + SM_MLOC); const float* ACH = (const float*)(C.ws + WS_SMALL + SM_ACH); float* MPREV = (float*)(C.ws + WS_SMALL + SM_MPREV);
    for (int idx = C.bid * NTHR + C.tid; idx < 32 * 4096; idx += C.G * NTHR) {
        const int seq = idx >> 12, e8 = idx & 4095;
        float st[8];
#pragma unroll
        for (int e = 0; e < 8; ++e) st[e] = 0.f;
        if (seq < 16) {
            float m_st = 0.f; float nst[8];
#pragma unroll
            for (int e = 0; e < 8; ++e) nst[e] = 0.f;
            for (int ch = 0; ch < 32; ++ch) {
                const size_t o = ((size_t)seq * 32 + ch) * 32768 + (size_t)e8 * 8;
                *(u32x4*)(CPREV + o) = pack8(st);
                if (e8 < 16) { *(f32x4*)(NPREV + (seq * 32 + ch) * 128 + e8 * 8) = (f32x4){nst[0], nst[1], nst[2], nst[3]}; *(f32x4*)(NPREV + (seq * 32 + ch) * 128 + e8 * 8 + 4) = (f32x4){nst[4], nst[5], nst[6], nst[7]}; }
                if (e8 == 0) MPREV[seq * 32 + ch] = m_st;
                const float A = ACH[seq * 32 + ch], ml = MLOC[seq * 32 + ch];
                const float m_new = fmaxf(A + m_st, ml), sp = __expf(A + m_st - m_new), sl = __expf(ml - m_new);
                float f[8]; unpack8(*(const u32x4*)(CLOC + o), f);
#pragma unroll
                for (int e = 0; e < 8; ++e) st[e] = sp * st[e] + sl * f[e];
                if (e8 < 16) { const float* nl = NLOC + (seq * 32 + ch) * 128 + e8 * 8;
#pragma unroll
                    for (int e = 0; e < 8; ++e) nst[e] = sp * nst[e] + sl * nl[e]; }
                m_st = m_new;
            }
        } else {
            const float g = __expf(ret_lg(seq & 3) * 128.0f);
            for (int ch = 0; ch < 32; ++ch) {
                const size_t o = ((size_t)seq * 32 + ch) * 32768 + (size_t)e8 * 8;
                *(u32x4*)(CPREV + o) = pack8(st);
                float f[8]; unpack8(*(const u32x4*)(CLOC + o), f);
#pragma unroll
                for (int e = 0; e < 8; ++e) st[e] = g * st[e] + f[e];
            }
        }
    }
}

DI void phase_out(Ctx& C) {
    LAS float* av = (LAS float*)C.lds;
    LAS float* bv = av + 128;
    LAS float* mt = bv + 128;
    LAS float* isc = mt + 128;
    LAS float* den = isc + 128;
    LAS float* rs = den + 128;
    LAS float* P = rs + 1024;
    LAS float* Qs = P + 128 * 129;
    const float* IFG = (const float*)(C.ws + WS_IFG);
    const bf16* CPREV = (const bf16*)(C.ws + WS_CPREV);
    const float* NPREV = (const float*)(C.ws + WS_SMALL + SM_NPREV); const float* MPREV = (const float*)(C.ws + WS_SMALL + SM_MPREV);
    const int t = C.tid;
    for (int u = C.bid; u < 1024; u += C.G) {
        const int mixer = u >> 9, bh = (u >> 5) & 15, ch = u & 31, b = bh >> 2, h = bh & 3, t0 = b * SEQ + ch * CH;
        const bf16 *Qp, *Kp, *Vp; int ldq; const bf16* cp = CPREV + ((size_t)(mixer * 16 + bh) * 32 + ch) * 32768;
        float lg = 0.f;
        if (mixer == 0) {
            Qp = (const bf16*)(C.ws + WS_QC) + (size_t)t0 * D + h * 128; Kp = Qp + 512; ldq = D;
            Vp = (const bf16*)(C.ws + WS_MLV) + (size_t)t0 * D + h * 256;
            if (t < 128) mt[t] = logsigmoidf_(IFG[(size_t)(t0 + t) * 8 + 4 + h]);
            __syncthreads();
            if (t < 128) { float s = 0.f; for (int j = 0; j <= t; ++j) s += mt[j]; av[t] = s; bv[t] = IFG[(size_t)(t0 + t) * 8 + h] - s; }
            __syncthreads();
            if (t < 128) { float cm = -3.0e38f; for (int j = 0; j <= t; ++j) cm = fmaxf(cm, bv[j]);
                const float il = av[t] + MPREV[bh * 32 + ch], m = fmaxf(il, av[t] + cm); isc[t] = __expf(il - m); mt[t] = m; }
        } else {
            lg = ret_lg(h);
            Qp = (const bf16*)(C.ws + WS_RETQ) + (size_t)t0 * 512 + h * 128; Kp = (const bf16*)(C.ws + WS_RETK) + (size_t)t0 * 512 + h * 128; ldq = 512;
            Vp = (const bf16*)(C.ws + WS_RETV) + (size_t)t0 * D + h * 256;
            if (t < 128) isc[t] = __expf(lg * (float)(t + 1));
        }
        for (int e = t; e < 128 * 16; e += NTHR) { const int j = e >> 4, k8 = e & 15; float f[8]; unpack8(*(const u32x4*)(Qp + (size_t)j * ldq + k8 * 8), f);
#pragma unroll
            for (int i = 0; i < 8; ++i) Qs[j * 129 + k8 * 8 + i] = f[i]; }
        __syncthreads();
        for (int e = t; e < 128 * 128; e += NTHR) {
            const int j = e >> 7, s = e & 127; float p = 0.f;
            if (s <= j) {
                float d = 0.f;
#pragma unroll 4
                for (int k8 = 0; k8 < 16; ++k8) { float fk[8]; unpack8(*(const u32x4*)(Kp + (size_t)s * ldq + k8 * 8), fk);
#pragma unroll
                    for (int i = 0; i < 8; ++i) d += Qs[j * 129 + k8 * 8 + i] * fk[i]; }
                p = d * (mixer == 0 ? __expf(av[j] + bv[s] - mt[j]) : __expf(lg * (float)(j - s)));
            }
            P[j * 129 + s] = p;
        }
        __syncthreads();
        if (mixer == 0 && t < 128) { float s = 0.f; for (int i = 0; i < 128; ++i) s += P[t * 129 + i];
            float qn = 0.f; const float* np = NPREV + (bh * 32 + ch) * 128; for (int k = 0; k < 128; ++k) qn += Qs[t * 129 + k] * np[k];
            den[t] = fmaxf(fabsf(s + isc[t] * qn), __expf(-mt[t])); }
        __syncthreads();
        const float gain = (mixer == 0 ? C.ml_norm_g : C.ret_norm_g)[h * 256 + (t & 255)];
#pragma unroll 1
        for (int pass = 0; pass < 2; ++pass) {
            const int jh = t >> 8, v = t & 255, r0 = (pass * 2 + jh) * 32;
            float acc[32];
#pragma unroll
            for (int i = 0; i < 32; ++i) acc[i] = 0.f;
            const LAS float* qb = Qs + r0 * 129; const LAS float* pb = P + r0 * 129;
            for (int k = 0; k < 128; ++k) {
                const float cv = bf2f(cp[(size_t)k * 256 + v]);
#pragma unroll
                for (int i = 0; i < 32; ++i) acc[i] += qb[i * 129 + k] * cv;
            }
#pragma unroll
            for (int i = 0; i < 32; ++i) acc[i] *= isc[r0 + i];
            for (int s = 0; s < 128; ++s) {
                const float vv = bf2f(Vp[(size_t)s * D + v]);
#pragma unroll
                for (int i = 0; i < 32; ++i) acc[i] += pb[i * 129 + s] * vv;
            }
            if (mixer == 0) {
#pragma unroll
                for (int i = 0; i < 32; ++i) acc[i] = acc[i] / den[r0 + i];
            }
            const int wq = C.wave & 3;
#pragma unroll
            for (int i = 0; i < 32; ++i) { const float s1 = wave_sum(acc[i]); if (C.lane == 0) rs[wq * 128 + r0 + i] = s1; }
            __syncthreads();
#pragma unroll
            for (int i = 0; i < 32; ++i) { const int r = r0 + i; acc[i] -= (rs[r] + rs[128 + r] + rs[256 + r] + rs[384 + r]) * (1.0f / 256.0f); }
#pragma unroll
            for (int i = 0; i < 32; ++i) { const float s2 = wave_sum(acc[i] * acc[i]); if (C.lane == 0) rs[512 + wq * 128 + r0 + i] = s2; }
            __syncthreads();
            const bf16* gate = (const bf16*)(C.ws + (mixer == 0 ? WS_MLO : WS_RETG)) + (size_t)t0 * D + h * 256 + v;
            bf16* outp = (bf16*)(C.ws + (mixer == 0 ? WS_HML : WS_HRET)) + (size_t)t0 * D + h * 256 + v;
#pragma unroll
            for (int i = 0; i < 32; ++i) { const int r = r0 + i;
                const float var = (rs[512 + r] + rs[512 + 128 + r] + rs[512 + 256 + r] + rs[512 + 384 + r]) * (1.0f / 256.0f);
                const float y = acc[i] * (1.0f / sqrtf(var + EPS)) * gain * bf2f(gate[(size_t)r * D]);
                outp[(size_t)r * D] = (bf16)f2bf(y); }
            __syncthreads();
        }
    }
}

struct BF_plain { const float* w; DI const float* ptr(int, int tn) const { return w + tn * 128; } };
struct EF_f32 { float* dst; DI void put(int tm, int tn, int r, int c, const float (&v)[4]) const { *(f32x4*)(dst + (size_t)(tm * 128 + r) * D + tn * 128 + c) = (f32x4){v[0], v[1], v[2], v[3]}; } };
struct EF_merge { const float* t1; const bf16* g1; const bf16* g2; bf16* y;
    DI void put(int tm, int tn, int r, int c, const float (&v)[4]) const {
        const size_t o = (size_t)(tm * 128 + r) * D + tn * 128 + c; const f32x4 a = *(const f32x4*)(t1 + o);
        const u32x2 w1 = *(const u32x2*)(g1 + o), w2 = *(const u32x2*)(g2 + o);
        const float o0 = __uint_as_float(w1.x << 16) * a.x + __uint_as_float(w2.x << 16) * v[0], o1 = __uint_as_float(w1.x & 0xffff0000u) * a.y + __uint_as_float(w2.x & 0xffff0000u) * v[1];
        const float o2 = __uint_as_float(w1.y << 16) * a.z + __uint_as_float(w2.y << 16) * v[2], o3 = __uint_as_float(w1.y & 0xffff0000u) * a.w + __uint_as_float(w2.y & 0xffff0000u) * v[3];
        u32x2 w; w.x = pk2(o0, o1); w.y = pk2(o2, o3); *(u32x2*)(y + o) = w; } };
DI void phase_branch(Ctx& C) {
    AF_rows a1{(const bf16*)(C.ws + WS_HML), D}, a2{(const bf16*)(C.ws + WS_HRET), D}; BF_plain b1{C.w_bml}, b2{C.w_bret};
    EF_f32 e1{(float*)(C.ws + WS_TMP)}; EF_merge e2{(const float*)(C.ws + WS_TMP), (const bf16*)(C.ws + WS_GML), (const bf16*)(C.ws + WS_GRET), (bf16*)(C.ws + WS_H1)};
    const int nt = (T / 128) * 8;
    for (int u = C.bid; u < nt; u += C.G) { naive_gemm_tile(C, u / 8, u % 8, D, D, a1, b1, e1); naive_gemm_tile(C, u / 8, u % 8, D, D, a2, b2, e2); }
}
struct EF_resid { const float* x; const float* mod; float* x1;
    DI void put(int tm, int tn, int r, int c, const float (&v)[4]) const {
        const int row = tm * 128 + r, col = tn * 128 + c, b = row / SEQ; const size_t o = (size_t)row * D + col;
        const f32x4 xv = *(const f32x4*)(x + o), g = *(const f32x4*)(mod + b * 6144 + 2048 + col);
        *(f32x4*)(x1 + o) = xv + g * (f32x4){v[0], v[1], v[2], v[3]}; } };
DI void phase_outproj(Ctx& C) {
    AF_rows a{(const bf16*)(C.ws + WS_H1), D}; BF_plain b{C.w_out}; EF_resid e{C.x, (const float*)(C.ws + WS_MOD), (float*)(C.ws + WS_X1)};
    const int nt = (T / 128) * 8;
    for (int u = C.bid; u < nt; u += C.G) naive_gemm_tile(C, u / 8, u % 8, D, D, a, b, e);
}

DI void phase_norm2_route(Ctx& C) {
    LAS float* wr = (LAS float*)C.lds;
    LAS float* lg = wr + 32768;
    for (int i = C.tid; i < 32768 / 4; i += NTHR) *(LAS f32x4*)(wr + i * 4) = *(const f32x4*)(C.w_router + i * 4);
    __syncthreads();
    const float* mod = (const float*)(C.ws + WS_MOD); const float* X1 = (const float*)(C.ws + WS_X1);
    bf16* H2 = (bf16*)(C.ws + WS_H1);
    int* TOPI = (int*)(C.ws + WS_ROUTE + RT_TOPI); float* TOPW = (float*)(C.ws + WS_ROUTE + RT_TOPW); int* RANK = (int*)(C.ws + WS_ROUTE + RT_RANK);
    unsigned* CNT = (unsigned*)(C.ws + WS_CTL) + CW_CNT;
    const int lane = C.lane, gw = C.bid * NWAVES + C.wave, NGW = C.G * NWAVES;
    for (int m = gw; m < T; m += NGW) {
        const int b = m / SEQ;
        const f32x4* xr = (const f32x4*)(X1 + (size_t)m * D) + lane;
        f32x4 v[4]; float ss = 0.f;
#pragma unroll
        for (int j = 0; j < 4; ++j) { v[j] = xr[64 * j]; ss += (v[j].x * v[j].x + v[j].y * v[j].y) + (v[j].z * v[j].z + v[j].w * v[j].w); }
        const float rstd = 1.0f / sqrtf(wave_sum(ss) * (1.0f / D) + EPS);
        float acc[32];
#pragma unroll
        for (int e = 0; e < 32; ++e) acc[e] = 0.f;
        u32x2* o8 = (u32x2*)(H2 + (size_t)m * D) + lane;
#pragma unroll
        for (int j = 0; j < 4; ++j) {
            const int col = 4 * (lane + 64 * j);
            const f32x4 g = *(const f32x4*)(C.norm_ffn_g + col), sh = *(const f32x4*)(mod + b * 6144 + 3072 + col), sc = *(const f32x4*)(mod + b * 6144 + 4096 + col);
            const f32x4 h = (v[j] * rstd * g) * (sc + 1.0f) + sh;
            u32x2 w; w.x = pk2(h.x, h.y); w.y = pk2(h.z, h.w); o8[64 * j] = w;
            const float hh[4] = {h.x, h.y, h.z, h.w};
#pragma unroll
            for (int i = 0; i < 4; ++i) {
                const LAS f32x4* wp = (const LAS f32x4*)(wr + (col + i) * 32);
#pragma unroll
                for (int e4 = 0; e4 < 8; ++e4) { const f32x4 w4 = wp[e4]; acc[e4 * 4 + 0] += hh[i] * w4.x; acc[e4 * 4 + 1] += hh[i] * w4.y; acc[e4 * 4 + 2] += hh[i] * w4.z; acc[e4 * 4 + 3] += hh[i] * w4.w; }
                asm volatile("" ::: "memory");
            }
        }
#pragma unroll
        for (int e = 0; e < 32; ++e) acc[e] = wave_sum(acc[e]);
        float l[32];
#pragma unroll
        for (int e = 0; e < 32; ++e) l[e] = acc[e] + C.b_router[e];
        float tv[4]; int ti[4];
#pragma unroll
        for (int k = 0; k < 4; ++k) {
            float bvv = -3.0e38f; int bi = 0;
#pragma unroll
            for (int e = 0; e < 32; ++e) { const bool take = l[e] > bvv; bvv = take ? l[e] : bvv; bi = take ? e : bi; }
            tv[k] = bvv; ti[k] = bi;
#pragma unroll
            for (int e = 0; e < 32; ++e) l[e] = (e == bi) ? -3.0e38f : l[e];
        }
        const float e1 = __expf(tv[1] - tv[0]), e2 = __expf(tv[2] - tv[0]), e3 = __expf(tv[3] - tv[0]), inv = 1.0f / (1.0f + e1 + e2 + e3);
        if (lane < 4) {
            const int e = lane == 0 ? ti[0] : lane == 1 ? ti[1] : lane == 2 ? ti[2] : ti[3];
            const float w = (lane == 0 ? 1.0f : lane == 1 ? e1 : lane == 2 ? e2 : e3) * inv;
            TOPI[m * 4 + lane] = e; TOPW[m * 4 + lane] = w; RANK[m * 4 + lane] = (int)atomicAdd(CNT + e, 1u);
        }
    }
    (void)lg;
    int* SLOTTOK = (int*)(C.ws + WS_ROUTE + RT_SLOTTOK); float* SLOTW = (float*)(C.ws + WS_ROUTE + RT_SLOTW);
    for (int i = C.bid * NTHR + C.tid; i < NSLOTS; i += C.G * NTHR) { SLOTTOK[i] = T; SLOTW[i] = 0.f; }
    if (C.bid == 0) for (int i = C.tid; i < D / 2; i += NTHR) ((unsigned*)(H2 + (size_t)T * D))[i] = 0u;
    __syncthreads();
}

DI void phase_slots(Ctx& C) {
    LAS int* pstart = (LAS int*)C.lds;
    unsigned* CNT = (unsigned*)(C.ws + WS_CTL) + CW_CNT;
    unsigned* ctl = (unsigned*)(C.ws + WS_CTL);
    if (C.tid == 0) {
        int nb = 0;
        for (int e = 0; e < NE; ++e) { pstart[e] = nb * 256; const int bl = ((int)__hip_atomic_load(CNT + e, __ATOMIC_RELAXED, __HIP_MEMORY_SCOPE_AGENT) + 255) >> 8;
            if (C.bid == 0) for (int i = 0; i < bl; ++i) ctl[CW_BLKE + nb + i] = (unsigned)e;
            nb += bl; }
        if (C.bid == 0) ctl[CW_NBLK] = (unsigned)nb;
    }
    __syncthreads();
    const int* TOPI = (const int*)(C.ws + WS_ROUTE + RT_TOPI); const float* TOPW = (const float*)(C.ws + WS_ROUTE + RT_TOPW); const int* RANK = (const int*)(C.ws + WS_ROUTE + RT_RANK);
    int* ASLOT = (int*)(C.ws + WS_ROUTE + RT_ASLOT); int* SLOTTOK = (int*)(C.ws + WS_ROUTE + RT_SLOTTOK); float* SLOTW = (float*)(C.ws + WS_ROUTE + RT_SLOTW);
    for (int i = C.bid * NTHR + C.tid; i < T * 4; i += C.G * NTHR) {
        const int slot = pstart[TOPI[i]] + RANK[i];
        ASLOT[i] = slot; SLOTTOK[slot] = i >> 2; SLOTW[slot] = TOPW[i];
    }
    __syncthreads();
}

struct AF_gather { const bf16* base; const int* slottok; DI const bf16* row(int tm, int r) const { return base + (size_t)slottok[tm * 128 + r] * D; } };
struct BF_expert { const float* w; const unsigned* blke; size_t estride; DI const float* ptr(int tm, int tn) const { return w + (size_t)blke[tm >> 1] * estride + tn * 128; } };
struct EF_swiglu { const float* bias; const unsigned* blke; bf16* act;
    DI void put(int tm, int tn, int r, int c, const float (&v)[4]) const {
        const int e = (int)blke[tm >> 1]; const float* bp = bias + (size_t)e * 2048 + tn * 128 + c;
        float o[2];
#pragma unroll
        for (int j = 0; j < 2; ++j) { const float xg = fminf(v[2 * j] + bp[2 * j], 7.0f), xl = fminf(fmaxf(v[2 * j + 1] + bp[2 * j + 1], -7.0f), 7.0f); o[j] = xg * sigmoidf_(1.702f * xg) * (xl + 1.0f); }
        *(unsigned*)(act + (size_t)(tm * 128 + r) * D + (tn * 128 + c) / 2) = pk2(o[0], o[1]); } };
DI void phase_gateup(Ctx& C) {
    const unsigned* ctl = (const unsigned*)(C.ws + WS_CTL); const int nblk = (int)ctl[CW_NBLK];
    AF_gather a{(const bf16*)(C.ws + WS_H1), (const int*)(C.ws + WS_ROUTE + RT_SLOTTOK)}; BF_expert b{C.w_gu, ctl + CW_BLKE, (size_t)D * 2048};
    EF_swiglu e{C.b_gu, ctl + CW_BLKE, (bf16*)(C.ws + WS_ACT)};
    const int nt = nblk * 2 * 16;
    for (int u = C.bid; u < nt; u += C.G) naive_gemm_tile(C, u / 16, u % 16, D, 2048, a, b, e);
}
struct EF_down { const float* bias; const unsigned* blke; const float* slotw; bf16* ys;
    DI void put(int tm, int tn, int r, int c, const float (&v)[4]) const {
        const int e = (int)blke[tm >> 1], slot = tm * 128 + r; const float w = slotw[slot]; const float* bp = bias + (size_t)e * D + tn * 128 + c;
        u32x2 o; o.x = pk2((v[0] + bp[0]) * w, (v[1] + bp[1]) * w); o.y = pk2((v[2] + bp[2]) * w, (v[3] + bp[3]) * w);
        *(u32x2*)(ys + (size_t)slot * D + tn * 128 + c) = o; } };
DI void phase_down(Ctx& C) {
    const unsigned* ctl = (const unsigned*)(C.ws + WS_CTL); const int nblk = (int)ctl[CW_NBLK];
    AF_rows a{(const bf16*)(C.ws + WS_ACT), D}; BF_expert b{C.w_dn, ctl + CW_BLKE, (size_t)D * D};
    EF_down e{C.b_dn, ctl + CW_BLKE, (const float*)(C.ws + WS_ROUTE + RT_SLOTW), (bf16*)(C.ws + WS_YS)};
    const int nt = nblk * 2 * 8;
    for (int u = C.bid; u < nt; u += C.G) naive_gemm_tile(C, u / 8, u % 8, D, D, a, b, e);
}
DI void phase_final(Ctx& C) {
    const float* mod = (const float*)(C.ws + WS_MOD); const float* X1 = (const float*)(C.ws + WS_X1); const bf16* YS = (const bf16*)(C.ws + WS_YS);
    const int* ASLOT = (const int*)(C.ws + WS_ROUTE + RT_ASLOT);
    const int lane = C.lane, gw = C.bid * NWAVES + C.wave, NGW = C.G * NWAVES;
    for (int m = gw; m < T; m += NGW) {
        const int b = m / SEQ;
        const int s0 = ASLOT[m * 4 + 0], s1 = ASLOT[m * 4 + 1], s2 = ASLOT[m * 4 + 2], s3 = ASLOT[m * 4 + 3];
        f32x4 v[4]; float ss = 0.f;
#pragma unroll
        for (int j = 0; j < 4; ++j) {
            const int col = 4 * (lane + 64 * j);
            f32x4 y = (f32x4){0.f, 0.f, 0.f, 0.f};
            const int sl[4] = {s0, s1, s2, s3};
#pragma unroll
            for (int k = 0; k < 4; ++k) { const u32x2 w = *(const u32x2*)(YS + (size_t)sl[k] * D + col);
                y += (f32x4){__uint_as_float(w.x << 16), __uint_as_float(w.x & 0xffff0000u), __uint_as_float(w.y << 16), __uint_as_float(w.y & 0xffff0000u)}; }
            const f32x4 g = *(const f32x4*)(mod + b * 6144 + 5120 + col);
            v[j] = *(const f32x4*)(X1 + (size_t)m * D + col) + g * y;
            ss += (v[j].x * v[j].x + v[j].y * v[j].y) + (v[j].z * v[j].z + v[j].w * v[j].w);
        }
        const float rstd = 1.0f / sqrtf(wave_sum(ss) * (1.0f / D) + EPS);
#pragma unroll
        for (int j = 0; j < 4; ++j) { const int col = 4 * (lane + 64 * j); *(f32x4*)(C.out + (size_t)m * D + col) = v[j] * rstd * *(const f32x4*)(C.norm_final_g + col); }
    }
}

namespace pg8 {
typedef short bf16x8 __attribute__((ext_vector_type(8)));
constexpr int BM = 256, BK = 64, HALF = 128, HTB = HALF * BK * 2, STAGE_BYTES = 8 * HTB, NXCD = 8, WGM = 8;
DI int lds_byte(int r, int c) { const int st = (r >> 4) * 2 + (c >> 5), rr = r & 15, cc = c & 31, ob = rr * 64 + cc * 2; return st * 1024 + (ob ^ (((ob >> 9) & 1) << 5)); }
DI void stage_rc(int b, int& R, int& C) { const int st = b / 1024, sb = b % 1024, swz = sb ^ (((sb >> 9) & 1) << 5); R = (st >> 1) * 16 + swz / 64; C = (st & 1) * 32 + (swz % 64) / 2; }
struct Unit { int pm, pn, aux; };
struct Gemm { const bf16* A; const bf16* Bt; int K; };
DI unsigned cvt_pk_bf16(float lo, float hi) { unsigned r; asm volatile("v_cvt_pk_bf16_f32 %0, %1, %2" : "=v"(r) : "v"(lo), "v"(hi)); return r; }

struct TileOrder {
    int nM, nN, nwg;
    DI void init(int nM_, int nN_) { nM = nM_; nN = nN_; nwg = nM * nN; }
    DI bool tile(long L, int& pm, int& pn) const {
        if (L >= nwg) return false;
        int wgid = (int)L; { const int q = nwg / NXCD, r = nwg % NXCD, xcd = wgid % NXCD, off = wgid / NXCD; wgid = (xcd < r ? xcd * (q + 1) : r * (q + 1) + (xcd - r) * q) + off; }
        const int nig = WGM * nN, gid = wgid / nig, fm = gid * WGM, gsz = (nM - fm) < WGM ? (nM - fm) : WGM;
        pm = fm + ((wgid % nig) % gsz); pn = (wgid % nig) / gsz; return true;
    }
};

template <class Epi, class Sched, bool ALIGN_EPI, bool SP2>
DI void gemm_phase(LAS unsigned char* lds, const Gemm g, const Sched& S, const Epi& E) {
    const int tid = threadIdx.x, wid = __builtin_amdgcn_readfirstlane(tid >> 6), lane = tid & 63, wr = wid >> 2, wc = wid & 3, fr = lane & 15, fq = lane >> 4;
    const int K = g.K, nt = K / BK;
    unsigned voffB[2]; int Rr[2]; unsigned cb[2];
#pragma unroll
    for (int i = 0; i < 2; ++i) { int R, C; stage_rc(tid * 16 + i * 8192, R, C); voffB[i] = (unsigned)(R * K + C) * 2u; Rr[i] = R; cb[i] = (unsigned)C * 2u; }
    const size_t kstep = (size_t)(BK * 2);
    const size_t hstep = (size_t)HALF * K * 2;
    const size_t tstep = 2 * hstep;
    const unsigned ldsw = (unsigned)wid * 1024u;
    const int aoff = lds_byte(wr * 64 + fr, fq * 8), boff = lds_byte(wc * 32 + fr, fq * 8);
    const unsigned rowb = (unsigned)K * 2u;
#define PG8_SA(b, h) (((b) * 2 + (h)) * HTB)
#define PG8_SB(b, h) ((4 + (b) * 2 + (h)) * HTB)
#define PG8_STAGE(bufoff, gbase, voff) do { _Pragma("unroll") for (int _i = 0; _i < 2; ++_i) \
        __builtin_amdgcn_global_load_lds((const unsigned*)((const char*)(gbase) + (voff)[_i]), (LAS unsigned*)(lds + (bufoff) + ldsw + _i * 8192), 16, 0, 0); } while (0)
#define PG8_LDA(dst, b, h) do { _Pragma("unroll") for (int m = 0; m < 4; ++m) _Pragma("unroll") for (int k = 0; k < 2; ++k) dst[m][k] = *(const LAS bf16x8*)(lds + PG8_SA(b, h) + aoff + m * 2048 + k * 1024); } while (0)
#define PG8_LDB(dst, b, h) do { _Pragma("unroll") for (int n = 0; n < 2; ++n) _Pragma("unroll") for (int k = 0; k < 2; ++k) dst[n][k] = *(const LAS bf16x8*)(lds + PG8_SB(b, h) + boff + n * 2048 + k * 1024); } while (0)
#define PG8_MMA(ai, bj, At, Bt) do { __builtin_amdgcn_s_setprio(1); _Pragma("unroll") for (int m = 0; m < 4; ++m) _Pragma("unroll") for (int n = 0; n < 2; ++n) _Pragma("unroll") for (int k = 0; k < 2; ++k) \
        acc[ai][bj][m][n] = __builtin_amdgcn_mfma_f32_16x16x32_bf16(Bt[n][k], At[m][k], acc[ai][bj][m][n], 0, 0, 0); __builtin_amdgcn_s_setprio(0); } while (0)
#define PG8_WAIT_V(n) asm volatile("s_waitcnt vmcnt(" #n ")" ::: "memory")
#define PG8_WAIT_L(n) asm volatile("s_waitcnt lgkmcnt(" #n ")" ::: "memory")
#define PG8_BAR __builtin_amdgcn_s_barrier()
#define PG8_SCHED __builtin_amdgcn_sched_barrier(0)
    Unit cur, nxt; int ui = 0;
    if (!S.next(0, cur)) return;
    f32x4 acc[2][2][4][2];
#pragma unroll
    for (int a = 0; a < 2; ++a)
#pragma unroll
        for (int b = 0; b < 2; ++b)
#pragma unroll
            for (int m = 0; m < 4; ++m)
#pragma unroll
                for (int n = 0; n < 2; ++n) acc[a][b][m][n] = (f32x4){0.f, 0.f, 0.f, 0.f};
    bf16x8 At[4][2], B0[2][2], B1[2][2];
    const char* Ab = (const char*)g.A;
    const char* cB = (const char*)g.Bt + (size_t)cur.pn * tstep;
    unsigned c0[2], c1[2], n0[2], n1[2];
#pragma unroll
    for (int i = 0; i < 2; ++i) { c0[i] = (unsigned)S.arow(cur, Rr[i]) * rowb + cb[i]; c1[i] = (unsigned)S.arow(cur, HALF + Rr[i]) * rowb + cb[i]; n0[i] = c0[i]; n1[i] = c1[i]; }
    if constexpr (SP2) {
        PG8_STAGE(PG8_SB(0, 0), cB, voffB); PG8_STAGE(PG8_SB(0, 1), cB + hstep, voffB); PG8_STAGE(PG8_SA(0, 0), Ab, c0); PG8_STAGE(PG8_SA(0, 1), Ab, c1);
        if (wr == 1) PG8_BAR;
        PG8_WAIT_V(2); PG8_BAR;
        PG8_STAGE(PG8_SB(1, 0), cB + kstep, voffB); PG8_STAGE(PG8_SA(1, 0), Ab + kstep, c0); PG8_STAGE(PG8_SB(1, 1), cB + hstep + kstep, voffB);
        PG8_WAIT_V(6); PG8_BAR;
    } else {
        PG8_STAGE(PG8_SB(0, 0), cB, voffB); PG8_STAGE(PG8_SA(0, 0), Ab, c0); PG8_STAGE(PG8_SB(0, 1), cB + hstep, voffB); PG8_STAGE(PG8_SA(0, 1), Ab, c1);
        if (wr == 1) PG8_BAR;
        PG8_WAIT_V(4); PG8_BAR;
        PG8_STAGE(PG8_SB(1, 0), cB + kstep, voffB); PG8_STAGE(PG8_SA(1, 0), Ab + kstep, c0); PG8_STAGE(PG8_SB(1, 1), cB + hstep + kstep, voffB);
        PG8_WAIT_V(6); PG8_BAR;
    }
    for (;;) {
        const bool has_next = S.next(ui + 1, nxt);
        const char* nB = has_next ? (const char*)g.Bt + (size_t)nxt.pn * tstep : cB;
        if (has_next) {
#pragma unroll
            for (int i = 0; i < 2; ++i) { n0[i] = (unsigned)S.arow(nxt, Rr[i]) * rowb + cb[i]; n1[i] = (unsigned)S.arow(nxt, HALF + Rr[i]) * rowb + cb[i]; }
        } else {
#pragma unroll
            for (int i = 0; i < 2; ++i) { n0[i] = c0[i]; n1[i] = c1[i]; }
        }
        for (int t = 0; t < nt; t += 2) {
            const bool last = (t == nt - 2);
            const char* a1 = Ab + (size_t)(t + 1) * kstep;
            const char* a2 = last ? Ab : Ab + (size_t)(t + 2) * kstep; const char* b2 = last ? nB : cB + (size_t)(t + 2) * kstep;
            const char* a3 = a2 + kstep; const char* b3 = b2 + kstep;
            unsigned x0[2], x1[2];
#pragma unroll
            for (int i = 0; i < 2; ++i) { x0[i] = last ? n0[i] : c0[i]; x1[i] = last ? n1[i] : c1[i]; }
            if constexpr (SP2) {
            PG8_LDB(B0, 0, 0); PG8_LDB(B1, 0, 1); PG8_SCHED; PG8_LDA(At, 0, 0); PG8_STAGE(PG8_SA(1, 1), a1, c1);
            PG8_WAIT_V(8); PG8_WAIT_L(0); PG8_BAR; PG8_MMA(0, 0, At, B0); PG8_MMA(0, 1, At, B1); PG8_BAR; PG8_SCHED;
            PG8_LDA(At, 0, 1); PG8_STAGE(PG8_SB(0, 0), b2, voffB); PG8_STAGE(PG8_SB(0, 1), b2 + hstep, voffB); PG8_STAGE(PG8_SA(0, 0), a2, x0);
            PG8_WAIT_V(8); PG8_WAIT_L(0); PG8_BAR; PG8_MMA(1, 0, At, B0); PG8_MMA(1, 1, At, B1); PG8_BAR; PG8_SCHED;
            PG8_LDB(B0, 1, 0); PG8_LDB(B1, 1, 1); PG8_SCHED; PG8_LDA(At, 1, 0); PG8_STAGE(PG8_SA(0, 1), a2, x1);
            PG8_WAIT_V(8); PG8_WAIT_L(0); PG8_BAR; PG8_MMA(0, 0, At, B0); PG8_MMA(0, 1, At, B1); PG8_BAR; PG8_SCHED;
            PG8_LDA(At, 1, 1); PG8_STAGE(PG8_SB(1, 0), b3, voffB); PG8_STAGE(PG8_SB(1, 1), b3 + hstep, voffB); PG8_STAGE(PG8_SA(1, 0), a3, x0);
            PG8_WAIT_V(8); PG8_WAIT_L(0); PG8_BAR; PG8_MMA(1, 0, At, B0); PG8_MMA(1, 1, At, B1); PG8_BAR; PG8_SCHED;
            } else {
            PG8_LDB(B0, 0, 0); PG8_SCHED; PG8_LDA(At, 0, 0); PG8_STAGE(PG8_SA(1, 1), a1, c1);
            PG8_WAIT_L(8); PG8_BAR; PG8_WAIT_L(0); PG8_MMA(0, 0, At, B0); PG8_BAR; PG8_SCHED;
            PG8_LDB(B1, 0, 1); PG8_STAGE(PG8_SB(0, 0), b2, voffB);
            PG8_BAR; PG8_WAIT_L(0); PG8_MMA(0, 1, At, B1); PG8_BAR;
            PG8_LDA(At, 0, 1); PG8_STAGE(PG8_SA(0, 0), a2, x0);
            PG8_BAR; PG8_WAIT_L(0); PG8_MMA(1, 0, At, B0); PG8_BAR; PG8_SCHED;
            PG8_STAGE(PG8_SB(0, 1), b2 + hstep, voffB);
            PG8_WAIT_V(6); PG8_BAR; PG8_MMA(1, 1, At, B1); PG8_BAR;
            PG8_LDB(B0, 1, 0); PG8_SCHED; PG8_LDA(At, 1, 0); PG8_STAGE(PG8_SA(0, 1), a2, x1);
            PG8_WAIT_L(8); PG8_BAR; PG8_WAIT_L(0); PG8_MMA(0, 0, At, B0); PG8_BAR; PG8_SCHED;
            PG8_LDB(B1, 1, 1); PG8_STAGE(PG8_SB(1, 0), b3, voffB);
            PG8_BAR; PG8_WAIT_L(0); PG8_MMA(0, 1, At, B1); PG8_BAR;
            PG8_LDA(At, 1, 1); PG8_STAGE(PG8_SA(1, 0), a3, x0);
            PG8_BAR; PG8_WAIT_L(0); PG8_MMA(1, 0, At, B0); PG8_BAR; PG8_SCHED;
            PG8_STAGE(PG8_SB(1, 1), b3 + hstep, voffB);
            PG8_WAIT_V(6); PG8_BAR; PG8_MMA(1, 1, At, B1); PG8_BAR;
            }
        }
        if constexpr (ALIGN_EPI) { if (wr == 0) PG8_BAR; }
        const bool keep = E(acc, cur, wr, wc, fr, fq);
        if (!has_next) break;
        if (!keep) {
#pragma unroll
            for (int a = 0; a < 2; ++a)
#pragma unroll
                for (int b = 0; b < 2; ++b)
#pragma unroll
                    for (int m = 0; m < 4; ++m)
#pragma unroll
                        for (int n = 0; n < 2; ++n) acc[a][b][m][n] = (f32x4){0.f, 0.f, 0.f, 0.f};
        }
        cur = nxt; cB = nB; ++ui;
#pragma unroll
        for (int i = 0; i < 2; ++i) { c0[i] = n0[i]; c1[i] = n1[i]; }
        if constexpr (ALIGN_EPI) { if (wr == 1) PG8_BAR; }
    }
    PG8_WAIT_V(0);
    if constexpr (!ALIGN_EPI) { if (wr == 0) PG8_BAR; }
    PG8_BAR;
#undef PG8_SA
#undef PG8_SB
#undef PG8_STAGE
#undef PG8_LDA
#undef PG8_LDB
#undef PG8_MMA
#undef PG8_WAIT_V
#undef PG8_WAIT_L
#undef PG8_BAR
#undef PG8_SCHED
}
}

DI int pos_bf8(int o) { const int o32 = o & 31; return (o & ~31) | (16 * ((o32 >> 2) & 1) + 4 * (o32 >> 3) + (o32 & 3)); }
DI int pos_rope(int o) { const int head = o >> 7, bj = (o >> 6) & 1, r = o & 63, w = r >> 5, fq = (r >> 3) & 3, n = (r >> 2) & 1, j = r & 3; return 128 * bj + 32 * (2 * head + w) + 16 * n + 4 * fq + j; }
DI int pos_swiglu(int o) { const int wc = o >> 6, fq = (o >> 4) & 3, bj = (o >> 3) & 1, n = (o >> 2) & 1, j = o & 3; return 128 * bj + 32 * wc + 16 * n + 4 * fq + j; }
template <int PT  >
DI void tr_item(const float* src, int ldw, int K, bf16* WT, int tile_row0, int o0  , int k0, LAS float* scr, int lane) {
    float v[32];
#pragma unroll
    for (int i = 0; i < 32; ++i) { const int kk = 2 * i + (lane >> 5); v[i] = src[(size_t)kk * ldw + (lane & 31)]; }
#pragma unroll
    for (int i = 0; i < 32; ++i) { const int kk = 2 * i + (lane >> 5); scr[kk * 33 + (lane & 31)] = v[i]; }
    asm volatile("s_waitcnt lgkmcnt(0)" ::: "memory");
    const int c = lane & 7;
#pragma unroll
    for (int j = 0; j < 4; ++j) { const int n = (lane >> 3) + 8 * j; const LAS float* s = scr + (8 * c) * 33 + n;
        u32x4 o; o.x = pk2(s[0 * 33], s[1 * 33]); o.y = pk2(s[2 * 33], s[3 * 33]); o.z = pk2(s[4 * 33], s[5 * 33]); o.w = pk2(s[6 * 33], s[7 * 33]);
        const int oc = o0 + n; const int p = PT == 0 ? oc : PT == 1 ? pos_bf8(oc) : PT == 2 ? pos_rope(oc) : pos_swiglu(oc);
        *(u32x4*)(WT + (size_t)(tile_row0 + p) * K + k0 + 8 * c) = o; }
    asm volatile("s_waitcnt lgkmcnt(0)" ::: "memory");
}
DI void convert_weights(Ctx& C) {
    LAS float* scr = (LAS float*)(C.lds + C.wave * 16384);
    const int gw = C.bid * NWAVES + C.wave, NGW = C.G * NWAVES, lane = C.lane;
    bf16* WT_IN = (bf16*)(C.ws + WS_WT_IN); bf16* WT_BR = (bf16*)(C.ws + WS_WT_BR); bf16* WT_OUT = (bf16*)(C.ws + WS_WT_OUT); bf16* WT_GU = (bf16*)(C.ws + WS_WT_GU); bf16* WT_DN = (bf16*)(C.ws + WS_WT_DN);
    constexpr int I_IN = 16 * 256, I_SQ = 16 * 32, I_GU = 32 * 16 * 64, I_DN = 32 * 16 * 32;
    constexpr int NITEMS = I_IN + 3 * I_SQ + I_GU + I_DN;
    for (int it = gw; it < NITEMS; it += NGW) {
        int r = it;
        if (r < I_IN) { const int kb = r >> 8, nb = r & 255, n0 = nb * 32, sc = n0 < 3072 ? n0 : n0 + 8, tile = n0 >> 8;
            const float* src = C.w_in + (size_t)(kb * 64) * DIN + sc;
            if (tile >= 12 && tile < 16) tr_item<2>(src, DIN, D, WT_IN, tile * 256, n0 & 255, kb * 64, scr, lane); else tr_item<1>(src, DIN, D, WT_IN, tile * 256, n0 & 255, kb * 64, scr, lane);
            continue; } r -= I_IN;
        if (r < 2 * I_SQ) { const int which = r >> 9, q = r & 511, kb = q >> 5, nb = q & 31, n0 = nb * 32;
            const float* src = (which ? C.w_bret : C.w_bml) + (size_t)(kb * 64) * D + n0;
            tr_item<1>(src, D, D, WT_BR, which * 1024 + (n0 & ~255), n0 & 255, kb * 64, scr, lane); continue; } r -= 2 * I_SQ;
        if (r < I_SQ) { const int kb = r >> 5, nb = r & 31, n0 = nb * 32;
            tr_item<0>(C.w_out + (size_t)(kb * 64) * D + n0, D, D, WT_OUT, n0 & ~255, n0 & 255, kb * 64, scr, lane); continue; } r -= I_SQ;
        if (r < I_GU) { const int e = r >> 10, q = r & 1023, kb = q >> 6, nb = q & 63, n0 = nb * 32;
            tr_item<3>(C.w_gu + (size_t)e * D * 2048 + (size_t)(kb * 64) * 2048 + n0, 2048, D, WT_GU, e * 2048 + (n0 & ~255), n0 & 255, kb * 64, scr, lane); continue; } r -= I_GU;
        { const int e = r >> 9, q = r & 511, kb = q >> 5, nb = q & 31, n0 = nb * 32;
            tr_item<1>(C.w_dn + (size_t)e * D * D + (size_t)(kb * 64) * D + n0, D, D, WT_DN, e * 1024 + (n0 & ~255), n0 & 255, kb * 64, scr, lane); }
    }
}

struct SchedDense { pg8::TileOrder o; int G, c;
    DI bool next(int i, pg8::Unit& u) const { int pm, pn; if (!o.tile((long)i * G + c, pm, pn)) return false; u.pm = pm; u.pn = pn; u.aux = 0; return true; }
    DI int arow(const pg8::Unit& u, int r) const { return u.pm * 256 + r; } };
DI u32x4 pack8v(const f32x4 a, const f32x4 b) { u32x4 w; w.x = pg8::cvt_pk_bf16(a.x, a.y); w.y = pg8::cvt_pk_bf16(a.z, a.w); w.z = pg8::cvt_pk_bf16(b.x, b.y); w.w = pg8::cvt_pk_bf16(b.z, b.w); return w; }
DI f32x4 sig4(const f32x4 v) { return (f32x4){sigmoidf_(v.x), sigmoidf_(v.y), sigmoidf_(v.z), sigmoidf_(v.w)}; }
DI f32x4 silu4(const f32x4 v) { return (f32x4){siluf_(v.x), siluf_(v.y), siluf_(v.z), siluf_(v.w)}; }
DI void unpack8v(const u32x4 w, f32x4& a, f32x4& b) { a = (f32x4){__uint_as_float(w.x << 16), __uint_as_float(w.x & 0xffff0000u), __uint_as_float(w.y << 16), __uint_as_float(w.y & 0xffff0000u)};
    b = (f32x4){__uint_as_float(w.z << 16), __uint_as_float(w.z & 0xffff0000u), __uint_as_float(w.w << 16), __uint_as_float(w.w & 0xffff0000u)}; }

struct EpiInproj { unsigned char* ws;
    DI bool operator()(f32x4 (&acc)[2][2][4][2], const pg8::Unit& u, int wr, int wc, int fr, int fq) const {
        const int seg = u.pn >> 2, row0 = u.pm * 256 + wr * 64 + fr;
        if (seg == 3) {
            const int which = (u.pn >> 1) & 1, head = 2 * (u.pn & 1) + (wc >> 1), i0 = 32 * (wc & 1) + 8 * fq;
            bf16* dst = (bf16*)(ws + (which ? WS_RETK : WS_RETQ)); const float sc = which ? 0.08838834764831845f : 1.0f;
            const float* COS = (const float*)(ws + WS_COS); const float* SIN = (const float*)(ws + WS_SIN);
#pragma unroll
            for (int ai = 0; ai < 2; ++ai)
#pragma unroll
                for (int m = 0; m < 4; ++m) { const int row = row0 + ai * 128 + m * 16;
                    const f32x4 c0 = *(const f32x4*)(COS + (size_t)row * 64 + i0) * sc, c1 = *(const f32x4*)(COS + (size_t)row * 64 + i0 + 4) * sc;
                    const f32x4 s0 = *(const f32x4*)(SIN + (size_t)row * 64 + i0) * sc, s1 = *(const f32x4*)(SIN + (size_t)row * 64 + i0 + 4) * sc;
                    const f32x4 x1a = acc[ai][0][m][0], x1b = acc[ai][0][m][1], x2a = acc[ai][1][m][0], x2b = acc[ai][1][m][1];
                    bf16* rp = dst + (size_t)row * 512 + head * 128 + i0;
                    *(u32x4*)rp = pack8v(x1a * c0 - x2a * s0, x1b * c1 - x2b * s1);
                    *(u32x4*)(rp + 64) = pack8v(x2a * c0 + x1a * s0, x2b * c1 + x1b * s1);
                    asm volatile("" ::: "memory"); }
            return false;
        }
        bf16* dst; int act = 0;
        switch (seg) { case 0: dst = (bf16*)(ws + WS_QKRAW); break; case 1: dst = (bf16*)(ws + WS_MLV); break; case 2: dst = (bf16*)(ws + WS_MLO); act = 1; break;
            case 4: dst = (bf16*)(ws + WS_RETV); break; case 5: dst = (bf16*)(ws + WS_RETG); act = 2; break; case 6: dst = (bf16*)(ws + WS_GML); act = 1; break; default: dst = (bf16*)(ws + WS_GRET); act = 1; break; }
        const int col0 = (u.pn & 3) * 256 + wc * 32 + 8 * fq;
#pragma unroll
        for (int ai = 0; ai < 2; ++ai)
#pragma unroll
            for (int m = 0; m < 4; ++m) { bf16* rp = dst + (size_t)(row0 + ai * 128 + m * 16) * D + col0;
#pragma unroll
                for (int bj = 0; bj < 2; ++bj) { f32x4 v0 = acc[ai][bj][m][0], v1 = acc[ai][bj][m][1];
                    if (act == 1) { v0 = sig4(v0); v1 = sig4(v1); } else if (act == 2) { v0 = silu4(v0); v1 = silu4(v1); }
                    *(u32x4*)(rp + bj * 128) = pack8v(v0, v1); } }
        return false;
    } };
DI void phase_inproj_mfma(Ctx& C) {
    pg8::Gemm g{(const bf16*)(C.ws + WS_H1), (const bf16*)(C.ws + WS_WT_IN), D};
    SchedDense S; S.o.init(T / 256, 32); S.G = C.G; S.c = C.bid;
    EpiInproj E{C.ws};
    pg8::gemm_phase<EpiInproj, SchedDense, true, true>(C.lds, g, S, E);
}

struct SchedBranch { pg8::TileOrder o; int G, c;
    DI bool next(int i, pg8::Unit& u) const { int pm, pn; if (!o.tile((long)(i >> 1) * G + c, pm, pn)) return false; const int seg = i & 1; u.pm = seg * 64 + pm; u.pn = seg * 4 + pn; u.aux = seg; return true; }
    DI int arow(const pg8::Unit& u, int r) const { return u.pm * 256 + r; } };
struct EpiBranch { const bf16* g1; const bf16* g2; bf16* y;
    DI bool operator()(f32x4 (&acc)[2][2][4][2], const pg8::Unit& u, int wr, int wc, int fr, int fq) const {
        const int seg = u.aux, row0 = (u.pm & 63) * 256 + wr * 64 + fr, col0 = (u.pn & 3) * 256 + wc * 32 + 8 * fq;
#pragma unroll
        for (int ai = 0; ai < 2; ++ai)
#pragma unroll
            for (int m = 0; m < 4; ++m) { const size_t o = (size_t)(row0 + ai * 128 + m * 16) * D + col0;
#pragma unroll
                for (int bj = 0; bj < 2; ++bj) {
                    f32x4 b0, b1; unpack8v(*(const u32x4*)(g2 + o + bj * 128), b0, b1);
                    if (seg == 0) { f32x4 a0, a1; unpack8v(*(const u32x4*)(g1 + o + bj * 128), a0, a1);
#pragma unroll
                        for (int j = 0; j < 4; ++j) { acc[ai][bj][m][0][j] *= a0[j] / fmaxf(b0[j], 1e-12f); acc[ai][bj][m][1][j] *= a1[j] / fmaxf(b1[j], 1e-12f); }
                    } else *(u32x4*)(y + o + bj * 128) = pack8v(acc[ai][bj][m][0] * b0, acc[ai][bj][m][1] * b1);
                }
                asm volatile("" ::: "memory"); }
        return seg == 0;
    } };
DI void phase_branch_mfma(Ctx& C) {
    pg8::Gemm g{(const bf16*)(C.ws + WS_HML), (const bf16*)(C.ws + WS_WT_BR), D};
    SchedBranch S; S.o.init(T / 256, 4); S.G = C.G; S.c = C.bid;
    EpiBranch E{(const bf16*)(C.ws + WS_GML), (const bf16*)(C.ws + WS_GRET), (bf16*)(C.ws + WS_H1)};
    pg8::gemm_phase<EpiBranch, SchedBranch, true, true>(C.lds, g, S, E);
}
struct EpiOut { const float* x; const float* mod; float* x1;
    DI bool operator()(f32x4 (&acc)[2][2][4][2], const pg8::Unit& u, int wr, int wc, int fr, int fq) const {
        const int row0 = u.pm * 256 + wr * 64 + fr, col0 = u.pn * 256 + wc * 32 + 4 * fq; const int b = (u.pm * 256) / SEQ;
        f32x4 gv[2][2];
#pragma unroll
        for (int bj = 0; bj < 2; ++bj)
#pragma unroll
            for (int n = 0; n < 2; ++n) gv[bj][n] = *(const f32x4*)(mod + b * 6144 + 2048 + col0 + bj * 128 + n * 16);
#pragma unroll
        for (int ai = 0; ai < 2; ++ai)
#pragma unroll
            for (int m = 0; m < 4; ++m) { const size_t o = (size_t)(row0 + ai * 128 + m * 16) * D + col0;
#pragma unroll
                for (int bj = 0; bj < 2; ++bj)
#pragma unroll
                    for (int n = 0; n < 2; ++n) *(f32x4*)(x1 + o + bj * 128 + n * 16) = *(const f32x4*)(x + o + bj * 128 + n * 16) + gv[bj][n] * acc[ai][bj][m][n];
                asm volatile("" ::: "memory"); }
        return false;
    } };
DI void phase_outproj_mfma(Ctx& C) {
    pg8::Gemm g{(const bf16*)(C.ws + WS_H1), (const bf16*)(C.ws + WS_WT_OUT), D};
    SchedDense S; S.o.init(T / 256, 4); S.G = C.G; S.c = C.bid;
    EpiOut E{C.x, (const float*)(C.ws + WS_MOD), (float*)(C.ws + WS_X1)};
    pg8::gemm_phase<EpiOut, SchedDense, false, true>(C.lds, g, S, E);
}
struct SchedMoe { const unsigned* blke; const int* slottok; int nunits, ntn, G, c;
    DI bool next(int i, pg8::Unit& u) const { const long L = (long)i * G + c; if (L >= nunits) return false; const int bi = (int)(L / ntn), pn = (int)(L % ntn);
        const int e = (int)__builtin_amdgcn_readfirstlane((int)blke[bi]); u.pm = bi; u.pn = e * ntn + pn; u.aux = e | (pn << 8); return true; }
    DI int arow(const pg8::Unit& u, int r) const { return slottok ? slottok[u.pm * 256 + r] : u.pm * 256 + r; } };
struct EpiSwiglu { const float* bias; bf16* act;
    DI bool operator()(f32x4 (&acc)[2][2][4][2], const pg8::Unit& u, int wr, int wc, int fr, int fq) const {
        const int e = u.aux & 255, pn = u.aux >> 8, slot0 = u.pm * 256 + wr * 64 + fr;
        const float* bp = bias + (size_t)e * 2048 + pn * 256 + 64 * wc + 16 * fq;
        f32x4 bv[2][2];
#pragma unroll
        for (int bj = 0; bj < 2; ++bj)
#pragma unroll
            for (int n = 0; n < 2; ++n) bv[bj][n] = *(const f32x4*)(bp + 8 * bj + 4 * n);
#pragma unroll
        for (int ai = 0; ai < 2; ++ai)
#pragma unroll
            for (int m = 0; m < 4; ++m) { float o[8];
#pragma unroll
                for (int bj = 0; bj < 2; ++bj)
#pragma unroll
                    for (int n = 0; n < 2; ++n) { const f32x4 v = acc[ai][bj][m][n] + bv[bj][n];
#pragma unroll
                        for (int p = 0; p < 2; ++p) { const float xg = fminf(v[2 * p], 7.0f), xl = fminf(fmaxf(v[2 * p + 1], -7.0f), 7.0f); o[4 * bj + 2 * n + p] = xg * sigmoidf_(1.702f * xg) * (xl + 1.0f); } }
                u32x4 w; w.x = pg8::cvt_pk_bf16(o[0], o[1]); w.y = pg8::cvt_pk_bf16(o[2], o[3]); w.z = pg8::cvt_pk_bf16(o[4], o[5]); w.w = pg8::cvt_pk_bf16(o[6], o[7]);
                *(u32x4*)(act + (size_t)(slot0 + ai * 128 + m * 16) * D + pn * 128 + 32 * wc + 8 * fq) = w; }
        return false;
    } };
struct EpiDown { const float* bias; const float* slotw; bf16* ys;
    DI bool operator()(f32x4 (&acc)[2][2][4][2], const pg8::Unit& u, int wr, int wc, int fr, int fq) const {
        const int e = u.aux & 255, pn = u.aux >> 8, slot0 = u.pm * 256 + wr * 64 + fr, col0 = pn * 256 + wc * 32 + 8 * fq;
        f32x4 bv[2][2];
#pragma unroll
        for (int bj = 0; bj < 2; ++bj)
#pragma unroll
            for (int n = 0; n < 2; ++n) bv[bj][n] = *(const f32x4*)(bias + (size_t)e * D + col0 + bj * 128 + 4 * n);
#pragma unroll
        for (int ai = 0; ai < 2; ++ai)
#pragma unroll
            for (int m = 0; m < 4; ++m) { const int slot = slot0 + ai * 128 + m * 16; const float w = slotw[slot];
#pragma unroll
                for (int bj = 0; bj < 2; ++bj) *(u32x4*)(ys + (size_t)slot * D + col0 + bj * 128) = pack8v((acc[ai][bj][m][0] + bv[bj][0]) * w, (acc[ai][bj][m][1] + bv[bj][1]) * w); }
        return false;
    } };
DI void phase_gateup_mfma(Ctx& C) {
    unsigned* ctl = (unsigned*)(C.ws + WS_CTL); const int nblk = (int)__builtin_amdgcn_readfirstlane((int)__hip_atomic_load(ctl + CW_NBLK, __ATOMIC_RELAXED, __HIP_MEMORY_SCOPE_AGENT));
    pg8::Gemm g{(const bf16*)(C.ws + WS_H1), (const bf16*)(C.ws + WS_WT_GU), D};
    SchedMoe S{ctl + CW_BLKE, (const int*)(C.ws + WS_ROUTE + RT_SLOTTOK), nblk * 8, 8, C.G, C.bid};
    EpiSwiglu E{C.b_gu, (bf16*)(C.ws + WS_ACT)};
    pg8::gemm_phase<EpiSwiglu, SchedMoe, true, true>(C.lds, g, S, E);
}
DI void phase_down_mfma(Ctx& C) {
    unsigned* ctl = (unsigned*)(C.ws + WS_CTL); const int nblk = (int)__builtin_amdgcn_readfirstlane((int)__hip_atomic_load(ctl + CW_NBLK, __ATOMIC_RELAXED, __HIP_MEMORY_SCOPE_AGENT));
    pg8::Gemm g{(const bf16*)(C.ws + WS_ACT), (const bf16*)(C.ws + WS_WT_DN), D};
    SchedMoe S{ctl + CW_BLKE, nullptr, nblk * 4, 4, C.G, C.bid};
    EpiDown E{C.b_dn, (const float*)(C.ws + WS_ROUTE + RT_SLOTW), (bf16*)(C.ws + WS_YS)};
    pg8::gemm_phase<EpiDown, SchedMoe, true, true>(C.lds, g, S, E);
}

#define XB_TMO      128
#define XB_XCNT(j)  (256  + 64 * (j))
#define XB_XSUB(j)  (1280 + 64 * (j))
#define XB_XGEN(j)  (2304 + 64 * (j))
#define XB_TOP      3328
#define XB_TOPGEN   3392
#define XCD_BAR_WORDS 3456
#define XB_SPIN_CAP (1u << 22)
DI unsigned xb_ld(unsigned* p)              { return __hip_atomic_load(p, __ATOMIC_RELAXED, __HIP_MEMORY_SCOPE_AGENT); }
DI unsigned xb_add(unsigned* p, unsigned v) { return __hip_atomic_fetch_add(p, v, __ATOMIC_RELAXED, __HIP_MEMORY_SCOPE_AGENT); }
DI unsigned xb_xcc_id() { return (unsigned)__builtin_amdgcn_s_getreg((3 << 11) | 20) & 0xFu; }
#define XB_SPIN(cond, bar) do { unsigned _sp = 0; while (cond) { __builtin_amdgcn_s_sleep(1); \
    if ((++_sp & 255u) == 0u) { if (xb_ld(&(bar)[XB_TMO])) break; if (_sp > XB_SPIN_CAP) { atomicAdd(&(bar)[XB_TMO], 1u); break; } } } } while (0)
struct XcdBarrier { unsigned* bar; unsigned x; volatile LAS unsigned* st; };
DI XcdBarrier xcd_barrier_post(unsigned* bar, volatile LAS unsigned* st) {
    XcdBarrier b; b.bar = bar; b.x = xb_xcc_id(); b.st = st;
    if (threadIdx.x == 0) (void)xb_add(&bar[XB_XCNT(b.x)], 1u);
    return b;
}
DI void xcd_barrier_complete(unsigned* bar, unsigned x, unsigned& nloc, unsigned& nx) {
    const unsigned G = gridDim.x * gridDim.y * gridDim.z;
    unsigned sum, cnt, mine, sp = 0u;
    for (;;) {
        sum = 0u; cnt = 0u; mine = 0u;
#pragma unroll
        for (unsigned j = 0; j < 16; ++j) { const unsigned c = xb_ld(&bar[XB_XCNT(j)]); sum += c; cnt += (c > 0u) ? 1u : 0u; mine = (j == x) ? c : mine; }
        if (sum == G) break;
        __builtin_amdgcn_s_sleep(1);
        if ((++sp & 255u) == 0u) { if (xb_ld(&bar[XB_TMO])) break; if (sp > XB_SPIN_CAP) { atomicAdd(&bar[XB_TMO], 1u); break; } }
    }
    nloc = mine > 0u ? mine : 1u; nx = cnt > 0u ? cnt : 1u;
}
DI void xcd_barrier(const XcdBarrier& b) {
    asm volatile("s_waitcnt vmcnt(0)" ::: "memory");
    __syncthreads();
    if (threadIdx.x == 0) {
        unsigned* bar = b.bar;
        __builtin_amdgcn_s_waitcnt(0);
        unsigned nloc = b.st[0], nx = b.st[1];
        if (nloc == 0u) { xcd_barrier_complete(bar, b.x, nloc, nx); b.st[0] = nloc; b.st[1] = nx; }
        const unsigned old = xb_add(&bar[XB_XSUB(b.x)], 1u);
        const unsigned gen = old / nloc;
        if (old + 1u == (gen + 1u) * nloc) {
            __builtin_amdgcn_fence(__ATOMIC_RELEASE, "agent");
            asm volatile("s_waitcnt vmcnt(0)" ::: "memory");
            const unsigned og = xb_add(&bar[XB_TOP], 1u);
            const unsigned tg = og / nx;
            if (og + 1u == (tg + 1u) * nx) xb_add(&bar[XB_TOPGEN], 1u);
            else XB_SPIN(xb_ld(&bar[XB_TOPGEN]) == tg, bar);
            __builtin_amdgcn_fence(__ATOMIC_ACQUIRE, "agent");
            xb_add(&bar[XB_XGEN(b.x)], 1u);
            asm volatile("s_waitcnt vmcnt(0)" ::: "memory");
        } else {
            XB_SPIN(xb_ld(&bar[XB_XGEN(b.x)]) == gen, bar);
            __builtin_amdgcn_fence(__ATOMIC_ACQUIRE, "agent");
            asm volatile("s_waitcnt vmcnt(0)" ::: "memory");
        }
    }
    __syncthreads();
}

constexpr int NPHASES = 14;
__global__ void __launch_bounds__(NTHR, 2) fwd(Args a) {
    extern __shared__ __attribute__((aligned(16))) unsigned char lds[];
    Ctx C;
    C.lds = (LAS unsigned char*)lds; C.tid = threadIdx.x; C.lane = C.tid & 63; C.wave = __builtin_amdgcn_readfirstlane(C.tid >> 6); C.G = gridDim.x; C.bid = blockIdx.x;
    C.x = (const float*)a.in[0]; C.c = (const float*)a.in[1]; C.positions = (const int*)a.in[2]; C.w_ada = (const float*)a.in[3]; C.b_ada = (const float*)a.in[4];
    C.norm_mix_g = (const float*)a.in[5]; C.w_in = (const float*)a.in[6]; C.conv_w = (const float*)a.in[7]; C.conv_b = (const float*)a.in[8]; C.b_if = (const float*)a.in[9];
    C.ml_norm_g = (const float*)a.in[10]; C.ret_norm_g = (const float*)a.in[11]; C.w_bml = (const float*)a.in[12]; C.w_bret = (const float*)a.in[13]; C.w_out = (const float*)a.in[14];
    C.norm_ffn_g = (const float*)a.in[15]; C.w_router = (const float*)a.in[16]; C.b_router = (const float*)a.in[17]; C.w_gu = (const float*)a.in[18]; C.b_gu = (const float*)a.in[19];
    C.w_dn = (const float*)a.in[20]; C.b_dn = (const float*)a.in[21]; C.norm_final_g = (const float*)a.in[22];
    C.out = a.out; C.ws = a.ws;
    const int lo = a.ph_lo, hi = a.ph_hi;
    volatile LAS unsigned* bst = (volatile LAS unsigned*)(C.lds + LDS_BYTES - 16);
    if (C.tid < 4) bst[C.tid] = 0u;
    __syncthreads();
    XcdBarrier bar; bar.bar = (unsigned*)(C.ws + WS_CTL) + CW_BAR; bar.x = 0; bar.st = bst;
    if (hi - lo > 1) bar = xcd_barrier_post((unsigned*)(C.ws + WS_CTL) + CW_BAR, bst);
#define SEAM(k) do { if (IN(k) && IN((k) + 1)) xcd_barrier(bar); } while (0)
#ifdef ONLY_PHASE
#define IN(k) ((k) == ONLY_PHASE && lo <= (k) && (k) < hi)
#else
#define IN(k) (lo <= (k) && (k) < hi)
#endif
    if (IN(0)) phase_mod(C); SEAM(0);
    if (IN(1)) { phase_norm1(C);
#if OPT_ANY
        convert_weights(C);
#endif
    } SEAM(1);
#if OPT_INPROJ
    if (IN(2)) phase_inproj_mfma(C); SEAM(2);
#else
    if (IN(2)) phase_inproj(C); SEAM(2);
#endif
    if (IN(3)) phase_conv_rope(C); SEAM(3);
    if (IN(4)) phase_local(C); SEAM(4);
    if (IN(5)) phase_scan(C); SEAM(5);
    if (IN(6)) phase_out(C); SEAM(6);
#if OPT_BRANCH
    if (IN(7)) phase_branch_mfma(C); SEAM(7);
#else
    if (IN(7)) phase_branch(C); SEAM(7);
#endif
#if OPT_OUT
    if (IN(8)) phase_outproj_mfma(C); SEAM(8);
#else
    if (IN(8)) phase_outproj(C); SEAM(8);
#endif
    if (IN(9)) phase_norm2_route(C); SEAM(9);
    if (IN(10)) phase_slots(C); SEAM(10);
#if OPT_MOE
    if (IN(11)) phase_gateup_mfma(C); SEAM(11);
#else
    if (IN(11)) phase_gateup(C); SEAM(11);
#endif
#if OPT_MOE
    if (IN(12)) phase_down_mfma(C); SEAM(12);
#else
    if (IN(12)) phase_down(C); SEAM(12);
#endif
    if (IN(13)) phase_final(C); SEAM(13);
#undef IN
}

extern "C" void kernel_launch(void* const* d_in, const int* in_sizes, int n_in, void* d_out, int out_size, void* d_ws, size_t ws_size, hipStream_t stream) {
    static int grid = 0;
    if (grid == 0) {
        if (n_in != 23 || out_size != T * D || ws_size < WS_END) { fprintf(stderr, "kernel_launch: unexpected shapes: n_in %d out %d ws %zu (need %zu)\n", n_in, out_size, ws_size, (size_t)WS_END); grid = -1; return; }
        int dev = 0, cus = 0;
        if (hipGetDevice(&dev) != hipSuccess || hipDeviceGetAttribute(&cus, hipDeviceAttributeMultiprocessorCount, dev) != hipSuccess) { grid = -1; return; }
        if (hipFuncSetAttribute((const void*)fwd, hipFuncAttributeMaxDynamicSharedMemorySize, LDS_BYTES) != hipSuccess) { fprintf(stderr, "kernel_launch: hipFuncSetAttribute failed\n"); grid = -1; return; }
        grid = cus > 0 ? cus : 256;
    }
    if (grid < 0) return;
    Args a{};
    for (int i = 0; i < 23; ++i) a.in[i] = d_in[i];
    a.out = (float*)d_out; a.ws = (unsigned char*)d_ws;
    (void)hipMemsetAsync((char*)d_ws + WS_CTL, 0, CTL_ZERO_BYTES, stream);
#ifdef MK_PER_PHASE
    for (int p = 0; p < NPHASES; ++p) { a.ph_lo = p; a.ph_hi = p + 1; hipLaunchKernelGGL(fwd, dim3(grid), dim3(NTHR), LDS_BYTES, stream, a); }
#else
    a.ph_lo = 0; a.ph_hi = NPHASES;
    hipLaunchKernelGGL(fwd, dim3(grid), dim3(NTHR), LDS_BYTES, stream, a);
#endif
}
```

```cpp
#include <hip/hip_runtime.h>
#include <cstdio>
#include <cstdint>

#ifndef OPT_INPROJ
#define OPT_INPROJ 1
#endif
#ifndef OPT_BRANCH
#define OPT_BRANCH 1
#endif
#ifndef OPT_OUT
#define OPT_OUT 1
#endif
#ifndef OPT_MOE
#define OPT_MOE 1
#endif
#ifndef OPT_LOCAL
#define OPT_LOCAL 1
#endif
#ifndef OPT_OUTP
#define OPT_OUTP 1
#endif
#define OPT_ANY (OPT_INPROJ || OPT_BRANCH || OPT_OUT || OPT_MOE)
#define DI __device__ __forceinline__
#define LAS __attribute__((address_space(3)))
typedef unsigned short bf16;
typedef float f32x4 __attribute__((ext_vector_type(4)));
typedef unsigned u32x4 __attribute__((ext_vector_type(4)));
typedef unsigned u32x2 __attribute__((ext_vector_type(2)));

constexpr int D = 1024, NB = 4, SEQ = 4096, T = NB * SEQ;
constexpr int DIN = 8200, CH = 128, NCH = SEQ / CH;
constexpr int NE = 32, TOPK = 4, NSLOT_BLK = 288, NSLOTS = NSLOT_BLK * 256;
constexpr float EPS = 1e-5f;
constexpr int NTHR = 512, NWAVES = 8;

constexpr size_t MiB = 1u << 20;
constexpr size_t WS_CTL   = 0;
constexpr size_t WS_MOD   = 1 * MiB;
constexpr size_t WS_IFG   = 2 * MiB;
constexpr size_t WS_COS   = 3 * MiB;
constexpr size_t WS_SIN   = 7 * MiB;
constexpr size_t WS_ROUTE = 11 * MiB;
constexpr size_t WS_SMALL = 14 * MiB;
constexpr size_t WS_H1    = 16 * MiB;
constexpr size_t WS_X1    = 50 * MiB;
constexpr size_t WS_TMP   = 114 * MiB;
constexpr size_t WS_B     = 178 * MiB;
constexpr size_t WS_QKRAW = WS_B;
constexpr size_t WS_QC    = WS_B + 32 * MiB;
constexpr size_t WS_MLV   = WS_B + 64 * MiB;
constexpr size_t WS_MLO   = WS_B + 96 * MiB;
constexpr size_t WS_RETQ  = WS_B + 128 * MiB;
constexpr size_t WS_RETK  = WS_B + 144 * MiB;
constexpr size_t WS_RETV  = WS_B + 160 * MiB;
constexpr size_t WS_RETG  = WS_B + 192 * MiB;
constexpr size_t WS_GML   = WS_B + 224 * MiB;
constexpr size_t WS_GRET  = WS_B + 256 * MiB;
constexpr size_t WS_CLOC  = WS_B + 288 * MiB;
constexpr size_t WS_CPREV = WS_B + 352 * MiB;
constexpr size_t WS_HML   = WS_B + 416 * MiB;
constexpr size_t WS_HRET  = WS_B + 448 * MiB;
constexpr size_t WS_B_END = WS_B + 480 * MiB;
constexpr size_t WS_ACT   = WS_B;
constexpr size_t WS_YS    = WS_B + 160 * MiB;
constexpr size_t WS_WT_IN = WS_B_END;
constexpr size_t WS_WT_BR = WS_WT_IN + 16 * MiB;
constexpr size_t WS_WT_OUT = WS_WT_BR + 4 * MiB;
constexpr size_t WS_WT_GU = WS_WT_OUT + 2 * MiB;
constexpr size_t WS_WT_DN = WS_WT_GU + 128 * MiB;
constexpr size_t WS_END   = WS_WT_DN + 64 * MiB;
static_assert(WS_YS + (size_t)NSLOTS * 2048 <= WS_B_END, "ws map");

constexpr int CW_CNT = 64;
constexpr int CW_NBLK = 128;
constexpr int CW_BLKE = 192;
constexpr int CW_BAR = 4096;
constexpr size_t CTL_ZERO_BYTES = 65536;
constexpr size_t RT_TOPI = 0;
constexpr size_t RT_TOPW = 256 * 1024;
constexpr size_t RT_RANK = 512 * 1024;
constexpr size_t RT_ASLOT = 768 * 1024;
constexpr size_t RT_SLOTTOK = 1024 * 1024;
constexpr size_t RT_SLOTW = 1024 * 1024 + 512 * 1024;
constexpr size_t SM_NLOC = 0;
constexpr size_t SM_NPREV = 256 * 1024;
constexpr size_t SM_MLOC = 512 * 1024;
constexpr size_t SM_ACH = 512 * 1024 + 4096;
constexpr size_t SM_MPREV = 512 * 1024 + 8192;
constexpr size_t SM_AG = 1024 * 1024;
constexpr size_t SM_CMG = 1280 * 1024;

constexpr int LDS_BYTES = 147456;

DI float bf2f(bf16 v) { return __uint_as_float(((unsigned)v) << 16); }
DI unsigned f2bf(float f) { unsigned u = __float_as_uint(f); return (u + 0x7fffu + ((u >> 16) & 1u)) >> 16; }
DI unsigned pk2(float lo, float hi) { return f2bf(lo) | (f2bf(hi) << 16); }
DI float wave_sum(float v) {
#pragma unroll
    for (int o = 1; o < 64; o <<= 1) v += __shfl_xor(v, o);
    return v;
}
DI float sigmoidf_(float x) { return 1.0f / (1.0f + __expf(-x)); }
DI float siluf_(float x) { return x / (1.0f + __expf(-x)); }
DI float logsigmoidf_(float x) { return fminf(x, 0.f) - log1pf(__expf(-fabsf(x))); }
DI void unpack8(const u32x4 w, float (&f)[8]) {
    f[0] = __uint_as_float(w.x << 16); f[1] = __uint_as_float(w.x & 0xffff0000u);
    f[2] = __uint_as_float(w.y << 16); f[3] = __uint_as_float(w.y & 0xffff0000u);
    f[4] = __uint_as_float(w.z << 16); f[5] = __uint_as_float(w.z & 0xffff0000u);
    f[6] = __uint_as_float(w.w << 16); f[7] = __uint_as_float(w.w & 0xffff0000u);
}
DI u32x4 pack8(const float (&f)[8]) { u32x4 w; w.x = pk2(f[0], f[1]); w.y = pk2(f[2], f[3]); w.z = pk2(f[4], f[5]); w.w = pk2(f[6], f[7]); return w; }

struct Args { const void* in[23]; float* out; unsigned char* ws; int ph_lo, ph_hi; };

struct Ctx {
    LAS unsigned char* lds;
    int tid, lane, wave, G, bid;
    const float *x, *c, *w_ada, *b_ada, *norm_mix_g, *w_in, *conv_w, *conv_b, *b_if, *ml_norm_g, *ret_norm_g;
    const float *w_bml, *w_bret, *w_out, *norm_ffn_g, *w_router, *b_router, *w_gu, *b_gu, *w_dn, *b_dn, *norm_final_g;
    const int* positions;
    float* out; unsigned char* ws;
};

template <class AF, class BF, class EF>
DI void naive_gemm_tile(Ctx& C, int tm, int tn, int K, int ldb, const AF& af, const BF& bf, const EF& ef) {
    LAS float* As = (LAS float*)C.lds;
    LAS float* Bs = As + 16 * 132;
    const int t = C.tid, ty = t >> 5, tx = t & 31;
    float acc[8][4];
#pragma unroll
    for (int i = 0; i < 8; ++i)
#pragma unroll
        for (int j = 0; j < 4; ++j) acc[i][j] = 0.f;
    const int ar = t >> 2, ak = (t & 3) * 4;
    const bf16* arow = af.row(tm, ar);
    const int bk = t >> 5, bn = (t & 31) * 4;
    const float* bbase = bf.ptr(tm, tn) + bn;
    for (int k0 = 0; k0 < K; k0 += 16) {
        const u32x2 av = *(const u32x2*)(arow + k0 + ak);
        const f32x4 bv = *(const f32x4*)(bbase + (size_t)(k0 + bk) * ldb);
        __syncthreads();
        As[(ak + 0) * 132 + ar] = __uint_as_float(av.x << 16); As[(ak + 1) * 132 + ar] = __uint_as_float(av.x & 0xffff0000u);
        As[(ak + 2) * 132 + ar] = __uint_as_float(av.y << 16); As[(ak + 3) * 132 + ar] = __uint_as_float(av.y & 0xffff0000u);
        *(LAS f32x4*)(Bs + bk * 132 + bn) = bv;
        __syncthreads();
#pragma unroll 4
        for (int kk = 0; kk < 16; ++kk) {
            const f32x4 a0 = *(const LAS f32x4*)(As + kk * 132 + ty * 8), a1 = *(const LAS f32x4*)(As + kk * 132 + ty * 8 + 4);
            const f32x4 b = *(const LAS f32x4*)(Bs + kk * 132 + tx * 4);
            const float a[8] = {a0.x, a0.y, a0.z, a0.w, a1.x, a1.y, a1.z, a1.w};
#pragma unroll
            for (int i = 0; i < 8; ++i) { acc[i][0] += a[i] * b.x; acc[i][1] += a[i] * b.y; acc[i][2] += a[i] * b.z; acc[i][3] += a[i] * b.w; }
        }
    }
#pragma unroll
    for (int i = 0; i < 8; ++i) { ef.put(tm, tn, ty * 8 + i, tx * 4, acc[i]); asm volatile("" ::: "memory"); }
    __syncthreads();
}

DI void phase_mod(Ctx& C) {
    LAS float* red = (LAS float*)C.lds;
    float* mod = (float*)(C.ws + WS_MOD);
    for (int g = C.bid; g < 256; g += C.G) {
        const int n0 = g * 24, t = C.tid;
        if (t < 504) {
            const int col = t % 24, kg = t / 24;
            float a0 = 0.f, a1 = 0.f, a2 = 0.f, a3 = 0.f;
            for (int k = kg; k < D; k += 21) {
                const float w = C.w_ada[(size_t)k * 6144 + n0 + col];
                a0 += siluf_(C.c[k]) * w; a1 += siluf_(C.c[D + k]) * w; a2 += siluf_(C.c[2 * D + k]) * w; a3 += siluf_(C.c[3 * D + k]) * w;
            }
            red[(kg * 24 + col) * 4 + 0] = a0; red[(kg * 24 + col) * 4 + 1] = a1; red[(kg * 24 + col) * 4 + 2] = a2; red[(kg * 24 + col) * 4 + 3] = a3;
        }
        __syncthreads();
        if (t < 96) {
            const int col = t % 24, b = t / 24; float s = 0.f;
            for (int kg = 0; kg < 21; ++kg) s += red[(kg * 24 + col) * 4 + b];
            mod[b * 6144 + n0 + col] = s + C.b_ada[n0 + col];
        }
        __syncthreads();
    }
}

DI void phase_norm1(Ctx& C) {
    const float* mod = (const float*)(C.ws + WS_MOD);
    bf16* H1 = (bf16*)(C.ws + WS_H1);
    float* IFG = (float*)(C.ws + WS_IFG);
    const int lane = C.lane, gw = C.bid * NWAVES + C.wave, NGW = C.G * NWAVES;
    float wif[4][4][8];
#pragma unroll
    for (int j = 0; j < 4; ++j)
#pragma unroll
        for (int i = 0; i < 4; ++i) {
            const float* wp = C.w_in + (size_t)(4 * (lane + 64 * j) + i) * DIN + 3072;
#pragma unroll
            for (int e = 0; e < 8; ++e) wif[j][i][e] = wp[e];
        }
    for (int m = gw; m < T; m += NGW) {
        const int b = m / SEQ;
        const f32x4* xr = (const f32x4*)(C.x + (size_t)m * D) + lane;
        f32x4 v[4]; float ss = 0.f;
#pragma unroll
        for (int j = 0; j < 4; ++j) { v[j] = xr[64 * j]; ss += (v[j].x * v[j].x + v[j].y * v[j].y) + (v[j].z * v[j].z + v[j].w * v[j].w); }
        const float rstd = 1.0f / sqrtf(wave_sum(ss) * (1.0f / D) + EPS);
        float p[8];
#pragma unroll
        for (int e = 0; e < 8; ++e) p[e] = 0.f;
        u32x2* o8 = (u32x2*)(H1 + (size_t)m * D) + lane;
#pragma unroll
        for (int j = 0; j < 4; ++j) {
            const int col = 4 * (lane + 64 * j);
            const f32x4 g = *(const f32x4*)(C.norm_mix_g + col), sh = *(const f32x4*)(mod + b * 6144 + col), sc = *(const f32x4*)(mod + b * 6144 + 1024 + col);
            f32x4 h = (v[j] * rstd * g) * (sc + 1.0f) + sh;
            u32x2 w; w.x = pk2(h.x, h.y); w.y = pk2(h.z, h.w); o8[64 * j] = w;
            const float hh[4] = {h.x, h.y, h.z, h.w};
#pragma unroll
            for (int i = 0; i < 4; ++i)
#pragma unroll
                for (int e = 0; e < 8; ++e) p[e] += hh[i] * wif[j][i][e];
        }
#pragma unroll
        for (int e = 0; e < 8; ++e) p[e] = wave_sum(p[e]);
        if (lane < 8) { float r = p[0];
#pragma unroll
            for (int e = 1; e < 8; ++e) r = (lane == e) ? p[e] : r;
            IFG[(size_t)m * 8 + lane] = r + C.b_if[lane]; }
    }
    float* COS = (float*)(C.ws + WS_COS); float* SIN = (float*)(C.ws + WS_SIN);
    for (int idx = C.bid * NTHR + C.tid; idx < T * 64; idx += C.G * NTHR) {
        const int t = idx >> 6, i = idx & 63;
        const float inv = (float)exp(-(double)i * (9.210340371976184 / 64.0));
        const double ang = (double)C.positions[t] * (double)inv;
        const double kq = rint(ang * 0.6366197723675814);
        double r = fma(-kq, 1.5707963267948966, ang); r = fma(-kq, 6.123233995736766e-17, r);
        const float rf = (float)r; const float s = sinf(rf), c = cosf(rf);
        const int q = ((int)kq) & 3;
        const float cs = (q == 0) ? c : (q == 1) ? -s : (q == 2) ? -c : s;
        const float sn = (q == 0) ? s : (q == 1) ? c : (q == 2) ? -s : -c;
        COS[idx] = cs; SIN[idx] = sn;
    }
    if (C.bid == 0 && C.tid < 32) ((unsigned*)(C.ws + WS_CTL))[CW_CNT + C.tid] = 0u;
}

struct AF_rows { const bf16* base; int ld; DI const bf16* row(int tm, int r) const { return base + (size_t)(tm * 128 + r) * ld; } };
struct BF_inproj { const float* w; DI const float* ptr(int, int tn) const { return w + (tn < 24 ? tn * 128 : tn * 128 + 8); } };
struct EF_inproj { unsigned char* ws;
    DI void put(int tm, int tn, int r, int c, const float (&v)[4]) const {
        const int row = tm * 128 + r; const int seg = tn >> 3;
        bf16* dst; int ld = 1024, col = (tn & 7) * 128 + c; int act = 0;
        switch (seg) {
            case 0: dst = (bf16*)(ws + WS_QKRAW); break;
            case 1: dst = (bf16*)(ws + WS_MLV); break;
            case 2: dst = (bf16*)(ws + WS_MLO); act = 1; break;
            case 3: if ((tn & 7) < 4) dst = (bf16*)(ws + WS_RETQ); else { dst = (bf16*)(ws + WS_RETK); col -= 512; } ld = 512; break;
            case 4: dst = (bf16*)(ws + WS_RETV); break;
            case 5: dst = (bf16*)(ws + WS_RETG); act = 2; break;
            case 6: dst = (bf16*)(ws + WS_GML); act = 1; break;
            default: dst = (bf16*)(ws + WS_GRET); act = 1; break;
        }
        float o[4];
#pragma unroll
        for (int j = 0; j < 4; ++j) o[j] = act == 1 ? sigmoidf_(v[j]) : act == 2 ? siluf_(v[j]) : v[j];
        u32x2 w; w.x = pk2(o[0], o[1]); w.y = pk2(o[2], o[3]);
        *(u32x2*)(dst + (size_t)row * ld + col) = w;
    } };
DI void phase_inproj(Ctx& C) {
    AF_rows af{(const bf16*)(C.ws + WS_H1), D}; BF_inproj bf{C.w_in}; EF_inproj ef{C.ws};
    const int ntn = 64, nt = (T / 128) * ntn;
    for (int u = C.bid; u < nt; u += C.G) naive_gemm_tile(C, u / ntn, u % ntn, D, DIN, af, bf, ef);
}

DI void phase_conv_rope(Ctx& C) {
    const bf16* QKRAW = (const bf16*)(C.ws + WS_QKRAW); bf16* QC = (bf16*)(C.ws + WS_QC);
    for (int idx = C.bid * NTHR + C.tid; idx < T * 128; idx += C.G * NTHR) {
        const int t = idx >> 7, c0 = (idx & 127) * 8, s = t % SEQ;
        float acc[8];
#pragma unroll
        for (int e = 0; e < 8; ++e) acc[e] = C.conv_b[c0 + e];
#pragma unroll
        for (int j = 0; j < 4; ++j) {
            if (s - 3 + j >= 0) {
                float f[8]; unpack8(*(const u32x4*)(QKRAW + (size_t)(t - 3 + j) * D + c0), f);
#pragma unroll
                for (int e = 0; e < 8; ++e) acc[e] += f[e] * C.conv_w[j * D + c0 + e];
            }
        }
        const float sc = (c0 < 512) ? 0.08838834764831845f : 1.0f;
#pragma unroll
        for (int e = 0; e < 8; ++e) acc[e] = siluf_(acc[e]) * sc;
        *(u32x4*)(QC + (size_t)t * D + c0) = pack8(acc);
    }
#if !OPT_INPROJ
    const float* COS = (const float*)(C.ws + WS_COS); const float* SIN = (const float*)(C.ws + WS_SIN);
    for (int idx = C.bid * NTHR + C.tid; idx < T * 64; idx += C.G * NTHR) {
        const int t = idx >> 6, r = idx & 63, which = r >> 5, h = (r >> 3) & 3, i0 = (r & 7) * 8;
        bf16* base = (bf16*)(C.ws + (which ? WS_RETK : WS_RETQ)) + (size_t)t * 512 + h * 128;
        float x1[8], x2[8], o1[8], o2[8]; unpack8(*(const u32x4*)(base + i0), x1); unpack8(*(const u32x4*)(base + 64 + i0), x2);
        const float sc = which ? 0.08838834764831845f : 1.0f;
#pragma unroll
        for (int e = 0; e < 8; ++e) { const float cs = COS[t * 64 + i0 + e], sn = SIN[t * 64 + i0 + e]; o1[e] = (x1[e] * cs - x2[e] * sn) * sc; o2[e] = (x2[e] * cs + x1[e] * sn) * sc; }
        *(u32x4*)(base + i0) = pack8(o1); *(u32x4*)(base + 64 + i0) = pack8(o2);
    }
#endif
}

DI float ret_lg(int h) { return logf(1.0f - exp2f(-5.0f - (float)h)); }

DI void phase_local(Ctx& C) {
    LAS float* lf = (LAS float*)C.lds; LAS float* a = lf + 128; LAS float* ws = a + 128; LAS float* red = ws + 128;
    const float* IFG = (const float*)(C.ws + WS_IFG);
    bf16* CLOC = (bf16*)(C.ws + WS_CLOC);
    float* NLOC = (float*)(C.ws + WS_SMALL + SM_NLOC); float* MLOC = (float*)(C.ws + WS_SMALL + SM_MLOC); float* ACH = (float*)(C.ws + WS_SMALL + SM_ACH);
    const int t = C.tid;
    for (int u = C.bid; u < 1024; u += C.G) {
        const int mixer = u >> 9, bh = (u >> 5) & 15, ch = u & 31, b = bh >> 2, h = bh & 3, t0 = b * SEQ + ch * CH;
        const bf16 *Kp, *Vp; int ldk;
        if (mixer == 0) {
            if (t < 128) lf[t] = logsigmoidf_(IFG[(size_t)(t0 + t) * 8 + 4 + h]);
            __syncthreads();
            if (t < 128) { float s = 0.f; for (int j = 0; j <= t; ++j) s += lf[j]; a[t] = s; }
            __syncthreads();
            const float A = a[127];
            if (t < 128) ws[t] = A - a[t] + IFG[(size_t)(t0 + t) * 8 + h];
            __syncthreads();
            float mloc = -3.0e38f; for (int j = 0; j < 128; ++j) mloc = fmaxf(mloc, ws[j]);
            __syncthreads();
            if (t < 128) ws[t] = __expf(ws[t] - mloc);
            if (t == 0) { MLOC[bh * 32 + ch] = mloc; ACH[bh * 32 + ch] = A; }
            __syncthreads();
            Kp = (const bf16*)(C.ws + WS_QC) + (size_t)t0 * D + 512 + h * 128; ldk = D;
            Vp = (const bf16*)(C.ws + WS_MLV) + (size_t)t0 * D + h * 256;
        } else {
            const float lg = ret_lg(h);
            if (t < 128) ws[t] = __expf(lg * (float)(127 - t));
            __syncthreads();
            Kp = (const bf16*)(C.ws + WS_RETK) + (size_t)t0 * 512 + h * 128; ldk = 512;
            Vp = (const bf16*)(C.ws + WS_RETV) + (size_t)t0 * D + h * 256;
        }
        const int kh = t >> 8, v = t & 255;
        float acc[64];
#pragma unroll
        for (int i = 0; i < 64; ++i) acc[i] = 0.f;
        for (int s = 0; s < 128; ++s) {
            const float vv = ws[s] * bf2f(Vp[(size_t)s * D + v]);
            const bf16* kr = Kp + (size_t)s * ldk + kh * 64;
#pragma unroll
            for (int i8 = 0; i8 < 8; ++i8) { float f[8]; unpack8(*(const u32x4*)(kr + i8 * 8), f);
#pragma unroll
                for (int e = 0; e < 8; ++e) acc[i8 * 8 + e] += f[e] * vv; }
        }
        bf16* cl = CLOC + ((size_t)(mixer * 16 + bh) * 32 + ch) * 32768;
#pragma unroll
        for (int i = 0; i < 64; ++i) cl[(size_t)v * 128 + (kh * 64 + i)] = (bf16)f2bf(acc[i]);
        if (mixer == 0 && t < 128) { float s = 0.f; for (int j = 0; j < 128; ++j) s += ws[j] * bf2f(Kp[(size_t)j * ldk + t]); NLOC[(bh * 32 + ch) * 128 + t] = s; }
        __syncthreads();
    }
    (void)red;
}

DI void phase_scan(Ctx& C) {
    const bf16* CLOC = (const bf16*)(C.ws + WS_CLOC); bf16* CPREV = (bf16*)(C.ws + WS_CPREV);
    const float* NLOC = (const float*)(C.ws + WS_SMALL + SM_NLOC); float* NPREV = (float*)(C.ws + WS_SMALL + SM_NPREV);
    const float* MLOC = (const float*)(C.ws + WS_SMALL + SM_MLOC); const float* ACH = (const float*)(C.ws + WS_SMALL + SM_ACH); float* MPREV = (float*)(C.ws + WS_SMALL + SM_MPREV);
    for (int idx = C.bid * NTHR + C.tid; idx < 32 * 4096; idx += C.G * NTHR) {
        const int seq = idx >> 12, e8 = idx & 4095;
        float st[8];
#pragma unroll
        for (int e = 0; e < 8; ++e) st[e] = 0.f;
        if (seq < 16) {
            float m_st = 0.f; float nst[8];
#pragma unroll
            for (int e = 0; e < 8; ++e) nst[e] = 0.f;
            for (int ch = 0; ch < 32; ++ch) {
                const size_t o = ((size_t)seq * 32 + ch) * 32768 + (size_t)e8 * 8;
                *(u32x4*)(CPREV + o) = pack8(st);
                if (e8 < 16) { *(f32x4*)(NPREV + (seq * 32 + ch) * 128 + e8 * 8) = (f32x4){nst[0], nst[1], nst[2], nst[3]}; *(f32x4*)(NPREV + (seq * 32 + ch) * 128 + e8 * 8 + 4) = (f32x4){nst[4], nst[5], nst[6], nst[7]}; }
                if (e8 == 0) MPREV[seq * 32 + ch] = m_st;
                const float A = ACH[seq * 32 + ch], ml = MLOC[seq * 32 + ch];
                const float m_new = fmaxf(A + m_st, ml), sp = __expf(A + m_st - m_new), sl = __expf(ml - m_new);
                float f[8]; unpack8(*(const u32x4*)(CLOC + o), f);
#pragma unroll
                for (int e = 0; e < 8; ++e) st[e] = sp * st[e] + sl * f[e];
                if (e8 < 16) { const float* nl = NLOC + (seq * 32 + ch) * 128 + e8 * 8;
#pragma unroll
                    for (int e = 0; e < 8; ++e) nst[e] = sp * nst[e] + sl * nl[e]; }
                m_st = m_new;
            }
        } else {
            const float g = __expf(ret_lg(seq & 3) * 128.0f);
            for (int ch = 0; ch < 32; ++ch) {
                const size_t o = ((size_t)seq * 32 + ch) * 32768 + (size_t)e8 * 8;
                *(u32x4*)(CPREV + o) = pack8(st);
                float f[8]; unpack8(*(const u32x4*)(CLOC + o), f);
#pragma unroll
                for (int e = 0; e < 8; ++e) st[e] = g * st[e] + f[e];
            }
        }
    }
}

DI void phase_out(Ctx& C) {
    LAS float* av = (LAS float*)C.lds;
    LAS float* bv = av + 128;
    LAS float* mt = bv + 128;
    LAS float* isc = mt + 128;
    LAS float* den = isc + 128;
    LAS float* rs = den + 128;
    LAS float* P = rs + 1024;
    LAS float* Qs = P + 128 * 129;
    const float* IFG = (const float*)(C.ws + WS_IFG);
    const bf16* CPREV = (const bf16*)(C.ws + WS_CPREV);
    const float* NPREV = (const float*)(C.ws + WS_SMALL + SM_NPREV); const float* MPREV = (const float*)(C.ws + WS_SMALL + SM_MPREV);
    const int t = C.tid;
    for (int u = C.bid; u < 1024; u += C.G) {
        const int mixer = u >> 9, bh = (u >> 5) & 15, ch = u & 31, b = bh >> 2, h = bh & 3, t0 = b * SEQ + ch * CH;
        const bf16 *Qp, *Kp, *Vp; int ldq; const bf16* cp = CPREV + ((size_t)(mixer * 16 + bh) * 32 + ch) * 32768;
        float lg = 0.f;
        if (mixer == 0) {
            Qp = (const bf16*)(C.ws + WS_QC) + (size_t)t0 * D + h * 128; Kp = Qp + 512; ldq = D;
            Vp = (const bf16*)(C.ws + WS_MLV) + (size_t)t0 * D + h * 256;
            if (t < 128) mt[t] = logsigmoidf_(IFG[(size_t)(t0 + t) * 8 + 4 + h]);
            __syncthreads();
            if (t < 128) { float s = 0.f; for (int j = 0; j <= t; ++j) s += mt[j]; av[t] = s; bv[t] = IFG[(size_t)(t0 + t) * 8 + h] - s; }
            __syncthreads();
            if (t < 128) { float cm = -3.0e38f; for (int j = 0; j <= t; ++j) cm = fmaxf(cm, bv[j]);
                const float il = av[t] + MPREV[bh * 32 + ch], m = fmaxf(il, av[t] + cm); isc[t] = __expf(il - m); mt[t] = m; }
        } else {
            lg = ret_lg(h);
            Qp = (const bf16*)(C.ws + WS_RETQ) + (size_t)t0 * 512 + h * 128; Kp = (const bf16*)(C.ws + WS_RETK) + (size_t)t0 * 512 + h * 128; ldq = 512;
            Vp = (const bf16*)(C.ws + WS_RETV) + (size_t)t0 * D + h * 256;
            if (t < 128) isc[t] = __expf(lg * (float)(t + 1));
        }
        for (int e = t; e < 128 * 16; e += NTHR) { const int j = e >> 4, k8 = e & 15; float f[8]; unpack8(*(const u32x4*)(Qp + (size_t)j * ldq + k8 * 8), f);
#pragma unroll
            for (int i = 0; i < 8; ++i) Qs[j * 129 + k8 * 8 + i] = f[i]; }
        __syncthreads();
        for (int e = t; e < 128 * 128; e += NTHR) {
            const int j = e >> 7, s = e & 127; float p = 0.f;
            if (s <= j) {
                float d = 0.f;
#pragma unroll 4
                for (int k8 = 0; k8 < 16; ++k8) { float fk[8]; unpack8(*(const u32x4*)(Kp + (size_t)s * ldq + k8 * 8), fk);
#pragma unroll
                    for (int i = 0; i < 8; ++i) d += Qs[j * 129 + k8 * 8 + i] * fk[i]; }
                p = d * (mixer == 0 ? __expf(av[j] + bv[s] - mt[j]) : __expf(lg * (float)(j - s)));
            }
            P[j * 129 + s] = p;
        }
        __syncthreads();
        if (mixer == 0 && t < 128) { float s = 0.f; for (int i = 0; i < 128; ++i) s += P[t * 129 + i];
            float qn = 0.f; const float* np = NPREV + (bh * 32 + ch) * 128; for (int k = 0; k < 128; ++k) qn += Qs[t * 129 + k] * np[k];
            den[t] = fmaxf(fabsf(s + isc[t] * qn), __expf(-mt[t])); }
        __syncthreads();
        const float gain = (mixer == 0 ? C.ml_norm_g : C.ret_norm_g)[h * 256 + (t & 255)];
#pragma unroll 1
        for (int pass = 0; pass < 2; ++pass) {
            const int jh = t >> 8, v = t & 255, r0 = (pass * 2 + jh) * 32;
            float acc[32];
#pragma unroll
            for (int i = 0; i < 32; ++i) acc[i] = 0.f;
            const LAS float* qb = Qs + r0 * 129; const LAS float* pb = P + r0 * 129;
            for (int k = 0; k < 128; ++k) {
                const float cv = bf2f(cp[(size_t)v * 128 + k]);
#pragma unroll
                for (int i = 0; i < 32; ++i) acc[i] += qb[i * 129 + k] * cv;
            }
#pragma unroll
            for (int i = 0; i < 32; ++i) acc[i] *= isc[r0 + i];
            for (int s = 0; s < 128; ++s) {
                const float vv = bf2f(Vp[(size_t)s * D + v]);
#pragma unroll
                for (int i = 0; i < 32; ++i) acc[i] += pb[i * 129 + s] * vv;
            }
            if (mixer == 0) {
#pragma unroll
                for (int i = 0; i < 32; ++i) acc[i] = acc[i] / den[r0 + i];
            }
            const int wq = C.wave & 3;
#pragma unroll
            for (int i = 0; i < 32; ++i) { const float s1 = wave_sum(acc[i]); if (C.lane == 0) rs[wq * 128 + r0 + i] = s1; }
            __syncthreads();
#pragma unroll
            for (int i = 0; i < 32; ++i) { const int r = r0 + i; acc[i] -= (rs[r] + rs[128 + r] + rs[256 + r] + rs[384 + r]) * (1.0f / 256.0f); }
#pragma unroll
            for (int i = 0; i < 32; ++i) { const float s2 = wave_sum(acc[i] * acc[i]); if (C.lane == 0) rs[512 + wq * 128 + r0 + i] = s2; }
            __syncthreads();
            const bf16* gate = (const bf16*)(C.ws + (mixer == 0 ? WS_MLO : WS_RETG)) + (size_t)t0 * D + h * 256 + v;
            bf16* outp = (bf16*)(C.ws + (mixer == 0 ? WS_HML : WS_HRET)) + (size_t)t0 * D + h * 256 + v;
#pragma unroll
            for (int i = 0; i < 32; ++i) { const int r = r0 + i;
                const float var = (rs[512 + r] + rs[512 + 128 + r] + rs[512 + 256 + r] + rs[512 + 384 + r]) * (1.0f / 256.0f);
                const float y = acc[i] * (1.0f / sqrtf(var + EPS)) * gain * bf2f(gate[(size_t)r * D]);
                outp[(size_t)r * D] = (bf16)f2bf(y); }
            __syncthreads();
        }
    }
}

struct BF_plain { const float* w; DI const float* ptr(int, int tn) const { return w + tn * 128; } };
struct EF_f32 { float* dst; DI void put(int tm, int tn, int r, int c, const float (&v)[4]) const { *(f32x4*)(dst + (size_t)(tm * 128 + r) * D + tn * 128 + c) = (f32x4){v[0], v[1], v[2], v[3]}; } };
struct EF_merge { const float* t1; const bf16* g1; const bf16* g2; bf16* y;
    DI void put(int tm, int tn, int r, int c, const float (&v)[4]) const {
        const size_t o = (size_t)(tm * 128 + r) * D + tn * 128 + c; const f32x4 a = *(const f32x4*)(t1 + o);
        const u32x2 w1 = *(const u32x2*)(g1 + o), w2 = *(const u32x2*)(g2 + o);
        const float o0 = __uint_as_float(w1.x << 16) * a.x + __uint_as_float(w2.x << 16) * v[0], o1 = __uint_as_float(w1.x & 0xffff0000u) * a.y + __uint_as_float(w2.x & 0xffff0000u) * v[1];
        const float o2 = __uint_as_float(w1.y << 16) * a.z + __uint_as_float(w2.y << 16) * v[2], o3 = __uint_as_float(w1.y & 0xffff0000u) * a.w + __uint_as_float(w2.y & 0xffff0000u) * v[3];
        u32x2 w; w.x = pk2(o0, o1); w.y = pk2(o2, o3); *(u32x2*)(y + o) = w; } };
DI void phase_branch(Ctx& C) {
    AF_rows a1{(const bf16*)(C.ws + WS_HML), D}, a2{(const bf16*)(C.ws + WS_HRET), D}; BF_plain b1{C.w_bml}, b2{C.w_bret};
    EF_f32 e1{(float*)(C.ws + WS_TMP)}; EF_merge e2{(const float*)(C.ws + WS_TMP), (const bf16*)(C.ws + WS_GML), (const bf16*)(C.ws + WS_GRET), (bf16*)(C.ws + WS_H1)};
    const int nt = (T / 128) * 8;
    for (int u = C.bid; u < nt; u += C.G) { naive_gemm_tile(C, u / 8, u % 8, D, D, a1, b1, e1); naive_gemm_tile(C, u / 8, u % 8, D, D, a2, b2, e2); }
}
struct EF_resid { const float* x; const float* mod; float* x1;
    DI void put(int tm, int tn, int r, int c, const float (&v)[4]) const {
        const int row = tm * 128 + r, col = tn * 128 + c, b = row / SEQ; const size_t o = (size_t)row * D + col;
        const f32x4 xv = *(const f32x4*)(x + o), g = *(const f32x4*)(mod + b * 6144 + 2048 + col);
        *(f32x4*)(x1 + o) = xv + g * (f32x4){v[0], v[1], v[2], v[3]}; } };
DI void phase_outproj(Ctx& C) {
    AF_rows a{(const bf16*)(C.ws + WS_H1), D}; BF_plain b{C.w_out}; EF_resid e{C.x, (const float*)(C.ws + WS_MOD), (float*)(C.ws + WS_X1)};
    const int nt = (T / 128) * 8;
    for (int u = C.bid; u < nt; u += C.G) naive_gemm_tile(C, u / 8, u % 8, D, D, a, b, e);
}

DI void phase_norm2_route(Ctx& C) {
    LAS float* wr = (LAS float*)C.lds;
    LAS float* lg = wr + 32768;
    for (int i = C.tid; i < 32768 / 4; i += NTHR) *(LAS f32x4*)(wr + i * 4) = *(const f32x4*)(C.w_router + i * 4);
    __syncthreads();
    const float* mod = (const float*)(C.ws + WS_MOD); const float* X1 = (const float*)(C.ws + WS_X1);
    bf16* H2 = (bf16*)(C.ws + WS_H1);
    int* TOPI = (int*)(C.ws + WS_ROUTE + RT_TOPI); float* TOPW = (float*)(C.ws + WS_ROUTE + RT_TOPW); int* RANK = (int*)(C.ws + WS_ROUTE + RT_RANK);
    unsigned* CNT = (unsigned*)(C.ws + WS_CTL) + CW_CNT;
    const int lane = C.lane, gw = C.bid * NWAVES + C.wave, NGW = C.G * NWAVES;
    for (int m = gw; m < T; m += NGW) {
        const int b = m / SEQ;
        const f32x4* xr = (const f32x4*)(X1 + (size_t)m * D) + lane;
        f32x4 v[4]; float ss = 0.f;
#pragma unroll
        for (int j = 0; j < 4; ++j) { v[j] = xr[64 * j]; ss += (v[j].x * v[j].x + v[j].y * v[j].y) + (v[j].z * v[j].z + v[j].w * v[j].w); }
        const float rstd = 1.0f / sqrtf(wave_sum(ss) * (1.0f / D) + EPS);
        float acc[32];
#pragma unroll
        for (int e = 0; e < 32; ++e) acc[e] = 0.f;
        u32x2* o8 = (u32x2*)(H2 + (size_t)m * D) + lane;
#pragma unroll
        for (int j = 0; j < 4; ++j) {
            const int col = 4 * (lane + 64 * j);
            const f32x4 g = *(const f32x4*)(C.norm_ffn_g + col), sh = *(const f32x4*)(mod + b * 6144 + 3072 + col), sc = *(const f32x4*)(mod + b * 6144 + 4096 + col);
            const f32x4 h = (v[j] * rstd * g) * (sc + 1.0f) + sh;
            u32x2 w; w.x = pk2(h.x, h.y); w.y = pk2(h.z, h.w); o8[64 * j] = w;
            const float hh[4] = {h.x, h.y, h.z, h.w};
#pragma unroll
            for (int i = 0; i < 4; ++i) {
                const LAS f32x4* wp = (const LAS f32x4*)(wr + (col + i) * 32);
#pragma unroll
                for (int e4 = 0; e4 < 8; ++e4) { const f32x4 w4 = wp[e4]; acc[e4 * 4 + 0] += hh[i] * w4.x; acc[e4 * 4 + 1] += hh[i] * w4.y; acc[e4 * 4 + 2] += hh[i] * w4.z; acc[e4 * 4 + 3] += hh[i] * w4.w; }
                asm volatile("" ::: "memory");
            }
        }
#pragma unroll
        for (int e = 0; e < 32; ++e) acc[e] = wave_sum(acc[e]);
        float l[32];
#pragma unroll
        for (int e = 0; e < 32; ++e) l[e] = acc[e] + C.b_router[e];
        float tv[4]; int ti[4];
#pragma unroll
        for (int k = 0; k < 4; ++k) {
            float bvv = -3.0e38f; int bi = 0;
#pragma unroll
            for (int e = 0; e < 32; ++e) { const bool take = l[e] > bvv; bvv = take ? l[e] : bvv; bi = take ? e : bi; }
            tv[k] = bvv; ti[k] = bi;
#pragma unroll
            for (int e = 0; e < 32; ++e) l[e] = (e == bi) ? -3.0e38f : l[e];
        }
        const float e1 = __expf(tv[1] - tv[0]), e2 = __expf(tv[2] - tv[0]), e3 = __expf(tv[3] - tv[0]), inv = 1.0f / (1.0f + e1 + e2 + e3);
        if (lane < 4) {
            const int e = lane == 0 ? ti[0] : lane == 1 ? ti[1] : lane == 2 ? ti[2] : ti[3];
            const float w = (lane == 0 ? 1.0f : lane == 1 ? e1 : lane == 2 ? e2 : e3) * inv;
            TOPI[m * 4 + lane] = e; TOPW[m * 4 + lane] = w; RANK[m * 4 + lane] = (int)atomicAdd(CNT + e, 1u);
        }
    }
    (void)lg;
    int* SLOTTOK = (int*)(C.ws + WS_ROUTE + RT_SLOTTOK); float* SLOTW = (float*)(C.ws + WS_ROUTE + RT_SLOTW);
    for (int i = C.bid * NTHR + C.tid; i < NSLOTS; i += C.G * NTHR) { SLOTTOK[i] = T; SLOTW[i] = 0.f; }
    if (C.bid == 0) for (int i = C.tid; i < D / 2; i += NTHR) ((unsigned*)(H2 + (size_t)T * D))[i] = 0u;
    __syncthreads();
}

DI void phase_slots(Ctx& C) {
    LAS int* pstart = (LAS int*)C.lds;
    unsigned* CNT = (unsigned*)(C.ws + WS_CTL) + CW_CNT;
    unsigned* ctl = (unsigned*)(C.ws + WS_CTL);
    if (C.tid == 0) {
        int nb = 0;
        for (int e = 0; e < NE; ++e) { pstart[e] = nb * 256; const int bl = ((int)__hip_atomic_load(CNT + e, __ATOMIC_RELAXED, __HIP_MEMORY_SCOPE_AGENT) + 255) >> 8;
            if (C.bid == 0) for (int i = 0; i < bl; ++i) ctl[CW_BLKE + nb + i] = (unsigned)e;
            nb += bl; }
        if (C.bid == 0) ctl[CW_NBLK] = (unsigned)nb;
    }
    __syncthreads();
    const int* TOPI = (const int*)(C.ws + WS_ROUTE + RT_TOPI); const float* TOPW = (const float*)(C.ws + WS_ROUTE + RT_TOPW); const int* RANK = (const int*)(C.ws + WS_ROUTE + RT_RANK);
    int* ASLOT = (int*)(C.ws + WS_ROUTE + RT_ASLOT); int* SLOTTOK = (int*)(C.ws + WS_ROUTE + RT_SLOTTOK); float* SLOTW = (float*)(C.ws + WS_ROUTE + RT_SLOTW);
    for (int i = C.bid * NTHR + C.tid; i < T * 4; i += C.G * NTHR) {
        const int slot = pstart[TOPI[i]] + RANK[i];
        ASLOT[i] = slot; SLOTTOK[slot] = i >> 2; SLOTW[slot] = TOPW[i];
    }
    __syncthreads();
}

struct AF_gather { const bf16* base; const int* slottok; DI const bf16* row(int tm, int r) const { return base + (size_t)slottok[tm * 128 + r] * D; } };
struct BF_expert { const float* w; const unsigned* blke; size_t estride; DI const float* ptr(int tm, int tn) const { return w + (size_t)blke[tm >> 1] * estride + tn * 128; } };
struct EF_swiglu { const float* bias; const unsigned* blke; bf16* act;
    DI void put(int tm, int tn, int r, int c, const float (&v)[4]) const {
        const int e = (int)blke[tm >> 1]; const float* bp = bias + (size_t)e * 2048 + tn * 128 + c;
        float o[2];
#pragma unroll
        for (int j = 0; j < 2; ++j) { const float xg = fminf(v[2 * j] + bp[2 * j], 7.0f), xl = fminf(fmaxf(v[2 * j + 1] + bp[2 * j + 1], -7.0f), 7.0f); o[j] = xg * sigmoidf_(1.702f * xg) * (xl + 1.0f); }
        *(unsigned*)(act + (size_t)(tm * 128 + r) * D + (tn * 128 + c) / 2) = pk2(o[0], o[1]); } };
DI void phase_gateup(Ctx& C) {
    const unsigned* ctl = (const unsigned*)(C.ws + WS_CTL); const int nblk = (int)ctl[CW_NBLK];
    AF_gather a{(const bf16*)(C.ws + WS_H1), (const int*)(C.ws + WS_ROUTE + RT_SLOTTOK)}; BF_expert b{C.w_gu, ctl + CW_BLKE, (size_t)D * 2048};
    EF_swiglu e{C.b_gu, ctl + CW_BLKE, (bf16*)(C.ws + WS_ACT)};
    const int nt = nblk * 2 * 16;
    for (int u = C.bid; u < nt; u += C.G) naive_gemm_tile(C, u / 16, u % 16, D, 2048, a, b, e);
}
struct EF_down { const float* bias; const unsigned* blke; const float* slotw; bf16* ys;
    DI void put(int tm, int tn, int r, int c, const float (&v)[4]) const {
        const int e = (int)blke[tm >> 1], slot = tm * 128 + r; const float w = slotw[slot]; const float* bp = bias + (size_t)e * D + tn * 128 + c;
        u32x2 o; o.x = pk2((v[0] + bp[0]) * w, (v[1] + bp[1]) * w); o.y = pk2((v[2] + bp[2]) * w, (v[3] + bp[3]) * w);
        *(u32x2*)(ys + (size_t)slot * D + tn * 128 + c) = o; } };
DI void phase_down(Ctx& C) {
    const unsigned* ctl = (const unsigned*)(C.ws + WS_CTL); const int nblk = (int)ctl[CW_NBLK];
    AF_rows a{(const bf16*)(C.ws + WS_ACT), D}; BF_expert b{C.w_dn, ctl + CW_BLKE, (size_t)D * D};
    EF_down e{C.b_dn, ctl + CW_BLKE, (const float*)(C.ws + WS_ROUTE + RT_SLOTW), (bf16*)(C.ws + WS_YS)};
    const int nt = nblk * 2 * 8;
    for (int u = C.bid; u < nt; u += C.G) naive_gemm_tile(C, u / 8, u % 8, D, D, a, b, e);
}
DI void phase_final(Ctx& C) {
    const float* mod = (const float*)(C.ws + WS_MOD); const float* X1 = (const float*)(C.ws + WS_X1); const bf16* YS = (const bf16*)(C.ws + WS_YS);
    const int* ASLOT = (const int*)(C.ws + WS_ROUTE + RT_ASLOT);
    const int lane = C.lane, gw = C.bid * NWAVES + C.wave, NGW = C.G * NWAVES;
    for (int m = gw; m < T; m += NGW) {
        const int b = m / SEQ;
        const int s0 = ASLOT[m * 4 + 0], s1 = ASLOT[m * 4 + 1], s2 = ASLOT[m * 4 + 2], s3 = ASLOT[m * 4 + 3];
        f32x4 v[4]; float ss = 0.f;
#pragma unroll
        for (int j = 0; j < 4; ++j) {
            const int col = 4 * (lane + 64 * j);
            f32x4 y = (f32x4){0.f, 0.f, 0.f, 0.f};
            const int sl[4] = {s0, s1, s2, s3};
#pragma unroll
            for (int k = 0; k < 4; ++k) { const u32x2 w = *(const u32x2*)(YS + (size_t)sl[k] * D + col);
                y += (f32x4){__uint_as_float(w.x << 16), __uint_as_float(w.x & 0xffff0000u), __uint_as_float(w.y << 16), __uint_as_float(w.y & 0xffff0000u)}; }
            const f32x4 g = *(const f32x4*)(mod + b * 6144 + 5120 + col);
            v[j] = *(const f32x4*)(X1 + (size_t)m * D + col) + g * y;
            ss += (v[j].x * v[j].x + v[j].y * v[j].y) + (v[j].z * v[j].z + v[j].w * v[j].w);
        }
        const float rstd = 1.0f / sqrtf(wave_sum(ss) * (1.0f / D) + EPS);
#pragma unroll
        for (int j = 0; j < 4; ++j) { const int col = 4 * (lane + 64 * j); *(f32x4*)(C.out + (size_t)m * D + col) = v[j] * rstd * *(const f32x4*)(C.norm_final_g + col); }
    }
}

namespace pg8 {
typedef short bf16x8 __attribute__((ext_vector_type(8)));
constexpr int BM = 256, BK = 64, HALF = 128, HTB = HALF * BK * 2, STAGE_BYTES = 8 * HTB, NXCD = 8, WGM = 8;
DI int lds_byte(int r, int c) { const int st = (r >> 4) * 2 + (c >> 5), rr = r & 15, cc = c & 31, ob = rr * 64 + cc * 2; return st * 1024 + (ob ^ (((ob >> 9) & 1) << 5)); }
DI void stage_rc(int b, int& R, int& C) { const int st = b / 1024, sb = b % 1024, swz = sb ^ (((sb >> 9) & 1) << 5); R = (st >> 1) * 16 + swz / 64; C = (st & 1) * 32 + (swz % 64) / 2; }
struct Unit { int pm, pn, aux; };
struct Gemm { const bf16* A; const bf16* Bt; int K; };
DI unsigned cvt_pk_bf16(float lo, float hi) { unsigned r; asm volatile("v_cvt_pk_bf16_f32 %0, %1, %2" : "=v"(r) : "v"(lo), "v"(hi)); return r; }

struct TileOrder {
    int nM, nN, nwg;
    DI void init(int nM_, int nN_) { nM = nM_; nN = nN_; nwg = nM * nN; }
    DI bool tile(long L, int& pm, int& pn) const {
        if (L >= nwg) return false;
        int wgid = (int)L; { const int q = nwg / NXCD, r = nwg % NXCD, xcd = wgid % NXCD, off = wgid / NXCD; wgid = (xcd < r ? xcd * (q + 1) : r * (q + 1) + (xcd - r) * q) + off; }
        const int nig = WGM * nN, gid = wgid / nig, fm = gid * WGM, gsz = (nM - fm) < WGM ? (nM - fm) : WGM;
        pm = fm + ((wgid % nig) % gsz); pn = (wgid % nig) / gsz; return true;
    }
};

template <class Epi, class Sched, bool ALIGN_EPI, bool SP2>
DI void gemm_phase(LAS unsigned char* lds, const Gemm g, const Sched& S, const Epi& E) {
    const int tid = threadIdx.x, wid = __builtin_amdgcn_readfirstlane(tid >> 6), lane = tid & 63, wr = wid >> 2, wc = wid & 3, fr = lane & 15, fq = lane >> 4;
    const int K = g.K, nt = K / BK;
    unsigned voffB[2]; int Rr[2]; unsigned cb[2];
#pragma unroll
    for (int i = 0; i < 2; ++i) { int R, C; stage_rc(tid * 16 + i * 8192, R, C); voffB[i] = (unsigned)(R * K + C) * 2u; Rr[i] = R; cb[i] = (unsigned)C * 2u; }
    const size_t kstep = (size_t)(BK * 2);
    const size_t hstep = (size_t)HALF * K * 2;
    const size_t tstep = 2 * hstep;
    const unsigned ldsw = (unsigned)wid * 1024u;
    const int aoff = lds_byte(wr * 64 + fr, fq * 8), boff = lds_byte(wc * 32 + fr, fq * 8);
    const unsigned rowb = (unsigned)K * 2u;
#define PG8_SA(b, h) (((b) * 2 + (h)) * HTB)
#define PG8_SB(b, h) ((4 + (b) * 2 + (h)) * HTB)
#define PG8_STAGE(bufoff, gbase, voff) do { _Pragma("unroll") for (int _i = 0; _i < 2; ++_i) \
        __builtin_amdgcn_global_load_lds((const unsigned*)((const char*)(gbase) + (voff)[_i]), (LAS unsigned*)(lds + (bufoff) + ldsw + _i * 8192), 16, 0, 0); } while (0)
#define PG8_LDA(dst, b, h) do { _Pragma("unroll") for (int m = 0; m < 4; ++m) _Pragma("unroll") for (int k = 0; k < 2; ++k) dst[m][k] = *(const LAS bf16x8*)(lds + PG8_SA(b, h) + aoff + m * 2048 + k * 1024); } while (0)
#define PG8_LDB(dst, b, h) do { _Pragma("unroll") for (int n = 0; n < 2; ++n) _Pragma("unroll") for (int k = 0; k < 2; ++k) dst[n][k] = *(const LAS bf16x8*)(lds + PG8_SB(b, h) + boff + n * 2048 + k * 1024); } while (0)
#define PG8_MMA(ai, bj, At, Bt) do { __builtin_amdgcn_s_setprio(1); _Pragma("unroll") for (int m = 0; m < 4; ++m) _Pragma("unroll") for (int n = 0; n < 2; ++n) _Pragma("unroll") for (int k = 0; k < 2; ++k) \
        acc[ai][bj][m][n] = __builtin_amdgcn_mfma_f32_16x16x32_bf16(Bt[n][k], At[m][k], acc[ai][bj][m][n], 0, 0, 0); __builtin_amdgcn_s_setprio(0); } while (0)
#define PG8_WAIT_V(n) asm volatile("s_waitcnt vmcnt(" #n ")" ::: "memory")
#define PG8_WAIT_L(n) asm volatile("s_waitcnt lgkmcnt(" #n ")" ::: "memory")
#define PG8_BAR __builtin_amdgcn_s_barrier()
#define PG8_SCHED __builtin_amdgcn_sched_barrier(0)
    Unit cur, nxt; int ui = 0;
    if (!S.next(0, cur)) return;
    f32x4 acc[2][2][4][2];
#pragma unroll
    for (int a = 0; a < 2; ++a)
#pragma unroll
        for (int b = 0; b < 2; ++b)
#pragma unroll
            for (int m = 0; m < 4; ++m)
#pragma unroll
                for (int n = 0; n < 2; ++n) acc[a][b][m][n] = (f32x4){0.f, 0.f, 0.f, 0.f};
    bf16x8 At[4][2], B0[2][2], B1[2][2];
    const char* Ab = (const char*)g.A;
    const char* cB = (const char*)g.Bt + (size_t)cur.pn * tstep;
    unsigned c0[2], c1[2], n0[2], n1[2];
#pragma unroll
    for (int i = 0; i < 2; ++i) { c0[i] = (unsigned)S.arow(cur, Rr[i]) * rowb + cb[i]; c1[i] = (unsigned)S.arow(cur, HALF + Rr[i]) * rowb + cb[i]; n0[i] = c0[i]; n1[i] = c1[i]; }
    if constexpr (SP2) {
        PG8_STAGE(PG8_SB(0, 0), cB, voffB); PG8_STAGE(PG8_SB(0, 1), cB + hstep, voffB); PG8_STAGE(PG8_SA(0, 0), Ab, c0); PG8_STAGE(PG8_SA(0, 1), Ab, c1);
        if (wr == 1) PG8_BAR;
        PG8_WAIT_V(2); PG8_BAR;
        PG8_STAGE(PG8_SB(1, 0), cB + kstep, voffB); PG8_STAGE(PG8_SA(1, 0), Ab + kstep, c0); PG8_STAGE(PG8_SB(1, 1), cB + hstep + kstep, voffB);
        PG8_WAIT_V(6); PG8_BAR;
    } else {
        PG8_STAGE(PG8_SB(0, 0), cB, voffB); PG8_STAGE(PG8_SA(0, 0), Ab, c0); PG8_STAGE(PG8_SB(0, 1), cB + hstep, voffB); PG8_STAGE(PG8_SA(0, 1), Ab, c1);
        if (wr == 1) PG8_BAR;
        PG8_WAIT_V(4); PG8_BAR;
        PG8_STAGE(PG8_SB(1, 0), cB + kstep, voffB); PG8_STAGE(PG8_SA(1, 0), Ab + kstep, c0); PG8_STAGE(PG8_SB(1, 1), cB + hstep + kstep, voffB);
        PG8_WAIT_V(6); PG8_BAR;
    }
    for (;;) {
        const bool has_next = S.next(ui + 1, nxt);
        const char* nB = has_next ? (const char*)g.Bt + (size_t)nxt.pn * tstep : cB;
        if (has_next) {
#pragma unroll
            for (int i = 0; i < 2; ++i) { n0[i] = (unsigned)S.arow(nxt, Rr[i]) * rowb + cb[i]; n1[i] = (unsigned)S.arow(nxt, HALF + Rr[i]) * rowb + cb[i]; }
        } else {
#pragma unroll
            for (int i = 0; i < 2; ++i) { n0[i] = c0[i]; n1[i] = c1[i]; }
        }
        for (int t = 0; t < nt; t += 2) {
            const bool last = (t == nt - 2);
            const char* a1 = Ab + (size_t)(t + 1) * kstep;
            const char* a2 = last ? Ab : Ab + (size_t)(t + 2) * kstep; const char* b2 = last ? nB : cB + (size_t)(t + 2) * kstep;
            const char* a3 = a2 + kstep; const char* b3 = b2 + kstep;
            unsigned x0[2], x1[2];
#pragma unroll
            for (int i = 0; i < 2; ++i) { x0[i] = last ? n0[i] : c0[i]; x1[i] = last ? n1[i] : c1[i]; }
            if constexpr (SP2) {
            PG8_LDB(B0, 0, 0); PG8_LDB(B1, 0, 1); PG8_SCHED; PG8_LDA(At, 0, 0); PG8_STAGE(PG8_SA(1, 1), a1, c1);
            PG8_WAIT_V(8); PG8_WAIT_L(0); PG8_BAR; PG8_MMA(0, 0, At, B0); PG8_MMA(0, 1, At, B1); PG8_BAR; PG8_SCHED;
            PG8_LDA(At, 0, 1); PG8_STAGE(PG8_SB(0, 0), b2, voffB); PG8_STAGE(PG8_SB(0, 1), b2 + hstep, voffB); PG8_STAGE(PG8_SA(0, 0), a2, x0);
            PG8_WAIT_V(8); PG8_WAIT_L(0); PG8_BAR; PG8_MMA(1, 0, At, B0); PG8_MMA(1, 1, At, B1); PG8_BAR; PG8_SCHED;
            PG8_LDB(B0, 1, 0); PG8_LDB(B1, 1, 1); PG8_SCHED; PG8_LDA(At, 1, 0); PG8_STAGE(PG8_SA(0, 1), a2, x1);
            PG8_WAIT_V(8); PG8_WAIT_L(0); PG8_BAR; PG8_MMA(0, 0, At, B0); PG8_MMA(0, 1, At, B1); PG8_BAR; PG8_SCHED;
            PG8_LDA(At, 1, 1); PG8_STAGE(PG8_SB(1, 0), b3, voffB); PG8_STAGE(PG8_SB(1, 1), b3 + hstep, voffB); PG8_STAGE(PG8_SA(1, 0), a3, x0);
            PG8_WAIT_V(8); PG8_WAIT_L(0); PG8_BAR; PG8_MMA(1, 0, At, B0); PG8_MMA(1, 1, At, B1); PG8_BAR; PG8_SCHED;
            } else {
            PG8_LDB(B0, 0, 0); PG8_SCHED; PG8_LDA(At, 0, 0); PG8_STAGE(PG8_SA(1, 1), a1, c1);
            PG8_WAIT_L(8); PG8_BAR; PG8_WAIT_L(0); PG8_MMA(0, 0, At, B0); PG8_BAR; PG8_SCHED;
            PG8_LDB(B1, 0, 1); PG8_STAGE(PG8_SB(0, 0), b2, voffB);
            PG8_BAR; PG8_WAIT_L(0); PG8_MMA(0, 1, At, B1); PG8_BAR;
            PG8_LDA(At, 0, 1); PG8_STAGE(PG8_SA(0, 0), a2, x0);
            PG8_BAR; PG8_WAIT_L(0); PG8_MMA(1, 0, At, B0); PG8_BAR; PG8_SCHED;
            PG8_STAGE(PG8_SB(0, 1), b2 + hstep, voffB);
            PG8_WAIT_V(6); PG8_BAR; PG8_MMA(1, 1, At, B1); PG8_BAR;
            PG8_LDB(B0, 1, 0); PG8_SCHED; PG8_LDA(At, 1, 0); PG8_STAGE(PG8_SA(0, 1), a2, x1);
            PG8_WAIT_L(8); PG8_BAR; PG8_WAIT_L(0); PG8_MMA(0, 0, At, B0); PG8_BAR; PG8_SCHED;
            PG8_LDB(B1, 1, 1); PG8_STAGE(PG8_SB(1, 0), b3, voffB);
            PG8_BAR; PG8_WAIT_L(0); PG8_MMA(0, 1, At, B1); PG8_BAR;
            PG8_LDA(At, 1, 1); PG8_STAGE(PG8_SA(1, 0), a3, x0);
            PG8_BAR; PG8_WAIT_L(0); PG8_MMA(1, 0, At, B0); PG8_BAR; PG8_SCHED;
            PG8_STAGE(PG8_SB(1, 1), b3 + hstep, voffB);
            PG8_WAIT_V(6); PG8_BAR; PG8_MMA(1, 1, At, B1); PG8_BAR;
            }
        }
        if constexpr (ALIGN_EPI) { if (wr == 0) PG8_BAR; }
        const bool keep = E(acc, cur, wr, wc, fr, fq);
        if (!has_next) break;
        if (!keep) {
#pragma unroll
            for (int a = 0; a < 2; ++a)
#pragma unroll
                for (int b = 0; b < 2; ++b)
#pragma unroll
                    for (int m = 0; m < 4; ++m)
#pragma unroll
                        for (int n = 0; n < 2; ++n) acc[a][b][m][n] = (f32x4){0.f, 0.f, 0.f, 0.f};
        }
        cur = nxt; cB = nB; ++ui;
#pragma unroll
        for (int i = 0; i < 2; ++i) { c0[i] = n0[i]; c1[i] = n1[i]; }
        if constexpr (ALIGN_EPI) { if (wr == 1) PG8_BAR; }
    }
    PG8_WAIT_V(0);
    if constexpr (!ALIGN_EPI) { if (wr == 0) PG8_BAR; }
    PG8_BAR;
#undef PG8_SA
#undef PG8_SB
#undef PG8_STAGE
#undef PG8_LDA
#undef PG8_LDB
#undef PG8_MMA
#undef PG8_WAIT_V
#undef PG8_WAIT_L
#undef PG8_BAR
#undef PG8_SCHED
}
}

DI int pos_bf8(int o) { const int o32 = o & 31; return (o & ~31) | (16 * ((o32 >> 2) & 1) + 4 * (o32 >> 3) + (o32 & 3)); }
DI int pos_rope(int o) { const int head = o >> 7, bj = (o >> 6) & 1, r = o & 63, w = r >> 5, fq = (r >> 3) & 3, n = (r >> 2) & 1, j = r & 3; return 128 * bj + 32 * (2 * head + w) + 16 * n + 4 * fq + j; }
DI int pos_swiglu(int o) { const int wc = o >> 6, fq = (o >> 4) & 3, bj = (o >> 3) & 1, n = (o >> 2) & 1, j = o & 3; return 128 * bj + 32 * wc + 16 * n + 4 * fq + j; }
template <int PT  >
DI void tr_item(const float* src, int ldw, int K, bf16* WT, int tile_row0, int o0  , int k0, LAS float* scr, int lane) {
    float v[32];
#pragma unroll
    for (int i = 0; i < 32; ++i) { const int kk = 2 * i + (lane >> 5); v[i] = src[(size_t)kk * ldw + (lane & 31)]; }
#pragma unroll
    for (int i = 0; i < 32; ++i) { const int kk = 2 * i + (lane >> 5); scr[kk * 33 + (lane & 31)] = v[i]; }
    asm volatile("s_waitcnt lgkmcnt(0)" ::: "memory");
    const int c = lane & 7;
#pragma unroll
    for (int j = 0; j < 4; ++j) { const int n = (lane >> 3) + 8 * j; const LAS float* s = scr + (8 * c) * 33 + n;
        u32x4 o; o.x = pk2(s[0 * 33], s[1 * 33]); o.y = pk2(s[2 * 33], s[3 * 33]); o.z = pk2(s[4 * 33], s[5 * 33]); o.w = pk2(s[6 * 33], s[7 * 33]);
        const int oc = o0 + n; const int p = PT == 0 ? oc : PT == 1 ? pos_bf8(oc) : PT == 2 ? pos_rope(oc) : pos_swiglu(oc);
        *(u32x4*)(WT + (size_t)(tile_row0 + p) * K + k0 + 8 * c) = o; }
    asm volatile("s_waitcnt lgkmcnt(0)" ::: "memory");
}
DI void convert_weights(Ctx& C) {
    LAS float* scr = (LAS float*)(C.lds + C.wave * 16384);
    const int gw = C.bid * NWAVES + C.wave, NGW = C.G * NWAVES, lane = C.lane;
    bf16* WT_IN = (bf16*)(C.ws + WS_WT_IN); bf16* WT_BR = (bf16*)(C.ws + WS_WT_BR); bf16* WT_OUT = (bf16*)(C.ws + WS_WT_OUT); bf16* WT_GU = (bf16*)(C.ws + WS_WT_GU); bf16* WT_DN = (bf16*)(C.ws + WS_WT_DN);
    constexpr int I_IN = 16 * 256, I_SQ = 16 * 32, I_GU = 32 * 16 * 64, I_DN = 32 * 16 * 32;
    constexpr int NITEMS = I_IN + 3 * I_SQ + I_GU + I_DN;
    for (int it = gw; it < NITEMS; it += NGW) {
        int r = it;
        if (r < I_IN) { const int kb = r >> 8, nb = r & 255, n0 = nb * 32, sc = n0 < 3072 ? n0 : n0 + 8, tile = n0 >> 8;
            const float* src = C.w_in + (size_t)(kb * 64) * DIN + sc;
            if (tile >= 12 && tile < 16) tr_item<2>(src, DIN, D, WT_IN, tile * 256, n0 & 255, kb * 64, scr, lane); else tr_item<1>(src, DIN, D, WT_IN, tile * 256, n0 & 255, kb * 64, scr, lane);
            continue; } r -= I_IN;
        if (r < 2 * I_SQ) { const int which = r >> 9, q = r & 511, kb = q >> 5, nb = q & 31, n0 = nb * 32;
            const float* src = (which ? C.w_bret : C.w_bml) + (size_t)(kb * 64) * D + n0;
            tr_item<1>(src, D, D, WT_BR, which * 1024 + (n0 & ~255), n0 & 255, kb * 64, scr, lane); continue; } r -= 2 * I_SQ;
        if (r < I_SQ) { const int kb = r >> 5, nb = r & 31, n0 = nb * 32;
            tr_item<0>(C.w_out + (size_t)(kb * 64) * D + n0, D, D, WT_OUT, n0 & ~255, n0 & 255, kb * 64, scr, lane); continue; } r -= I_SQ;
        if (r < I_GU) { const int e = r >> 10, q = r & 1023, kb = q >> 6, nb = q & 63, n0 = nb * 32;
            tr_item<3>(C.w_gu + (size_t)e * D * 2048 + (size_t)(kb * 64) * 2048 + n0, 2048, D, WT_GU, e * 2048 + (n0 & ~255), n0 & 255, kb * 64, scr, lane); continue; } r -= I_GU;
        { const int e = r >> 9, q = r & 511, kb = q >> 5, nb = q & 31, n0 = nb * 32;
            tr_item<1>(C.w_dn + (size_t)e * D * D + (size_t)(kb * 64) * D + n0, D, D, WT_DN, e * 1024 + (n0 & ~255), n0 & 255, kb * 64, scr, lane); }
    }
}

struct SchedDense { pg8::TileOrder o; int G, c;
    DI bool next(int i, pg8::Unit& u) const { int pm, pn; if (!o.tile((long)i * G + c, pm, pn)) return false; u.pm = pm; u.pn = pn; u.aux = 0; return true; }
    DI int arow(const pg8::Unit& u, int r) const { return u.pm * 256 + r; } };
DI u32x4 pack8v(const f32x4 a, const f32x4 b) { u32x4 w; w.x = pg8::cvt_pk_bf16(a.x, a.y); w.y = pg8::cvt_pk_bf16(a.z, a.w); w.z = pg8::cvt_pk_bf16(b.x, b.y); w.w = pg8::cvt_pk_bf16(b.z, b.w); return w; }
DI f32x4 sig4(const f32x4 v) { return (f32x4){sigmoidf_(v.x), sigmoidf_(v.y), sigmoidf_(v.z), sigmoidf_(v.w)}; }
DI f32x4 silu4(const f32x4 v) { return (f32x4){siluf_(v.x), siluf_(v.y), siluf_(v.z), siluf_(v.w)}; }
DI void unpack8v(const u32x4 w, f32x4& a, f32x4& b) { a = (f32x4){__uint_as_float(w.x << 16), __uint_as_float(w.x & 0xffff0000u), __uint_as_float(w.y << 16), __uint_as_float(w.y & 0xffff0000u)};
    b = (f32x4){__uint_as_float(w.z << 16), __uint_as_float(w.z & 0xffff0000u), __uint_as_float(w.w << 16), __uint_as_float(w.w & 0xffff0000u)}; }

struct EpiInproj { unsigned char* ws;
    DI bool operator()(f32x4 (&acc)[2][2][4][2], const pg8::Unit& u, int wr, int wc, int fr, int fq) const {
        const int seg = u.pn >> 2, row0 = u.pm * 256 + wr * 64 + fr;
        if (seg == 3) {
            const int which = (u.pn >> 1) & 1, head = 2 * (u.pn & 1) + (wc >> 1), i0 = 32 * (wc & 1) + 8 * fq;
            bf16* dst = (bf16*)(ws + (which ? WS_RETK : WS_RETQ)); const float sc = which ? 0.08838834764831845f : 1.0f;
            const float* COS = (const float*)(ws + WS_COS); const float* SIN = (const float*)(ws + WS_SIN);
#pragma unroll
            for (int ai = 0; ai < 2; ++ai)
#pragma unroll
                for (int m = 0; m < 4; ++m) { const int row = row0 + ai * 128 + m * 16;
                    const f32x4 c0 = *(const f32x4*)(COS + (size_t)row * 64 + i0) * sc, c1 = *(const f32x4*)(COS + (size_t)row * 64 + i0 + 4) * sc;
                    const f32x4 s0 = *(const f32x4*)(SIN + (size_t)row * 64 + i0) * sc, s1 = *(const f32x4*)(SIN + (size_t)row * 64 + i0 + 4) * sc;
                    const f32x4 x1a = acc[ai][0][m][0], x1b = acc[ai][0][m][1], x2a = acc[ai][1][m][0], x2b = acc[ai][1][m][1];
                    bf16* rp = dst + (size_t)row * 512 + head * 128 + i0;
                    *(u32x4*)rp = pack8v(x1a * c0 - x2a * s0, x1b * c1 - x2b * s1);
                    *(u32x4*)(rp + 64) = pack8v(x2a * c0 + x1a * s0, x2b * c1 + x1b * s1);
                    asm volatile("" ::: "memory"); }
            return false;
        }
        bf16* dst; int act = 0;
        switch (seg) { case 0: dst = (bf16*)(ws + WS_QKRAW); break; case 1: dst = (bf16*)(ws + WS_MLV); break; case 2: dst = (bf16*)(ws + WS_MLO); act = 1; break;
            case 4: dst = (bf16*)(ws + WS_RETV); break; case 5: dst = (bf16*)(ws + WS_RETG); act = 2; break; case 6: dst = (bf16*)(ws + WS_GML); act = 1; break; default: dst = (bf16*)(ws + WS_GRET); act = 1; break; }
        const int col0 = (u.pn & 3) * 256 + wc * 32 + 8 * fq;
#pragma unroll
        for (int ai = 0; ai < 2; ++ai)
#pragma unroll
            for (int m = 0; m < 4; ++m) { bf16* rp = dst + (size_t)(row0 + ai * 128 + m * 16) * D + col0;
#pragma unroll
                for (int bj = 0; bj < 2; ++bj) { f32x4 v0 = acc[ai][bj][m][0], v1 = acc[ai][bj][m][1];
                    if (act == 1) { v0 = sig4(v0); v1 = sig4(v1); } else if (act == 2) { v0 = silu4(v0); v1 = silu4(v1); }
                    *(u32x4*)(rp + bj * 128) = pack8v(v0, v1); } }
        return false;
    } };
DI void phase_inproj_mfma(Ctx& C) {
    pg8::Gemm g{(const bf16*)(C.ws + WS_H1), (const bf16*)(C.ws + WS_WT_IN), D};
    SchedDense S; S.o.init(T / 256, 32); S.G = C.G; S.c = C.bid;
    EpiInproj E{C.ws};
    pg8::gemm_phase<EpiInproj, SchedDense, true, true>(C.lds, g, S, E);
}

struct SchedBranch { pg8::TileOrder o; int G, c;
    DI bool next(int i, pg8::Unit& u) const { int pm, pn; if (!o.tile((long)(i >> 1) * G + c, pm, pn)) return false; const int seg = i & 1; u.pm = seg * 64 + pm; u.pn = seg * 4 + pn; u.aux = seg; return true; }
    DI int arow(const pg8::Unit& u, int r) const { return u.pm * 256 + r; } };
struct EpiBranch { const bf16* g1; const bf16* g2; bf16* y;
    DI bool operator()(f32x4 (&acc)[2][2][4][2], const pg8::Unit& u, int wr, int wc, int fr, int fq) const {
        const int seg = u.aux, row0 = (u.pm & 63) * 256 + wr * 64 + fr, col0 = (u.pn & 3) * 256 + wc * 32 + 8 * fq;
#pragma unroll
        for (int ai = 0; ai < 2; ++ai)
#pragma unroll
            for (int m = 0; m < 4; ++m) { const size_t o = (size_t)(row0 + ai * 128 + m * 16) * D + col0;
#pragma unroll
                for (int bj = 0; bj < 2; ++bj) {
                    f32x4 b0, b1; unpack8v(*(const u32x4*)(g2 + o + bj * 128), b0, b1);
                    if (seg == 0) { f32x4 a0, a1; unpack8v(*(const u32x4*)(g1 + o + bj * 128), a0, a1);
#pragma unroll
                        for (int j = 0; j < 4; ++j) { acc[ai][bj][m][0][j] *= a0[j] / fmaxf(b0[j], 1e-12f); acc[ai][bj][m][1][j] *= a1[j] / fmaxf(b1[j], 1e-12f); }
                    } else *(u32x4*)(y + o + bj * 128) = pack8v(acc[ai][bj][m][0] * b0, acc[ai][bj][m][1] * b1);
                }
                asm volatile("" ::: "memory"); }
        return seg == 0;
    } };
DI void phase_branch_mfma(Ctx& C) {
    pg8::Gemm g{(const bf16*)(C.ws + WS_HML), (const bf16*)(C.ws + WS_WT_BR), D};
    SchedBranch S; S.o.init(T / 256, 4); S.G = C.G; S.c = C.bid;
    EpiBranch E{(const bf16*)(C.ws + WS_GML), (const bf16*)(C.ws + WS_GRET), (bf16*)(C.ws + WS_H1)};
    pg8::gemm_phase<EpiBranch, SchedBranch, true, true>(C.lds, g, S, E);
}
struct EpiOut { const float* x; const float* mod; float* x1;
    DI bool operator()(f32x4 (&acc)[2][2][4][2], const pg8::Unit& u, int wr, int wc, int fr, int fq) const {
        const int row0 = u.pm * 256 + wr * 64 + fr, col0 = u.pn * 256 + wc * 32 + 4 * fq; const int b = (u.pm * 256) / SEQ;
        f32x4 gv[2][2];
#pragma unroll
        for (int bj = 0; bj < 2; ++bj)
#pragma unroll
            for (int n = 0; n < 2; ++n) gv[bj][n] = *(const f32x4*)(mod + b * 6144 + 2048 + col0 + bj * 128 + n * 16);
#pragma unroll
        for (int ai = 0; ai < 2; ++ai)
#pragma unroll
            for (int m = 0; m < 4; ++m) { const size_t o = (size_t)(row0 + ai * 128 + m * 16) * D + col0;
#pragma unroll
                for (int bj = 0; bj < 2; ++bj)
#pragma unroll
                    for (int n = 0; n < 2; ++n) *(f32x4*)(x1 + o + bj * 128 + n * 16) = *(const f32x4*)(x + o + bj * 128 + n * 16) + gv[bj][n] * acc[ai][bj][m][n];
                asm volatile("" ::: "memory"); }
        return false;
    } };
DI void phase_outproj_mfma(Ctx& C) {
    pg8::Gemm g{(const bf16*)(C.ws + WS_H1), (const bf16*)(C.ws + WS_WT_OUT), D};
    SchedDense S; S.o.init(T / 256, 4); S.G = C.G; S.c = C.bid;
    EpiOut E{C.x, (const float*)(C.ws + WS_MOD), (float*)(C.ws + WS_X1)};
    pg8::gemm_phase<EpiOut, SchedDense, false, true>(C.lds, g, S, E);
}
struct SchedMoe { const unsigned* blke; const int* slottok; int nunits, ntn, G, c;
    DI bool next(int i, pg8::Unit& u) const { const long L = (long)i * G + c; if (L >= nunits) return false; const int bi = (int)(L / ntn), pn = (int)(L % ntn);
        const int e = (int)__builtin_amdgcn_readfirstlane((int)blke[bi]); u.pm = bi; u.pn = e * ntn + pn; u.aux = e | (pn << 8); return true; }
    DI int arow(const pg8::Unit& u, int r) const { return slottok ? slottok[u.pm * 256 + r] : u.pm * 256 + r; } };
struct EpiSwiglu { const float* bias; bf16* act;
    DI bool operator()(f32x4 (&acc)[2][2][4][2], const pg8::Unit& u, int wr, int wc, int fr, int fq) const {
        const int e = u.aux & 255, pn = u.aux >> 8, slot0 = u.pm * 256 + wr * 64 + fr;
        const float* bp = bias + (size_t)e * 2048 + pn * 256 + 64 * wc + 16 * fq;
        f32x4 bv[2][2];
#pragma unroll
        for (int bj = 0; bj < 2; ++bj)
#pragma unroll
            for (int n = 0; n < 2; ++n) bv[bj][n] = *(const f32x4*)(bp + 8 * bj + 4 * n);
#pragma unroll
        for (int ai = 0; ai < 2; ++ai)
#pragma unroll
            for (int m = 0; m < 4; ++m) { float o[8];
#pragma unroll
                for (int bj = 0; bj < 2; ++bj)
#pragma unroll
                    for (int n = 0; n < 2; ++n) { const f32x4 v = acc[ai][bj][m][n] + bv[bj][n];
#pragma unroll
                        for (int p = 0; p < 2; ++p) { const float xg = fminf(v[2 * p], 7.0f), xl = fminf(fmaxf(v[2 * p + 1], -7.0f), 7.0f); o[4 * bj + 2 * n + p] = xg * sigmoidf_(1.702f * xg) * (xl + 1.0f); } }
                u32x4 w; w.x = pg8::cvt_pk_bf16(o[0], o[1]); w.y = pg8::cvt_pk_bf16(o[2], o[3]); w.z = pg8::cvt_pk_bf16(o[4], o[5]); w.w = pg8::cvt_pk_bf16(o[6], o[7]);
                *(u32x4*)(act + (size_t)(slot0 + ai * 128 + m * 16) * D + pn * 128 + 32 * wc + 8 * fq) = w; }
        return false;
    } };
struct EpiDown { const float* bias; const float* slotw; bf16* ys;
    DI bool operator()(f32x4 (&acc)[2][2][4][2], const pg8::Unit& u, int wr, int wc, int fr, int fq) const {
        const int e = u.aux & 255, pn = u.aux >> 8, slot0 = u.pm * 256 + wr * 64 + fr, col0 = pn * 256 + wc * 32 + 8 * fq;
        f32x4 bv[2][2];
#pragma unroll
        for (int bj = 0; bj < 2; ++bj)
#pragma unroll
            for (int n = 0; n < 2; ++n) bv[bj][n] = *(const f32x4*)(bias + (size_t)e * D + col0 + bj * 128 + 4 * n);
#pragma unroll
        for (int ai = 0; ai < 2; ++ai)
#pragma unroll
            for (int m = 0; m < 4; ++m) { const int slot = slot0 + ai * 128 + m * 16; const float w = slotw[slot];
#pragma unroll
                for (int bj = 0; bj < 2; ++bj) *(u32x4*)(ys + (size_t)slot * D + col0 + bj * 128) = pack8v((acc[ai][bj][m][0] + bv[bj][0]) * w, (acc[ai][bj][m][1] + bv[bj][1]) * w); }
        return false;
    } };
DI void phase_gateup_mfma(Ctx& C) {
    unsigned* ctl = (unsigned*)(C.ws + WS_CTL); const int nblk = (int)__builtin_amdgcn_readfirstlane((int)__hip_atomic_load(ctl + CW_NBLK, __ATOMIC_RELAXED, __HIP_MEMORY_SCOPE_AGENT));
    pg8::Gemm g{(const bf16*)(C.ws + WS_H1), (const bf16*)(C.ws + WS_WT_GU), D};
    SchedMoe S{ctl + CW_BLKE, (const int*)(C.ws + WS_ROUTE + RT_SLOTTOK), nblk * 8, 8, C.G, C.bid};
    EpiSwiglu E{C.b_gu, (bf16*)(C.ws + WS_ACT)};
    pg8::gemm_phase<EpiSwiglu, SchedMoe, true, true>(C.lds, g, S, E);
}
DI void phase_down_mfma(Ctx& C) {
    unsigned* ctl = (unsigned*)(C.ws + WS_CTL); const int nblk = (int)__builtin_amdgcn_readfirstlane((int)__hip_atomic_load(ctl + CW_NBLK, __ATOMIC_RELAXED, __HIP_MEMORY_SCOPE_AGENT));
    pg8::Gemm g{(const bf16*)(C.ws + WS_ACT), (const bf16*)(C.ws + WS_WT_DN), D};
    SchedMoe S{ctl + CW_BLKE, nullptr, nblk * 4, 4, C.G, C.bid};
    EpiDown E{C.b_dn, (const float*)(C.ws + WS_ROUTE + RT_SLOTW), (bf16*)(C.ws + WS_YS)};
    pg8::gemm_phase<EpiDown, SchedMoe, true, true>(C.lds, g, S, E);
}

typedef short s16x4 __attribute__((ext_vector_type(4)));
typedef short bf16x8 __attribute__((ext_vector_type(8)));
DI unsigned off_b(unsigned row, unsigned ch) { return 256u * row + 16u * (ch ^ (((row & 3u) << 2) | ((row >> 2) & 3u))); }
DI s16x4 tr_read(LAS unsigned char* p) { return __builtin_amdgcn_ds_read_tr16_b64_v4i16((LAS s16x4*)p); }
DI bf16x8 cat8(const s16x4 lo, const s16x4 hi) { return __builtin_shufflevector(lo, hi, 0, 1, 2, 3, 4, 5, 6, 7); }
DI bf16x8 row_read(LAS unsigned char* img, unsigned row, unsigned ch) { return *(const LAS bf16x8*)(img + off_b(row, ch)); }
#define MFMA16(a, b, c) __builtin_amdgcn_mfma_f32_16x16x32_bf16((a), (b), (c), 0, 0, 0)
DI void fill_image(LAS unsigned char* img, const bf16* src, int ld, int nrows, int tid) {
    for (int e = tid; e < nrows * 16; e += NTHR) { const int row = e >> 4, ch = e & 15; *(LAS u32x4*)(img + off_b(row, ch)) = *(const u32x4*)(src + (size_t)row * ld + ch * 8); }
}

DI void phase_local_mfma(Ctx& C) {
    LAS unsigned char* Kimg = C.lds; LAS unsigned char* Vimg = C.lds + 32768;
    LAS float* lf = (LAS float*)(C.lds + 98304); LAS float* bvl = lf + 128; LAS float* wsv = bvl + 128; LAS float* nl = wsv + 128;
    const float* IFG = (const float*)(C.ws + WS_IFG);
    bf16* CLOC = (bf16*)(C.ws + WS_CLOC);
    float* NLOC = (float*)(C.ws + WS_SMALL + SM_NLOC); float* MLOC = (float*)(C.ws + WS_SMALL + SM_MLOC); float* ACH = (float*)(C.ws + WS_SMALL + SM_ACH);
    float* AG = (float*)(C.ws + WS_SMALL + SM_AG); float* CMG = (float*)(C.ws + WS_SMALL + SM_CMG);
    const int t = C.tid, lane = C.lane, w = C.wave, g = lane >> 4, q = (lane & 15) >> 2, p = lane & 3;
    for (int u = C.bid; u < 1024; u += C.G) {
        const int mixer = u >> 9, bh = (u >> 5) & 15, ch = u & 31, b = bh >> 2, h = bh & 3, t0 = b * SEQ + ch * CH;
        const bf16 *Kp, *Vp; int ldk;
        if (mixer == 0) {
            float iv = 0.f;
            if (t < 128) { lf[t] = logsigmoidf_(IFG[(size_t)(t0 + t) * 8 + 4 + h]); iv = IFG[(size_t)(t0 + t) * 8 + h]; nl[t] = 0.f; }
            __syncthreads();
            if (t < 128) { float s = 0.f; for (int j = 0; j <= t; ++j) s += lf[j]; bvl[t] = iv - s; AG[bh * SEQ + ch * CH + t] = s; if (t == 127) wsv[0] = s; }
            __syncthreads();
            float gm = -3.0e38f, cm = -3.0e38f; const float Aall = wsv[0];
            if (t < 128) { for (int j = 0; j < 128; ++j) { const float x = bvl[j]; gm = fmaxf(gm, x); cm = (j <= t) ? fmaxf(cm, x) : cm; } CMG[bh * SEQ + ch * CH + t] = cm; }
            __syncthreads();
            if (t < 128) wsv[t] = __expf(bvl[t] - gm);
            if (t == 0) { MLOC[bh * 32 + ch] = Aall + gm; ACH[bh * 32 + ch] = Aall; }
            Kp = (const bf16*)(C.ws + WS_QC) + (size_t)t0 * D + 512 + h * 128; ldk = D;
            Vp = (const bf16*)(C.ws + WS_MLV) + (size_t)t0 * D + h * 256;
        } else {
            const float lg = ret_lg(h);
            if (t < 128) wsv[t] = __expf(lg * (float)(127 - t));
            Kp = (const bf16*)(C.ws + WS_RETK) + (size_t)t0 * 512 + h * 128; ldk = 512;
            Vp = (const bf16*)(C.ws + WS_RETV) + (size_t)t0 * D + h * 256;
        }
        __syncthreads();
        {
            float ns[8];
#pragma unroll
            for (int e = 0; e < 8; ++e) ns[e] = 0.f;
            const int chk = t & 15;
#pragma unroll
            for (int i = 0; i < 4; ++i) { const int row = (t >> 4) + 32 * i; float f[8]; unpack8(*(const u32x4*)(Kp + (size_t)row * ldk + chk * 8), f); const float wv = wsv[row];
#pragma unroll
                for (int e = 0; e < 8; ++e) { f[e] *= wv; ns[e] += f[e]; }
                *(LAS u32x4*)(Kimg + off_b(row, chk)) = pack8(f); }
            if (mixer == 0) {
#pragma unroll
                for (int e = 0; e < 8; ++e) atomicAdd((float*)(nl + chk * 8 + e), ns[e]);
            }
        }
        fill_image(Vimg, Vp, D, 128, t); fill_image(Vimg + 32768, Vp + 128, D, 128, t);
        __syncthreads();
        const int kh = w & 1, vq = w >> 1;
        f32x4 acc[2][2][4];
#pragma unroll
        for (int a = 0; a < 2; ++a)
#pragma unroll
            for (int x = 0; x < 2; ++x)
#pragma unroll
                for (int c = 0; c < 4; ++c) acc[a][x][c] = (f32x4){0.f, 0.f, 0.f, 0.f};
        unsigned ba[2][2], bb[4][2];
#pragma unroll
        for (int ul = 0; ul < 2; ++ul)
#pragma unroll
            for (int tt = 0; tt < 2; ++tt) ba[ul][tt] = off_b(8 * g + q + 4 * tt, 4 * (2 * kh + ul) + p);
#pragma unroll
        for (int cl = 0; cl < 4; ++cl)
#pragma unroll
            for (int tt = 0; tt < 2; ++tt) { const int c = 4 * vq + cl; bb[cl][tt] = 32768 + (c >> 3) * 32768 + off_b(8 * g + q + 4 * tt, 2 * (c & 7) + (p >> 1)) + 8 * (p & 1); }
#pragma unroll
        for (int ks = 0; ks < 4; ++ks) {
            bf16x8 af[2][2], bfr[4];
#pragma unroll
            for (int ul = 0; ul < 2; ++ul)
#pragma unroll
                for (int x = 0; x < 2; ++x) af[ul][x] = cat8(tr_read(C.lds + ba[ul][0] + (8192 * ks + 8 * x)), tr_read(C.lds + ba[ul][1] + (8192 * ks + 8 * x)));
#pragma unroll
            for (int cl = 0; cl < 4; ++cl) bfr[cl] = cat8(tr_read(C.lds + bb[cl][0] + 8192 * ks), tr_read(C.lds + bb[cl][1] + 8192 * ks));
#pragma unroll
            for (int ul = 0; ul < 2; ++ul)
#pragma unroll
                for (int x = 0; x < 2; ++x)
#pragma unroll
                    for (int cl = 0; cl < 4; ++cl) acc[ul][x][cl] = MFMA16(af[ul][x], bfr[cl], acc[ul][x][cl]);
            asm volatile("" ::: "memory");
        }
        bf16* cl_ = CLOC + ((size_t)(mixer * 16 + bh) * 32 + ch) * 32768;
#pragma unroll
        for (int ul = 0; ul < 2; ++ul)
#pragma unroll
            for (int cl = 0; cl < 4; ++cl) { const int v = 16 * (4 * vq + cl) + (lane & 15), k0 = 32 * (2 * kh + ul) + 8 * g;
                u32x4 o; o.x = pk2(acc[ul][0][cl][0], acc[ul][0][cl][1]); o.y = pk2(acc[ul][0][cl][2], acc[ul][0][cl][3]); o.z = pk2(acc[ul][1][cl][0], acc[ul][1][cl][1]); o.w = pk2(acc[ul][1][cl][2], acc[ul][1][cl][3]);
                *(u32x4*)(cl_ + (size_t)v * 128 + k0) = o; }
        if (mixer == 0 && t < 128) NLOC[(bh * 32 + ch) * 128 + t] = nl[t];
        __syncthreads();
    }
}

DI void phase_out_mfma(Ctx& C) {
    LAS unsigned char* Qimg = C.lds; LAS unsigned char* Kimg = C.lds + 32768; LAS unsigned char* R1 = C.lds + 65536;
    LAS float* ea = (LAS float*)(C.lds + 131072); LAS float* bs = ea + 128; LAS float* isc = bs + 128; LAS float* edn = isc + 128; LAS float* npv = edn + 128;
    const float* IFG = (const float*)(C.ws + WS_IFG);
    const bf16* CPREV = (const bf16*)(C.ws + WS_CPREV);
    const float* NPREV = (const float*)(C.ws + WS_SMALL + SM_NPREV); const float* MPREV = (const float*)(C.ws + WS_SMALL + SM_MPREV);
    const float* AG = (const float*)(C.ws + WS_SMALL + SM_AG); const float* CMG = (const float*)(C.ws + WS_SMALL + SM_CMG);
    const int t = C.tid, lane = C.lane, w = C.wave, g = lane >> 4, q = (lane & 15) >> 2, p = lane & 3, jl = lane & 15;
    for (int u = C.bid; u < 1024; u += C.G) {
        const int mixer = u >> 9, bh = (u >> 5) & 15, ch = u & 31, b = bh >> 2, h = bh & 3, t0 = b * SEQ + ch * CH;
        const bf16 *Qp, *Kp, *Vp; int ldq; const bf16* cp = CPREV + ((size_t)(mixer * 16 + bh) * 32 + ch) * 32768;
        if (mixer == 0) {
            Qp = (const bf16*)(C.ws + WS_QC) + (size_t)t0 * D + h * 128; Kp = Qp + 512; ldq = D;
            Vp = (const bf16*)(C.ws + WS_MLV) + (size_t)t0 * D + h * 256;
            if (t < 128) { const float a = AG[bh * SEQ + ch * CH + t], cm = CMG[bh * SEQ + ch * CH + t], iv = IFG[(size_t)(t0 + t) * 8 + h];
                const float il = a + MPREV[bh * 32 + ch], m = fmaxf(il, a + cm);
                ea[t] = a - m; bs[t] = iv - a; isc[t] = __expf(il - m); edn[t] = __expf(-m); npv[t] = NPREV[(bh * 32 + ch) * 128 + t]; }
        } else {
            const float lg = ret_lg(h);
            Qp = (const bf16*)(C.ws + WS_RETQ) + (size_t)t0 * 512 + h * 128; Kp = (const bf16*)(C.ws + WS_RETK) + (size_t)t0 * 512 + h * 128; ldq = 512;
            Vp = (const bf16*)(C.ws + WS_RETV) + (size_t)t0 * D + h * 256;
            if (t < 128) { ea[t] = lg * (float)t; bs[t] = -lg * (float)t; isc[t] = __expf(lg * (float)(t + 1)); edn[t] = 1.0f; npv[t] = 0.f; }
        }
        fill_image(Qimg, Qp, ldq, 128, t); fill_image(Kimg, Kp, ldq, 128, t); fill_image(R1, cp, 128, 256, t);
        __syncthreads();
        unsigned bk[4];
#pragma unroll
        for (int kk = 0; kk < 4; ++kk) bk[kk] = off_b(jl, 4 * kk + g);
        bf16x8 qf[4];
#pragma unroll
        for (int kk = 0; kk < 4; ++kk) qf[kk] = *(const LAS bf16x8*)(Qimg + 4096 * w + bk[kk]);
        f32x4 st[8];
#pragma unroll
        for (int sb = 0; sb < 8; ++sb) { st[sb] = (f32x4){0.f, 0.f, 0.f, 0.f};
            if (sb <= w) {
#pragma unroll
                for (int kk = 0; kk < 4; ++kk) st[sb] = MFMA16(*(const LAS bf16x8*)(Kimg + bk[kk] + 4096 * sb), qf[kk], st[sb]);
            } }
        const int j = 16 * w + jl; const float eaj = ea[j];
        float psum = 0.f;
#pragma unroll
        for (int sb = 0; sb < 8; ++sb) { const f32x4 b4 = *(const LAS f32x4*)(bs + 16 * sb + 4 * g);
#pragma unroll
            for (int r = 0; r < 4; ++r) { const int s = 16 * sb + 4 * g + r; const float pv = (s <= j) ? __expf(eaj + b4[r]) * st[sb][r] : 0.f; st[sb][r] = pv; psum += pv; } }
        float qn = 0.f;
#pragma unroll
        for (int kk = 0; kk < 4; ++kk) { const f32x4 n0 = *(const LAS f32x4*)(npv + 32 * kk + 8 * g), n1 = *(const LAS f32x4*)(npv + 32 * kk + 8 * g + 4);
            float f[8]; unpack8(__builtin_bit_cast(u32x4, qf[kk]), f);
            qn += f[0] * n0.x + f[1] * n0.y + f[2] * n0.z + f[3] * n0.w + f[4] * n1.x + f[5] * n1.y + f[6] * n1.z + f[7] * n1.w; }
        psum += __shfl_xor(psum, 16); psum += __shfl_xor(psum, 32); qn += __shfl_xor(qn, 16); qn += __shfl_xor(qn, 32);
        const float iscj = isc[j];
        const float dinv = (mixer == 0) ? 1.0f / fmaxf(fabsf(psum + iscj * qn), edn[j]) : 1.0f;
        bf16x8 pf[4];
#pragma unroll
        for (int ks = 0; ks < 4; ++ks) { u32x4 pw; pw.x = pk2(st[2 * ks][0], st[2 * ks][1]); pw.y = pk2(st[2 * ks][2], st[2 * ks][3]); pw.z = pk2(st[2 * ks + 1][0], st[2 * ks + 1][1]); pw.w = pk2(st[2 * ks + 1][2], st[2 * ks + 1][3]);
            pf[ks] = __builtin_bit_cast(bf16x8, pw); }
        u32x4 vst[8];
#pragma unroll
        for (int i = 0; i < 8; ++i) { const int e = t + NTHR * i, half = e >> 11, row = (e >> 4) & 127, chk = e & 15; vst[i] = *(const u32x4*)(Vp + (size_t)row * D + half * 128 + chk * 8); }
        f32x4 acc[2][4][2];
#pragma unroll
        for (int hv = 0; hv < 2; ++hv)
#pragma unroll
            for (int uu = 0; uu < 4; ++uu)
#pragma unroll
                for (int x = 0; x < 2; ++x) acc[hv][uu][x] = (f32x4){0.f, 0.f, 0.f, 0.f};
#pragma unroll
        for (int kk = 0; kk < 4; ++kk) {
            const unsigned bi0 = off_b(8 * (jl >> 2) + (jl & 3), 4 * kk + g), bi1 = off_b(8 * (jl >> 2) + 4 + (jl & 3), 4 * kk + g);
#pragma unroll
            for (int hv = 0; hv < 2; ++hv) {
#pragma unroll
                for (int uu = 0; uu < 4; ++uu) {
                    acc[hv][uu][0] = MFMA16(*(const LAS bf16x8*)(R1 + bi0 + (32768 * hv + 8192 * uu)), qf[kk], acc[hv][uu][0]);
                    acc[hv][uu][1] = MFMA16(*(const LAS bf16x8*)(R1 + bi1 + (32768 * hv + 8192 * uu)), qf[kk], acc[hv][uu][1]); }
                asm volatile("" ::: "memory"); }
        }
#pragma unroll
        for (int hv = 0; hv < 2; ++hv)
#pragma unroll
            for (int uu = 0; uu < 4; ++uu)
#pragma unroll
                for (int x = 0; x < 2; ++x) acc[hv][uu][x] *= iscj;
        __syncthreads();
#pragma unroll
        for (int i = 0; i < 8; ++i) { const int e = t + NTHR * i, half = e >> 11, row = (e >> 4) & 127, chk = e & 15; *(LAS u32x4*)(R1 + half * 32768 + off_b(row, chk)) = vst[i]; }
        __syncthreads();
        unsigned bp[4];
#pragma unroll
        for (int uu = 0; uu < 4; ++uu) bp[uu] = off_b(4 * g + q, 4 * uu + p);
#pragma unroll
        for (int ks = 0; ks < 4; ++ks) {
            if (2 * ks <= w) {
#pragma unroll
                for (int hv = 0; hv < 2; ++hv)
#pragma unroll
                    for (int uu = 0; uu < 4; ++uu)
#pragma unroll
                        for (int x = 0; x < 2; ++x) {
                            const bf16x8 vf = cat8(tr_read(R1 + bp[uu] + (32768 * hv + 8192 * ks + 8 * x)), tr_read(R1 + bp[uu] + (32768 * hv + 8192 * ks + 4096 + 8 * x)));
                            acc[hv][uu][x] = MFMA16(vf, pf[ks], acc[hv][uu][x]); }
            }
            asm volatile("" ::: "memory"); }
        float s1 = 0.f;
#pragma unroll
        for (int hv = 0; hv < 2; ++hv)
#pragma unroll
            for (int uu = 0; uu < 4; ++uu)
#pragma unroll
                for (int x = 0; x < 2; ++x) { acc[hv][uu][x] *= dinv; s1 += (acc[hv][uu][x][0] + acc[hv][uu][x][1]) + (acc[hv][uu][x][2] + acc[hv][uu][x][3]); }
        s1 += __shfl_xor(s1, 16); s1 += __shfl_xor(s1, 32);
        const float mu = s1 * (1.0f / 256.0f); float s2 = 0.f;
#pragma unroll
        for (int hv = 0; hv < 2; ++hv)
#pragma unroll
            for (int uu = 0; uu < 4; ++uu)
#pragma unroll
                for (int x = 0; x < 2; ++x) { acc[hv][uu][x] -= mu; const f32x4 d = acc[hv][uu][x]; s2 += (d[0] * d[0] + d[1] * d[1]) + (d[2] * d[2] + d[3] * d[3]); }
        s2 += __shfl_xor(s2, 16); s2 += __shfl_xor(s2, 32);
        const float rstd = 1.0f / sqrtf(s2 * (1.0f / 256.0f) + EPS);
        const float* gain = (mixer == 0 ? C.ml_norm_g : C.ret_norm_g) + h * 256;
        const bf16* gate = (const bf16*)(C.ws + (mixer == 0 ? WS_MLO : WS_RETG)) + (size_t)(t0 + j) * D + h * 256;
        bf16* outp = (bf16*)(C.ws + (mixer == 0 ? WS_HML : WS_HRET)) + (size_t)(t0 + j) * D + h * 256;
#pragma unroll
        for (int hv = 0; hv < 2; ++hv)
#pragma unroll
            for (int uu = 0; uu < 4; ++uu) { const int v0 = 128 * hv + 32 * uu + 8 * g;
                const f32x4 g0 = *(const f32x4*)(gain + v0), g1 = *(const f32x4*)(gain + v0 + 4); f32x4 t0v, t1v; unpack8v(*(const u32x4*)(gate + v0), t0v, t1v);
                *(u32x4*)(outp + v0) = pack8v(acc[hv][uu][0] * rstd * g0 * t0v, acc[hv][uu][1] * rstd * g1 * t1v); }
        __syncthreads();
    }
}

#define XB_TMO      128
#define XB_XCNT(j)  (256  + 64 * (j))
#define XB_XSUB(j)  (1280 + 64 * (j))
#define XB_XGEN(j)  (2304 + 64 * (j))
#define XB_TOP      3328
#define XB_TOPGEN   3392
#define XCD_BAR_WORDS 3456
#define XB_SPIN_CAP (1u << 22)
DI unsigned xb_ld(unsigned* p)              { return __hip_atomic_load(p, __ATOMIC_RELAXED, __HIP_MEMORY_SCOPE_AGENT); }
DI unsigned xb_add(unsigned* p, unsigned v) { return __hip_atomic_fetch_add(p, v, __ATOMIC_RELAXED, __HIP_MEMORY_SCOPE_AGENT); }
DI unsigned xb_xcc_id() { return (unsigned)__builtin_amdgcn_s_getreg((3 << 11) | 20) & 0xFu; }
#define XB_SPIN(cond, bar) do { unsigned _sp = 0; while (cond) { __builtin_amdgcn_s_sleep(1); \
    if ((++_sp & 255u) == 0u) { if (xb_ld(&(bar)[XB_TMO])) break; if (_sp > XB_SPIN_CAP) { atomicAdd(&(bar)[XB_TMO], 1u); break; } } } } while (0)
struct XcdBarrier { unsigned* bar; unsigned x; volatile LAS unsigned* st; };
DI XcdBarrier xcd_barrier_post(unsigned* bar, volatile LAS unsigned* st) {
    XcdBarrier b; b.bar = bar; b.x = xb_xcc_id(); b.st = st;
    if (threadIdx.x == 0) (void)xb_add(&bar[XB_XCNT(b.x)], 1u);
    return b;
}
DI void xcd_barrier_complete(unsigned* bar, unsigned x, unsigned& nloc, unsigned& nx) {
    const unsigned G = gridDim.x * gridDim.y * gridDim.z;
    unsigned sum, cnt, mine, sp = 0u;
    for (;;) {
        sum = 0u; cnt = 0u; mine = 0u;
#pragma unroll
        for (unsigned j = 0; j < 16; ++j) { const unsigned c = xb_ld(&bar[XB_XCNT(j)]); sum += c; cnt += (c > 0u) ? 1u : 0u; mine = (j == x) ? c : mine; }
        if (sum == G) break;
        __builtin_amdgcn_s_sleep(1);
        if ((++sp & 255u) == 0u) { if (xb_ld(&bar[XB_TMO])) break; if (sp > XB_SPIN_CAP) { atomicAdd(&bar[XB_TMO], 1u); break; } }
    }
    nloc = mine > 0u ? mine : 1u; nx = cnt > 0u ? cnt : 1u;
}
DI void xcd_barrier(const XcdBarrier& b) {
    asm volatile("s_waitcnt vmcnt(0)" ::: "memory");
    __syncthreads();
    if (threadIdx.x == 0) {
        unsigned* bar = b.bar;
        __builtin_amdgcn_s_waitcnt(0);
        unsigned nloc = b.st[0], nx = b.st[1];
        if (nloc == 0u) { xcd_barrier_complete(bar, b.x, nloc, nx); b.st[0] = nloc; b.st[1] = nx; }
        const unsigned old = xb_add(&bar[XB_XSUB(b.x)], 1u);
        const unsigned gen = old / nloc;
        if (old + 1u == (gen + 1u) * nloc) {
            __builtin_amdgcn_fence(__ATOMIC_RELEASE, "agent");
            asm volatile("s_waitcnt vmcnt(0)" ::: "memory");
            const unsigned og = xb_add(&bar[XB_TOP], 1u);
            const unsigned tg = og / nx;
            if (og + 1u == (tg + 1u) * nx) xb_add(&bar[XB_TOPGEN], 1u);
            else XB_SPIN(xb_ld(&bar[XB_TOPGEN]) == tg, bar);
            __builtin_amdgcn_fence(__ATOMIC_ACQUIRE, "agent");
            xb_add(&bar[XB_XGEN(b.x)], 1u);
            asm volatile("s_waitcnt vmcnt(0)" ::: "memory");
        } else {
            XB_SPIN(xb_ld(&bar[XB_XGEN(b.x)]) == gen, bar);
            __builtin_amdgcn_fence(__ATOMIC_ACQUIRE, "agent");
            asm volatile("s_waitcnt vmcnt(0)" ::: "memory");
        }
    }
    __syncthreads();
}

constexpr int NPHASES = 14;
__global__ void __launch_bounds__(NTHR, 2) fwd(Args a) {
    extern __shared__ __attribute__((aligned(16))) unsigned char lds[];
    Ctx C;
    C.lds = (LAS unsigned char*)lds; C.tid = threadIdx.x; C.lane = C.tid & 63; C.wave = __builtin_amdgcn_readfirstlane(C.tid >> 6); C.G = gridDim.x; C.bid = blockIdx.x;
    C.x = (const float*)a.in[0]; C.c = (const float*)a.in[1]; C.positions = (const int*)a.in[2]; C.w_ada = (const float*)a.in[3]; C.b_ada = (const float*)a.in[4];
    C.norm_mix_g = (const float*)a.in[5]; C.w_in = (const float*)a.in[6]; C.conv_w = (const float*)a.in[7]; C.conv_b = (const float*)a.in[8]; C.b_if = (const float*)a.in[9];
    C.ml_norm_g = (const float*)a.in[10]; C.ret_norm_g = (const float*)a.in[11]; C.w_bml = (const float*)a.in[12]; C.w_bret = (const float*)a.in[13]; C.w_out = (const float*)a.in[14];
    C.norm_ffn_g = (const float*)a.in[15]; C.w_router = (const float*)a.in[16]; C.b_router = (const float*)a.in[17]; C.w_gu = (const float*)a.in[18]; C.b_gu = (const float*)a.in[19];
    C.w_dn = (const float*)a.in[20]; C.b_dn = (const float*)a.in[21]; C.norm_final_g = (const float*)a.in[22];
    C.out = a.out; C.ws = a.ws;
    const int lo = a.ph_lo, hi = a.ph_hi;
    volatile LAS unsigned* bst = (volatile LAS unsigned*)(C.lds + LDS_BYTES - 16);
    if (C.tid < 4) bst[C.tid] = 0u;
    __syncthreads();
    XcdBarrier bar; bar.bar = (unsigned*)(C.ws + WS_CTL) + CW_BAR; bar.x = 0; bar.st = bst;
    if (hi - lo > 1) bar = xcd_barrier_post((unsigned*)(C.ws + WS_CTL) + CW_BAR, bst);
#define SEAM(k) do { if (IN(k) && IN((k) + 1)) xcd_barrier(bar); } while (0)
#ifdef ONLY_PHASE
#define IN(k) ((k) == ONLY_PHASE && lo <= (k) && (k) < hi)
#else
#define IN(k) (lo <= (k) && (k) < hi)
#endif
    if (IN(0)) phase_mod(C); SEAM(0);
    if (IN(1)) { phase_norm1(C);
#if OPT_ANY
        convert_weights(C);
#endif
    } SEAM(1);
#if OPT_INPROJ
    if (IN(2)) phase_inproj_mfma(C); SEAM(2);
#else
    if (IN(2)) phase_inproj(C); SEAM(2);
#endif
    if (IN(3)) phase_conv_rope(C); SEAM(3);
#if OPT_LOCAL
    if (IN(4)) phase_local_mfma(C); SEAM(4);
#else
    if (IN(4)) phase_local(C); SEAM(4);
#endif
    if (IN(5)) phase_scan(C); SEAM(5);
#if OPT_OUTP
    if (IN(6)) phase_out_mfma(C); SEAM(6);
#else
    if (IN(6)) phase_out(C); SEAM(6);
#endif
#if OPT_BRANCH
    if (IN(7)) phase_branch_mfma(C); SEAM(7);
#else
    if (IN(7)) phase_branch(C); SEAM(7);
#endif
#if OPT_OUT
    if (IN(8)) phase_outproj_mfma(C); SEAM(8);
#else
    if (IN(8)) phase_outproj(C); SEAM(8);
#endif
    if (IN(9)) phase_norm2_route(C); SEAM(9);
    if (IN(10)) phase_slots(C); SEAM(10);
#if OPT_MOE
    if (IN(11)) phase_gateup_mfma(C); SEAM(11);
#else
    if (IN(11)) phase_gateup(C); SEAM(11);
#endif
#if OPT_MOE
    if (IN(12)) phase_down_mfma(C); SEAM(12);
#else
    if (IN(12)) phase_down(C); SEAM(12);
#endif
    if (IN(13)) phase_final(C); SEAM(13);
#undef IN
}

extern "C" void kernel_launch(void* const* d_in, const int* in_sizes, int n_in, void* d_out, int out_size, void* d_ws, size_t ws_size, hipStream_t stream) {
    static int grid = 0;
    if (grid == 0) {
        if (n_in != 23 || out_size != T * D || ws_size < WS_END) { fprintf(stderr, "kernel_launch: unexpected shapes: n_in %d out %d ws %zu (need %zu)\n", n_in, out_size, ws_size, (size_t)WS_END); grid = -1; return; }
        int dev = 0, cus = 0;
        if (hipGetDevice(&dev) != hipSuccess || hipDeviceGetAttribute(&cus, hipDeviceAttributeMultiprocessorCount, dev) != hipSuccess) { grid = -1; return; }
        if (hipFuncSetAttribute((const void*)fwd, hipFuncAttributeMaxDynamicSharedMemorySize, LDS_BYTES) != hipSuccess) { fprintf(stderr, "kernel_launch: hipFuncSetAttribute failed\n"); grid = -1; return; }
        grid = cus > 0 ? cus : 256;
    }
    if (grid < 0) return;
    Args a{};
    for (int i = 0; i < 23; ++i) a.in[i] = d_in[i];
    a.out = (float*)d_out; a.ws = (unsigned char*)d_ws;
    (void)hipMemsetAsync((char*)d_ws + WS_CTL, 0, CTL_ZERO_BYTES, stream);
#ifdef MK_PER_PHASE
    for (int p = 0; p < NPHASES; ++p) { a.ph_lo = p; a.ph_hi = p + 1; hipLaunchKernelGGL(fwd, dim3(grid), dim3(NTHR), LDS_BYTES, stream, a); }
#else
    a.ph_lo = 0; a.ph_hi = NPHASES;
    hipLaunchKernelGGL(fwd, dim3(grid), dim3(NTHR), LDS_BYTES, stream, a);
#endif
}
```

```cpp
#include <hip/hip_runtime.h>
#include <cstdio>
#include <cstdint>

#ifndef OPT_INPROJ
#define OPT_INPROJ 1
#endif
#ifndef OPT_BRANCH
#define OPT_BRANCH 1
#endif
#ifndef OPT_OUT
#define OPT_OUT 1
#endif
#ifndef OPT_MOE
#define OPT_MOE 1
#endif
#ifndef OPT_LOCAL
#define OPT_LOCAL 1
#endif
#ifndef OPT_OUTP
#define OPT_OUTP 1
#endif
#ifndef OPT_ROUTE
#define OPT_ROUTE 1
#endif
#define OPT_ANY (OPT_INPROJ || OPT_BRANCH || OPT_OUT || OPT_MOE)
#define DI __device__ __forceinline__
#define LAS __attribute__((address_space(3)))
typedef unsigned short bf16;
typedef float f32x4 __attribute__((ext_vector_type(4)));
typedef unsigned u32x4 __attribute__((ext_vector_type(4)));
typedef unsigned u32x2 __attribute__((ext_vector_type(2)));

constexpr int D = 1024, NB = 4, SEQ = 4096, T = NB * SEQ;
constexpr int DIN = 8200, CH = 128, NCH = SEQ / CH;
constexpr int NE = 32, TOPK = 4, NSLOT_BLK = 288, NSLOTS = NSLOT_BLK * 256;
constexpr float EPS = 1e-5f;
constexpr int NTHR = 512, NWAVES = 8;

constexpr size_t MiB = 1u << 20;
constexpr size_t WS_CTL   = 0;
constexpr size_t WS_MOD   = 1 * MiB;
constexpr size_t WS_IFG   = 2 * MiB;
constexpr size_t WS_COS   = 3 * MiB;
constexpr size_t WS_SIN   = 7 * MiB;
constexpr size_t WS_ROUTE = 11 * MiB;
constexpr size_t WS_SMALL = 14 * MiB;
constexpr size_t WS_H1    = 16 * MiB;
constexpr size_t WS_X1    = 50 * MiB;
constexpr size_t WS_TMP   = 114 * MiB;
constexpr size_t WS_B     = 178 * MiB;
constexpr size_t WS_QKRAW = WS_B;
constexpr size_t WS_QC    = WS_B + 32 * MiB;
constexpr size_t WS_MLV   = WS_B + 64 * MiB;
constexpr size_t WS_MLO   = WS_B + 96 * MiB;
constexpr size_t WS_RETQ  = WS_B + 128 * MiB;
constexpr size_t WS_RETK  = WS_B + 144 * MiB;
constexpr size_t WS_RETV  = WS_B + 160 * MiB;
constexpr size_t WS_RETG  = WS_B + 192 * MiB;
constexpr size_t WS_GML   = WS_B + 224 * MiB;
constexpr size_t WS_GRET  = WS_B + 256 * MiB;
constexpr size_t WS_CLOC  = WS_B + 288 * MiB;
constexpr size_t WS_CPREV = WS_B + 352 * MiB;
constexpr size_t WS_HML   = WS_B + 416 * MiB;
constexpr size_t WS_HRET  = WS_B + 448 * MiB;
constexpr size_t WS_B_END = WS_B + 480 * MiB;
constexpr size_t WS_ACT   = WS_B;
constexpr size_t WS_YS    = WS_B + 160 * MiB;
constexpr size_t WS_WT_IN = WS_B_END;
constexpr size_t WS_WT_BR = WS_WT_IN + 16 * MiB;
constexpr size_t WS_WT_OUT = WS_WT_BR + 4 * MiB;
constexpr size_t WS_WT_GU = WS_WT_OUT + 2 * MiB;
constexpr size_t WS_WT_DN = WS_WT_GU + 128 * MiB;
constexpr size_t WS_END   = WS_WT_DN + 64 * MiB;
static_assert(WS_YS + (size_t)NSLOTS * 2048 <= WS_B_END, "ws map");

constexpr int CW_CNT = 64;
constexpr int CW_NBLK = 128;
constexpr int CW_BLKE = 192;
constexpr int CW_BAR = 4096;
constexpr size_t CTL_ZERO_BYTES = 65536;
constexpr size_t RT_TOPI = 0;
constexpr size_t RT_TOPW = 256 * 1024;
constexpr size_t RT_RANK = 512 * 1024;
constexpr size_t RT_ASLOT = 768 * 1024;
constexpr size_t RT_SLOTTOK = 1024 * 1024;
constexpr size_t RT_SLOTW = 1024 * 1024 + 512 * 1024;
constexpr size_t RT_BLKCNT = 2048 * 1024;
constexpr size_t SM_NLOC = 0;
constexpr size_t SM_NPREV = 256 * 1024;
constexpr size_t SM_MLOC = 512 * 1024;
constexpr size_t SM_ACH = 512 * 1024 + 4096;
constexpr size_t SM_MPREV = 512 * 1024 + 8192;
constexpr size_t SM_AG = 1024 * 1024;
constexpr size_t SM_CMG = 1280 * 1024;

constexpr int LDS_BYTES = 163840;

DI float bf2f(bf16 v) { return __uint_as_float(((unsigned)v) << 16); }
DI unsigned f2bf(float f) { unsigned u = __float_as_uint(f); return (u + 0x7fffu + ((u >> 16) & 1u)) >> 16; }
DI unsigned pk2(float lo, float hi) { return f2bf(lo) | (f2bf(hi) << 16); }
DI float wave_sum(float v) {
#pragma unroll
    for (int o = 1; o < 64; o <<= 1) v += __shfl_xor(v, o);
    return v;
}
DI float sigmoidf_(float x) { return 1.0f / (1.0f + __expf(-x)); }
DI float siluf_(float x) { return x / (1.0f + __expf(-x)); }
DI float logsigmoidf_(float x) { return fminf(x, 0.f) - log1pf(__expf(-fabsf(x))); }
DI void unpack8(const u32x4 w, float (&f)[8]) {
    f[0] = __uint_as_float(w.x << 16); f[1] = __uint_as_float(w.x & 0xffff0000u);
    f[2] = __uint_as_float(w.y << 16); f[3] = __uint_as_float(w.y & 0xffff0000u);
    f[4] = __uint_as_float(w.z << 16); f[5] = __uint_as_float(w.z & 0xffff0000u);
    f[6] = __uint_as_float(w.w << 16); f[7] = __uint_as_float(w.w & 0xffff0000u);
}
DI u32x4 pack8(const float (&f)[8]) { u32x4 w; w.x = pk2(f[0], f[1]); w.y = pk2(f[2], f[3]); w.z = pk2(f[4], f[5]); w.w = pk2(f[6], f[7]); return w; }

struct Args { const void* in[23]; float* out; unsigned char* ws; int ph_lo, ph_hi; };

struct Ctx {
    LAS unsigned char* lds;
    int tid, lane, wave, G, bid;
    const float *x, *c, *w_ada, *b_ada, *norm_mix_g, *w_in, *conv_w, *conv_b, *b_if, *ml_norm_g, *ret_norm_g;
    const float *w_bml, *w_bret, *w_out, *norm_ffn_g, *w_router, *b_router, *w_gu, *b_gu, *w_dn, *b_dn, *norm_final_g;
    const int* positions;
    float* out; unsigned char* ws;
};

template <class AF, class BF, class EF>
DI void naive_gemm_tile(Ctx& C, int tm, int tn, int K, int ldb, const AF& af, const BF& bf, const EF& ef) {
    LAS float* As = (LAS float*)C.lds;
    LAS float* Bs = As + 16 * 132;
    const int t = C.tid, ty = t >> 5, tx = t & 31;
    float acc[8][4];
#pragma unroll
    for (int i = 0; i < 8; ++i)
#pragma unroll
        for (int j = 0; j < 4; ++j) acc[i][j] = 0.f;
    const int ar = t >> 2, ak = (t & 3) * 4;
    const bf16* arow = af.row(tm, ar);
    const int bk = t >> 5, bn = (t & 31) * 4;
    const float* bbase = bf.ptr(tm, tn) + bn;
    for (int k0 = 0; k0 < K; k0 += 16) {
        const u32x2 av = *(const u32x2*)(arow + k0 + ak);
        const f32x4 bv = *(const f32x4*)(bbase + (size_t)(k0 + bk) * ldb);
        __syncthreads();
        As[(ak + 0) * 132 + ar] = __uint_as_float(av.x << 16); As[(ak + 1) * 132 + ar] = __uint_as_float(av.x & 0xffff0000u);
        As[(ak + 2) * 132 + ar] = __uint_as_float(av.y << 16); As[(ak + 3) * 132 + ar] = __uint_as_float(av.y & 0xffff0000u);
        *(LAS f32x4*)(Bs + bk * 132 + bn) = bv;
        __syncthreads();
#pragma unroll 4
        for (int kk = 0; kk < 16; ++kk) {
            const f32x4 a0 = *(const LAS f32x4*)(As + kk * 132 + ty * 8), a1 = *(const LAS f32x4*)(As + kk * 132 + ty * 8 + 4);
            const f32x4 b = *(const LAS f32x4*)(Bs + kk * 132 + tx * 4);
            const float a[8] = {a0.x, a0.y, a0.z, a0.w, a1.x, a1.y, a1.z, a1.w};
#pragma unroll
            for (int i = 0; i < 8; ++i) { acc[i][0] += a[i] * b.x; acc[i][1] += a[i] * b.y; acc[i][2] += a[i] * b.z; acc[i][3] += a[i] * b.w; }
        }
    }
#pragma unroll
    for (int i = 0; i < 8; ++i) { ef.put(tm, tn, ty * 8 + i, tx * 4, acc[i]); asm volatile("" ::: "memory"); }
    __syncthreads();
}

DI void phase_mod(Ctx& C) {
    LAS float* red = (LAS float*)C.lds;
    float* mod = (float*)(C.ws + WS_MOD);
    for (int g = C.bid; g < 256; g += C.G) {
        const int n0 = g * 24, t = C.tid;
        if (t < 504) {
            const int col = t % 24, kg = t / 24;
            float a0 = 0.f, a1 = 0.f, a2 = 0.f, a3 = 0.f;
            for (int k = kg; k < D; k += 21) {
                const float w = C.w_ada[(size_t)k * 6144 + n0 + col];
                a0 += siluf_(C.c[k]) * w; a1 += siluf_(C.c[D + k]) * w; a2 += siluf_(C.c[2 * D + k]) * w; a3 += siluf_(C.c[3 * D + k]) * w;
            }
            red[(kg * 24 + col) * 4 + 0] = a0; red[(kg * 24 + col) * 4 + 1] = a1; red[(kg * 24 + col) * 4 + 2] = a2; red[(kg * 24 + col) * 4 + 3] = a3;
        }
        __syncthreads();
        if (t < 96) {
            const int col = t % 24, b = t / 24; float s = 0.f;
            for (int kg = 0; kg < 21; ++kg) s += red[(kg * 24 + col) * 4 + b];
            mod[b * 6144 + n0 + col] = s + C.b_ada[n0 + col];
        }
        __syncthreads();
    }
}

DI void phase_norm1(Ctx& C) {
    const float* mod = (const float*)(C.ws + WS_MOD);
    bf16* H1 = (bf16*)(C.ws + WS_H1);
    float* IFG = (float*)(C.ws + WS_IFG);
    const int lane = C.lane, gw = C.bid * NWAVES + C.wave, NGW = C.G * NWAVES;
    float wif[4][4][8];
#pragma unroll
    for (int j = 0; j < 4; ++j)
#pragma unroll
        for (int i = 0; i < 4; ++i) {
            const float* wp = C.w_in + (size_t)(4 * (lane + 64 * j) + i) * DIN + 3072;
#pragma unroll
            for (int e = 0; e < 8; ++e) wif[j][i][e] = wp[e];
        }
    for (int m = gw; m < T; m += NGW) {
        const int b = m / SEQ;
        const f32x4* xr = (const f32x4*)(C.x + (size_t)m * D) + lane;
        f32x4 v[4]; float ss = 0.f;
#pragma unroll
        for (int j = 0; j < 4; ++j) { v[j] = xr[64 * j]; ss += (v[j].x * v[j].x + v[j].y * v[j].y) + (v[j].z * v[j].z + v[j].w * v[j].w); }
        const float rstd = 1.0f / sqrtf(wave_sum(ss) * (1.0f / D) + EPS);
        float p[8];
#pragma unroll
        for (int e = 0; e < 8; ++e) p[e] = 0.f;
        u32x2* o8 = (u32x2*)(H1 + (size_t)m * D) + lane;
#pragma unroll
        for (int j = 0; j < 4; ++j) {
            const int col = 4 * (lane + 64 * j);
            const f32x4 g = *(const f32x4*)(C.norm_mix_g + col), sh = *(const f32x4*)(mod + b * 6144 + col), sc = *(const f32x4*)(mod + b * 6144 + 1024 + col);
            f32x4 h = (v[j] * rstd * g) * (sc + 1.0f) + sh;
            u32x2 w; w.x = pk2(h.x, h.y); w.y = pk2(h.z, h.w); o8[64 * j] = w;
            const float hh[4] = {h.x, h.y, h.z, h.w};
#pragma unroll
            for (int i = 0; i < 4; ++i)
#pragma unroll
                for (int e = 0; e < 8; ++e) p[e] += hh[i] * wif[j][i][e];
        }
#pragma unroll
        for (int e = 0; e < 8; ++e) p[e] = wave_sum(p[e]);
        if (lane < 8) { float r = p[0];
#pragma unroll
            for (int e = 1; e < 8; ++e) r = (lane == e) ? p[e] : r;
            IFG[(size_t)m * 8 + lane] = r + C.b_if[lane]; }
    }
    float* COS = (float*)(C.ws + WS_COS); float* SIN = (float*)(C.ws + WS_SIN);
    for (int idx = C.bid * NTHR + C.tid; idx < T * 64; idx += C.G * NTHR) {
        const int t = idx >> 6, i = idx & 63;
        const float inv = (float)exp(-(double)i * (9.210340371976184 / 64.0));
        const double ang = (double)C.positions[t] * (double)inv;
        const double kq = rint(ang * 0.6366197723675814);
        double r = fma(-kq, 1.5707963267948966, ang); r = fma(-kq, 6.123233995736766e-17, r);
        const float rf = (float)r; const float s = sinf(rf), c = cosf(rf);
        const int q = ((int)kq) & 3;
        const float cs = (q == 0) ? c : (q == 1) ? -s : (q == 2) ? -c : s;
        const float sn = (q == 0) ? s : (q == 1) ? c : (q == 2) ? -s : -c;
        COS[idx] = cs; SIN[idx] = sn;
    }
    if (C.bid == 0 && C.tid < 32) ((unsigned*)(C.ws + WS_CTL))[CW_CNT + C.tid] = 0u;
}

struct AF_rows { const bf16* base; int ld; DI const bf16* row(int tm, int r) const { return base + (size_t)(tm * 128 + r) * ld; } };
struct BF_inproj { const float* w; DI const float* ptr(int, int tn) const { return w + (tn < 24 ? tn * 128 : tn * 128 + 8); } };
struct EF_inproj { unsigned char* ws;
    DI void put(int tm, int tn, int r, int c, const float (&v)[4]) const {
        const int row = tm * 128 + r; const int seg = tn >> 3;
        bf16* dst; int ld = 1024, col = (tn & 7) * 128 + c; int act = 0;
        switch (seg) {
            case 0: dst = (bf16*)(ws + WS_QKRAW); break;
            case 1: dst = (bf16*)(ws + WS_MLV); break;
            case 2: dst = (bf16*)(ws + WS_MLO); act = 1; break;
            case 3: if ((tn & 7) < 4) dst = (bf16*)(ws + WS_RETQ); else { dst = (bf16*)(ws + WS_RETK); col -= 512; } ld = 512; break;
            case 4: dst = (bf16*)(ws + WS_RETV); break;
            case 5: dst = (bf16*)(ws + WS_RETG); act = 2; break;
            case 6: dst = (bf16*)(ws + WS_GML); act = 1; break;
            default: dst = (bf16*)(ws + WS_GRET); act = 1; break;
        }
        float o[4];
#pragma unroll
        for (int j = 0; j < 4; ++j) o[j] = act == 1 ? sigmoidf_(v[j]) : act == 2 ? siluf_(v[j]) : v[j];
        u32x2 w; w.x = pk2(o[0], o[1]); w.y = pk2(o[2], o[3]);
        *(u32x2*)(dst + (size_t)row * ld + col) = w;
    } };
DI void phase_inproj(Ctx& C) {
    AF_rows af{(const bf16*)(C.ws + WS_H1), D}; BF_inproj bf{C.w_in}; EF_inproj ef{C.ws};
    const int ntn = 64, nt = (T / 128) * ntn;
    for (int u = C.bid; u < nt; u += C.G) naive_gemm_tile(C, u / ntn, u % ntn, D, DIN, af, bf, ef);
}

DI void phase_conv_rope(Ctx& C) {
    const bf16* QKRAW = (const bf16*)(C.ws + WS_QKRAW); bf16* QC = (bf16*)(C.ws + WS_QC);
    for (int idx = C.bid * NTHR + C.tid; idx < T * 128; idx += C.G * NTHR) {
        const int t = idx >> 7, c0 = (idx & 127) * 8, s = t % SEQ;
        float acc[8];
#pragma unroll
        for (int e = 0; e < 8; ++e) acc[e] = C.conv_b[c0 + e];
#pragma unroll
        for (int j = 0; j < 4; ++j) {
            if (s - 3 + j >= 0) {
                float f[8]; unpack8(*(const u32x4*)(QKRAW + (size_t)(t - 3 + j) * D + c0), f);
#pragma unroll
                for (int e = 0; e < 8; ++e) acc[e] += f[e] * C.conv_w[j * D + c0 + e];
            }
        }
        const float sc = (c0 < 512) ? 0.08838834764831845f : 1.0f;
#pragma unroll
        for (int e = 0; e < 8; ++e) acc[e] = siluf_(acc[e]) * sc;
        *(u32x4*)(QC + (size_t)t * D + c0) = pack8(acc);
    }
#if !OPT_INPROJ
    const float* COS = (const float*)(C.ws + WS_COS); const float* SIN = (const float*)(C.ws + WS_SIN);
    for (int idx = C.bid * NTHR + C.tid; idx < T * 64; idx += C.G * NTHR) {
        const int t = idx >> 6, r = idx & 63, which = r >> 5, h = (r >> 3) & 3, i0 = (r & 7) * 8;
        bf16* base = (bf16*)(C.ws + (which ? WS_RETK : WS_RETQ)) + (size_t)t * 512 + h * 128;
        float x1[8], x2[8], o1[8], o2[8]; unpack8(*(const u32x4*)(base + i0), x1); unpack8(*(const u32x4*)(base + 64 + i0), x2);
        const float sc = which ? 0.08838834764831845f : 1.0f;
#pragma unroll
        for (int e = 0; e < 8; ++e) { const float cs = COS[t * 64 + i0 + e], sn = SIN[t * 64 + i0 + e]; o1[e] = (x1[e] * cs - x2[e] * sn) * sc; o2[e] = (x2[e] * cs + x1[e] * sn) * sc; }
        *(u32x4*)(base + i0) = pack8(o1); *(u32x4*)(base + 64 + i0) = pack8(o2);
    }
#endif
}

DI float ret_lg(int h) { return logf(1.0f - exp2f(-5.0f - (float)h)); }

DI void phase_local(Ctx& C) {
    LAS float* lf = (LAS float*)C.lds; LAS float* a = lf + 128; LAS float* ws = a + 128; LAS float* red = ws + 128;
    const float* IFG = (const float*)(C.ws + WS_IFG);
    bf16* CLOC = (bf16*)(C.ws + WS_CLOC);
    float* NLOC = (float*)(C.ws + WS_SMALL + SM_NLOC); float* MLOC = (float*)(C.ws + WS_SMALL + SM_MLOC); float* ACH = (float*)(C.ws + WS_SMALL + SM_ACH);
    const int t = C.tid;
    for (int u = C.bid; u < 1024; u += C.G) {
        const int mixer = u >> 9, bh = (u >> 5) & 15, ch = u & 31, b = bh >> 2, h = bh & 3, t0 = b * SEQ + ch * CH;
        const bf16 *Kp, *Vp; int ldk;
        if (mixer == 0) {
            if (t < 128) lf[t] = logsigmoidf_(IFG[(size_t)(t0 + t) * 8 + 4 + h]);
            __syncthreads();
            if (t < 128) { float s = 0.f; for (int j = 0; j <= t; ++j) s += lf[j]; a[t] = s; }
            __syncthreads();
            const float A = a[127];
            if (t < 128) ws[t] = A - a[t] + IFG[(size_t)(t0 + t) * 8 + h];
            __syncthreads();
            float mloc = -3.0e38f; for (int j = 0; j < 128; ++j) mloc = fmaxf(mloc, ws[j]);
            __syncthreads();
            if (t < 128) ws[t] = __expf(ws[t] - mloc);
            if (t == 0) { MLOC[bh * 32 + ch] = mloc; ACH[bh * 32 + ch] = A; }
            __syncthreads();
            Kp = (const bf16*)(C.ws + WS_QC) + (size_t)t0 * D + 512 + h * 128; ldk = D;
            Vp = (const bf16*)(C.ws + WS_MLV) + (size_t)t0 * D + h * 256;
        } else {
            const float lg = ret_lg(h);
            if (t < 128) ws[t] = __expf(lg * (float)(127 - t));
            __syncthreads();
            Kp = (const bf16*)(C.ws + WS_RETK) + (size_t)t0 * 512 + h * 128; ldk = 512;
            Vp = (const bf16*)(C.ws + WS_RETV) + (size_t)t0 * D + h * 256;
        }
        const int kh = t >> 8, v = t & 255;
        float acc[64];
#pragma unroll
        for (int i = 0; i < 64; ++i) acc[i] = 0.f;
        for (int s = 0; s < 128; ++s) {
            const float vv = ws[s] * bf2f(Vp[(size_t)s * D + v]);
            const bf16* kr = Kp + (size_t)s * ldk + kh * 64;
#pragma unroll
            for (int i8 = 0; i8 < 8; ++i8) { float f[8]; unpack8(*(const u32x4*)(kr + i8 * 8), f);
#pragma unroll
                for (int e = 0; e < 8; ++e) acc[i8 * 8 + e] += f[e] * vv; }
        }
        bf16* cl = CLOC + ((size_t)(mixer * 16 + bh) * 32 + ch) * 32768;
#pragma unroll
        for (int i = 0; i < 64; ++i) cl[(size_t)v * 128 + (kh * 64 + i)] = (bf16)f2bf(acc[i]);
        if (mixer == 0 && t < 128) { float s = 0.f; for (int j = 0; j < 128; ++j) s += ws[j] * bf2f(Kp[(size_t)j * ldk + t]); NLOC[(bh * 32 + ch) * 128 + t] = s; }
        __syncthreads();
    }
    (void)red;
}

DI void phase_scan(Ctx& C) {
    const bf16* CLOC = (const bf16*)(C.ws + WS_CLOC); bf16* CPREV = (bf16*)(C.ws + WS_CPREV);
    const float* NLOC = (const float*)(C.ws + WS_SMALL + SM_NLOC); float* NPREV = (float*)(C.ws + WS_SMALL + SM_NPREV);
    const float* MLOC = (const float*)(C.ws + WS_SMALL + SM_MLOC); const float* ACH = (const float*)(C.ws + WS_SMALL + SM_ACH); float* MPREV = (float*)(C.ws + WS_SMALL + SM_MPREV);
    for (int idx = C.bid * NTHR + C.tid; idx < 32 * 4096; idx += C.G * NTHR) {
        const int seq = idx >> 12, e8 = idx & 4095;
        float st[8];
#pragma unroll
        for (int e = 0; e < 8; ++e) st[e] = 0.f;
        if (seq < 16) {
            float m_st = 0.f; float nst[8];
#pragma unroll
            for (int e = 0; e < 8; ++e) nst[e] = 0.f;
            for (int ch = 0; ch < 32; ++ch) {
                const size_t o = ((size_t)seq * 32 + ch) * 32768 + (size_t)e8 * 8;
                *(u32x4*)(CPREV + o) = pack8(st);
                if (e8 < 16) { *(f32x4*)(NPREV + (seq * 32 + ch) * 128 + e8 * 8) = (f32x4){nst[0], nst[1], nst[2], nst[3]}; *(f32x4*)(NPREV + (seq * 32 + ch) * 128 + e8 * 8 + 4) = (f32x4){nst[4], nst[5], nst[6], nst[7]}; }
                if (e8 == 0) MPREV[seq * 32 + ch] = m_st;
                const float A = ACH[seq * 32 + ch], ml = MLOC[seq * 32 + ch];
                const float m_new = fmaxf(A + m_st, ml), sp = __expf(A + m_st - m_new), sl = __expf(ml - m_new);
                float f[8]; unpack8(*(const u32x4*)(CLOC + o), f);
#pragma unroll
                for (int e = 0; e < 8; ++e) st[e] = sp * st[e] + sl * f[e];
                if (e8 < 16) { const float* nl = NLOC + (seq * 32 + ch) * 128 + e8 * 8;
#pragma unroll
                    for (int e = 0; e < 8; ++e) nst[e] = sp * nst[e] + sl * nl[e]; }
                m_st = m_new;
            }
        } else {
            const float g = __expf(ret_lg(seq & 3) * 128.0f);
            for (int ch = 0; ch < 32; ++ch) {
                const size_t o = ((size_t)seq * 32 + ch) * 32768 + (size_t)e8 * 8;
                *(u32x4*)(CPREV + o) = pack8(st);
                float f[8]; unpack8(*(const u32x4*)(CLOC + o), f);
#pragma unroll
                for (int e = 0; e < 8; ++e) st[e] = g * st[e] + f[e];
            }
        }
    }
}

DI void phase_out(Ctx& C) {
    LAS float* av = (LAS float*)C.lds;
    LAS float* bv = av + 128;
    LAS float* mt = bv + 128;
    LAS float* isc = mt + 128;
    LAS float* den = isc + 128;
    LAS float* rs = den + 128;
    LAS float* P = rs + 1024;
    LAS float* Qs = P + 128 * 129;
    const float* IFG = (const float*)(C.ws + WS_IFG);
    const bf16* CPREV = (const bf16*)(C.ws + WS_CPREV);
    const float* NPREV = (const float*)(C.ws + WS_SMALL + SM_NPREV); const float* MPREV = (const float*)(C.ws + WS_SMALL + SM_MPREV);
    const int t = C.tid;
    for (int u = C.bid; u < 1024; u += C.G) {
        const int mixer = u >> 9, bh = (u >> 5) & 15, ch = u & 31, b = bh >> 2, h = bh & 3, t0 = b * SEQ + ch * CH;
        const bf16 *Qp, *Kp, *Vp; int ldq; const bf16* cp = CPREV + ((size_t)(mixer * 16 + bh) * 32 + ch) * 32768;
        float lg = 0.f;
        if (mixer == 0) {
            Qp = (const bf16*)(C.ws + WS_QC) + (size_t)t0 * D + h * 128; Kp = Qp + 512; ldq = D;
            Vp = (const bf16*)(C.ws + WS_MLV) + (size_t)t0 * D + h * 256;
            if (t < 128) mt[t] = logsigmoidf_(IFG[(size_t)(t0 + t) * 8 + 4 + h]);
            __syncthreads();
            if (t < 128) { float s = 0.f; for (int j = 0; j <= t; ++j) s += mt[j]; av[t] = s; bv[t] = IFG[(size_t)(t0 + t) * 8 + h] - s; }
            __syncthreads();
            if (t < 128) { float cm = -3.0e38f; for (int j = 0; j <= t; ++j) cm = fmaxf(cm, bv[j]);
                const float il = av[t] + MPREV[bh * 32 + ch], m = fmaxf(il, av[t] + cm); isc[t] = __expf(il - m); mt[t] = m; }
        } else {
            lg = ret_lg(h);
            Qp = (const bf16*)(C.ws + WS_RETQ) + (size_t)t0 * 512 + h * 128; Kp = (const bf16*)(C.ws + WS_RETK) + (size_t)t0 * 512 + h * 128; ldq = 512;
            Vp = (const bf16*)(C.ws + WS_RETV) + (size_t)t0 * D + h * 256;
            if (t < 128) isc[t] = __expf(lg * (float)(t + 1));
        }
        for (int e = t; e < 128 * 16; e += NTHR) { const int j = e >> 4, k8 = e & 15; float f[8]; unpack8(*(const u32x4*)(Qp + (size_t)j * ldq + k8 * 8), f);
#pragma unroll
            for (int i = 0; i < 8; ++i) Qs[j * 129 + k8 * 8 + i] = f[i]; }
        __syncthreads();
        for (int e = t; e < 128 * 128; e += NTHR) {
            const int j = e >> 7, s = e & 127; float p = 0.f;
            if (s <= j) {
                float d = 0.f;
#pragma unroll 4
                for (int k8 = 0; k8 < 16; ++k8) { float fk[8]; unpack8(*(const u32x4*)(Kp + (size_t)s * ldq + k8 * 8), fk);
#pragma unroll
                    for (int i = 0; i < 8; ++i) d += Qs[j * 129 + k8 * 8 + i] * fk[i]; }
                p = d * (mixer == 0 ? __expf(av[j] + bv[s] - mt[j]) : __expf(lg * (float)(j - s)));
            }
            P[j * 129 + s] = p;
        }
        __syncthreads();
        if (mixer == 0 && t < 128) { float s = 0.f; for (int i = 0; i < 128; ++i) s += P[t * 129 + i];
            float qn = 0.f; const float* np = NPREV + (bh * 32 + ch) * 128; for (int k = 0; k < 128; ++k) qn += Qs[t * 129 + k] * np[k];
            den[t] = fmaxf(fabsf(s + isc[t] * qn), __expf(-mt[t])); }
        __syncthreads();
        const float gain = (mixer == 0 ? C.ml_norm_g : C.ret_norm_g)[h * 256 + (t & 255)];
#pragma unroll 1
        for (int pass = 0; pass < 2; ++pass) {
            const int jh = t >> 8, v = t & 255, r0 = (pass * 2 + jh) * 32;
            float acc[32];
#pragma unroll
            for (int i = 0; i < 32; ++i) acc[i] = 0.f;
            const LAS float* qb = Qs + r0 * 129; const LAS float* pb = P + r0 * 129;
            for (int k = 0; k < 128; ++k) {
                const float cv = bf2f(cp[(size_t)v * 128 + k]);
#pragma unroll
                for (int i = 0; i < 32; ++i) acc[i] += qb[i * 129 + k] * cv;
            }
#pragma unroll
            for (int i = 0; i < 32; ++i) acc[i] *= isc[r0 + i];
            for (int s = 0; s < 128; ++s) {
                const float vv = bf2f(Vp[(size_t)s * D + v]);
#pragma unroll
                for (int i = 0; i < 32; ++i) acc[i] += pb[i * 129 + s] * vv;
            }
            if (mixer == 0) {
#pragma unroll
                for (int i = 0; i < 32; ++i) acc[i] = acc[i] / den[r0 + i];
            }
            const int wq = C.wave & 3;
#pragma unroll
            for (int i = 0; i < 32; ++i) { const float s1 = wave_sum(acc[i]); if (C.lane == 0) rs[wq * 128 + r0 + i] = s1; }
            __syncthreads();
#pragma unroll
            for (int i = 0; i < 32; ++i) { const int r = r0 + i; acc[i] -= (rs[r] + rs[128 + r] + rs[256 + r] + rs[384 + r]) * (1.0f / 256.0f); }
#pragma unroll
            for (int i = 0; i < 32; ++i) { const float s2 = wave_sum(acc[i] * acc[i]); if (C.lane == 0) rs[512 + wq * 128 + r0 + i] = s2; }
            __syncthreads();
            const bf16* gate = (const bf16*)(C.ws + (mixer == 0 ? WS_MLO : WS_RETG)) + (size_t)t0 * D + h * 256 + v;
            bf16* outp = (bf16*)(C.ws + (mixer == 0 ? WS_HML : WS_HRET)) + (size_t)t0 * D + h * 256 + v;
#pragma unroll
            for (int i = 0; i < 32; ++i) { const int r = r0 + i;
                const float var = (rs[512 + r] + rs[512 + 128 + r] + rs[512 + 256 + r] + rs[512 + 384 + r]) * (1.0f / 256.0f);
                const float y = acc[i] * (1.0f / sqrtf(var + EPS)) * gain * bf2f(gate[(size_t)r * D]);
                outp[(size_t)r * D] = (bf16)f2bf(y); }
            __syncthreads();
        }
    }
}

struct BF_plain { const float* w; DI const float* ptr(int, int tn) const { return w + tn * 128; } };
struct EF_f32 { float* dst; DI void put(int tm, int tn, int r, int c, const float (&v)[4]) const { *(f32x4*)(dst + (size_t)(tm * 128 + r) * D + tn * 128 + c) = (f32x4){v[0], v[1], v[2], v[3]}; } };
struct EF_merge { const float* t1; const bf16* g1; const bf16* g2; bf16* y;
    DI void put(int tm, int tn, int r, int c, const float (&v)[4]) const {
        const size_t o = (size_t)(tm * 128 + r) * D + tn * 128 + c; const f32x4 a = *(const f32x4*)(t1 + o);
        const u32x2 w1 = *(const u32x2*)(g1 + o), w2 = *(const u32x2*)(g2 + o);
        const float o0 = __uint_as_float(w1.x << 16) * a.x + __uint_as_float(w2.x << 16) * v[0], o1 = __uint_as_float(w1.x & 0xffff0000u) * a.y + __uint_as_float(w2.x & 0xffff0000u) * v[1];
        const float o2 = __uint_as_float(w1.y << 16) * a.z + __uint_as_float(w2.y << 16) * v[2], o3 = __uint_as_float(w1.y & 0xffff0000u) * a.w + __uint_as_float(w2.y & 0xffff0000u) * v[3];
        u32x2 w; w.x = pk2(o0, o1); w.y = pk2(o2, o3); *(u32x2*)(y + o) = w; } };
DI void phase_branch(Ctx& C) {
    AF_rows a1{(const bf16*)(C.ws + WS_HML), D}, a2{(const bf16*)(C.ws + WS_HRET), D}; BF_plain b1{C.w_bml}, b2{C.w_bret};
    EF_f32 e1{(float*)(C.ws + WS_TMP)}; EF_merge e2{(const float*)(C.ws + WS_TMP), (const bf16*)(C.ws + WS_GML), (const bf16*)(C.ws + WS_GRET), (bf16*)(C.ws + WS_H1)};
    const int nt = (T / 128) * 8;
    for (int u = C.bid; u < nt; u += C.G) { naive_gemm_tile(C, u / 8, u % 8, D, D, a1, b1, e1); naive_gemm_tile(C, u / 8, u % 8, D, D, a2, b2, e2); }
}
struct EF_resid { const float* x; const float* mod; float* x1;
    DI void put(int tm, int tn, int r, int c, const float (&v)[4]) const {
        const int row = tm * 128 + r, col = tn * 128 + c, b = row / SEQ; const size_t o = (size_t)row * D + col;
        const f32x4 xv = *(const f32x4*)(x + o), g = *(const f32x4*)(mod + b * 6144 + 2048 + col);
        *(f32x4*)(x1 + o) = xv + g * (f32x4){v[0], v[1], v[2], v[3]}; } };
DI void phase_outproj(Ctx& C) {
    AF_rows a{(const bf16*)(C.ws + WS_H1), D}; BF_plain b{C.w_out}; EF_resid e{C.x, (const float*)(C.ws + WS_MOD), (float*)(C.ws + WS_X1)};
    const int nt = (T / 128) * 8;
    for (int u = C.bid; u < nt; u += C.G) naive_gemm_tile(C, u / 8, u % 8, D, D, a, b, e);
}

DI void phase_norm2_route(Ctx& C) {
    LAS float* wr = (LAS float*)C.lds;
    LAS float* lg = wr + 32768;
    for (int i = C.tid; i < 32768 / 4; i += NTHR) *(LAS f32x4*)(wr + i * 4) = *(const f32x4*)(C.w_router + i * 4);
    __syncthreads();
    const float* mod = (const float*)(C.ws + WS_MOD); const float* X1 = (const float*)(C.ws + WS_X1);
    bf16* H2 = (bf16*)(C.ws + WS_H1);
    int* TOPI = (int*)(C.ws + WS_ROUTE + RT_TOPI); float* TOPW = (float*)(C.ws + WS_ROUTE + RT_TOPW); int* RANK = (int*)(C.ws + WS_ROUTE + RT_RANK);
    unsigned* CNT = (unsigned*)(C.ws + WS_CTL) + CW_CNT;
    const int lane = C.lane, gw = C.bid * NWAVES + C.wave, NGW = C.G * NWAVES;
    for (int m = gw; m < T; m += NGW) {
        const int b = m / SEQ;
        const f32x4* xr = (const f32x4*)(X1 + (size_t)m * D) + lane;
        f32x4 v[4]; float ss = 0.f;
#pragma unroll
        for (int j = 0; j < 4; ++j) { v[j] = xr[64 * j]; ss += (v[j].x * v[j].x + v[j].y * v[j].y) + (v[j].z * v[j].z + v[j].w * v[j].w); }
        const float rstd = 1.0f / sqrtf(wave_sum(ss) * (1.0f / D) + EPS);
        float acc[32];
#pragma unroll
        for (int e = 0; e < 32; ++e) acc[e] = 0.f;
        u32x2* o8 = (u32x2*)(H2 + (size_t)m * D) + lane;
#pragma unroll
        for (int j = 0; j < 4; ++j) {
            const int col = 4 * (lane + 64 * j);
            const f32x4 g = *(const f32x4*)(C.norm_ffn_g + col), sh = *(const f32x4*)(mod + b * 6144 + 3072 + col), sc = *(const f32x4*)(mod + b * 6144 + 4096 + col);
            const f32x4 h = (v[j] * rstd * g) * (sc + 1.0f) + sh;
            u32x2 w; w.x = pk2(h.x, h.y); w.y = pk2(h.z, h.w); o8[64 * j] = w;
            const float hh[4] = {h.x, h.y, h.z, h.w};
#pragma unroll
            for (int i = 0; i < 4; ++i) {
                const LAS f32x4* wp = (const LAS f32x4*)(wr + (col + i) * 32);
#pragma unroll
                for (int e4 = 0; e4 < 8; ++e4) { const f32x4 w4 = wp[e4]; acc[e4 * 4 + 0] += hh[i] * w4.x; acc[e4 * 4 + 1] += hh[i] * w4.y; acc[e4 * 4 + 2] += hh[i] * w4.z; acc[e4 * 4 + 3] += hh[i] * w4.w; }
                asm volatile("" ::: "memory");
            }
        }
#pragma unroll
        for (int e = 0; e < 32; ++e) acc[e] = wave_sum(acc[e]);
        float l[32];
#pragma unroll
        for (int e = 0; e < 32; ++e) l[e] = acc[e] + C.b_router[e];
        float tv[4]; int ti[4];
#pragma unroll
        for (int k = 0; k < 4; ++k) {
            float bvv = -3.0e38f; int bi = 0;
#pragma unroll
            for (int e = 0; e < 32; ++e) { const bool take = l[e] > bvv; bvv = take ? l[e] : bvv; bi = take ? e : bi; }
            tv[k] = bvv; ti[k] = bi;
#pragma unroll
            for (int e = 0; e < 32; ++e) l[e] = (e == bi) ? -3.0e38f : l[e];
        }
        const float e1 = __expf(tv[1] - tv[0]), e2 = __expf(tv[2] - tv[0]), e3 = __expf(tv[3] - tv[0]), inv = 1.0f / (1.0f + e1 + e2 + e3);
        if (lane < 4) {
            const int e = lane == 0 ? ti[0] : lane == 1 ? ti[1] : lane == 2 ? ti[2] : ti[3];
            const float w = (lane == 0 ? 1.0f : lane == 1 ? e1 : lane == 2 ? e2 : e3) * inv;
            TOPI[m * 4 + lane] = e; TOPW[m * 4 + lane] = w; RANK[m * 4 + lane] = (int)atomicAdd(CNT + e, 1u);
        }
    }
    (void)lg;
    int* SLOTTOK = (int*)(C.ws + WS_ROUTE + RT_SLOTTOK); float* SLOTW = (float*)(C.ws + WS_ROUTE + RT_SLOTW);
    for (int i = C.bid * NTHR + C.tid; i < NSLOTS; i += C.G * NTHR) { SLOTTOK[i] = T; SLOTW[i] = 0.f; }
    if (C.bid == 0) for (int i = C.tid; i < D / 2; i += NTHR) ((unsigned*)(H2 + (size_t)T * D))[i] = 0u;
    __syncthreads();
}

DI void phase_slots(Ctx& C) {
    LAS int* tot = (LAS int*)C.lds;
    LAS int* pstart = tot + 32;
    LAS int* base = pstart + 32;
    LAS int* part = base + 32;
    const unsigned* BLKCNT = (const unsigned*)(C.ws + WS_ROUTE + RT_BLKCNT);
    unsigned* ctl = (unsigned*)(C.ws + WS_CTL);
    const int* TOPI = (const int*)(C.ws + WS_ROUTE + RT_TOPI); const float* TOPW = (const float*)(C.ws + WS_ROUTE + RT_TOPW); const int* RANK = (const int*)(C.ws + WS_ROUTE + RT_RANK);
    int* ASLOT = (int*)(C.ws + WS_ROUTE + RT_ASLOT); int* SLOTTOK = (int*)(C.ws + WS_ROUTE + RT_SLOTTOK); float* SLOTW = (float*)(C.ws + WS_ROUTE + RT_SLOTW);
    for (int sg = C.bid; sg < T / 64; sg += C.G) {
        const int e = C.tid & 31, pt = C.tid >> 5;
        int sa = 0, sb = 0;
        for (int g2 = pt; g2 < T / 64; g2 += 16) { const int c = (int)BLKCNT[g2 * 32 + e]; sa += c; sb += (g2 < sg) ? c : 0; }
        part[(pt * 32 + e) * 2] = sa; part[(pt * 32 + e) * 2 + 1] = sb;
        __syncthreads();
        if (C.tid < 32) { int a = 0, b2 = 0; for (int p2 = 0; p2 < 16; ++p2) { a += part[(p2 * 32 + C.tid) * 2]; b2 += part[(p2 * 32 + C.tid) * 2 + 1]; } tot[C.tid] = a; base[C.tid] = b2; }
        __syncthreads();
        if (C.tid == 0) {
            int nb = 0;
            for (int e2 = 0; e2 < NE; ++e2) { pstart[e2] = nb * 256; const int bl = (tot[e2] + 255) >> 8;
                if (sg == 0) for (int i = 0; i < bl; ++i) ctl[CW_BLKE + nb + i] = (unsigned)e2;
                nb += bl; }
            if (sg == 0) ctl[CW_NBLK] = (unsigned)nb;
        }
        __syncthreads();
        if (C.tid < 256) { const int i = sg * 256 + C.tid, ex = TOPI[i];
            const int slot = pstart[ex] + base[ex] + RANK[i];
            ASLOT[i] = slot; SLOTTOK[slot] = i >> 2; SLOTW[slot] = TOPW[i]; }
        __syncthreads();
    }
}

struct AF_gather { const bf16* base; const int* slottok; DI const bf16* row(int tm, int r) const { return base + (size_t)slottok[tm * 128 + r] * D; } };
struct BF_expert { const float* w; const unsigned* blke; size_t estride; DI const float* ptr(int tm, int tn) const { return w + (size_t)blke[tm >> 1] * estride + tn * 128; } };
struct EF_swiglu { const float* bias; const unsigned* blke; bf16* act;
    DI void put(int tm, int tn, int r, int c, const float (&v)[4]) const {
        const int e = (int)blke[tm >> 1]; const float* bp = bias + (size_t)e * 2048 + tn * 128 + c;
        float o[2];
#pragma unroll
        for (int j = 0; j < 2; ++j) { const float xg = fminf(v[2 * j] + bp[2 * j], 7.0f), xl = fminf(fmaxf(v[2 * j + 1] + bp[2 * j + 1], -7.0f), 7.0f); o[j] = xg * sigmoidf_(1.702f * xg) * (xl + 1.0f); }
        *(unsigned*)(act + (size_t)(tm * 128 + r) * D + (tn * 128 + c) / 2) = pk2(o[0], o[1]); } };
DI void phase_gateup(Ctx& C) {
    const unsigned* ctl = (const unsigned*)(C.ws + WS_CTL); const int nblk = (int)ctl[CW_NBLK];
    AF_gather a{(const bf16*)(C.ws + WS_H1), (const int*)(C.ws + WS_ROUTE + RT_SLOTTOK)}; BF_expert b{C.w_gu, ctl + CW_BLKE, (size_t)D * 2048};
    EF_swiglu e{C.b_gu, ctl + CW_BLKE, (bf16*)(C.ws + WS_ACT)};
    const int nt = nblk * 2 * 16;
    for (int u = C.bid; u < nt; u += C.G) naive_gemm_tile(C, u / 16, u % 16, D, 2048, a, b, e);
}
struct EF_down { const float* bias; const unsigned* blke; const float* slotw; bf16* ys;
    DI void put(int tm, int tn, int r, int c, const float (&v)[4]) const {
        const int e = (int)blke[tm >> 1], slot = tm * 128 + r; const float w = slotw[slot]; const float* bp = bias + (size_t)e * D + tn * 128 + c;
        u32x2 o; o.x = pk2((v[0] + bp[0]) * w, (v[1] + bp[1]) * w); o.y = pk2((v[2] + bp[2]) * w, (v[3] + bp[3]) * w);
        *(u32x2*)(ys + (size_t)slot * D + tn * 128 + c) = o; } };
DI void phase_down(Ctx& C) {
    const unsigned* ctl = (const unsigned*)(C.ws + WS_CTL); const int nblk = (int)ctl[CW_NBLK];
    AF_rows a{(const bf16*)(C.ws + WS_ACT), D}; BF_expert b{C.w_dn, ctl + CW_BLKE, (size_t)D * D};
    EF_down e{C.b_dn, ctl + CW_BLKE, (const float*)(C.ws + WS_ROUTE + RT_SLOTW), (bf16*)(C.ws + WS_YS)};
    const int nt = nblk * 2 * 8;
    for (int u = C.bid; u < nt; u += C.G) naive_gemm_tile(C, u / 8, u % 8, D, D, a, b, e);
}
DI void phase_final(Ctx& C) {
    const float* mod = (const float*)(C.ws + WS_MOD); const float* X1 = (const float*)(C.ws + WS_X1); const bf16* YS = (const bf16*)(C.ws + WS_YS);
    const int* ASLOT = (const int*)(C.ws + WS_ROUTE + RT_ASLOT);
    const int lane = C.lane, gw = C.bid * NWAVES + C.wave, NGW = C.G * NWAVES;
    for (int m = gw; m < T; m += NGW) {
        const int b = m / SEQ;
        const int s0 = ASLOT[m * 4 + 0], s1 = ASLOT[m * 4 + 1], s2 = ASLOT[m * 4 + 2], s3 = ASLOT[m * 4 + 3];
        f32x4 v[4]; float ss = 0.f;
#pragma unroll
        for (int j = 0; j < 4; ++j) {
            const int col = 4 * (lane + 64 * j);
            f32x4 y = (f32x4){0.f, 0.f, 0.f, 0.f};
            const int sl[4] = {s0, s1, s2, s3};
#pragma unroll
            for (int k = 0; k < 4; ++k) { const u32x2 w = *(const u32x2*)(YS + (size_t)sl[k] * D + col);
                y += (f32x4){__uint_as_float(w.x << 16), __uint_as_float(w.x & 0xffff0000u), __uint_as_float(w.y << 16), __uint_as_float(w.y & 0xffff0000u)}; }
            const f32x4 g = *(const f32x4*)(mod + b * 6144 + 5120 + col);
            v[j] = *(const f32x4*)(X1 + (size_t)m * D + col) + g * y;
            ss += (v[j].x * v[j].x + v[j].y * v[j].y) + (v[j].z * v[j].z + v[j].w * v[j].w);
        }
        const float rstd = 1.0f / sqrtf(wave_sum(ss) * (1.0f / D) + EPS);
#pragma unroll
        for (int j = 0; j < 4; ++j) { const int col = 4 * (lane + 64 * j); *(f32x4*)(C.out + (size_t)m * D + col) = v[j] * rstd * *(const f32x4*)(C.norm_final_g + col); }
    }
}

namespace pg8 {
typedef short bf16x8 __attribute__((ext_vector_type(8)));
constexpr int BM = 256, BK = 64, HALF = 128, HTB = HALF * BK * 2, STAGE_BYTES = 8 * HTB, NXCD = 8, WGM = 8;
DI int lds_byte(int r, int c) { const int st = (r >> 4) * 2 + (c >> 5), rr = r & 15, cc = c & 31, ob = rr * 64 + cc * 2; return st * 1024 + (ob ^ (((ob >> 9) & 1) << 5)); }
DI void stage_rc(int b, int& R, int& C) { const int st = b / 1024, sb = b % 1024, swz = sb ^ (((sb >> 9) & 1) << 5); R = (st >> 1) * 16 + swz / 64; C = (st & 1) * 32 + (swz % 64) / 2; }
struct Unit { int pm, pn, aux; };
struct Gemm { const bf16* A; const bf16* Bt; int K; };
DI unsigned cvt_pk_bf16(float lo, float hi) { unsigned r; asm volatile("v_cvt_pk_bf16_f32 %0, %1, %2" : "=v"(r) : "v"(lo), "v"(hi)); return r; }

struct TileOrder {
    int nM, nN, nwg;
    DI void init(int nM_, int nN_) { nM = nM_; nN = nN_; nwg = nM * nN; }
    DI bool tile(long L, int& pm, int& pn) const {
        if (L >= nwg) return false;
        int wgid = (int)L; { const int q = nwg / NXCD, r = nwg % NXCD, xcd = wgid % NXCD, off = wgid / NXCD; wgid = (xcd < r ? xcd * (q + 1) : r * (q + 1) + (xcd - r) * q) + off; }
        const int nig = WGM * nN, gid = wgid / nig, fm = gid * WGM, gsz = (nM - fm) < WGM ? (nM - fm) : WGM;
        pm = fm + ((wgid % nig) % gsz); pn = (wgid % nig) / gsz; return true;
    }
};

template <class Epi, class Sched, bool ALIGN_EPI, bool SP2>
DI void gemm_phase(LAS unsigned char* lds, const Gemm g, const Sched& S, const Epi& E) {
    const int tid = threadIdx.x, wid = __builtin_amdgcn_readfirstlane(tid >> 6), lane = tid & 63, wr = wid >> 2, wc = wid & 3, fr = lane & 15, fq = lane >> 4;
    const int K = g.K, nt = K / BK;
    unsigned voffB[2]; int Rr[2]; unsigned cb[2];
#pragma unroll
    for (int i = 0; i < 2; ++i) { int R, C; stage_rc(tid * 16 + i * 8192, R, C); voffB[i] = (unsigned)(R * K + C) * 2u; Rr[i] = R; cb[i] = (unsigned)C * 2u; }
    const size_t kstep = (size_t)(BK * 2);
    const size_t hstep = (size_t)HALF * K * 2;
    const size_t tstep = 2 * hstep;
    const unsigned ldsw = (unsigned)wid * 1024u;
    const int aoff = lds_byte(wr * 64 + fr, fq * 8), boff = lds_byte(wc * 32 + fr, fq * 8);
    const unsigned rowb = (unsigned)K * 2u;
#define PG8_SA(b, h) (((b) * 2 + (h)) * HTB)
#define PG8_SB(b, h) ((4 + (b) * 2 + (h)) * HTB)
#define PG8_STAGE(bufoff, gbase, voff) do { _Pragma("unroll") for (int _i = 0; _i < 2; ++_i) \
        __builtin_amdgcn_global_load_lds((const unsigned*)((const char*)(gbase) + (voff)[_i]), (LAS unsigned*)(lds + (bufoff) + ldsw + _i * 8192), 16, 0, 0); } while (0)
#define PG8_LDA(dst, b, h) do { _Pragma("unroll") for (int m = 0; m < 4; ++m) _Pragma("unroll") for (int k = 0; k < 2; ++k) dst[m][k] = *(const LAS bf16x8*)(lds + PG8_SA(b, h) + aoff + m * 2048 + k * 1024); } while (0)
#define PG8_LDB(dst, b, h) do { _Pragma("unroll") for (int n = 0; n < 2; ++n) _Pragma("unroll") for (int k = 0; k < 2; ++k) dst[n][k] = *(const LAS bf16x8*)(lds + PG8_SB(b, h) + boff + n * 2048 + k * 1024); } while (0)
#define PG8_MMA(ai, bj, At, Bt) do { __builtin_amdgcn_s_setprio(1); _Pragma("unroll") for (int m = 0; m < 4; ++m) _Pragma("unroll") for (int n = 0; n < 2; ++n) _Pragma("unroll") for (int k = 0; k < 2; ++k) \
        acc[ai][bj][m][n] = __builtin_amdgcn_mfma_f32_16x16x32_bf16(Bt[n][k], At[m][k], acc[ai][bj][m][n], 0, 0, 0); __builtin_amdgcn_s_setprio(0); } while (0)
#define PG8_WAIT_V(n) asm volatile("s_waitcnt vmcnt(" #n ")" ::: "memory")
#define PG8_WAIT_L(n) asm volatile("s_waitcnt lgkmcnt(" #n ")" ::: "memory")
#define PG8_BAR __builtin_amdgcn_s_barrier()
#define PG8_SCHED __builtin_amdgcn_sched_barrier(0)
    Unit cur, nxt; int ui = 0;
    if (!S.next(0, cur)) return;
    f32x4 acc[2][2][4][2];
#pragma unroll
    for (int a = 0; a < 2; ++a)
#pragma unroll
        for (int b = 0; b < 2; ++b)
#pragma unroll
            for (int m = 0; m < 4; ++m)
#pragma unroll
                for (int n = 0; n < 2; ++n) acc[a][b][m][n] = (f32x4){0.f, 0.f, 0.f, 0.f};
    bf16x8 At[4][2], B0[2][2], B1[2][2];
    const char* Ab = (const char*)g.A;
    const char* cB = (const char*)g.Bt + (size_t)cur.pn * tstep;
    unsigned c0[2], c1[2], n0[2], n1[2];
#pragma unroll
    for (int i = 0; i < 2; ++i) { c0[i] = (unsigned)S.arow(cur, Rr[i]) * rowb + cb[i]; c1[i] = (unsigned)S.arow(cur, HALF + Rr[i]) * rowb + cb[i]; n0[i] = c0[i]; n1[i] = c1[i]; }
    if constexpr (SP2) {
        PG8_STAGE(PG8_SB(0, 0), cB, voffB); PG8_STAGE(PG8_SB(0, 1), cB + hstep, voffB); PG8_STAGE(PG8_SA(0, 0), Ab, c0); PG8_STAGE(PG8_SA(0, 1), Ab, c1);
        if (wr == 1) PG8_BAR;
        PG8_WAIT_V(2); PG8_BAR;
        PG8_STAGE(PG8_SB(1, 0), cB + kstep, voffB); PG8_STAGE(PG8_SA(1, 0), Ab + kstep, c0); PG8_STAGE(PG8_SB(1, 1), cB + hstep + kstep, voffB);
        PG8_WAIT_V(6); PG8_BAR;
    } else {
        PG8_STAGE(PG8_SB(0, 0), cB, voffB); PG8_STAGE(PG8_SA(0, 0), Ab, c0); PG8_STAGE(PG8_SB(0, 1), cB + hstep, voffB); PG8_STAGE(PG8_SA(0, 1), Ab, c1);
        if (wr == 1) PG8_BAR;
        PG8_WAIT_V(4); PG8_BAR;
        PG8_STAGE(PG8_SB(1, 0), cB + kstep, voffB); PG8_STAGE(PG8_SA(1, 0), Ab + kstep, c0); PG8_STAGE(PG8_SB(1, 1), cB + hstep + kstep, voffB);
        PG8_WAIT_V(6); PG8_BAR;
    }
    for (;;) {
        const bool has_next = S.next(ui + 1, nxt);
        const char* nB = has_next ? (const char*)g.Bt + (size_t)nxt.pn * tstep : cB;
        if (has_next) {
#pragma unroll
            for (int i = 0; i < 2; ++i) { n0[i] = (unsigned)S.arow(nxt, Rr[i]) * rowb + cb[i]; n1[i] = (unsigned)S.arow(nxt, HALF + Rr[i]) * rowb + cb[i]; }
        } else {
#pragma unroll
            for (int i = 0; i < 2; ++i) { n0[i] = c0[i]; n1[i] = c1[i]; }
        }
        for (int t = 0; t < nt; t += 2) {
            const bool last = (t == nt - 2);
            const char* a1 = Ab + (size_t)(t + 1) * kstep;
            const char* a2 = last ? Ab : Ab + (size_t)(t + 2) * kstep; const char* b2 = last ? nB : cB + (size_t)(t + 2) * kstep;
            const char* a3 = a2 + kstep; const char* b3 = b2 + kstep;
            unsigned x0[2], x1[2];
#pragma unroll
            for (int i = 0; i < 2; ++i) { x0[i] = last ? n0[i] : c0[i]; x1[i] = last ? n1[i] : c1[i]; }
            if constexpr (SP2) {
            PG8_LDB(B0, 0, 0); PG8_LDB(B1, 0, 1); PG8_SCHED; PG8_LDA(At, 0, 0); PG8_STAGE(PG8_SA(1, 1), a1, c1);
            PG8_WAIT_V(8); PG8_WAIT_L(0); PG8_BAR; PG8_MMA(0, 0, At, B0); PG8_MMA(0, 1, At, B1); PG8_BAR; PG8_SCHED;
            PG8_LDA(At, 0, 1); PG8_STAGE(PG8_SB(0, 0), b2, voffB); PG8_STAGE(PG8_SB(0, 1), b2 + hstep, voffB); PG8_STAGE(PG8_SA(0, 0), a2, x0);
            PG8_WAIT_V(8); PG8_WAIT_L(0); PG8_BAR; PG8_MMA(1, 0, At, B0); PG8_MMA(1, 1, At, B1); PG8_BAR; PG8_SCHED;
            PG8_LDB(B0, 1, 0); PG8_LDB(B1, 1, 1); PG8_SCHED; PG8_LDA(At, 1, 0); PG8_STAGE(PG8_SA(0, 1), a2, x1);
            PG8_WAIT_V(8); PG8_WAIT_L(0); PG8_BAR; PG8_MMA(0, 0, At, B0); PG8_MMA(0, 1, At, B1); PG8_BAR; PG8_SCHED;
            PG8_LDA(At, 1, 1); PG8_STAGE(PG8_SB(1, 0), b3, voffB); PG8_STAGE(PG8_SB(1, 1), b3 + hstep, voffB); PG8_STAGE(PG8_SA(1, 0), a3, x0);
            PG8_WAIT_V(8); PG8_WAIT_L(0); PG8_BAR; PG8_MMA(1, 0, At, B0); PG8_MMA(1, 1, At, B1); PG8_BAR; PG8_SCHED;
            } else {
            PG8_LDB(B0, 0, 0); PG8_SCHED; PG8_LDA(At, 0, 0); PG8_STAGE(PG8_SA(1, 1), a1, c1);
            PG8_WAIT_L(8); PG8_BAR; PG8_WAIT_L(0); PG8_MMA(0, 0, At, B0); PG8_BAR; PG8_SCHED;
            PG8_LDB(B1, 0, 1); PG8_STAGE(PG8_SB(0, 0), b2, voffB);
            PG8_BAR; PG8_WAIT_L(0); PG8_MMA(0, 1, At, B1); PG8_BAR;
            PG8_LDA(At, 0, 1); PG8_STAGE(PG8_SA(0, 0), a2, x0);
            PG8_BAR; PG8_WAIT_L(0); PG8_MMA(1, 0, At, B0); PG8_BAR; PG8_SCHED;
            PG8_STAGE(PG8_SB(0, 1), b2 + hstep, voffB);
            PG8_WAIT_V(6); PG8_BAR; PG8_MMA(1, 1, At, B1); PG8_BAR;
            PG8_LDB(B0, 1, 0); PG8_SCHED; PG8_LDA(At, 1, 0); PG8_STAGE(PG8_SA(0, 1), a2, x1);
            PG8_WAIT_L(8); PG8_BAR; PG8_WAIT_L(0); PG8_MMA(0, 0, At, B0); PG8_BAR; PG8_SCHED;
            PG8_LDB(B1, 1, 1); PG8_STAGE(PG8_SB(1, 0), b3, voffB);
            PG8_BAR; PG8_WAIT_L(0); PG8_MMA(0, 1, At, B1); PG8_BAR;
            PG8_LDA(At, 1, 1); PG8_STAGE(PG8_SA(1, 0), a3, x0);
            PG8_BAR; PG8_WAIT_L(0); PG8_MMA(1, 0, At, B0); PG8_BAR; PG8_SCHED;
            PG8_STAGE(PG8_SB(1, 1), b3 + hstep, voffB);
            PG8_WAIT_V(6); PG8_BAR; PG8_MMA(1, 1, At, B1); PG8_BAR;
            }
        }
        if constexpr (ALIGN_EPI) { if (wr == 0) PG8_BAR; }
        const bool keep = E(acc, cur, wr, wc, fr, fq);
        if (!has_next) break;
        if (!keep) {
#pragma unroll
            for (int a = 0; a < 2; ++a)
#pragma unroll
                for (int b = 0; b < 2; ++b)
#pragma unroll
                    for (int m = 0; m < 4; ++m)
#pragma unroll
                        for (int n = 0; n < 2; ++n) acc[a][b][m][n] = (f32x4){0.f, 0.f, 0.f, 0.f};
        }
        cur = nxt; cB = nB; ++ui;
#pragma unroll
        for (int i = 0; i < 2; ++i) { c0[i] = n0[i]; c1[i] = n1[i]; }
        if constexpr (ALIGN_EPI) { if (wr == 1) PG8_BAR; }
    }
    PG8_WAIT_V(0);
    if constexpr (!ALIGN_EPI) { if (wr == 0) PG8_BAR; }
    PG8_BAR;
#undef PG8_SA
#undef PG8_SB
#undef PG8_STAGE
#undef PG8_LDA
#undef PG8_LDB
#undef PG8_MMA
#undef PG8_WAIT_V
#undef PG8_WAIT_L
#undef PG8_BAR
#undef PG8_SCHED
}
}

DI int pos_bf8(int o) { const int o32 = o & 31; return (o & ~31) | (16 * ((o32 >> 2) & 1) + 4 * (o32 >> 3) + (o32 & 3)); }
DI int pos_rope(int o) { const int head = o >> 7, bj = (o >> 6) & 1, r = o & 63, w = r >> 5, fq = (r >> 3) & 3, n = (r >> 2) & 1, j = r & 3; return 128 * bj + 32 * (2 * head + w) + 16 * n + 4 * fq + j; }
DI int pos_swiglu(int o) { const int wc = o >> 6, fq = (o >> 4) & 3, bj = (o >> 3) & 1, n = (o >> 2) & 1, j = o & 3; return 128 * bj + 32 * wc + 16 * n + 4 * fq + j; }
template <int PT  >
DI void tr_item(const float* src, int ldw, int K, bf16* WT, int tile_row0, int o0  , int k0, LAS float* scr, int lane) {
    float v[32];
#pragma unroll
    for (int i = 0; i < 32; ++i) { const int kk = 2 * i + (lane >> 5); v[i] = src[(size_t)kk * ldw + (lane & 31)]; }
#pragma unroll
    for (int i = 0; i < 32; ++i) { const int kk = 2 * i + (lane >> 5); scr[kk * 33 + (lane & 31)] = v[i]; }
    asm volatile("s_waitcnt lgkmcnt(0)" ::: "memory");
    const int c = lane & 7;
#pragma unroll
    for (int j = 0; j < 4; ++j) { const int n = (lane >> 3) + 8 * j; const LAS float* s = scr + (8 * c) * 33 + n;
        u32x4 o; o.x = pk2(s[0 * 33], s[1 * 33]); o.y = pk2(s[2 * 33], s[3 * 33]); o.z = pk2(s[4 * 33], s[5 * 33]); o.w = pk2(s[6 * 33], s[7 * 33]);
        const int oc = o0 + n; const int p = PT == 0 ? oc : PT == 1 ? pos_bf8(oc) : PT == 2 ? pos_rope(oc) : pos_swiglu(oc);
        *(u32x4*)(WT + (size_t)(tile_row0 + p) * K + k0 + 8 * c) = o; }
    asm volatile("s_waitcnt lgkmcnt(0)" ::: "memory");
}
DI void convert_weights(Ctx& C) {
    LAS float* scr = (LAS float*)(C.lds + C.wave * 16384);
    const int gw = C.bid * NWAVES + C.wave, NGW = C.G * NWAVES, lane = C.lane;
    bf16* WT_IN = (bf16*)(C.ws + WS_WT_IN); bf16* WT_BR = (bf16*)(C.ws + WS_WT_BR); bf16* WT_OUT = (bf16*)(C.ws + WS_WT_OUT); bf16* WT_GU = (bf16*)(C.ws + WS_WT_GU); bf16* WT_DN = (bf16*)(C.ws + WS_WT_DN);
    constexpr int I_IN = 16 * 256, I_SQ = 16 * 32, I_GU = 32 * 16 * 64, I_DN = 32 * 16 * 32;
    constexpr int NITEMS = I_IN + 3 * I_SQ + I_GU + I_DN;
    for (int it = gw; it < NITEMS; it += NGW) {
        int r = it;
        if (r < I_IN) { const int kb = r >> 8, nb = r & 255, n0 = nb * 32, sc = n0 < 3072 ? n0 : n0 + 8, tile = n0 >> 8;
            const float* src = C.w_in + (size_t)(kb * 64) * DIN + sc;
            if (tile >= 12 && tile < 16) tr_item<2>(src, DIN, D, WT_IN, tile * 256, n0 & 255, kb * 64, scr, lane); else tr_item<1>(src, DIN, D, WT_IN, tile * 256, n0 & 255, kb * 64, scr, lane);
            continue; } r -= I_IN;
        if (r < 2 * I_SQ) { const int which = r >> 9, q = r & 511, kb = q >> 5, nb = q & 31, n0 = nb * 32;
            const float* src = (which ? C.w_bret : C.w_bml) + (size_t)(kb * 64) * D + n0;
            tr_item<1>(src, D, D, WT_BR, which * 1024 + (n0 & ~255), n0 & 255, kb * 64, scr, lane); continue; } r -= 2 * I_SQ;
        if (r < I_SQ) { const int kb = r >> 5, nb = r & 31, n0 = nb * 32;
            tr_item<0>(C.w_out + (size_t)(kb * 64) * D + n0, D, D, WT_OUT, n0 & ~255, n0 & 255, kb * 64, scr, lane); continue; } r -= I_SQ;
        if (r < I_GU) { const int e = r >> 10, q = r & 1023, kb = q >> 6, nb = q & 63, n0 = nb * 32;
            tr_item<3>(C.w_gu + (size_t)e * D * 2048 + (size_t)(kb * 64) * 2048 + n0, 2048, D, WT_GU, e * 2048 + (n0 & ~255), n0 & 255, kb * 64, scr, lane); continue; } r -= I_GU;
        { const int e = r >> 9, q = r & 511, kb = q >> 5, nb = q & 31, n0 = nb * 32;
            tr_item<1>(C.w_dn + (size_t)e * D * D + (size_t)(kb * 64) * D + n0, D, D, WT_DN, e * 1024 + (n0 & ~255), n0 & 255, kb * 64, scr, lane); }
    }
}

struct SchedDense { pg8::TileOrder o; int G, c;
    DI bool next(int i, pg8::Unit& u) const { int pm, pn; if (!o.tile((long)i * G + c, pm, pn)) return false; u.pm = pm; u.pn = pn; u.aux = 0; return true; }
    DI int arow(const pg8::Unit& u, int r) const { return u.pm * 256 + r; } };
DI u32x4 pack8v(const f32x4 a, const f32x4 b) { u32x4 w; w.x = pg8::cvt_pk_bf16(a.x, a.y); w.y = pg8::cvt_pk_bf16(a.z, a.w); w.z = pg8::cvt_pk_bf16(b.x, b.y); w.w = pg8::cvt_pk_bf16(b.z, b.w); return w; }
DI f32x4 sig4(const f32x4 v) { return (f32x4){sigmoidf_(v.x), sigmoidf_(v.y), sigmoidf_(v.z), sigmoidf_(v.w)}; }
DI f32x4 silu4(const f32x4 v) { return (f32x4){siluf_(v.x), siluf_(v.y), siluf_(v.z), siluf_(v.w)}; }
DI void unpack8v(const u32x4 w, f32x4& a, f32x4& b) { a = (f32x4){__uint_as_float(w.x << 16), __uint_as_float(w.x & 0xffff0000u), __uint_as_float(w.y << 16), __uint_as_float(w.y & 0xffff0000u)};
    b = (f32x4){__uint_as_float(w.z << 16), __uint_as_float(w.z & 0xffff0000u), __uint_as_float(w.w << 16), __uint_as_float(w.w & 0xffff0000u)}; }

struct EpiInproj { unsigned char* ws;
    DI bool operator()(f32x4 (&acc)[2][2][4][2], const pg8::Unit& u, int wr, int wc, int fr, int fq) const {
        const int seg = u.pn >> 2, row0 = u.pm * 256 + wr * 64 + fr;
        if (seg == 3) {
            const int which = (u.pn >> 1) & 1, head = 2 * (u.pn & 1) + (wc >> 1), i0 = 32 * (wc & 1) + 8 * fq;
            bf16* dst = (bf16*)(ws + (which ? WS_RETK : WS_RETQ)); const float sc = which ? 0.08838834764831845f : 1.0f;
            const float* COS = (const float*)(ws + WS_COS); const float* SIN = (const float*)(ws + WS_SIN);
#pragma unroll
            for (int ai = 0; ai < 2; ++ai)
#pragma unroll
                for (int m = 0; m < 4; ++m) { const int row = row0 + ai * 128 + m * 16;
                    const f32x4 c0 = *(const f32x4*)(COS + (size_t)row * 64 + i0) * sc, c1 = *(const f32x4*)(COS + (size_t)row * 64 + i0 + 4) * sc;
                    const f32x4 s0 = *(const f32x4*)(SIN + (size_t)row * 64 + i0) * sc, s1 = *(const f32x4*)(SIN + (size_t)row * 64 + i0 + 4) * sc;
                    const f32x4 x1a = acc[ai][0][m][0], x1b = acc[ai][0][m][1], x2a = acc[ai][1][m][0], x2b = acc[ai][1][m][1];
                    bf16* rp = dst + (size_t)row * 512 + head * 128 + i0;
                    *(u32x4*)rp = pack8v(x1a * c0 - x2a * s0, x1b * c1 - x2b * s1);
                    *(u32x4*)(rp + 64) = pack8v(x2a * c0 + x1a * s0, x2b * c1 + x1b * s1);
                    asm volatile("" ::: "memory"); }
            return false;
        }
        bf16* dst; int act = 0;
        switch (seg) { case 0: dst = (bf16*)(ws + WS_QKRAW); break; case 1: dst = (bf16*)(ws + WS_MLV); break; case 2: dst = (bf16*)(ws + WS_MLO); act = 1; break;
            case 4: dst = (bf16*)(ws + WS_RETV); break; case 5: dst = (bf16*)(ws + WS_RETG); act = 2; break; case 6: dst = (bf16*)(ws + WS_GML); act = 1; break; default: dst = (bf16*)(ws + WS_GRET); act = 1; break; }
        const int col0 = (u.pn & 3) * 256 + wc * 32 + 8 * fq;
#pragma unroll
        for (int ai = 0; ai < 2; ++ai)
#pragma unroll
            for (int m = 0; m < 4; ++m) { bf16* rp = dst + (size_t)(row0 + ai * 128 + m * 16) * D + col0;
#pragma unroll
                for (int bj = 0; bj < 2; ++bj) { f32x4 v0 = acc[ai][bj][m][0], v1 = acc[ai][bj][m][1];
                    if (act == 1) { v0 = sig4(v0); v1 = sig4(v1); } else if (act == 2) { v0 = silu4(v0); v1 = silu4(v1); }
                    *(u32x4*)(rp + bj * 128) = pack8v(v0, v1); } }
        return false;
    } };
DI void phase_inproj_mfma(Ctx& C) {
    pg8::Gemm g{(const bf16*)(C.ws + WS_H1), (const bf16*)(C.ws + WS_WT_IN), D};
    SchedDense S; S.o.init(T / 256, 32); S.G = C.G; S.c = C.bid;
    EpiInproj E{C.ws};
    pg8::gemm_phase<EpiInproj, SchedDense, true, true>(C.lds, g, S, E);
}

struct SchedBranch { pg8::TileOrder o; int G, c;
    DI bool next(int i, pg8::Unit& u) const { int pm, pn; if (!o.tile((long)(i >> 1) * G + c, pm, pn)) return false; const int seg = i & 1; u.pm = seg * 64 + pm; u.pn = seg * 4 + pn; u.aux = seg; return true; }
    DI int arow(const pg8::Unit& u, int r) const { return u.pm * 256 + r; } };
struct EpiBranch { const bf16* g1; const bf16* g2; bf16* y;
    DI bool operator()(f32x4 (&acc)[2][2][4][2], const pg8::Unit& u, int wr, int wc, int fr, int fq) const {
        const int seg = u.aux, row0 = (u.pm & 63) * 256 + wr * 64 + fr, col0 = (u.pn & 3) * 256 + wc * 32 + 8 * fq;
#pragma unroll
        for (int ai = 0; ai < 2; ++ai)
#pragma unroll
            for (int m = 0; m < 4; ++m) { const size_t o = (size_t)(row0 + ai * 128 + m * 16) * D + col0;
#pragma unroll
                for (int bj = 0; bj < 2; ++bj) {
                    f32x4 b0, b1; unpack8v(*(const u32x4*)(g2 + o + bj * 128), b0, b1);
                    if (seg == 0) { f32x4 a0, a1; unpack8v(*(const u32x4*)(g1 + o + bj * 128), a0, a1);
#pragma unroll
                        for (int j = 0; j < 4; ++j) { acc[ai][bj][m][0][j] *= a0[j] / fmaxf(b0[j], 1e-12f); acc[ai][bj][m][1][j] *= a1[j] / fmaxf(b1[j], 1e-12f); }
                    } else *(u32x4*)(y + o + bj * 128) = pack8v(acc[ai][bj][m][0] * b0, acc[ai][bj][m][1] * b1);
                }
                asm volatile("" ::: "memory"); }
        return seg == 0;
    } };
DI void phase_branch_mfma(Ctx& C) {
    pg8::Gemm g{(const bf16*)(C.ws + WS_HML), (const bf16*)(C.ws + WS_WT_BR), D};
    SchedBranch S; S.o.init(T / 256, 4); S.G = C.G; S.c = C.bid;
    EpiBranch E{(const bf16*)(C.ws + WS_GML), (const bf16*)(C.ws + WS_GRET), (bf16*)(C.ws + WS_H1)};
    pg8::gemm_phase<EpiBranch, SchedBranch, true, true>(C.lds, g, S, E);
}
struct EpiOut { const float* x; const float* mod; float* x1;
    DI bool operator()(f32x4 (&acc)[2][2][4][2], const pg8::Unit& u, int wr, int wc, int fr, int fq) const {
        const int row0 = u.pm * 256 + wr * 64 + fr, col0 = u.pn * 256 + wc * 32 + 4 * fq; const int b = (u.pm * 256) / SEQ;
        f32x4 gv[2][2];
#pragma unroll
        for (int bj = 0; bj < 2; ++bj)
#pragma unroll
            for (int n = 0; n < 2; ++n) gv[bj][n] = *(const f32x4*)(mod + b * 6144 + 2048 + col0 + bj * 128 + n * 16);
#pragma unroll
        for (int ai = 0; ai < 2; ++ai)
#pragma unroll
            for (int m = 0; m < 4; ++m) { const size_t o = (size_t)(row0 + ai * 128 + m * 16) * D + col0;
#pragma unroll
                for (int bj = 0; bj < 2; ++bj)
#pragma unroll
                    for (int n = 0; n < 2; ++n) *(f32x4*)(x1 + o + bj * 128 + n * 16) = *(const f32x4*)(x + o + bj * 128 + n * 16) + gv[bj][n] * acc[ai][bj][m][n];
                asm volatile("" ::: "memory"); }
        return false;
    } };
DI void phase_outproj_mfma(Ctx& C) {
    pg8::Gemm g{(const bf16*)(C.ws + WS_H1), (const bf16*)(C.ws + WS_WT_OUT), D};
    SchedDense S; S.o.init(T / 256, 4); S.G = C.G; S.c = C.bid;
    EpiOut E{C.x, (const float*)(C.ws + WS_MOD), (float*)(C.ws + WS_X1)};
    pg8::gemm_phase<EpiOut, SchedDense, false, true>(C.lds, g, S, E);
}
struct SchedMoe { const unsigned* blke; const int* slottok; int nunits, ntn, G, c;
    DI bool next(int i, pg8::Unit& u) const { const long L = (long)i * G + c; if (L >= nunits) return false; const int bi = (int)(L / ntn), pn = (int)(L % ntn);
        const int e = (int)__builtin_amdgcn_readfirstlane((int)blke[bi]); u.pm = bi; u.pn = e * ntn + pn; u.aux = e | (pn << 8); return true; }
    DI int arow(const pg8::Unit& u, int r) const { return slottok ? slottok[u.pm * 256 + r] : u.pm * 256 + r; } };
struct EpiSwiglu { const float* bias; bf16* act;
    DI bool operator()(f32x4 (&acc)[2][2][4][2], const pg8::Unit& u, int wr, int wc, int fr, int fq) const {
        const int e = u.aux & 255, pn = u.aux >> 8, slot0 = u.pm * 256 + wr * 64 + fr;
        const float* bp = bias + (size_t)e * 2048 + pn * 256 + 64 * wc + 16 * fq;
        f32x4 bv[2][2];
#pragma unroll
        for (int bj = 0; bj < 2; ++bj)
#pragma unroll
            for (int n = 0; n < 2; ++n) bv[bj][n] = *(const f32x4*)(bp + 8 * bj + 4 * n);
#pragma unroll
        for (int ai = 0; ai < 2; ++ai)
#pragma unroll
            for (int m = 0; m < 4; ++m) { float o[8];
#pragma unroll
                for (int bj = 0; bj < 2; ++bj)
#pragma unroll
                    for (int n = 0; n < 2; ++n) { const f32x4 v = acc[ai][bj][m][n] + bv[bj][n];
#pragma unroll
                        for (int p = 0; p < 2; ++p) { const float xg = fminf(v[2 * p], 7.0f), xl = fminf(fmaxf(v[2 * p + 1], -7.0f), 7.0f); o[4 * bj + 2 * n + p] = xg * sigmoidf_(1.702f * xg) * (xl + 1.0f); } }
                u32x4 w; w.x = pg8::cvt_pk_bf16(o[0], o[1]); w.y = pg8::cvt_pk_bf16(o[2], o[3]); w.z = pg8::cvt_pk_bf16(o[4], o[5]); w.w = pg8::cvt_pk_bf16(o[6], o[7]);
                *(u32x4*)(act + (size_t)(slot0 + ai * 128 + m * 16) * D + pn * 128 + 32 * wc + 8 * fq) = w; }
        return false;
    } };
struct EpiDown { const float* bias; const float* slotw; bf16* ys;
    DI bool operator()(f32x4 (&acc)[2][2][4][2], const pg8::Unit& u, int wr, int wc, int fr, int fq) const {
        const int e = u.aux & 255, pn = u.aux >> 8, slot0 = u.pm * 256 + wr * 64 + fr, col0 = pn * 256 + wc * 32 + 8 * fq;
        f32x4 bv[2][2];
#pragma unroll
        for (int bj = 0; bj < 2; ++bj)
#pragma unroll
            for (int n = 0; n < 2; ++n) bv[bj][n] = *(const f32x4*)(bias + (size_t)e * D + col0 + bj * 128 + 4 * n);
#pragma unroll
        for (int ai = 0; ai < 2; ++ai)
#pragma unroll
            for (int m = 0; m < 4; ++m) { const int slot = slot0 + ai * 128 + m * 16; const float w = slotw[slot];
#pragma unroll
                for (int bj = 0; bj < 2; ++bj) *(u32x4*)(ys + (size_t)slot * D + col0 + bj * 128) = pack8v((acc[ai][bj][m][0] + bv[bj][0]) * w, (acc[ai][bj][m][1] + bv[bj][1]) * w); }
        return false;
    } };
DI void phase_gateup_mfma(Ctx& C) {
    unsigned* ctl = (unsigned*)(C.ws + WS_CTL); const int nblk = (int)__builtin_amdgcn_readfirstlane((int)__hip_atomic_load(ctl + CW_NBLK, __ATOMIC_RELAXED, __HIP_MEMORY_SCOPE_AGENT));
    pg8::Gemm g{(const bf16*)(C.ws + WS_H1), (const bf16*)(C.ws + WS_WT_GU), D};
    SchedMoe S{ctl + CW_BLKE, (const int*)(C.ws + WS_ROUTE + RT_SLOTTOK), nblk * 8, 8, C.G, C.bid};
    EpiSwiglu E{C.b_gu, (bf16*)(C.ws + WS_ACT)};
    pg8::gemm_phase<EpiSwiglu, SchedMoe, true, true>(C.lds, g, S, E);
}
DI void phase_down_mfma(Ctx& C) {
    unsigned* ctl = (unsigned*)(C.ws + WS_CTL); const int nblk = (int)__builtin_amdgcn_readfirstlane((int)__hip_atomic_load(ctl + CW_NBLK, __ATOMIC_RELAXED, __HIP_MEMORY_SCOPE_AGENT));
    pg8::Gemm g{(const bf16*)(C.ws + WS_ACT), (const bf16*)(C.ws + WS_WT_DN), D};
    SchedMoe S{ctl + CW_BLKE, nullptr, nblk * 4, 4, C.G, C.bid};
    EpiDown E{C.b_dn, (const float*)(C.ws + WS_ROUTE + RT_SLOTW), (bf16*)(C.ws + WS_YS)};
    pg8::gemm_phase<EpiDown, SchedMoe, true, true>(C.lds, g, S, E);
}

typedef short s16x4 __attribute__((ext_vector_type(4)));
typedef short bf16x8 __attribute__((ext_vector_type(8)));
DI unsigned off_b(unsigned row, unsigned ch) { return 256u * row + 16u * (ch ^ (((row & 3u) << 2) | ((row >> 2) & 3u))); }
DI s16x4 tr_read(LAS unsigned char* p) { return __builtin_amdgcn_ds_read_tr16_b64_v4i16((LAS s16x4*)p); }
DI bf16x8 cat8(const s16x4 lo, const s16x4 hi) { return __builtin_shufflevector(lo, hi, 0, 1, 2, 3, 4, 5, 6, 7); }
DI bf16x8 row_read(LAS unsigned char* img, unsigned row, unsigned ch) { return *(const LAS bf16x8*)(img + off_b(row, ch)); }
#define MFMA16(a, b, c) __builtin_amdgcn_mfma_f32_16x16x32_bf16((a), (b), (c), 0, 0, 0)
DI void fill_image(LAS unsigned char* img, const bf16* src, int ld, int nrows, int tid) {
    for (int e = tid; e < nrows * 16; e += NTHR) { const int row = e >> 4, ch = e & 15; *(LAS u32x4*)(img + off_b(row, ch)) = *(const u32x4*)(src + (size_t)row * ld + ch * 8); }
}

DI void phase_local_mfma(Ctx& C) {
    LAS unsigned char* Kimg = C.lds; LAS unsigned char* Vimg = C.lds + 32768;
    LAS float* lf = (LAS float*)(C.lds + 98304); LAS float* bvl = lf + 128; LAS float* wsv = bvl + 128; LAS float* nl = wsv + 128;
    const float* IFG = (const float*)(C.ws + WS_IFG);
    bf16* CLOC = (bf16*)(C.ws + WS_CLOC);
    float* NLOC = (float*)(C.ws + WS_SMALL + SM_NLOC); float* MLOC = (float*)(C.ws + WS_SMALL + SM_MLOC); float* ACH = (float*)(C.ws + WS_SMALL + SM_ACH);
    float* AG = (float*)(C.ws + WS_SMALL + SM_AG); float* CMG = (float*)(C.ws + WS_SMALL + SM_CMG);
    const int t = C.tid, lane = C.lane, w = C.wave, g = lane >> 4, q = (lane & 15) >> 2, p = lane & 3;
    for (int u = C.bid; u < 1024; u += C.G) {
        const int mixer = u >> 9, bh = (u >> 5) & 15, ch = u & 31, b = bh >> 2, h = bh & 3, t0 = b * SEQ + ch * CH;
        const bf16 *Kp, *Vp; int ldk;
        if (mixer == 0) {
            float iv = 0.f;
            if (t < 128) { lf[t] = logsigmoidf_(IFG[(size_t)(t0 + t) * 8 + 4 + h]); iv = IFG[(size_t)(t0 + t) * 8 + h]; nl[t] = 0.f; }
            __syncthreads();
            if (t < 128) { float s = 0.f; for (int j = 0; j <= t; ++j) s += lf[j]; bvl[t] = iv - s; AG[bh * SEQ + ch * CH + t] = s; if (t == 127) wsv[0] = s; }
            __syncthreads();
            float gm = -3.0e38f, cm = -3.0e38f; const float Aall = wsv[0];
            if (t < 128) { for (int j = 0; j < 128; ++j) { const float x = bvl[j]; gm = fmaxf(gm, x); cm = (j <= t) ? fmaxf(cm, x) : cm; } CMG[bh * SEQ + ch * CH + t] = cm; }
            __syncthreads();
            if (t < 128) wsv[t] = __expf(bvl[t] - gm);
            if (t == 0) { MLOC[bh * 32 + ch] = Aall + gm; ACH[bh * 32 + ch] = Aall; }
            Kp = (const bf16*)(C.ws + WS_QC) + (size_t)t0 * D + 512 + h * 128; ldk = D;
            Vp = (const bf16*)(C.ws + WS_MLV) + (size_t)t0 * D + h * 256;
        } else {
            const float lg = ret_lg(h);
            if (t < 128) wsv[t] = __expf(lg * (float)(127 - t));
            Kp = (const bf16*)(C.ws + WS_RETK) + (size_t)t0 * 512 + h * 128; ldk = 512;
            Vp = (const bf16*)(C.ws + WS_RETV) + (size_t)t0 * D + h * 256;
        }
        __syncthreads();
        {
            float ns[8];
#pragma unroll
            for (int e = 0; e < 8; ++e) ns[e] = 0.f;
            const int chk = t & 15;
#pragma unroll
            for (int i = 0; i < 4; ++i) { const int row = (t >> 4) + 32 * i; float f[8]; unpack8(*(const u32x4*)(Kp + (size_t)row * ldk + chk * 8), f); const float wv = wsv[row];
#pragma unroll
                for (int e = 0; e < 8; ++e) { f[e] *= wv; ns[e] += f[e]; }
                *(LAS u32x4*)(Kimg + off_b(row, chk)) = pack8(f); }
            if (mixer == 0) {
#pragma unroll
                for (int e = 0; e < 8; ++e) atomicAdd((float*)(nl + chk * 8 + e), ns[e]);
            }
        }
        fill_image(Vimg, Vp, D, 128, t); fill_image(Vimg + 32768, Vp + 128, D, 128, t);
        __syncthreads();
        const int kh = w & 1, vq = w >> 1;
        f32x4 acc[2][2][4];
#pragma unroll
        for (int a = 0; a < 2; ++a)
#pragma unroll
            for (int x = 0; x < 2; ++x)
#pragma unroll
                for (int c = 0; c < 4; ++c) acc[a][x][c] = (f32x4){0.f, 0.f, 0.f, 0.f};
        unsigned ba[2][2], bb[4][2];
#pragma unroll
        for (int ul = 0; ul < 2; ++ul)
#pragma unroll
            for (int tt = 0; tt < 2; ++tt) ba[ul][tt] = off_b(8 * g + q + 4 * tt, 4 * (2 * kh + ul) + p);
#pragma unroll
        for (int cl = 0; cl < 4; ++cl)
#pragma unroll
            for (int tt = 0; tt < 2; ++tt) { const int c = 4 * vq + cl; bb[cl][tt] = 32768 + (c >> 3) * 32768 + off_b(8 * g + q + 4 * tt, 2 * (c & 7) + (p >> 1)) + 8 * (p & 1); }
#pragma unroll
        for (int ks = 0; ks < 4; ++ks) {
            bf16x8 af[2][2], bfr[4];
#pragma unroll
            for (int ul = 0; ul < 2; ++ul)
#pragma unroll
                for (int x = 0; x < 2; ++x) af[ul][x] = cat8(tr_read(C.lds + ba[ul][0] + (8192 * ks + 8 * x)), tr_read(C.lds + ba[ul][1] + (8192 * ks + 8 * x)));
#pragma unroll
            for (int cl = 0; cl < 4; ++cl) bfr[cl] = cat8(tr_read(C.lds + bb[cl][0] + 8192 * ks), tr_read(C.lds + bb[cl][1] + 8192 * ks));
#pragma unroll
            for (int ul = 0; ul < 2; ++ul)
#pragma unroll
                for (int x = 0; x < 2; ++x)
#pragma unroll
                    for (int cl = 0; cl < 4; ++cl) acc[ul][x][cl] = MFMA16(af[ul][x], bfr[cl], acc[ul][x][cl]);
            asm volatile("" ::: "memory");
        }
        bf16* cl_ = CLOC + ((size_t)(mixer * 16 + bh) * 32 + ch) * 32768;
#pragma unroll
        for (int ul = 0; ul < 2; ++ul)
#pragma unroll
            for (int cl = 0; cl < 4; ++cl) { const int v = 16 * (4 * vq + cl) + (lane & 15), k0 = 32 * (2 * kh + ul) + 8 * g;
                u32x4 o; o.x = pk2(acc[ul][0][cl][0], acc[ul][0][cl][1]); o.y = pk2(acc[ul][0][cl][2], acc[ul][0][cl][3]); o.z = pk2(acc[ul][1][cl][0], acc[ul][1][cl][1]); o.w = pk2(acc[ul][1][cl][2], acc[ul][1][cl][3]);
                *(u32x4*)(cl_ + (size_t)v * 128 + k0) = o; }
        if (mixer == 0 && t < 128) NLOC[(bh * 32 + ch) * 128 + t] = nl[t];
        __syncthreads();
    }
}

DI void phase_out_mfma(Ctx& C) {
    LAS unsigned char* Qimg = C.lds; LAS unsigned char* Kimg = C.lds + 32768; LAS unsigned char* R1 = C.lds + 65536;
    LAS float* ea = (LAS float*)(C.lds + 131072); LAS float* bs = ea + 128; LAS float* isc = bs + 128; LAS float* edn = isc + 128; LAS float* npv = edn + 128;
    const float* IFG = (const float*)(C.ws + WS_IFG);
    const bf16* CPREV = (const bf16*)(C.ws + WS_CPREV);
    const float* NPREV = (const float*)(C.ws + WS_SMALL + SM_NPREV); const float* MPREV = (const float*)(C.ws + WS_SMALL + SM_MPREV);
    const float* AG = (const float*)(C.ws + WS_SMALL + SM_AG); const float* CMG = (const float*)(C.ws + WS_SMALL + SM_CMG);
    const int t = C.tid, lane = C.lane, w = C.wave, g = lane >> 4, q = (lane & 15) >> 2, p = lane & 3, jl = lane & 15;
    for (int u = C.bid; u < 1024; u += C.G) {
        const int mixer = u >> 9, bh = (u >> 5) & 15, ch = u & 31, b = bh >> 2, h = bh & 3, t0 = b * SEQ + ch * CH;
        const bf16 *Qp, *Kp, *Vp; int ldq; const bf16* cp = CPREV + ((size_t)(mixer * 16 + bh) * 32 + ch) * 32768;
        if (mixer == 0) {
            Qp = (const bf16*)(C.ws + WS_QC) + (size_t)t0 * D + h * 128; Kp = Qp + 512; ldq = D;
            Vp = (const bf16*)(C.ws + WS_MLV) + (size_t)t0 * D + h * 256;
            if (t < 128) { const float a = AG[bh * SEQ + ch * CH + t], cm = CMG[bh * SEQ + ch * CH + t], iv = IFG[(size_t)(t0 + t) * 8 + h];
                const float il = a + MPREV[bh * 32 + ch], m = fmaxf(il, a + cm);
                ea[t] = a - m; bs[t] = iv - a; isc[t] = __expf(il - m); edn[t] = __expf(-m); npv[t] = NPREV[(bh * 32 + ch) * 128 + t]; }
        } else {
            const float lg = ret_lg(h);
            Qp = (const bf16*)(C.ws + WS_RETQ) + (size_t)t0 * 512 + h * 128; Kp = (const bf16*)(C.ws + WS_RETK) + (size_t)t0 * 512 + h * 128; ldq = 512;
            Vp = (const bf16*)(C.ws + WS_RETV) + (size_t)t0 * D + h * 256;
            if (t < 128) { ea[t] = lg * (float)t; bs[t] = -lg * (float)t; isc[t] = __expf(lg * (float)(t + 1)); edn[t] = 1.0f; npv[t] = 0.f; }
        }
        fill_image(Qimg, Qp, ldq, 128, t); fill_image(Kimg, Kp, ldq, 128, t); fill_image(R1, cp, 128, 256, t);
        __syncthreads();
        unsigned bk[4];
#pragma unroll
        for (int kk = 0; kk < 4; ++kk) bk[kk] = off_b(jl, 4 * kk + g);
        bf16x8 qf[4];
#pragma unroll
        for (int kk = 0; kk < 4; ++kk) qf[kk] = *(const LAS bf16x8*)(Qimg + 4096 * w + bk[kk]);
        f32x4 st[8];
#pragma unroll
        for (int sb = 0; sb < 8; ++sb) { st[sb] = (f32x4){0.f, 0.f, 0.f, 0.f};
            if (sb <= w) {
#pragma unroll
                for (int kk = 0; kk < 4; ++kk) st[sb] = MFMA16(*(const LAS bf16x8*)(Kimg + bk[kk] + 4096 * sb), qf[kk], st[sb]);
            } }
        const int j = 16 * w + jl; const float eaj = ea[j];
        float psum = 0.f;
#pragma unroll
        for (int sb = 0; sb < 8; ++sb) { const f32x4 b4 = *(const LAS f32x4*)(bs + 16 * sb + 4 * g);
#pragma unroll
            for (int r = 0; r < 4; ++r) { const int s = 16 * sb + 4 * g + r; const float pv = (s <= j) ? __expf(eaj + b4[r]) * st[sb][r] : 0.f; st[sb][r] = pv; psum += pv; } }
        float qn = 0.f;
#pragma unroll
        for (int kk = 0; kk < 4; ++kk) { const f32x4 n0 = *(const LAS f32x4*)(npv + 32 * kk + 8 * g), n1 = *(const LAS f32x4*)(npv + 32 * kk + 8 * g + 4);
            float f[8]; unpack8(__builtin_bit_cast(u32x4, qf[kk]), f);
            qn += f[0] * n0.x + f[1] * n0.y + f[2] * n0.z + f[3] * n0.w + f[4] * n1.x + f[5] * n1.y + f[6] * n1.z + f[7] * n1.w; }
        psum += __shfl_xor(psum, 16); psum += __shfl_xor(psum, 32); qn += __shfl_xor(qn, 16); qn += __shfl_xor(qn, 32);
        const float iscj = isc[j];
        const float dinv = (mixer == 0) ? 1.0f / fmaxf(fabsf(psum + iscj * qn), edn[j]) : 1.0f;
        bf16x8 pf[4];
#pragma unroll
        for (int ks = 0; ks < 4; ++ks) { u32x4 pw; pw.x = pk2(st[2 * ks][0], st[2 * ks][1]); pw.y = pk2(st[2 * ks][2], st[2 * ks][3]); pw.z = pk2(st[2 * ks + 1][0], st[2 * ks + 1][1]); pw.w = pk2(st[2 * ks + 1][2], st[2 * ks + 1][3]);
            pf[ks] = __builtin_bit_cast(bf16x8, pw); }
        u32x4 vst[8];
#pragma unroll
        for (int i = 0; i < 8; ++i) { const int e = t + NTHR * i, half = e >> 11, row = (e >> 4) & 127, chk = e & 15; vst[i] = *(const u32x4*)(Vp + (size_t)row * D + half * 128 + chk * 8); }
        f32x4 acc[2][4][2];
#pragma unroll
        for (int hv = 0; hv < 2; ++hv)
#pragma unroll
            for (int uu = 0; uu < 4; ++uu)
#pragma unroll
                for (int x = 0; x < 2; ++x) acc[hv][uu][x] = (f32x4){0.f, 0.f, 0.f, 0.f};
#pragma unroll
        for (int kk = 0; kk < 4; ++kk) {
            const unsigned bi0 = off_b(8 * (jl >> 2) + (jl & 3), 4 * kk + g), bi1 = off_b(8 * (jl >> 2) + 4 + (jl & 3), 4 * kk + g);
#pragma unroll
            for (int hv = 0; hv < 2; ++hv) {
#pragma unroll
                for (int uu = 0; uu < 4; ++uu) {
                    acc[hv][uu][0] = MFMA16(*(const LAS bf16x8*)(R1 + bi0 + (32768 * hv + 8192 * uu)), qf[kk], acc[hv][uu][0]);
                    acc[hv][uu][1] = MFMA16(*(const LAS bf16x8*)(R1 + bi1 + (32768 * hv + 8192 * uu)), qf[kk], acc[hv][uu][1]); }
                asm volatile("" ::: "memory"); }
        }
#pragma unroll
        for (int hv = 0; hv < 2; ++hv)
#pragma unroll
            for (int uu = 0; uu < 4; ++uu)
#pragma unroll
                for (int x = 0; x < 2; ++x) acc[hv][uu][x] *= iscj;
        __syncthreads();
#pragma unroll
        for (int i = 0; i < 8; ++i) { const int e = t + NTHR * i, half = e >> 11, row = (e >> 4) & 127, chk = e & 15; *(LAS u32x4*)(R1 + half * 32768 + off_b(row, chk)) = vst[i]; }
        __syncthreads();
        unsigned bp[4];
#pragma unroll
        for (int uu = 0; uu < 4; ++uu) bp[uu] = off_b(4 * g + q, 4 * uu + p);
#pragma unroll
        for (int ks = 0; ks < 4; ++ks) {
            if (2 * ks <= w) {
#pragma unroll
                for (int hv = 0; hv < 2; ++hv)
#pragma unroll
                    for (int uu = 0; uu < 4; ++uu)
#pragma unroll
                        for (int x = 0; x < 2; ++x) {
                            const bf16x8 vf = cat8(tr_read(R1 + bp[uu] + (32768 * hv + 8192 * ks + 8 * x)), tr_read(R1 + bp[uu] + (32768 * hv + 8192 * ks + 4096 + 8 * x)));
                            acc[hv][uu][x] = MFMA16(vf, pf[ks], acc[hv][uu][x]); }
            }
            asm volatile("" ::: "memory"); }
        float s1 = 0.f;
#pragma unroll
        for (int hv = 0; hv < 2; ++hv)
#pragma unroll
            for (int uu = 0; uu < 4; ++uu)
#pragma unroll
                for (int x = 0; x < 2; ++x) { acc[hv][uu][x] *= dinv; s1 += (acc[hv][uu][x][0] + acc[hv][uu][x][1]) + (acc[hv][uu][x][2] + acc[hv][uu][x][3]); }
        s1 += __shfl_xor(s1, 16); s1 += __shfl_xor(s1, 32);
        const float mu = s1 * (1.0f / 256.0f); float s2 = 0.f;
#pragma unroll
        for (int hv = 0; hv < 2; ++hv)
#pragma unroll
            for (int uu = 0; uu < 4; ++uu)
#pragma unroll
                for (int x = 0; x < 2; ++x) { acc[hv][uu][x] -= mu; const f32x4 d = acc[hv][uu][x]; s2 += (d[0] * d[0] + d[1] * d[1]) + (d[2] * d[2] + d[3] * d[3]); }
        s2 += __shfl_xor(s2, 16); s2 += __shfl_xor(s2, 32);
        const float rstd = 1.0f / sqrtf(s2 * (1.0f / 256.0f) + EPS);
        const float* gain = (mixer == 0 ? C.ml_norm_g : C.ret_norm_g) + h * 256;
        const bf16* gate = (const bf16*)(C.ws + (mixer == 0 ? WS_MLO : WS_RETG)) + (size_t)(t0 + j) * D + h * 256;
        bf16* outp = (bf16*)(C.ws + (mixer == 0 ? WS_HML : WS_HRET)) + (size_t)(t0 + j) * D + h * 256;
#pragma unroll
        for (int hv = 0; hv < 2; ++hv)
#pragma unroll
            for (int uu = 0; uu < 4; ++uu) { const int v0 = 128 * hv + 32 * uu + 8 * g;
                const f32x4 g0 = *(const f32x4*)(gain + v0), g1 = *(const f32x4*)(gain + v0 + 4); f32x4 t0v, t1v; unpack8v(*(const u32x4*)(gate + v0), t0v, t1v);
                *(u32x4*)(outp + v0) = pack8v(acc[hv][uu][0] * rstd * g0 * t0v, acc[hv][uu][1] * rstd * g1 * t1v); }
        __syncthreads();
    }
}

DI void phase_norm2_route_mfma(Ctx& C) {
    LAS float* wr = (LAS float*)C.lds;
    LAS float* pg = wr + 32768;
    LAS float* ps = pg + 1024;
    LAS float* lgt = ps + 1024;
    const float* mod = (const float*)(C.ws + WS_MOD); const float* X1 = (const float*)(C.ws + WS_X1);
    bf16* H2 = (bf16*)(C.ws + WS_H1);
    int* TOPI = (int*)(C.ws + WS_ROUTE + RT_TOPI); float* TOPW = (float*)(C.ws + WS_ROUTE + RT_TOPW); int* RANK = (int*)(C.ws + WS_ROUTE + RT_RANK);
    unsigned* BLKCNT = (unsigned*)(C.ws + WS_ROUTE + RT_BLKCNT);
    LAS unsigned* cntL = (LAS unsigned*)(lgt + 2048);
    const int lane = C.lane, r = lane & 15, kq = lane >> 4;
    for (int i = C.tid; i < 32768 / 4; i += NTHR) *(LAS f32x4*)(wr + i * 4) = *(const f32x4*)(C.w_router + i * 4);
    int cur_b = -1;
    for (int sg = C.bid; sg < T / 64; sg += C.G) {
        const int b = (sg * 64) / SEQ;
        if (b != cur_b) { __syncthreads();
            for (int i = C.tid; i < 1024; i += NTHR) { pg[i] = C.norm_ffn_g[i] * (1.0f + mod[b * 6144 + 4096 + i]); ps[i] = mod[b * 6144 + 3072 + i]; }
            cur_b = b; }
        if (C.tid < 32) cntL[C.tid] = 0u;
        __syncthreads();
        if (C.wave < 4) {
            const int row0 = sg * 64 + C.wave * 16;
            const float* xr = X1 + (size_t)(row0 + r) * D + 4 * kq;
            float ss = 0.f;
#pragma unroll 8
            for (int i = 0; i < 64; ++i) { const f32x4 v = *(const f32x4*)(xr + 16 * i); ss += (v.x * v.x + v.y * v.y) + (v.z * v.z + v.w * v.w); }
            ss += __shfl_xor(ss, 16); ss += __shfl_xor(ss, 32);
            const float rstd = 1.0f / sqrtf(ss * (1.0f / D) + EPS);
            f32x4 acc0 = (f32x4){0.f, 0.f, 0.f, 0.f}, acc1 = acc0;
            bf16* hr = H2 + (size_t)(row0 + r) * D + 4 * kq;
            const LAS float* wb = wr + (4 * kq) * 32 + r;
#pragma unroll 4
            for (int i = 0; i < 64; ++i) {
                const f32x4 v = *(const f32x4*)(xr + 16 * i);
                const f32x4 g4 = *(const LAS f32x4*)(pg + 16 * i + 4 * kq), s4 = *(const LAS f32x4*)(ps + 16 * i + 4 * kq);
                const f32x4 h = v * rstd * g4 + s4;
                u32x2 w; w.x = pk2(h.x, h.y); w.y = pk2(h.z, h.w); *(u32x2*)(hr + 16 * i) = w;
                const LAS float* wi = wb + (16 * i) * 32;
                acc0 = __builtin_amdgcn_mfma_f32_16x16x4f32(h.x, wi[0], acc0, 0, 0, 0);       acc1 = __builtin_amdgcn_mfma_f32_16x16x4f32(h.x, wi[16], acc1, 0, 0, 0);
                acc0 = __builtin_amdgcn_mfma_f32_16x16x4f32(h.y, wi[32], acc0, 0, 0, 0);      acc1 = __builtin_amdgcn_mfma_f32_16x16x4f32(h.y, wi[32 + 16], acc1, 0, 0, 0);
                acc0 = __builtin_amdgcn_mfma_f32_16x16x4f32(h.z, wi[64], acc0, 0, 0, 0);      acc1 = __builtin_amdgcn_mfma_f32_16x16x4f32(h.z, wi[64 + 16], acc1, 0, 0, 0);
                acc0 = __builtin_amdgcn_mfma_f32_16x16x4f32(h.w, wi[96], acc0, 0, 0, 0);      acc1 = __builtin_amdgcn_mfma_f32_16x16x4f32(h.w, wi[96 + 16], acc1, 0, 0, 0);
            }
            LAS float* lw = lgt + C.wave * 512;
#pragma unroll
            for (int j = 0; j < 4; ++j) { lw[(4 * kq + j) * 32 + r] = acc0[j] + C.b_router[r]; lw[(4 * kq + j) * 32 + 16 + r] = acc1[j] + C.b_router[16 + r]; }
            asm volatile("s_waitcnt lgkmcnt(0)" ::: "memory");
            if (lane < 16) {
                float l[32];
#pragma unroll
                for (int e4 = 0; e4 < 8; ++e4) { const f32x4 t4 = *(const LAS f32x4*)(lw + lane * 32 + e4 * 4); l[e4 * 4] = t4.x; l[e4 * 4 + 1] = t4.y; l[e4 * 4 + 2] = t4.z; l[e4 * 4 + 3] = t4.w; }
                float tv[4]; int ti[4];
#pragma unroll
                for (int k = 0; k < 4; ++k) {
                    float bvv = -3.0e38f; int bi = 0;
#pragma unroll
                    for (int e = 0; e < 32; ++e) { const bool take = l[e] > bvv; bvv = take ? l[e] : bvv; bi = take ? e : bi; }
                    tv[k] = bvv; ti[k] = bi;
#pragma unroll
                    for (int e = 0; e < 32; ++e) l[e] = (e == bi) ? -3.0e38f : l[e];
                }
                const float e1 = __expf(tv[1] - tv[0]), e2 = __expf(tv[2] - tv[0]), e3 = __expf(tv[3] - tv[0]), inv = 1.0f / (1.0f + e1 + e2 + e3);
                const int m = row0 + lane;
                const float ww[4] = {inv, e1 * inv, e2 * inv, e3 * inv};
#pragma unroll
                for (int k = 0; k < 4; ++k) { TOPI[m * 4 + k] = ti[k]; TOPW[m * 4 + k] = ww[k]; RANK[m * 4 + k] = (int)__hip_atomic_fetch_add(cntL + ti[k], 1u, __ATOMIC_RELAXED, __HIP_MEMORY_SCOPE_WORKGROUP); }
            }
        }
        __syncthreads();
        if (C.tid < 32) BLKCNT[sg * 32 + C.tid] = cntL[C.tid];
    }
    int* SLOTTOK = (int*)(C.ws + WS_ROUTE + RT_SLOTTOK); float* SLOTW = (float*)(C.ws + WS_ROUTE + RT_SLOTW);
    for (int i = C.bid * NTHR + C.tid; i < NSLOTS; i += C.G * NTHR) { SLOTTOK[i] = T; SLOTW[i] = 0.f; }
    if (C.bid == 0) for (int i = C.tid; i < D / 2; i += NTHR) ((unsigned*)(H2 + (size_t)T * D))[i] = 0u;
    __syncthreads();
}

#define XB_TMO      128
#define XB_XCNT(j)  (256  + 64 * (j))
#define XB_XSUB(j)  (1280 + 64 * (j))
#define XB_XGEN(j)  (2304 + 64 * (j))
#define XB_TOP      3328
#define XB_TOPGEN   3392
#define XCD_BAR_WORDS 3456
#define XB_SPIN_CAP (1u << 22)
DI unsigned xb_ld(unsigned* p)              { return __hip_atomic_load(p, __ATOMIC_RELAXED, __HIP_MEMORY_SCOPE_AGENT); }
DI unsigned xb_add(unsigned* p, unsigned v) { return __hip_atomic_fetch_add(p, v, __ATOMIC_RELAXED, __HIP_MEMORY_SCOPE_AGENT); }
DI unsigned xb_xcc_id() { return (unsigned)__builtin_amdgcn_s_getreg((3 << 11) | 20) & 0xFu; }
#define XB_SPIN(cond, bar) do { unsigned _sp = 0; while (cond) { __builtin_amdgcn_s_sleep(1); \
    if ((++_sp & 255u) == 0u) { if (xb_ld(&(bar)[XB_TMO])) break; if (_sp > XB_SPIN_CAP) { atomicAdd(&(bar)[XB_TMO], 1u); break; } } } } while (0)
struct XcdBarrier { unsigned* bar; unsigned x; volatile LAS unsigned* st; };
DI XcdBarrier xcd_barrier_post(unsigned* bar, volatile LAS unsigned* st) {
    XcdBarrier b; b.bar = bar; b.x = xb_xcc_id(); b.st = st;
    if (threadIdx.x == 0) (void)xb_add(&bar[XB_XCNT(b.x)], 1u);
    return b;
}
DI void xcd_barrier_complete(unsigned* bar, unsigned x, unsigned& nloc, unsigned& nx) {
    const unsigned G = gridDim.x * gridDim.y * gridDim.z;
    unsigned sum, cnt, mine, sp = 0u;
    for (;;) {
        sum = 0u; cnt = 0u; mine = 0u;
#pragma unroll
        for (unsigned j = 0; j < 16; ++j) { const unsigned c = xb_ld(&bar[XB_XCNT(j)]); sum += c; cnt += (c > 0u) ? 1u : 0u; mine = (j == x) ? c : mine; }
        if (sum == G) break;
        __builtin_amdgcn_s_sleep(1);
        if ((++sp & 255u) == 0u) { if (xb_ld(&bar[XB_TMO])) break; if (sp > XB_SPIN_CAP) { atomicAdd(&bar[XB_TMO], 1u); break; } }
    }
    nloc = mine > 0u ? mine : 1u; nx = cnt > 0u ? cnt : 1u;
}
DI void xcd_barrier(const XcdBarrier& b) {
    asm volatile("s_waitcnt vmcnt(0)" ::: "memory");
    __syncthreads();
    if (threadIdx.x == 0) {
        unsigned* bar = b.bar;
        __builtin_amdgcn_s_waitcnt(0);
        unsigned nloc = b.st[0], nx = b.st[1];
        if (nloc == 0u) { xcd_barrier_complete(bar, b.x, nloc, nx); b.st[0] = nloc; b.st[1] = nx; }
        const unsigned old = xb_add(&bar[XB_XSUB(b.x)], 1u);
        const unsigned gen = old / nloc;
        if (old + 1u == (gen + 1u) * nloc) {
            __builtin_amdgcn_fence(__ATOMIC_RELEASE, "agent");
            asm volatile("s_waitcnt vmcnt(0)" ::: "memory");
            const unsigned og = xb_add(&bar[XB_TOP], 1u);
            const unsigned tg = og / nx;
            if (og + 1u == (tg + 1u) * nx) xb_add(&bar[XB_TOPGEN], 1u);
            else XB_SPIN(xb_ld(&bar[XB_TOPGEN]) == tg, bar);
            __builtin_amdgcn_fence(__ATOMIC_ACQUIRE, "agent");
            xb_add(&bar[XB_XGEN(b.x)], 1u);
            asm volatile("s_waitcnt vmcnt(0)" ::: "memory");
        } else {
            XB_SPIN(xb_ld(&bar[XB_XGEN(b.x)]) == gen, bar);
            __builtin_amdgcn_fence(__ATOMIC_ACQUIRE, "agent");
            asm volatile("s_waitcnt vmcnt(0)" ::: "memory");
        }
    }
    __syncthreads();
}

constexpr int NPHASES = 14;
__global__ void __launch_bounds__(NTHR, 2) fwd(Args a) {
    extern __shared__ __attribute__((aligned(16))) unsigned char lds[];
    Ctx C;
    C.lds = (LAS unsigned char*)lds; C.tid = threadIdx.x; C.lane = C.tid & 63; C.wave = __builtin_amdgcn_readfirstlane(C.tid >> 6); C.G = gridDim.x; C.bid = blockIdx.x;
    C.x = (const float*)a.in[0]; C.c = (const float*)a.in[1]; C.positions = (const int*)a.in[2]; C.w_ada = (const float*)a.in[3]; C.b_ada = (const float*)a.in[4];
    C.norm_mix_g = (const float*)a.in[5]; C.w_in = (const float*)a.in[6]; C.conv_w = (const float*)a.in[7]; C.conv_b = (const float*)a.in[8]; C.b_if = (const float*)a.in[9];
    C.ml_norm_g = (const float*)a.in[10]; C.ret_norm_g = (const float*)a.in[11]; C.w_bml = (const float*)a.in[12]; C.w_bret = (const float*)a.in[13]; C.w_out = (const float*)a.in[14];
    C.norm_ffn_g = (const float*)a.in[15]; C.w_router = (const float*)a.in[16]; C.b_router = (const float*)a.in[17]; C.w_gu = (const float*)a.in[18]; C.b_gu = (const float*)a.in[19];
    C.w_dn = (const float*)a.in[20]; C.b_dn = (const float*)a.in[21]; C.norm_final_g = (const float*)a.in[22];
    C.out = a.out; C.ws = a.ws;
    const int lo = a.ph_lo, hi = a.ph_hi;
    volatile LAS unsigned* bst = (volatile LAS unsigned*)(C.lds + LDS_BYTES - 16);
    if (C.tid < 4) bst[C.tid] = 0u;
    __syncthreads();
    XcdBarrier bar; bar.bar = (unsigned*)(C.ws + WS_CTL) + CW_BAR; bar.x = 0; bar.st = bst;
    if (hi - lo > 1) bar = xcd_barrier_post((unsigned*)(C.ws + WS_CTL) + CW_BAR, bst);
#define SEAM(k) do { if (IN(k) && IN((k) + 1)) xcd_barrier(bar); } while (0)
#ifdef ONLY_PHASE
#define IN(k) ((k) == ONLY_PHASE && lo <= (k) && (k) < hi)
#else
#define IN(k) (lo <= (k) && (k) < hi)
#endif
    if (IN(0)) phase_mod(C); SEAM(0);
    if (IN(1)) { phase_norm1(C);
#if OPT_ANY
        convert_weights(C);
#endif
    } SEAM(1);
#if OPT_INPROJ
    if (IN(2)) phase_inproj_mfma(C); SEAM(2);
#else
    if (IN(2)) phase_inproj(C); SEAM(2);
#endif
    if (IN(3)) phase_conv_rope(C); SEAM(3);
#if OPT_LOCAL
    if (IN(4)) phase_local_mfma(C); SEAM(4);
#else
    if (IN(4)) phase_local(C); SEAM(4);
#endif
    if (IN(5)) phase_scan(C); SEAM(5);
#if OPT_OUTP
    if (IN(6)) phase_out_mfma(C); SEAM(6);
#else
    if (IN(6)) phase_out(C); SEAM(6);
#endif
#if OPT_BRANCH
    if (IN(7)) phase_branch_mfma(C); SEAM(7);
#else
    if (IN(7)) phase_branch(C); SEAM(7);
#endif
#if OPT_OUT
    if (IN(8)) phase_outproj_mfma(C); SEAM(8);
#else
    if (IN(8)) phase_outproj(C); SEAM(8);
#endif
#if OPT_ROUTE
    if (IN(9)) phase_norm2_route_mfma(C); SEAM(9);
#else
    if (IN(9)) phase_norm2_route(C); SEAM(9);
#endif
    if (IN(10)) phase_slots(C); SEAM(10);
#if OPT_MOE
    if (IN(11)) phase_gateup_mfma(C); SEAM(11);
#else
    if (IN(11)) phase_gateup(C); SEAM(11);
#endif
#if OPT_MOE
    if (IN(12)) phase_down_mfma(C); SEAM(12);
#else
    if (IN(12)) phase_down(C); SEAM(12);
#endif
    if (IN(13)) phase_final(C); SEAM(13);
#undef IN
}

extern "C" void kernel_launch(void* const* d_in, const int* in_sizes, int n_in, void* d_out, int out_size, void* d_ws, size_t ws_size, hipStream_t stream) {
    static int grid = 0;
    if (grid == 0) {
        if (n_in != 23 || out_size != T * D || ws_size < WS_END) { fprintf(stderr, "kernel_launch: unexpected shapes: n_in %d out %d ws %zu (need %zu)\n", n_in, out_size, ws_size, (size_t)WS_END); grid = -1; return; }
        int dev = 0, cus = 0;
        if (hipGetDevice(&dev) != hipSuccess || hipDeviceGetAttribute(&cus, hipDeviceAttributeMultiprocessorCount, dev) != hipSuccess) { grid = -1; return; }
        if (hipFuncSetAttribute((const void*)fwd, hipFuncAttributeMaxDynamicSharedMemorySize, LDS_BYTES) != hipSuccess) { fprintf(stderr, "kernel_launch: hipFuncSetAttribute failed\n"); grid = -1; return; }
        grid = cus > 0 ? cus : 256;
    }
    if (grid < 0) return;
    Args a{};
    for (int i = 0; i < 23; ++i) a.in[i] = d_in[i];
    a.out = (float*)d_out; a.ws = (unsigned char*)d_ws;
    (void)hipMemsetAsync((char*)d_ws + WS_CTL, 0, CTL_ZERO_BYTES, stream);
#ifdef MK_PER_PHASE
    for (int p = 0; p < NPHASES; ++p) { a.ph_lo = p; a.ph_hi = p + 1; hipLaunchKernelGGL(fwd, dim3(grid), dim3(NTHR), LDS_BYTES, stream, a); }
#else
    a.ph_lo = 0; a.ph_hi = NPHASES;
    hipLaunchKernelGGL(fwd, dim3(grid), dim3(NTHR), LDS_BYTES, stream, a);
#endif
#ifdef PROBE_PHASE
    for (int r = 0; r < PROBE_REPS; ++r) { a.ph_lo = PROBE_PHASE; a.ph_hi = PROBE_PHASE + 1; hipLaunchKernelGGL(fwd, dim3(grid), dim3(NTHR), LDS_BYTES, stream, a); }
#endif
}
```

```cpp
#include <hip/hip_runtime.h>
#include <cstdio>
#include <cstdint>

#ifndef OPT_INPROJ
#define OPT_INPROJ 1
#endif
#ifndef OPT_BRANCH
#define OPT_BRANCH 1
#endif
#ifndef OPT_OUT
#define OPT_OUT 1
#endif
#ifndef OPT_MOE
#define OPT_MOE 1
#endif
#ifndef OPT_LOCAL
#define OPT_LOCAL 1
#endif
#ifndef OPT_OUTP
#define OPT_OUTP 1
#endif
#ifndef OPT_ROUTE
#define OPT_ROUTE 1
#endif
#define OPT_ANY (OPT_INPROJ || OPT_BRANCH || OPT_OUT || OPT_MOE)
#define DI __device__ __forceinline__
#define LAS __attribute__((address_space(3)))
typedef unsigned short bf16;
typedef float f32x4 __attribute__((ext_vector_type(4)));
typedef unsigned u32x4 __attribute__((ext_vector_type(4)));
typedef unsigned u32x2 __attribute__((ext_vector_type(2)));

constexpr int D = 1024, NB = 4, SEQ = 4096, T = NB * SEQ;
constexpr int DIN = 8200, CH = 128, NCH = SEQ / CH;
constexpr int NE = 32, TOPK = 4, NSLOT_BLK = 288, NSLOTS = NSLOT_BLK * 256;
constexpr float EPS = 1e-5f;
constexpr int NTHR = 512, NWAVES = 8;

constexpr size_t MiB = 1u << 20;
constexpr size_t WS_CTL   = 0;
constexpr size_t WS_MOD   = 1 * MiB;
constexpr size_t WS_IFG   = 2 * MiB;
constexpr size_t WS_COS   = 3 * MiB;
constexpr size_t WS_SIN   = 7 * MiB;
constexpr size_t WS_ROUTE = 11 * MiB;
constexpr size_t WS_SMALL = 14 * MiB;
constexpr size_t WS_H1    = 16 * MiB;
constexpr size_t WS_X1    = 50 * MiB;
constexpr size_t WS_TMP   = 114 * MiB;
constexpr size_t WS_B     = 178 * MiB;
constexpr size_t WS_QKRAW = WS_B;
constexpr size_t WS_QC    = WS_B + 32 * MiB;
constexpr size_t WS_MLV   = WS_B + 64 * MiB;
constexpr size_t WS_MLO   = WS_B + 96 * MiB;
constexpr size_t WS_RETQ  = WS_B + 128 * MiB;
constexpr size_t WS_RETK  = WS_B + 144 * MiB;
constexpr size_t WS_RETV  = WS_B + 160 * MiB;
constexpr size_t WS_RETG  = WS_B + 192 * MiB;
constexpr size_t WS_GML   = WS_B + 224 * MiB;
constexpr size_t WS_GRET  = WS_B + 256 * MiB;
constexpr size_t WS_CLOC  = WS_B + 288 * MiB;
constexpr size_t WS_CPREV = WS_B + 352 * MiB;
constexpr size_t WS_HML   = WS_B + 416 * MiB;
constexpr size_t WS_HRET  = WS_B + 448 * MiB;
constexpr size_t WS_B_END = WS_B + 480 * MiB;
constexpr size_t WS_ACT   = WS_B;
constexpr size_t WS_YS    = WS_B + 160 * MiB;
constexpr size_t WS_WT_IN = WS_B_END;
constexpr size_t WS_WT_BR = WS_WT_IN + 16 * MiB;
constexpr size_t WS_WT_OUT = WS_WT_BR + 4 * MiB;
constexpr size_t WS_WT_GU = WS_WT_OUT + 2 * MiB;
constexpr size_t WS_WT_DN = WS_WT_GU + 128 * MiB;
constexpr size_t WS_MODP  = WS_WT_DN + 64 * MiB;
constexpr size_t WS_END   = WS_MODP + 1 * MiB;
static_assert(WS_YS + (size_t)NSLOTS * 2048 <= WS_B_END, "ws map");

constexpr int CW_CNT = 64;
constexpr int CW_NBLK = 128;
constexpr int CW_BLKE = 192;
constexpr int CW_BAR = 4096;
constexpr size_t CTL_ZERO_BYTES = 65536;
constexpr size_t RT_TOPI = 0;
constexpr size_t RT_TOPW = 256 * 1024;
constexpr size_t RT_RANK = 512 * 1024;
constexpr size_t RT_ASLOT = 768 * 1024;
constexpr size_t RT_SLOTTOK = 1024 * 1024;
constexpr size_t RT_SLOTW = 1024 * 1024 + 512 * 1024;
constexpr size_t RT_BLKCNT = 2048 * 1024;
constexpr size_t SM_NLOC = 0;
constexpr size_t SM_NPREV = 256 * 1024;
constexpr size_t SM_MLOC = 512 * 1024;
constexpr size_t SM_ACH = 512 * 1024 + 4096;
constexpr size_t SM_MPREV = 512 * 1024 + 8192;
constexpr size_t SM_AG = 1024 * 1024;
constexpr size_t SM_CMG = 1280 * 1024;

constexpr int LDS_BYTES = 163840;

DI float bf2f(bf16 v) { return __uint_as_float(((unsigned)v) << 16); }
DI unsigned f2bf(float f) { unsigned u = __float_as_uint(f); return (u + 0x7fffu + ((u >> 16) & 1u)) >> 16; }
DI unsigned pk2(float lo, float hi) { return f2bf(lo) | (f2bf(hi) << 16); }
DI float wave_sum(float v) {
#pragma unroll
    for (int o = 1; o < 64; o <<= 1) v += __shfl_xor(v, o);
    return v;
}
DI float sigmoidf_(float x) { return 1.0f / (1.0f + __expf(-x)); }
DI float siluf_(float x) { return x / (1.0f + __expf(-x)); }
DI float logsigmoidf_(float x) { return fminf(x, 0.f) - log1pf(__expf(-fabsf(x))); }
DI void unpack8(const u32x4 w, float (&f)[8]) {
    f[0] = __uint_as_float(w.x << 16); f[1] = __uint_as_float(w.x & 0xffff0000u);
    f[2] = __uint_as_float(w.y << 16); f[3] = __uint_as_float(w.y & 0xffff0000u);
    f[4] = __uint_as_float(w.z << 16); f[5] = __uint_as_float(w.z & 0xffff0000u);
    f[6] = __uint_as_float(w.w << 16); f[7] = __uint_as_float(w.w & 0xffff0000u);
}
DI u32x4 pack8(const float (&f)[8]) { u32x4 w; w.x = pk2(f[0], f[1]); w.y = pk2(f[2], f[3]); w.z = pk2(f[4], f[5]); w.w = pk2(f[6], f[7]); return w; }

struct Args { const void* in[23]; float* out; unsigned char* ws; int ph_lo, ph_hi; };

struct Ctx {
    LAS unsigned char* lds;
    int tid, lane, wave, G, bid;
    const float *x, *c, *w_ada, *b_ada, *norm_mix_g, *w_in, *conv_w, *conv_b, *b_if, *ml_norm_g, *ret_norm_g;
    const float *w_bml, *w_bret, *w_out, *norm_ffn_g, *w_router, *b_router, *w_gu, *b_gu, *w_dn, *b_dn, *norm_final_g;
    const int* positions;
    float* out; unsigned char* ws;
};

template <class AF, class BF, class EF>
DI void naive_gemm_tile(Ctx& C, int tm, int tn, int K, int ldb, const AF& af, const BF& bf, const EF& ef) {
    LAS float* As = (LAS float*)C.lds;
    LAS float* Bs = As + 16 * 132;
    const int t = C.tid, ty = t >> 5, tx = t & 31;
    float acc[8][4];
#pragma unroll
    for (int i = 0; i < 8; ++i)
#pragma unroll
        for (int j = 0; j < 4; ++j) acc[i][j] = 0.f;
    const int ar = t >> 2, ak = (t & 3) * 4;
    const bf16* arow = af.row(tm, ar);
    const int bk = t >> 5, bn = (t & 31) * 4;
    const float* bbase = bf.ptr(tm, tn) + bn;
    for (int k0 = 0; k0 < K; k0 += 16) {
        const u32x2 av = *(const u32x2*)(arow + k0 + ak);
        const f32x4 bv = *(const f32x4*)(bbase + (size_t)(k0 + bk) * ldb);
        __syncthreads();
        As[(ak + 0) * 132 + ar] = __uint_as_float(av.x << 16); As[(ak + 1) * 132 + ar] = __uint_as_float(av.x & 0xffff0000u);
        As[(ak + 2) * 132 + ar] = __uint_as_float(av.y << 16); As[(ak + 3) * 132 + ar] = __uint_as_float(av.y & 0xffff0000u);
        *(LAS f32x4*)(Bs + bk * 132 + bn) = bv;
        __syncthreads();
#pragma unroll 4
        for (int kk = 0; kk < 16; ++kk) {
            const f32x4 a0 = *(const LAS f32x4*)(As + kk * 132 + ty * 8), a1 = *(const LAS f32x4*)(As + kk * 132 + ty * 8 + 4);
            const f32x4 b = *(const LAS f32x4*)(Bs + kk * 132 + tx * 4);
            const float a[8] = {a0.x, a0.y, a0.z, a0.w, a1.x, a1.y, a1.z, a1.w};
#pragma unroll
            for (int i = 0; i < 8; ++i) { acc[i][0] += a[i] * b.x; acc[i][1] += a[i] * b.y; acc[i][2] += a[i] * b.z; acc[i][3] += a[i] * b.w; }
        }
    }
#pragma unroll
    for (int i = 0; i < 8; ++i) { ef.put(tm, tn, ty * 8 + i, tx * 4, acc[i]); asm volatile("" ::: "memory"); }
    __syncthreads();
}

DI void phase_mod(Ctx& C) {
    LAS float* red = (LAS float*)C.lds;
    float* mod = (float*)(C.ws + WS_MOD);
    for (int g = C.bid; g < 256; g += C.G) {
        const int n0 = g * 24, t = C.tid;
        if (t < 504) {
            const int col = t % 24, kg = t / 24;
            float a0 = 0.f, a1 = 0.f, a2 = 0.f, a3 = 0.f;
            for (int k = kg; k < D; k += 21) {
                const float w = C.w_ada[(size_t)k * 6144 + n0 + col];
                a0 += siluf_(C.c[k]) * w; a1 += siluf_(C.c[D + k]) * w; a2 += siluf_(C.c[2 * D + k]) * w; a3 += siluf_(C.c[3 * D + k]) * w;
            }
            red[(kg * 24 + col) * 4 + 0] = a0; red[(kg * 24 + col) * 4 + 1] = a1; red[(kg * 24 + col) * 4 + 2] = a2; red[(kg * 24 + col) * 4 + 3] = a3;
        }
        __syncthreads();
        if (t < 96) {
            const int col = t % 24, b = t / 24; float s = 0.f;
            for (int kg = 0; kg < 21; ++kg) s += red[(kg * 24 + col) * 4 + b];
            mod[b * 6144 + n0 + col] = s + C.b_ada[n0 + col];
        }
        __syncthreads();
    }
}

DI void phase_norm1(Ctx& C) {
    const float* mod = (const float*)(C.ws + WS_MOD);
    bf16* H1 = (bf16*)(C.ws + WS_H1);
    float* IFG = (float*)(C.ws + WS_IFG);
    const int lane = C.lane, gw = C.bid * NWAVES + C.wave, NGW = C.G * NWAVES;
    float wif[4][4][8];
#pragma unroll
    for (int j = 0; j < 4; ++j)
#pragma unroll
        for (int i = 0; i < 4; ++i) {
            const float* wp = C.w_in + (size_t)(4 * (lane + 64 * j) + i) * DIN + 3072;
#pragma unroll
            for (int e = 0; e < 8; ++e) wif[j][i][e] = wp[e];
        }
    for (int m = gw; m < T; m += NGW) {
        const int b = m / SEQ;
        const f32x4* xr = (const f32x4*)(C.x + (size_t)m * D) + lane;
        f32x4 v[4]; float ss = 0.f;
#pragma unroll
        for (int j = 0; j < 4; ++j) { v[j] = xr[64 * j]; ss += (v[j].x * v[j].x + v[j].y * v[j].y) + (v[j].z * v[j].z + v[j].w * v[j].w); }
        const float rstd = 1.0f / sqrtf(wave_sum(ss) * (1.0f / D) + EPS);
        float p[8];
#pragma unroll
        for (int e = 0; e < 8; ++e) p[e] = 0.f;
        u32x2* o8 = (u32x2*)(H1 + (size_t)m * D) + lane;
#pragma unroll
        for (int j = 0; j < 4; ++j) {
            const int col = 4 * (lane + 64 * j);
            const f32x4 g = *(const f32x4*)(C.norm_mix_g + col), sh = *(const f32x4*)(mod + b * 6144 + col), sc = *(const f32x4*)(mod + b * 6144 + 1024 + col);
            f32x4 h = (v[j] * rstd * g) * (sc + 1.0f) + sh;
            u32x2 w; w.x = pk2(h.x, h.y); w.y = pk2(h.z, h.w); o8[64 * j] = w;
            const float hh[4] = {h.x, h.y, h.z, h.w};
#pragma unroll
            for (int i = 0; i < 4; ++i)
#pragma unroll
                for (int e = 0; e < 8; ++e) p[e] += hh[i] * wif[j][i][e];
        }
#pragma unroll
        for (int e = 0; e < 8; ++e) p[e] = wave_sum(p[e]);
        if (lane < 8) { float r = p[0];
#pragma unroll
            for (int e = 1; e < 8; ++e) r = (lane == e) ? p[e] : r;
            IFG[(size_t)m * 8 + lane] = r + C.b_if[lane]; }
    }
    float* COS = (float*)(C.ws + WS_COS); float* SIN = (float*)(C.ws + WS_SIN);
    for (int idx = C.bid * NTHR + C.tid; idx < T * 64; idx += C.G * NTHR) {
        const int t = idx >> 6, i = idx & 63;
        const float inv = (float)exp(-(double)i * (9.210340371976184 / 64.0));
        const double ang = (double)C.positions[t] * (double)inv;
        const double kq = rint(ang * 0.6366197723675814);
        double r = fma(-kq, 1.5707963267948966, ang); r = fma(-kq, 6.123233995736766e-17, r);
        const float rf = (float)r; const float s = sinf(rf), c = cosf(rf);
        const int q = ((int)kq) & 3;
        const float cs = (q == 0) ? c : (q == 1) ? -s : (q == 2) ? -c : s;
        const float sn = (q == 0) ? s : (q == 1) ? c : (q == 2) ? -s : -c;
        COS[idx] = cs; SIN[idx] = sn;
    }
    if (C.bid == 0 && C.tid < 32) ((unsigned*)(C.ws + WS_CTL))[CW_CNT + C.tid] = 0u;
}

struct AF_rows { const bf16* base; int ld; DI const bf16* row(int tm, int r) const { return base + (size_t)(tm * 128 + r) * ld; } };
struct BF_inproj { const float* w; DI const float* ptr(int, int tn) const { return w + (tn < 24 ? tn * 128 : tn * 128 + 8); } };
struct EF_inproj { unsigned char* ws;
    DI void put(int tm, int tn, int r, int c, const float (&v)[4]) const {
        const int row = tm * 128 + r; const int seg = tn >> 3;
        bf16* dst; int ld = 1024, col = (tn & 7) * 128 + c; int act = 0;
        switch (seg) {
            case 0: dst = (bf16*)(ws + WS_QKRAW); break;
            case 1: dst = (bf16*)(ws + WS_MLV); break;
            case 2: dst = (bf16*)(ws + WS_MLO); act = 1; break;
            case 3: if ((tn & 7) < 4) dst = (bf16*)(ws + WS_RETQ); else { dst = (bf16*)(ws + WS_RETK); col -= 512; } ld = 512; break;
            case 4: dst = (bf16*)(ws + WS_RETV); break;
            case 5: dst = (bf16*)(ws + WS_RETG); act = 2; break;
            case 6: dst = (bf16*)(ws + WS_GML); act = 1; break;
            default: dst = (bf16*)(ws + WS_GRET); act = 1; break;
        }
        float o[4];
#pragma unroll
        for (int j = 0; j < 4; ++j) o[j] = act == 1 ? sigmoidf_(v[j]) : act == 2 ? siluf_(v[j]) : v[j];
        u32x2 w; w.x = pk2(o[0], o[1]); w.y = pk2(o[2], o[3]);
        *(u32x2*)(dst + (size_t)row * ld + col) = w;
    } };
DI void phase_inproj(Ctx& C) {
    AF_rows af{(const bf16*)(C.ws + WS_H1), D}; BF_inproj bf{C.w_in}; EF_inproj ef{C.ws};
    const int ntn = 64, nt = (T / 128) * ntn;
    for (int u = C.bid; u < nt; u += C.G) naive_gemm_tile(C, u / ntn, u % ntn, D, DIN, af, bf, ef);
}

DI void phase_conv_rope(Ctx& C) {
    const bf16* QKRAW = (const bf16*)(C.ws + WS_QKRAW); bf16* QC = (bf16*)(C.ws + WS_QC);
    for (int idx = C.bid * NTHR + C.tid; idx < T * 128; idx += C.G * NTHR) {
        const int t = idx >> 7, c0 = (idx & 127) * 8, s = t % SEQ;
        float acc[8];
#pragma unroll
        for (int e = 0; e < 8; ++e) acc[e] = C.conv_b[c0 + e];
#pragma unroll
        for (int j = 0; j < 4; ++j) {
            if (s - 3 + j >= 0) {
                float f[8]; unpack8(*(const u32x4*)(QKRAW + (size_t)(t - 3 + j) * D + c0), f);
#pragma unroll
                for (int e = 0; e < 8; ++e) acc[e] += f[e] * C.conv_w[j * D + c0 + e];
            }
        }
        const float sc = (c0 < 512) ? 0.08838834764831845f : 1.0f;
#pragma unroll
        for (int e = 0; e < 8; ++e) acc[e] = siluf_(acc[e]) * sc;
        *(u32x4*)(QC + (size_t)t * D + c0) = pack8(acc);
    }
#if !OPT_INPROJ
    const float* COS = (const float*)(C.ws + WS_COS); const float* SIN = (const float*)(C.ws + WS_SIN);
    for (int idx = C.bid * NTHR + C.tid; idx < T * 64; idx += C.G * NTHR) {
        const int t = idx >> 6, r = idx & 63, which = r >> 5, h = (r >> 3) & 3, i0 = (r & 7) * 8;
        bf16* base = (bf16*)(C.ws + (which ? WS_RETK : WS_RETQ)) + (size_t)t * 512 + h * 128;
        float x1[8], x2[8], o1[8], o2[8]; unpack8(*(const u32x4*)(base + i0), x1); unpack8(*(const u32x4*)(base + 64 + i0), x2);
        const float sc = which ? 0.08838834764831845f : 1.0f;
#pragma unroll
        for (int e = 0; e < 8; ++e) { const float cs = COS[t * 64 + i0 + e], sn = SIN[t * 64 + i0 + e]; o1[e] = (x1[e] * cs - x2[e] * sn) * sc; o2[e] = (x2[e] * cs + x1[e] * sn) * sc; }
        *(u32x4*)(base + i0) = pack8(o1); *(u32x4*)(base + 64 + i0) = pack8(o2);
    }
#endif
}

DI float ret_lg(int h) { return logf(1.0f - exp2f(-5.0f - (float)h)); }

DI void phase_local(Ctx& C) {
    LAS float* lf = (LAS float*)C.lds; LAS float* a = lf + 128; LAS float* ws = a + 128; LAS float* red = ws + 128;
    const float* IFG = (const float*)(C.ws + WS_IFG);
    bf16* CLOC = (bf16*)(C.ws + WS_CLOC);
    float* NLOC = (float*)(C.ws + WS_SMALL + SM_NLOC); float* MLOC = (float*)(C.ws + WS_SMALL + SM_MLOC); float* ACH = (float*)(C.ws + WS_SMALL + SM_ACH);
    const int t = C.tid;
    for (int u = C.bid; u < 1024; u += C.G) {
        const int mixer = u >> 9, bh = (u >> 5) & 15, ch = u & 31, b = bh >> 2, h = bh & 3, t0 = b * SEQ + ch * CH;
        const bf16 *Kp, *Vp; int ldk;
        if (mixer == 0) {
            if (t < 128) lf[t] = logsigmoidf_(IFG[(size_t)(t0 + t) * 8 + 4 + h]);
            __syncthreads();
            if (t < 128) { float s = 0.f; for (int j = 0; j <= t; ++j) s += lf[j]; a[t] = s; }
            __syncthreads();
            const float A = a[127];
            if (t < 128) ws[t] = A - a[t] + IFG[(size_t)(t0 + t) * 8 + h];
            __syncthreads();
            float mloc = -3.0e38f; for (int j = 0; j < 128; ++j) mloc = fmaxf(mloc, ws[j]);
            __syncthreads();
            if (t < 128) ws[t] = __expf(ws[t] - mloc);
            if (t == 0) { MLOC[bh * 32 + ch] = mloc; ACH[bh * 32 + ch] = A; }
            __syncthreads();
            Kp = (const bf16*)(C.ws + WS_QC) + (size_t)t0 * D + 512 + h * 128; ldk = D;
            Vp = (const bf16*)(C.ws + WS_MLV) + (size_t)t0 * D + h * 256;
        } else {
            const float lg = ret_lg(h);
            if (t < 128) ws[t] = __expf(lg * (float)(127 - t));
            __syncthreads();
            Kp = (const bf16*)(C.ws + WS_RETK) + (size_t)t0 * 512 + h * 128; ldk = 512;
            Vp = (const bf16*)(C.ws + WS_RETV) + (size_t)t0 * D + h * 256;
        }
        const int kh = t >> 8, v = t & 255;
        float acc[64];
#pragma unroll
        for (int i = 0; i < 64; ++i) acc[i] = 0.f;
        for (int s = 0; s < 128; ++s) {
            const float vv = ws[s] * bf2f(Vp[(size_t)s * D + v]);
            const bf16* kr = Kp + (size_t)s * ldk + kh * 64;
#pragma unroll
            for (int i8 = 0; i8 < 8; ++i8) { float f[8]; unpack8(*(const u32x4*)(kr + i8 * 8), f);
#pragma unroll
                for (int e = 0; e < 8; ++e) acc[i8 * 8 + e] += f[e] * vv; }
        }
        bf16* cl = CLOC + ((size_t)(mixer * 16 + bh) * 32 + ch) * 32768;
#pragma unroll
        for (int i = 0; i < 64; ++i) cl[(size_t)v * 128 + (kh * 64 + i)] = (bf16)f2bf(acc[i]);
        if (mixer == 0 && t < 128) { float s = 0.f; for (int j = 0; j < 128; ++j) s += ws[j] * bf2f(Kp[(size_t)j * ldk + t]); NLOC[(bh * 32 + ch) * 128 + t] = s; }
        __syncthreads();
    }
    (void)red;
}

DI void phase_scan(Ctx& C) {
    const bf16* CLOC = (const bf16*)(C.ws + WS_CLOC); bf16* CPREV = (bf16*)(C.ws + WS_CPREV);
    const float* NLOC = (const float*)(C.ws + WS_SMALL + SM_NLOC); float* NPREV = (float*)(C.ws + WS_SMALL + SM_NPREV);
    const float* MLOC = (const float*)(C.ws + WS_SMALL + SM_MLOC); const float* ACH = (const float*)(C.ws + WS_SMALL + SM_ACH); float* MPREV = (float*)(C.ws + WS_SMALL + SM_MPREV);
    for (int idx = C.bid * NTHR + C.tid; idx < 32 * 4096; idx += C.G * NTHR) {
        const int seq = idx >> 12, e8 = idx & 4095;
        float st[8];
#pragma unroll
        for (int e = 0; e < 8; ++e) st[e] = 0.f;
        if (seq < 16) {
            float m_st = 0.f; float nst[8];
#pragma unroll
            for (int e = 0; e < 8; ++e) nst[e] = 0.f;
            for (int ch = 0; ch < 32; ++ch) {
                const size_t o = ((size_t)seq * 32 + ch) * 32768 + (size_t)e8 * 8;
                *(u32x4*)(CPREV + o) = pack8(st);
                if (e8 < 16) { *(f32x4*)(NPREV + (seq * 32 + ch) * 128 + e8 * 8) = (f32x4){nst[0], nst[1], nst[2], nst[3]}; *(f32x4*)(NPREV + (seq * 32 + ch) * 128 + e8 * 8 + 4) = (f32x4){nst[4], nst[5], nst[6], nst[7]}; }
                if (e8 == 0) MPREV[seq * 32 + ch] = m_st;
                const float A = ACH[seq * 32 + ch], ml = MLOC[seq * 32 + ch];
                const float m_new = fmaxf(A + m_st, ml), sp = __expf(A + m_st - m_new), sl = __expf(ml - m_new);
                float f[8]; unpack8(*(const u32x4*)(CLOC + o), f);
#pragma unroll
                for (int e = 0; e < 8; ++e) st[e] = sp * st[e] + sl * f[e];
                if (e8 < 16) { const float* nl = NLOC + (seq * 32 + ch) * 128 + e8 * 8;
#pragma unroll
                    for (int e = 0; e < 8; ++e) nst[e] = sp * nst[e] + sl * nl[e]; }
                m_st = m_new;
            }
        } else {
            const float g = __expf(ret_lg(seq & 3) * 128.0f);
            for (int ch = 0; ch < 32; ++ch) {
                const size_t o = ((size_t)seq * 32 + ch) * 32768 + (size_t)e8 * 8;
                *(u32x4*)(CPREV + o) = pack8(st);
                float f[8]; unpack8(*(const u32x4*)(CLOC + o), f);
#pragma unroll
                for (int e = 0; e < 8; ++e) st[e] = g * st[e] + f[e];
            }
        }
    }
}

DI void phase_out(Ctx& C) {
    LAS float* av = (LAS float*)C.lds;
    LAS float* bv = av + 128;
    LAS float* mt = bv + 128;
    LAS float* isc = mt + 128;
    LAS float* den = isc + 128;
    LAS float* rs = den + 128;
    LAS float* P = rs + 1024;
    LAS float* Qs = P + 128 * 129;
    const float* IFG = (const float*)(C.ws + WS_IFG);
    const bf16* CPREV = (const bf16*)(C.ws + WS_CPREV);
    const float* NPREV = (const float*)(C.ws + WS_SMALL + SM_NPREV); const float* MPREV = (const float*)(C.ws + WS_SMALL + SM_MPREV);
    const int t = C.tid;
    for (int u = C.bid; u < 1024; u += C.G) {
        const int mixer = u >> 9, bh = (u >> 5) & 15, ch = u & 31, b = bh >> 2, h = bh & 3, t0 = b * SEQ + ch * CH;
        const bf16 *Qp, *Kp, *Vp; int ldq; const bf16* cp = CPREV + ((size_t)(mixer * 16 + bh) * 32 + ch) * 32768;
        float lg = 0.f;
        if (mixer == 0) {
            Qp = (const bf16*)(C.ws + WS_QC) + (size_t)t0 * D + h * 128; Kp = Qp + 512; ldq = D;
            Vp = (const bf16*)(C.ws + WS_MLV) + (size_t)t0 * D + h * 256;
            if (t < 128) mt[t] = logsigmoidf_(IFG[(size_t)(t0 + t) * 8 + 4 + h]);
            __syncthreads();
            if (t < 128) { float s = 0.f; for (int j = 0; j <= t; ++j) s += mt[j]; av[t] = s; bv[t] = IFG[(size_t)(t0 + t) * 8 + h] - s; }
            __syncthreads();
            if (t < 128) { float cm = -3.0e38f; for (int j = 0; j <= t; ++j) cm = fmaxf(cm, bv[j]);
                const float il = av[t] + MPREV[bh * 32 + ch], m = fmaxf(il, av[t] + cm); isc[t] = __expf(il - m); mt[t] = m; }
        } else {
            lg = ret_lg(h);
            Qp = (const bf16*)(C.ws + WS_RETQ) + (size_t)t0 * 512 + h * 128; Kp = (const bf16*)(C.ws + WS_RETK) + (size_t)t0 * 512 + h * 128; ldq = 512;
            Vp = (const bf16*)(C.ws + WS_RETV) + (size_t)t0 * D + h * 256;
            if (t < 128) isc[t] = __expf(lg * (float)(t + 1));
        }
        for (int e = t; e < 128 * 16; e += NTHR) { const int j = e >> 4, k8 = e & 15; float f[8]; unpack8(*(const u32x4*)(Qp + (size_t)j * ldq + k8 * 8), f);
#pragma unroll
            for (int i = 0; i < 8; ++i) Qs[j * 129 + k8 * 8 + i] = f[i]; }
        __syncthreads();
        for (int e = t; e < 128 * 128; e += NTHR) {
            const int j = e >> 7, s = e & 127; float p = 0.f;
            if (s <= j) {
                float d = 0.f;
#pragma unroll 4
                for (int k8 = 0; k8 < 16; ++k8) { float fk[8]; unpack8(*(const u32x4*)(Kp + (size_t)s * ldq + k8 * 8), fk);
#pragma unroll
                    for (int i = 0; i < 8; ++i) d += Qs[j * 129 + k8 * 8 + i] * fk[i]; }
                p = d * (mixer == 0 ? __expf(av[j] + bv[s] - mt[j]) : __expf(lg * (float)(j - s)));
            }
            P[j * 129 + s] = p;
        }
        __syncthreads();
        if (mixer == 0 && t < 128) { float s = 0.f; for (int i = 0; i < 128; ++i) s += P[t * 129 + i];
            float qn = 0.f; const float* np = NPREV + (bh * 32 + ch) * 128; for (int k = 0; k < 128; ++k) qn += Qs[t * 129 + k] * np[k];
            den[t] = fmaxf(fabsf(s + isc[t] * qn), __expf(-mt[t])); }
        __syncthreads();
        const float gain = (mixer == 0 ? C.ml_norm_g : C.ret_norm_g)[h * 256 + (t & 255)];
#pragma unroll 1
        for (int pass = 0; pass < 2; ++pass) {
            const int jh = t >> 8, v = t & 255, r0 = (pass * 2 + jh) * 32;
            float acc[32];
#pragma unroll
            for (int i = 0; i < 32; ++i) acc[i] = 0.f;
            const LAS float* qb = Qs + r0 * 129; const LAS float* pb = P + r0 * 129;
            for (int k = 0; k < 128; ++k) {
                const float cv = bf2f(cp[(size_t)v * 128 + k]);
#pragma unroll
                for (int i = 0; i < 32; ++i) acc[i] += qb[i * 129 + k] * cv;
            }
#pragma unroll
            for (int i = 0; i < 32; ++i) acc[i] *= isc[r0 + i];
            for (int s = 0; s < 128; ++s) {
                const float vv = bf2f(Vp[(size_t)s * D + v]);
#pragma unroll
                for (int i = 0; i < 32; ++i) acc[i] += pb[i * 129 + s] * vv;
            }
            if (mixer == 0) {
#pragma unroll
                for (int i = 0; i < 32; ++i) acc[i] = acc[i] / den[r0 + i];
            }
            const int wq = C.wave & 3;
#pragma unroll
            for (int i = 0; i < 32; ++i) { const float s1 = wave_sum(acc[i]); if (C.lane == 0) rs[wq * 128 + r0 + i] = s1; }
            __syncthreads();
#pragma unroll
            for (int i = 0; i < 32; ++i) { const int r = r0 + i; acc[i] -= (rs[r] + rs[128 + r] + rs[256 + r] + rs[384 + r]) * (1.0f / 256.0f); }
#pragma unroll
            for (int i = 0; i < 32; ++i) { const float s2 = wave_sum(acc[i] * acc[i]); if (C.lane == 0) rs[512 + wq * 128 + r0 + i] = s2; }
            __syncthreads();
            const bf16* gate = (const bf16*)(C.ws + (mixer == 0 ? WS_MLO : WS_RETG)) + (size_t)t0 * D + h * 256 + v;
            bf16* outp = (bf16*)(C.ws + (mixer == 0 ? WS_HML : WS_HRET)) + (size_t)t0 * D + h * 256 + v;
#pragma unroll
            for (int i = 0; i < 32; ++i) { const int r = r0 + i;
                const float var = (rs[512 + r] + rs[512 + 128 + r] + rs[512 + 256 + r] + rs[512 + 384 + r]) * (1.0f / 256.0f);
                const float y = acc[i] * (1.0f / sqrtf(var + EPS)) * gain * bf2f(gate[(size_t)r * D]);
                outp[(size_t)r * D] = (bf16)f2bf(y); }
            __syncthreads();
        }
    }
}

struct BF_plain { const float* w; DI const float* ptr(int, int tn) const { return w + tn * 128; } };
struct EF_f32 { float* dst; DI void put(int tm, int tn, int r, int c, const float (&v)[4]) const { *(f32x4*)(dst + (size_t)(tm * 128 + r) * D + tn * 128 + c) = (f32x4){v[0], v[1], v[2], v[3]}; } };
struct EF_merge { const float* t1; const bf16* g1; const bf16* g2; bf16* y;
    DI void put(int tm, int tn, int r, int c, const float (&v)[4]) const {
        const size_t o = (size_t)(tm * 128 + r) * D + tn * 128 + c; const f32x4 a = *(const f32x4*)(t1 + o);
        const u32x2 w1 = *(const u32x2*)(g1 + o), w2 = *(const u32x2*)(g2 + o);
        const float o0 = __uint_as_float(w1.x << 16) * a.x + __uint_as_float(w2.x << 16) * v[0], o1 = __uint_as_float(w1.x & 0xffff0000u) * a.y + __uint_as_float(w2.x & 0xffff0000u) * v[1];
        const float o2 = __uint_as_float(w1.y << 16) * a.z + __uint_as_float(w2.y << 16) * v[2], o3 = __uint_as_float(w1.y & 0xffff0000u) * a.w + __uint_as_float(w2.y & 0xffff0000u) * v[3];
        u32x2 w; w.x = pk2(o0, o1); w.y = pk2(o2, o3); *(u32x2*)(y + o) = w; } };
DI void phase_branch(Ctx& C) {
    AF_rows a1{(const bf16*)(C.ws + WS_HML), D}, a2{(const bf16*)(C.ws + WS_HRET), D}; BF_plain b1{C.w_bml}, b2{C.w_bret};
    EF_f32 e1{(float*)(C.ws + WS_TMP)}; EF_merge e2{(const float*)(C.ws + WS_TMP), (const bf16*)(C.ws + WS_GML), (const bf16*)(C.ws + WS_GRET), (bf16*)(C.ws + WS_H1)};
    const int nt = (T / 128) * 8;
    for (int u = C.bid; u < nt; u += C.G) { naive_gemm_tile(C, u / 8, u % 8, D, D, a1, b1, e1); naive_gemm_tile(C, u / 8, u % 8, D, D, a2, b2, e2); }
}
struct EF_resid { const float* x; const float* mod; float* x1;
    DI void put(int tm, int tn, int r, int c, const float (&v)[4]) const {
        const int row = tm * 128 + r, col = tn * 128 + c, b = row / SEQ; const size_t o = (size_t)row * D + col;
        const f32x4 xv = *(const f32x4*)(x + o), g = *(const f32x4*)(mod + b * 6144 + 2048 + col);
        *(f32x4*)(x1 + o) = xv + g * (f32x4){v[0], v[1], v[2], v[3]}; } };
DI void phase_outproj(Ctx& C) {
    AF_rows a{(const bf16*)(C.ws + WS_H1), D}; BF_plain b{C.w_out}; EF_resid e{C.x, (const float*)(C.ws + WS_MOD), (float*)(C.ws + WS_X1)};
    const int nt = (T / 128) * 8;
    for (int u = C.bid; u < nt; u += C.G) naive_gemm_tile(C, u / 8, u % 8, D, D, a, b, e);
}

DI void phase_norm2_route(Ctx& C) {
    LAS float* wr = (LAS float*)C.lds;
    LAS float* lg = wr + 32768;
    for (int i = C.tid; i < 32768 / 4; i += NTHR) *(LAS f32x4*)(wr + i * 4) = *(const f32x4*)(C.w_router + i * 4);
    __syncthreads();
    const float* mod = (const float*)(C.ws + WS_MOD); const float* X1 = (const float*)(C.ws + WS_X1);
    bf16* H2 = (bf16*)(C.ws + WS_H1);
    int* TOPI = (int*)(C.ws + WS_ROUTE + RT_TOPI); float* TOPW = (float*)(C.ws + WS_ROUTE + RT_TOPW); int* RANK = (int*)(C.ws + WS_ROUTE + RT_RANK);
    unsigned* CNT = (unsigned*)(C.ws + WS_CTL) + CW_CNT;
    const int lane = C.lane, gw = C.bid * NWAVES + C.wave, NGW = C.G * NWAVES;
    for (int m = gw; m < T; m += NGW) {
        const int b = m / SEQ;
        const f32x4* xr = (const f32x4*)(X1 + (size_t)m * D) + lane;
        f32x4 v[4]; float ss = 0.f;
#pragma unroll
        for (int j = 0; j < 4; ++j) { v[j] = xr[64 * j]; ss += (v[j].x * v[j].x + v[j].y * v[j].y) + (v[j].z * v[j].z + v[j].w * v[j].w); }
        const float rstd = 1.0f / sqrtf(wave_sum(ss) * (1.0f / D) + EPS);
        float acc[32];
#pragma unroll
        for (int e = 0; e < 32; ++e) acc[e] = 0.f;
        u32x2* o8 = (u32x2*)(H2 + (size_t)m * D) + lane;
#pragma unroll
        for (int j = 0; j < 4; ++j) {
            const int col = 4 * (lane + 64 * j);
            const f32x4 g = *(const f32x4*)(C.norm_ffn_g + col), sh = *(const f32x4*)(mod + b * 6144 + 3072 + col), sc = *(const f32x4*)(mod + b * 6144 + 4096 + col);
            const f32x4 h = (v[j] * rstd * g) * (sc + 1.0f) + sh;
            u32x2 w; w.x = pk2(h.x, h.y); w.y = pk2(h.z, h.w); o8[64 * j] = w;
            const float hh[4] = {h.x, h.y, h.z, h.w};
#pragma unroll
            for (int i = 0; i < 4; ++i) {
                const LAS f32x4* wp = (const LAS f32x4*)(wr + (col + i) * 32);
#pragma unroll
                for (int e4 = 0; e4 < 8; ++e4) { const f32x4 w4 = wp[e4]; acc[e4 * 4 + 0] += hh[i] * w4.x; acc[e4 * 4 + 1] += hh[i] * w4.y; acc[e4 * 4 + 2] += hh[i] * w4.z; acc[e4 * 4 + 3] += hh[i] * w4.w; }
                asm volatile("" ::: "memory");
            }
        }
#pragma unroll
        for (int e = 0; e < 32; ++e) acc[e] = wave_sum(acc[e]);
        float l[32];
#pragma unroll
        for (int e = 0; e < 32; ++e) l[e] = acc[e] + C.b_router[e];
        float tv[4]; int ti[4];
#pragma unroll
        for (int k = 0; k < 4; ++k) {
            float bvv = -3.0e38f; int bi = 0;
#pragma unroll
            for (int e = 0; e < 32; ++e) { const bool take = l[e] > bvv; bvv = take ? l[e] : bvv; bi = take ? e : bi; }
            tv[k] = bvv; ti[k] = bi;
#pragma unroll
            for (int e = 0; e < 32; ++e) l[e] = (e == bi) ? -3.0e38f : l[e];
        }
        const float e1 = __expf(tv[1] - tv[0]), e2 = __expf(tv[2] - tv[0]), e3 = __expf(tv[3] - tv[0]), inv = 1.0f / (1.0f + e1 + e2 + e3);
        if (lane < 4) {
            const int e = lane == 0 ? ti[0] : lane == 1 ? ti[1] : lane == 2 ? ti[2] : ti[3];
            const float w = (lane == 0 ? 1.0f : lane == 1 ? e1 : lane == 2 ? e2 : e3) * inv;
            TOPI[m * 4 + lane] = e; TOPW[m * 4 + lane] = w; RANK[m * 4 + lane] = (int)atomicAdd(CNT + e, 1u);
        }
    }
    (void)lg;
    int* SLOTTOK = (int*)(C.ws + WS_ROUTE + RT_SLOTTOK); float* SLOTW = (float*)(C.ws + WS_ROUTE + RT_SLOTW);
    for (int i = C.bid * NTHR + C.tid; i < NSLOTS; i += C.G * NTHR) { SLOTTOK[i] = T; SLOTW[i] = 0.f; }
    if (C.bid == 0) for (int i = C.tid; i < D / 2; i += NTHR) ((unsigned*)(H2 + (size_t)T * D))[i] = 0u;
    __syncthreads();
}

DI void phase_slots(Ctx& C) {
    LAS int* tot = (LAS int*)C.lds;
    LAS int* pstart = tot + 32;
    LAS int* base = pstart + 32;
    LAS int* part = base + 32;
    const unsigned* BLKCNT = (const unsigned*)(C.ws + WS_ROUTE + RT_BLKCNT);
    unsigned* ctl = (unsigned*)(C.ws + WS_CTL);
    const int* TOPI = (const int*)(C.ws + WS_ROUTE + RT_TOPI); const float* TOPW = (const float*)(C.ws + WS_ROUTE + RT_TOPW); const int* RANK = (const int*)(C.ws + WS_ROUTE + RT_RANK);
    int* ASLOT = (int*)(C.ws + WS_ROUTE + RT_ASLOT); int* SLOTTOK = (int*)(C.ws + WS_ROUTE + RT_SLOTTOK); float* SLOTW = (float*)(C.ws + WS_ROUTE + RT_SLOTW);
    for (int sg = C.bid; sg < T / 64; sg += C.G) {
        const int e = C.tid & 31, pt = C.tid >> 5;
        int sa = 0, sb = 0;
        for (int g2 = pt; g2 < T / 64; g2 += 16) { const int c = (int)BLKCNT[g2 * 32 + e]; sa += c; sb += (g2 < sg) ? c : 0; }
        part[(pt * 32 + e) * 2] = sa; part[(pt * 32 + e) * 2 + 1] = sb;
        __syncthreads();
        if (C.tid < 32) { int a = 0, b2 = 0; for (int p2 = 0; p2 < 16; ++p2) { a += part[(p2 * 32 + C.tid) * 2]; b2 += part[(p2 * 32 + C.tid) * 2 + 1]; } tot[C.tid] = a; base[C.tid] = b2; }
        __syncthreads();
        if (C.tid == 0) {
            int nb = 0;
            for (int e2 = 0; e2 < NE; ++e2) { pstart[e2] = nb * 256; const int bl = (tot[e2] + 255) >> 8;
                if (sg == 0) for (int i = 0; i < bl; ++i) ctl[CW_BLKE + nb + i] = (unsigned)e2;
                nb += bl; }
            if (sg == 0) ctl[CW_NBLK] = (unsigned)nb;
        }
        __syncthreads();
        if (C.tid < 256) { const int i = sg * 256 + C.tid, ex = TOPI[i];
            const int slot = pstart[ex] + base[ex] + RANK[i];
            ASLOT[i] = slot; SLOTTOK[slot] = i >> 2; SLOTW[slot] = TOPW[i]; }
        __syncthreads();
    }
}

struct AF_gather { const bf16* base; const int* slottok; DI const bf16* row(int tm, int r) const { return base + (size_t)slottok[tm * 128 + r] * D; } };
struct BF_expert { const float* w; const unsigned* blke; size_t estride; DI const float* ptr(int tm, int tn) const { return w + (size_t)blke[tm >> 1] * estride + tn * 128; } };
struct EF_swiglu { const float* bias; const unsigned* blke; bf16* act;
    DI void put(int tm, int tn, int r, int c, const float (&v)[4]) const {
        const int e = (int)blke[tm >> 1]; const float* bp = bias + (size_t)e * 2048 + tn * 128 + c;
        float o[2];
#pragma unroll
        for (int j = 0; j < 2; ++j) { const float xg = fminf(v[2 * j] + bp[2 * j], 7.0f), xl = fminf(fmaxf(v[2 * j + 1] + bp[2 * j + 1], -7.0f), 7.0f); o[j] = xg * sigmoidf_(1.702f * xg) * (xl + 1.0f); }
        *(unsigned*)(act + (size_t)(tm * 128 + r) * D + (tn * 128 + c) / 2) = pk2(o[0], o[1]); } };
DI void phase_gateup(Ctx& C) {
    const unsigned* ctl = (const unsigned*)(C.ws + WS_CTL); const int nblk = (int)ctl[CW_NBLK];
    AF_gather a{(const bf16*)(C.ws + WS_H1), (const int*)(C.ws + WS_ROUTE + RT_SLOTTOK)}; BF_expert b{C.w_gu, ctl + CW_BLKE, (size_t)D * 2048};
    EF_swiglu e{C.b_gu, ctl + CW_BLKE, (bf16*)(C.ws + WS_ACT)};
    const int nt = nblk * 2 * 16;
    for (int u = C.bid; u < nt; u += C.G) naive_gemm_tile(C, u / 16, u % 16, D, 2048, a, b, e);
}
struct EF_down { const float* bias; const unsigned* blke; const float* slotw; bf16* ys;
    DI void put(int tm, int tn, int r, int c, const float (&v)[4]) const {
        const int e = (int)blke[tm >> 1], slot = tm * 128 + r; const float w = slotw[slot]; const float* bp = bias + (size_t)e * D + tn * 128 + c;
        u32x2 o; o.x = pk2((v[0] + bp[0]) * w, (v[1] + bp[1]) * w); o.y = pk2((v[2] + bp[2]) * w, (v[3] + bp[3]) * w);
        *(u32x2*)(ys + (size_t)slot * D + tn * 128 + c) = o; } };
DI void phase_down(Ctx& C) {
    const unsigned* ctl = (const unsigned*)(C.ws + WS_CTL); const int nblk = (int)ctl[CW_NBLK];
    AF_rows a{(const bf16*)(C.ws + WS_ACT), D}; BF_expert b{C.w_dn, ctl + CW_BLKE, (size_t)D * D};
    EF_down e{C.b_dn, ctl + CW_BLKE, (const float*)(C.ws + WS_ROUTE + RT_SLOTW), (bf16*)(C.ws + WS_YS)};
    const int nt = nblk * 2 * 8;
    for (int u = C.bid; u < nt; u += C.G) naive_gemm_tile(C, u / 8, u % 8, D, D, a, b, e);
}
DI void phase_final(Ctx& C) {
    const float* mod = (const float*)(C.ws + WS_MOD); const float* X1 = (const float*)(C.ws + WS_X1); const bf16* YS = (const bf16*)(C.ws + WS_YS);
    const int* ASLOT = (const int*)(C.ws + WS_ROUTE + RT_ASLOT);
    const int lane = C.lane, gw = C.bid * NWAVES + C.wave, NGW = C.G * NWAVES;
    for (int m = gw; m < T; m += NGW) {
        const int b = m / SEQ;
        const int s0 = ASLOT[m * 4 + 0], s1 = ASLOT[m * 4 + 1], s2 = ASLOT[m * 4 + 2], s3 = ASLOT[m * 4 + 3];
        f32x4 v[4]; float ss = 0.f;
#pragma unroll
        for (int j = 0; j < 4; ++j) {
            const int col = 4 * (lane + 64 * j);
            f32x4 y = (f32x4){0.f, 0.f, 0.f, 0.f};
            const int sl[4] = {s0, s1, s2, s3};
#pragma unroll
            for (int k = 0; k < 4; ++k) { const u32x2 w = *(const u32x2*)(YS + (size_t)sl[k] * D + col);
                y += (f32x4){__uint_as_float(w.x << 16), __uint_as_float(w.x & 0xffff0000u), __uint_as_float(w.y << 16), __uint_as_float(w.y & 0xffff0000u)}; }
            const f32x4 g = *(const f32x4*)(mod + b * 6144 + 5120 + col);
            v[j] = *(const f32x4*)(X1 + (size_t)m * D + col) + g * y;
            ss += (v[j].x * v[j].x + v[j].y * v[j].y) + (v[j].z * v[j].z + v[j].w * v[j].w);
        }
        const float rstd = 1.0f / sqrtf(wave_sum(ss) * (1.0f / D) + EPS);
#pragma unroll
        for (int j = 0; j < 4; ++j) { const int col = 4 * (lane + 64 * j); *(f32x4*)(C.out + (size_t)m * D + col) = v[j] * rstd * *(const f32x4*)(C.norm_final_g + col); }
    }
}

namespace pg8 {
typedef short bf16x8 __attribute__((ext_vector_type(8)));
constexpr int BM = 256, BK = 64, HALF = 128, HTB = HALF * BK * 2, STAGE_BYTES = 8 * HTB, NXCD = 8, WGM = 8;
DI int lds_byte(int r, int c) { const int st = (r >> 4) * 2 + (c >> 5), rr = r & 15, cc = c & 31, ob = rr * 64 + cc * 2; return st * 1024 + (ob ^ (((ob >> 9) & 1) << 5)); }
DI void stage_rc(int b, int& R, int& C) { const int st = b / 1024, sb = b % 1024, swz = sb ^ (((sb >> 9) & 1) << 5); R = (st >> 1) * 16 + swz / 64; C = (st & 1) * 32 + (swz % 64) / 2; }
struct Unit { int pm, pn, aux; };
struct Gemm { const bf16* A; const bf16* Bt; int K; };
DI unsigned cvt_pk_bf16(float lo, float hi) { unsigned r; asm volatile("v_cvt_pk_bf16_f32 %0, %1, %2" : "=v"(r) : "v"(lo), "v"(hi)); return r; }

struct TileOrder {
    int nM, nN, nwg;
    DI void init(int nM_, int nN_) { nM = nM_; nN = nN_; nwg = nM * nN; }
    DI bool tile(long L, int& pm, int& pn) const {
        if (L >= nwg) return false;
        int wgid = (int)L; { const int q = nwg / NXCD, r = nwg % NXCD, xcd = wgid % NXCD, off = wgid / NXCD; wgid = (xcd < r ? xcd * (q + 1) : r * (q + 1) + (xcd - r) * q) + off; }
        const int nig = WGM * nN, gid = wgid / nig, fm = gid * WGM, gsz = (nM - fm) < WGM ? (nM - fm) : WGM;
        pm = fm + ((wgid % nig) % gsz); pn = (wgid % nig) / gsz; return true;
    }
};

template <class Epi, class Sched, bool ALIGN_EPI, bool SP2>
DI void gemm_phase(LAS unsigned char* lds, const Gemm g, const Sched& S, const Epi& E) {
    const int tid = threadIdx.x, wid = __builtin_amdgcn_readfirstlane(tid >> 6), lane = tid & 63, wr = wid >> 2, wc = wid & 3, fr = lane & 15, fq = lane >> 4;
    const int K = g.K, nt = K / BK;
    unsigned voffB[2]; int Rr[2]; unsigned cb[2];
#pragma unroll
    for (int i = 0; i < 2; ++i) { int R, C; stage_rc(tid * 16 + i * 8192, R, C); voffB[i] = (unsigned)(R * K + C) * 2u; Rr[i] = R; cb[i] = (unsigned)C * 2u; }
    const size_t kstep = (size_t)(BK * 2);
    const size_t hstep = (size_t)HALF * K * 2;
    const size_t tstep = 2 * hstep;
    const unsigned ldsw = (unsigned)wid * 1024u;
    const int aoff = lds_byte(wr * 64 + fr, fq * 8), boff = lds_byte(wc * 32 + fr, fq * 8);
    const unsigned rowb = (unsigned)K * 2u;
#define PG8_SA(b, h) (((b) * 2 + (h)) * HTB)
#define PG8_SB(b, h) ((4 + (b) * 2 + (h)) * HTB)
#define PG8_STAGE(bufoff, gbase, voff) do { _Pragma("unroll") for (int _i = 0; _i < 2; ++_i) \
        __builtin_amdgcn_global_load_lds((const unsigned*)((const char*)(gbase) + (voff)[_i]), (LAS unsigned*)(lds + (bufoff) + ldsw + _i * 8192), 16, 0, 0); } while (0)
#define PG8_LDA(dst, b, h) do { _Pragma("unroll") for (int m = 0; m < 4; ++m) _Pragma("unroll") for (int k = 0; k < 2; ++k) dst[m][k] = *(const LAS bf16x8*)(lds + PG8_SA(b, h) + aoff + m * 2048 + k * 1024); } while (0)
#define PG8_LDB(dst, b, h) do { _Pragma("unroll") for (int n = 0; n < 2; ++n) _Pragma("unroll") for (int k = 0; k < 2; ++k) dst[n][k] = *(const LAS bf16x8*)(lds + PG8_SB(b, h) + boff + n * 2048 + k * 1024); } while (0)
#define PG8_MMA(ai, bj, At, Bt) do { __builtin_amdgcn_s_setprio(1); _Pragma("unroll") for (int m = 0; m < 4; ++m) _Pragma("unroll") for (int n = 0; n < 2; ++n) _Pragma("unroll") for (int k = 0; k < 2; ++k) \
        acc[ai][bj][m][n] = __builtin_amdgcn_mfma_f32_16x16x32_bf16(Bt[n][k], At[m][k], acc[ai][bj][m][n], 0, 0, 0); __builtin_amdgcn_s_setprio(0); } while (0)
#define PG8_WAIT_V(n) asm volatile("s_waitcnt vmcnt(" #n ")" ::: "memory")
#define PG8_WAIT_L(n) asm volatile("s_waitcnt lgkmcnt(" #n ")" ::: "memory")
#define PG8_BAR __builtin_amdgcn_s_barrier()
#define PG8_SCHED __builtin_amdgcn_sched_barrier(0)
    Unit cur, nxt; int ui = 0;
    if (!S.next(0, cur)) return;
    f32x4 acc[2][2][4][2];
#pragma unroll
    for (int a = 0; a < 2; ++a)
#pragma unroll
        for (int b = 0; b < 2; ++b)
#pragma unroll
            for (int m = 0; m < 4; ++m)
#pragma unroll
                for (int n = 0; n < 2; ++n) acc[a][b][m][n] = (f32x4){0.f, 0.f, 0.f, 0.f};
    bf16x8 At[4][2], B0[2][2], B1[2][2];
    const char* Ab = (const char*)g.A;
    const char* cB = (const char*)g.Bt + (size_t)cur.pn * tstep;
    unsigned c0[2], c1[2], n0[2], n1[2];
#pragma unroll
    for (int i = 0; i < 2; ++i) { c0[i] = (unsigned)S.arow(cur, Rr[i]) * rowb + cb[i]; c1[i] = (unsigned)S.arow(cur, HALF + Rr[i]) * rowb + cb[i]; n0[i] = c0[i]; n1[i] = c1[i]; }
    if constexpr (SP2) {
        PG8_STAGE(PG8_SB(0, 0), cB, voffB); PG8_STAGE(PG8_SB(0, 1), cB + hstep, voffB); PG8_STAGE(PG8_SA(0, 0), Ab, c0); PG8_STAGE(PG8_SA(0, 1), Ab, c1);
        if (wr == 1) PG8_BAR;
        PG8_WAIT_V(2); PG8_BAR;
        PG8_STAGE(PG8_SB(1, 0), cB + kstep, voffB); PG8_STAGE(PG8_SA(1, 0), Ab + kstep, c0); PG8_STAGE(PG8_SB(1, 1), cB + hstep + kstep, voffB);
        PG8_WAIT_V(6); PG8_BAR;
    } else {
        PG8_STAGE(PG8_SB(0, 0), cB, voffB); PG8_STAGE(PG8_SA(0, 0), Ab, c0); PG8_STAGE(PG8_SB(0, 1), cB + hstep, voffB); PG8_STAGE(PG8_SA(0, 1), Ab, c1);
        if (wr == 1) PG8_BAR;
        PG8_WAIT_V(4); PG8_BAR;
        PG8_STAGE(PG8_SB(1, 0), cB + kstep, voffB); PG8_STAGE(PG8_SA(1, 0), Ab + kstep, c0); PG8_STAGE(PG8_SB(1, 1), cB + hstep + kstep, voffB);
        PG8_WAIT_V(6); PG8_BAR;
    }
    for (;;) {
        const bool has_next = S.next(ui + 1, nxt);
        const char* nB = has_next ? (const char*)g.Bt + (size_t)nxt.pn * tstep : cB;
        if (has_next) {
#pragma unroll
            for (int i = 0; i < 2; ++i) { n0[i] = (unsigned)S.arow(nxt, Rr[i]) * rowb + cb[i]; n1[i] = (unsigned)S.arow(nxt, HALF + Rr[i]) * rowb + cb[i]; }
        } else {
#pragma unroll
            for (int i = 0; i < 2; ++i) { n0[i] = c0[i]; n1[i] = c1[i]; }
        }
        for (int t = 0; t < nt; t += 2) {
            const bool last = (t == nt - 2);
            const char* a1 = Ab + (size_t)(t + 1) * kstep;
            const char* a2 = last ? Ab : Ab + (size_t)(t + 2) * kstep; const char* b2 = last ? nB : cB + (size_t)(t + 2) * kstep;
            const char* a3 = a2 + kstep; const char* b3 = b2 + kstep;
            unsigned x0[2], x1[2];
#pragma unroll
            for (int i = 0; i < 2; ++i) { x0[i] = last ? n0[i] : c0[i]; x1[i] = last ? n1[i] : c1[i]; }
            if constexpr (SP2) {
            PG8_LDB(B0, 0, 0); PG8_LDB(B1, 0, 1); PG8_SCHED; PG8_LDA(At, 0, 0); PG8_STAGE(PG8_SA(1, 1), a1, c1);
            PG8_WAIT_V(8); PG8_WAIT_L(0); PG8_BAR; PG8_MMA(0, 0, At, B0); PG8_MMA(0, 1, At, B1); PG8_BAR; PG8_SCHED;
            PG8_LDA(At, 0, 1); PG8_STAGE(PG8_SB(0, 0), b2, voffB); PG8_STAGE(PG8_SB(0, 1), b2 + hstep, voffB); PG8_STAGE(PG8_SA(0, 0), a2, x0);
            PG8_WAIT_V(8); PG8_WAIT_L(0); PG8_BAR; PG8_MMA(1, 0, At, B0); PG8_MMA(1, 1, At, B1); PG8_BAR; PG8_SCHED;
            PG8_LDB(B0, 1, 0); PG8_LDB(B1, 1, 1); PG8_SCHED; PG8_LDA(At, 1, 0); PG8_STAGE(PG8_SA(0, 1), a2, x1);
            PG8_WAIT_V(8); PG8_WAIT_L(0); PG8_BAR; PG8_MMA(0, 0, At, B0); PG8_MMA(0, 1, At, B1); PG8_BAR; PG8_SCHED;
            PG8_LDA(At, 1, 1); PG8_STAGE(PG8_SB(1, 0), b3, voffB); PG8_STAGE(PG8_SB(1, 1), b3 + hstep, voffB); PG8_STAGE(PG8_SA(1, 0), a3, x0);
            PG8_WAIT_V(8); PG8_WAIT_L(0); PG8_BAR; PG8_MMA(1, 0, At, B0); PG8_MMA(1, 1, At, B1); PG8_BAR; PG8_SCHED;
            } else {
            PG8_LDB(B0, 0, 0); PG8_SCHED; PG8_LDA(At, 0, 0); PG8_STAGE(PG8_SA(1, 1), a1, c1);
            PG8_WAIT_L(8); PG8_BAR; PG8_WAIT_L(0); PG8_MMA(0, 0, At, B0); PG8_BAR; PG8_SCHED;
            PG8_LDB(B1, 0, 1); PG8_STAGE(PG8_SB(0, 0), b2, voffB);
            PG8_BAR; PG8_WAIT_L(0); PG8_MMA(0, 1, At, B1); PG8_BAR;
            PG8_LDA(At, 0, 1); PG8_STAGE(PG8_SA(0, 0), a2, x0);
            PG8_BAR; PG8_WAIT_L(0); PG8_MMA(1, 0, At, B0); PG8_BAR; PG8_SCHED;
            PG8_STAGE(PG8_SB(0, 1), b2 + hstep, voffB);
            PG8_WAIT_V(6); PG8_BAR; PG8_MMA(1, 1, At, B1); PG8_BAR;
            PG8_LDB(B0, 1, 0); PG8_SCHED; PG8_LDA(At, 1, 0); PG8_STAGE(PG8_SA(0, 1), a2, x1);
            PG8_WAIT_L(8); PG8_BAR; PG8_WAIT_L(0); PG8_MMA(0, 0, At, B0); PG8_BAR; PG8_SCHED;
            PG8_LDB(B1, 1, 1); PG8_STAGE(PG8_SB(1, 0), b3, voffB);
            PG8_BAR; PG8_WAIT_L(0); PG8_MMA(0, 1, At, B1); PG8_BAR;
            PG8_LDA(At, 1, 1); PG8_STAGE(PG8_SA(1, 0), a3, x0);
            PG8_BAR; PG8_WAIT_L(0); PG8_MMA(1, 0, At, B0); PG8_BAR; PG8_SCHED;
            PG8_STAGE(PG8_SB(1, 1), b3 + hstep, voffB);
            PG8_WAIT_V(6); PG8_BAR; PG8_MMA(1, 1, At, B1); PG8_BAR;
            }
        }
        if constexpr (ALIGN_EPI) { if (wr == 0) PG8_BAR; }
        const bool keep = E(acc, cur, wr, wc, fr, fq);
        if (!has_next) break;
        if (!keep) {
#pragma unroll
            for (int a = 0; a < 2; ++a)
#pragma unroll
                for (int b = 0; b < 2; ++b)
#pragma unroll
                    for (int m = 0; m < 4; ++m)
#pragma unroll
                        for (int n = 0; n < 2; ++n) acc[a][b][m][n] = (f32x4){0.f, 0.f, 0.f, 0.f};
        }
        cur = nxt; cB = nB; ++ui;
#pragma unroll
        for (int i = 0; i < 2; ++i) { c0[i] = n0[i]; c1[i] = n1[i]; }
        if constexpr (ALIGN_EPI) { if (wr == 1) PG8_BAR; }
    }
    PG8_WAIT_V(0);
    if constexpr (!ALIGN_EPI) { if (wr == 0) PG8_BAR; }
    PG8_BAR;
#undef PG8_SA
#undef PG8_SB
#undef PG8_STAGE
#undef PG8_LDA
#undef PG8_LDB
#undef PG8_MMA
#undef PG8_WAIT_V
#undef PG8_WAIT_L
#undef PG8_BAR
#undef PG8_SCHED
}
}

DI int pos_bf8(int o) { const int o32 = o & 31; return (o & ~31) | (16 * ((o32 >> 2) & 1) + 4 * (o32 >> 3) + (o32 & 3)); }
DI int pos_rope(int o) { const int head = o >> 7, bj = (o >> 6) & 1, r = o & 63, w = r >> 5, fq = (r >> 3) & 3, n = (r >> 2) & 1, j = r & 3; return 128 * bj + 32 * (2 * head + w) + 16 * n + 4 * fq + j; }
DI int pos_swiglu(int o) { const int wc = o >> 6, fq = (o >> 4) & 3, bj = (o >> 3) & 1, n = (o >> 2) & 1, j = o & 3; return 128 * bj + 32 * wc + 16 * n + 4 * fq + j; }
template <int PT  >
DI void tr_item(const float* src, int ldw, int K, bf16* WT, int tile_row0, int o0  , int k0, LAS float* scr, int lane) {
    float v[32];
#pragma unroll
    for (int i = 0; i < 32; ++i) { const int kk = 2 * i + (lane >> 5); v[i] = src[(size_t)kk * ldw + (lane & 31)]; }
#pragma unroll
    for (int i = 0; i < 32; ++i) { const int kk = 2 * i + (lane >> 5); scr[kk * 33 + (lane & 31)] = v[i]; }
    asm volatile("s_waitcnt lgkmcnt(0)" ::: "memory");
    const int c = lane & 7;
#pragma unroll
    for (int j = 0; j < 4; ++j) { const int n = (lane >> 3) + 8 * j; const LAS float* s = scr + (8 * c) * 33 + n;
        u32x4 o; o.x = pk2(s[0 * 33], s[1 * 33]); o.y = pk2(s[2 * 33], s[3 * 33]); o.z = pk2(s[4 * 33], s[5 * 33]); o.w = pk2(s[6 * 33], s[7 * 33]);
        const int oc = o0 + n; const int p = PT == 0 ? oc : PT == 1 ? pos_bf8(oc) : PT == 2 ? pos_rope(oc) : pos_swiglu(oc);
        *(u32x4*)(WT + (size_t)(tile_row0 + p) * K + k0 + 8 * c) = o; }
    asm volatile("s_waitcnt lgkmcnt(0)" ::: "memory");
}
DI void convert_weights(Ctx& C) {
    LAS float* scr = (LAS float*)(C.lds + C.wave * 16384);
    const int gw = C.bid * NWAVES + C.wave, NGW = C.G * NWAVES, lane = C.lane;
    bf16* WT_IN = (bf16*)(C.ws + WS_WT_IN); bf16* WT_BR = (bf16*)(C.ws + WS_WT_BR); bf16* WT_OUT = (bf16*)(C.ws + WS_WT_OUT); bf16* WT_GU = (bf16*)(C.ws + WS_WT_GU); bf16* WT_DN = (bf16*)(C.ws + WS_WT_DN);
    constexpr int I_IN = 16 * 256, I_SQ = 16 * 32, I_GU = 32 * 16 * 64, I_DN = 32 * 16 * 32;
    constexpr int NITEMS = I_IN + 3 * I_SQ + I_GU + I_DN;
    for (int it = gw; it < NITEMS; it += NGW) {
        int r = it;
        if (r < I_IN) { const int kb = r >> 8, nb = r & 255, n0 = nb * 32, sc = n0 < 3072 ? n0 : n0 + 8, tile = n0 >> 8;
            const float* src = C.w_in + (size_t)(kb * 64) * DIN + sc;
            if (tile >= 12 && tile < 16) tr_item<2>(src, DIN, D, WT_IN, tile * 256, n0 & 255, kb * 64, scr, lane); else tr_item<1>(src, DIN, D, WT_IN, tile * 256, n0 & 255, kb * 64, scr, lane);
            continue; } r -= I_IN;
        if (r < 2 * I_SQ) { const int which = r >> 9, q = r & 511, kb = q >> 5, nb = q & 31, n0 = nb * 32;
            const float* src = (which ? C.w_bret : C.w_bml) + (size_t)(kb * 64) * D + n0;
            tr_item<1>(src, D, D, WT_BR, which * 1024 + (n0 & ~255), n0 & 255, kb * 64, scr, lane); continue; } r -= 2 * I_SQ;
        if (r < I_SQ) { const int kb = r >> 5, nb = r & 31, n0 = nb * 32;
            tr_item<0>(C.w_out + (size_t)(kb * 64) * D + n0, D, D, WT_OUT, n0 & ~255, n0 & 255, kb * 64, scr, lane); continue; } r -= I_SQ;
        if (r < I_GU) { const int e = r >> 10, q = r & 1023, kb = q >> 6, nb = q & 63, n0 = nb * 32;
            tr_item<3>(C.w_gu + (size_t)e * D * 2048 + (size_t)(kb * 64) * 2048 + n0, 2048, D, WT_GU, e * 2048 + (n0 & ~255), n0 & 255, kb * 64, scr, lane); continue; } r -= I_GU;
        { const int e = r >> 9, q = r & 511, kb = q >> 5, nb = q & 31, n0 = nb * 32;
            tr_item<1>(C.w_dn + (size_t)e * D * D + (size_t)(kb * 64) * D + n0, D, D, WT_DN, e * 1024 + (n0 & ~255), n0 & 255, kb * 64, scr, lane); }
    }
}

struct SchedDense { pg8::TileOrder o; int G, c;
    DI bool next(int i, pg8::Unit& u) const { int pm, pn; if (!o.tile((long)i * G + c, pm, pn)) return false; u.pm = pm; u.pn = pn; u.aux = 0; return true; }
    DI int arow(const pg8::Unit& u, int r) const { return u.pm * 256 + r; } };
DI u32x4 pack8v(const f32x4 a, const f32x4 b) { u32x4 w; w.x = pg8::cvt_pk_bf16(a.x, a.y); w.y = pg8::cvt_pk_bf16(a.z, a.w); w.z = pg8::cvt_pk_bf16(b.x, b.y); w.w = pg8::cvt_pk_bf16(b.z, b.w); return w; }
DI f32x4 sig4(const f32x4 v) { return (f32x4){sigmoidf_(v.x), sigmoidf_(v.y), sigmoidf_(v.z), sigmoidf_(v.w)}; }
DI f32x4 silu4(const f32x4 v) { return (f32x4){siluf_(v.x), siluf_(v.y), siluf_(v.z), siluf_(v.w)}; }
DI void unpack8v(const u32x4 w, f32x4& a, f32x4& b) { a = (f32x4){__uint_as_float(w.x << 16), __uint_as_float(w.x & 0xffff0000u), __uint_as_float(w.y << 16), __uint_as_float(w.y & 0xffff0000u)};
    b = (f32x4){__uint_as_float(w.z << 16), __uint_as_float(w.z & 0xffff0000u), __uint_as_float(w.w << 16), __uint_as_float(w.w & 0xffff0000u)}; }

struct EpiInproj { unsigned char* ws;
    DI bool operator()(f32x4 (&acc)[2][2][4][2], const pg8::Unit& u, int wr, int wc, int fr, int fq) const {
        const int seg = u.pn >> 2, row0 = u.pm * 256 + wr * 64 + fr;
        if (seg == 3) {
            const int which = (u.pn >> 1) & 1, head = 2 * (u.pn & 1) + (wc >> 1), i0 = 32 * (wc & 1) + 8 * fq;
            bf16* dst = (bf16*)(ws + (which ? WS_RETK : WS_RETQ)); const float sc = which ? 0.08838834764831845f : 1.0f;
            const float* COS = (const float*)(ws + WS_COS); const float* SIN = (const float*)(ws + WS_SIN);
#pragma unroll
            for (int ai = 0; ai < 2; ++ai)
#pragma unroll
                for (int m = 0; m < 4; ++m) { const int row = row0 + ai * 128 + m * 16;
                    const f32x4 c0 = *(const f32x4*)(COS + (size_t)row * 64 + i0) * sc, c1 = *(const f32x4*)(COS + (size_t)row * 64 + i0 + 4) * sc;
                    const f32x4 s0 = *(const f32x4*)(SIN + (size_t)row * 64 + i0) * sc, s1 = *(const f32x4*)(SIN + (size_t)row * 64 + i0 + 4) * sc;
                    const f32x4 x1a = acc[ai][0][m][0], x1b = acc[ai][0][m][1], x2a = acc[ai][1][m][0], x2b = acc[ai][1][m][1];
                    bf16* rp = dst + (size_t)row * 512 + head * 128 + i0;
                    *(u32x4*)rp = pack8v(x1a * c0 - x2a * s0, x1b * c1 - x2b * s1);
                    *(u32x4*)(rp + 64) = pack8v(x2a * c0 + x1a * s0, x2b * c1 + x1b * s1);
                    asm volatile("" ::: "memory"); }
            return false;
        }
        bf16* dst; int act = 0;
        switch (seg) { case 0: dst = (bf16*)(ws + WS_QKRAW); break; case 1: dst = (bf16*)(ws + WS_MLV); break; case 2: dst = (bf16*)(ws + WS_MLO); act = 1; break;
            case 4: dst = (bf16*)(ws + WS_RETV); break; case 5: dst = (bf16*)(ws + WS_RETG); act = 2; break; case 6: dst = (bf16*)(ws + WS_GML); act = 1; break; default: dst = (bf16*)(ws + WS_GRET); act = 1; break; }
        const int col0 = (u.pn & 3) * 256 + wc * 32 + 8 * fq;
#pragma unroll
        for (int ai = 0; ai < 2; ++ai)
#pragma unroll
            for (int m = 0; m < 4; ++m) { bf16* rp = dst + (size_t)(row0 + ai * 128 + m * 16) * D + col0;
#pragma unroll
                for (int bj = 0; bj < 2; ++bj) { f32x4 v0 = acc[ai][bj][m][0], v1 = acc[ai][bj][m][1];
                    if (act == 1) { v0 = sig4(v0); v1 = sig4(v1); } else if (act == 2) { v0 = silu4(v0); v1 = silu4(v1); }
                    *(u32x4*)(rp + bj * 128) = pack8v(v0, v1); } }
        return false;
    } };
DI void phase_inproj_mfma(Ctx& C) {
    pg8::Gemm g{(const bf16*)(C.ws + WS_H1), (const bf16*)(C.ws + WS_WT_IN), D};
    SchedDense S; S.o.init(T / 256, 32); S.G = C.G; S.c = C.bid;
    EpiInproj E{C.ws};
    pg8::gemm_phase<EpiInproj, SchedDense, true, true>(C.lds, g, S, E);
}

struct SchedBranch { pg8::TileOrder o; int G, c;
    DI bool next(int i, pg8::Unit& u) const { int pm, pn; if (!o.tile((long)(i >> 1) * G + c, pm, pn)) return false; const int seg = i & 1; u.pm = seg * 64 + pm; u.pn = seg * 4 + pn; u.aux = seg; return true; }
    DI int arow(const pg8::Unit& u, int r) const { return u.pm * 256 + r; } };
struct EpiBranch { const bf16* g1; const bf16* g2; bf16* y;
    DI bool operator()(f32x4 (&acc)[2][2][4][2], const pg8::Unit& u, int wr, int wc, int fr, int fq) const {
        const int seg = u.aux, row0 = (u.pm & 63) * 256 + wr * 64 + fr, col0 = (u.pn & 3) * 256 + wc * 32 + 8 * fq;
#pragma unroll
        for (int ai = 0; ai < 2; ++ai)
#pragma unroll
            for (int m = 0; m < 4; ++m) { const size_t o = (size_t)(row0 + ai * 128 + m * 16) * D + col0;
#pragma unroll
                for (int bj = 0; bj < 2; ++bj) {
                    f32x4 b0, b1; unpack8v(*(const u32x4*)(g2 + o + bj * 128), b0, b1);
                    if (seg == 0) { f32x4 a0, a1; unpack8v(*(const u32x4*)(g1 + o + bj * 128), a0, a1);
#pragma unroll
                        for (int j = 0; j < 4; ++j) { acc[ai][bj][m][0][j] *= a0[j] / fmaxf(b0[j], 1e-12f); acc[ai][bj][m][1][j] *= a1[j] / fmaxf(b1[j], 1e-12f); }
                    } else *(u32x4*)(y + o + bj * 128) = pack8v(acc[ai][bj][m][0] * b0, acc[ai][bj][m][1] * b1);
                }
                asm volatile("" ::: "memory"); }
        return seg == 0;
    } };
DI void phase_branch_mfma(Ctx& C) {
    pg8::Gemm g{(const bf16*)(C.ws + WS_HML), (const bf16*)(C.ws + WS_WT_BR), D};
    SchedBranch S; S.o.init(T / 256, 4); S.G = C.G; S.c = C.bid;
    EpiBranch E{(const bf16*)(C.ws + WS_GML), (const bf16*)(C.ws + WS_GRET), (bf16*)(C.ws + WS_H1)};
    pg8::gemm_phase<EpiBranch, SchedBranch, true, true>(C.lds, g, S, E);
}
struct EpiOut { const float* x; const float* mod; float* x1;
    DI bool operator()(f32x4 (&acc)[2][2][4][2], const pg8::Unit& u, int wr, int wc, int fr, int fq) const {
        const int row0 = u.pm * 256 + wr * 64 + fr, col0 = u.pn * 256 + wc * 32 + 4 * fq; const int b = (u.pm * 256) / SEQ;
        f32x4 gv[2][2];
#pragma unroll
        for (int bj = 0; bj < 2; ++bj)
#pragma unroll
            for (int n = 0; n < 2; ++n) gv[bj][n] = *(const f32x4*)(mod + b * 6144 + 2048 + col0 + bj * 128 + n * 16);
#pragma unroll
        for (int ai = 0; ai < 2; ++ai)
#pragma unroll
            for (int m = 0; m < 4; ++m) { const size_t o = (size_t)(row0 + ai * 128 + m * 16) * D + col0;
#pragma unroll
                for (int bj = 0; bj < 2; ++bj)
#pragma unroll
                    for (int n = 0; n < 2; ++n) *(f32x4*)(x1 + o + bj * 128 + n * 16) = *(const f32x4*)(x + o + bj * 128 + n * 16) + gv[bj][n] * acc[ai][bj][m][n];
                asm volatile("" ::: "memory"); }
        return false;
    } };
DI void phase_outproj_mfma(Ctx& C) {
    pg8::Gemm g{(const bf16*)(C.ws + WS_H1), (const bf16*)(C.ws + WS_WT_OUT), D};
    SchedDense S; S.o.init(T / 256, 4); S.G = C.G; S.c = C.bid;
    EpiOut E{C.x, (const float*)(C.ws + WS_MOD), (float*)(C.ws + WS_X1)};
    pg8::gemm_phase<EpiOut, SchedDense, false, true>(C.lds, g, S, E);
}
struct SchedMoe { const unsigned* blke; const int* slottok; int nunits, ntn, G, c;
    DI bool next(int i, pg8::Unit& u) const { const long L = (long)i * G + c; if (L >= nunits) return false; const int bi = (int)(L / ntn), pn = (int)(L % ntn);
        const int e = (int)__builtin_amdgcn_readfirstlane((int)blke[bi]); u.pm = bi; u.pn = e * ntn + pn; u.aux = e | (pn << 8); return true; }
    DI int arow(const pg8::Unit& u, int r) const { return slottok ? slottok[u.pm * 256 + r] : u.pm * 256 + r; } };
struct EpiSwiglu { const float* bias; bf16* act;
    DI bool operator()(f32x4 (&acc)[2][2][4][2], const pg8::Unit& u, int wr, int wc, int fr, int fq) const {
        const int e = u.aux & 255, pn = u.aux >> 8, slot0 = u.pm * 256 + wr * 64 + fr;
        const float* bp = bias + (size_t)e * 2048 + pn * 256 + 64 * wc + 16 * fq;
        f32x4 bv[2][2];
#pragma unroll
        for (int bj = 0; bj < 2; ++bj)
#pragma unroll
            for (int n = 0; n < 2; ++n) bv[bj][n] = *(const f32x4*)(bp + 8 * bj + 4 * n);
#pragma unroll
        for (int ai = 0; ai < 2; ++ai)
#pragma unroll
            for (int m = 0; m < 4; ++m) { float o[8];
#pragma unroll
                for (int bj = 0; bj < 2; ++bj)
#pragma unroll
                    for (int n = 0; n < 2; ++n) { const f32x4 v = acc[ai][bj][m][n] + bv[bj][n];
#pragma unroll
                        for (int p = 0; p < 2; ++p) { const float xg = fminf(v[2 * p], 7.0f), xl = fminf(fmaxf(v[2 * p + 1], -7.0f), 7.0f); o[4 * bj + 2 * n + p] = xg * sigmoidf_(1.702f * xg) * (xl + 1.0f); } }
                u32x4 w; w.x = pg8::cvt_pk_bf16(o[0], o[1]); w.y = pg8::cvt_pk_bf16(o[2], o[3]); w.z = pg8::cvt_pk_bf16(o[4], o[5]); w.w = pg8::cvt_pk_bf16(o[6], o[7]);
                *(u32x4*)(act + (size_t)(slot0 + ai * 128 + m * 16) * D + pn * 128 + 32 * wc + 8 * fq) = w; }
        return false;
    } };
struct EpiDown { const float* bias; const float* slotw; bf16* ys;
    DI bool operator()(f32x4 (&acc)[2][2][4][2], const pg8::Unit& u, int wr, int wc, int fr, int fq) const {
        const int e = u.aux & 255, pn = u.aux >> 8, slot0 = u.pm * 256 + wr * 64 + fr, col0 = pn * 256 + wc * 32 + 8 * fq;
        f32x4 bv[2][2];
#pragma unroll
        for (int bj = 0; bj < 2; ++bj)
#pragma unroll
            for (int n = 0; n < 2; ++n) bv[bj][n] = *(const f32x4*)(bias + (size_t)e * D + col0 + bj * 128 + 4 * n);
#pragma unroll
        for (int ai = 0; ai < 2; ++ai)
#pragma unroll
            for (int m = 0; m < 4; ++m) { const int slot = slot0 + ai * 128 + m * 16; const float w = slotw[slot];
#pragma unroll
                for (int bj = 0; bj < 2; ++bj) *(u32x4*)(ys + (size_t)slot * D + col0 + bj * 128) = pack8v((acc[ai][bj][m][0] + bv[bj][0]) * w, (acc[ai][bj][m][1] + bv[bj][1]) * w); }
        return false;
    } };
DI void phase_gateup_mfma(Ctx& C) {
    unsigned* ctl = (unsigned*)(C.ws + WS_CTL); const int nblk = (int)__builtin_amdgcn_readfirstlane((int)__hip_atomic_load(ctl + CW_NBLK, __ATOMIC_RELAXED, __HIP_MEMORY_SCOPE_AGENT));
    pg8::Gemm g{(const bf16*)(C.ws + WS_H1), (const bf16*)(C.ws + WS_WT_GU), D};
    SchedMoe S{ctl + CW_BLKE, (const int*)(C.ws + WS_ROUTE + RT_SLOTTOK), nblk * 8, 8, C.G, C.bid};
    EpiSwiglu E{C.b_gu, (bf16*)(C.ws + WS_ACT)};
    pg8::gemm_phase<EpiSwiglu, SchedMoe, true, true>(C.lds, g, S, E);
}
DI void phase_down_mfma(Ctx& C) {
    unsigned* ctl = (unsigned*)(C.ws + WS_CTL); const int nblk = (int)__builtin_amdgcn_readfirstlane((int)__hip_atomic_load(ctl + CW_NBLK, __ATOMIC_RELAXED, __HIP_MEMORY_SCOPE_AGENT));
    pg8::Gemm g{(const bf16*)(C.ws + WS_ACT), (const bf16*)(C.ws + WS_WT_DN), D};
    SchedMoe S{ctl + CW_BLKE, nullptr, nblk * 4, 4, C.G, C.bid};
    EpiDown E{C.b_dn, (const float*)(C.ws + WS_ROUTE + RT_SLOTW), (bf16*)(C.ws + WS_YS)};
    pg8::gemm_phase<EpiDown, SchedMoe, true, true>(C.lds, g, S, E);
}

typedef short s16x4 __attribute__((ext_vector_type(4)));
typedef short bf16x8 __attribute__((ext_vector_type(8)));
DI unsigned off_b(unsigned row, unsigned ch) { return 256u * row + 16u * (ch ^ (((row & 3u) << 2) | ((row >> 2) & 3u))); }
DI s16x4 tr_read(LAS unsigned char* p) { return __builtin_amdgcn_ds_read_tr16_b64_v4i16((LAS s16x4*)p); }
DI bf16x8 cat8(const s16x4 lo, const s16x4 hi) { return __builtin_shufflevector(lo, hi, 0, 1, 2, 3, 4, 5, 6, 7); }
DI bf16x8 row_read(LAS unsigned char* img, unsigned row, unsigned ch) { return *(const LAS bf16x8*)(img + off_b(row, ch)); }
#define MFMA16(a, b, c) __builtin_amdgcn_mfma_f32_16x16x32_bf16((a), (b), (c), 0, 0, 0)
DI void fill_image(LAS unsigned char* img, const bf16* src, int ld, int nrows, int tid) {
    for (int e = tid; e < nrows * 16; e += NTHR) { const int row = e >> 4, ch = e & 15; *(LAS u32x4*)(img + off_b(row, ch)) = *(const u32x4*)(src + (size_t)row * ld + ch * 8); }
}

DI void phase_local_mfma(Ctx& C) {
    LAS unsigned char* Kimg = C.lds; LAS unsigned char* Vimg = C.lds + 32768;
    LAS float* lf = (LAS float*)(C.lds + 98304); LAS float* bvl = lf + 128; LAS float* wsv = bvl + 128; LAS float* nl = wsv + 128;
    const float* IFG = (const float*)(C.ws + WS_IFG);
    bf16* CLOC = (bf16*)(C.ws + WS_CLOC);
    float* NLOC = (float*)(C.ws + WS_SMALL + SM_NLOC); float* MLOC = (float*)(C.ws + WS_SMALL + SM_MLOC); float* ACH = (float*)(C.ws + WS_SMALL + SM_ACH);
    float* AG = (float*)(C.ws + WS_SMALL + SM_AG); float* CMG = (float*)(C.ws + WS_SMALL + SM_CMG);
    const int t = C.tid, lane = C.lane, w = C.wave, g = lane >> 4, q = (lane & 15) >> 2, p = lane & 3;
    for (int u = C.bid; u < 1024; u += C.G) {
        const int mixer = u >> 9, bh = (u >> 5) & 15, ch = u & 31, b = bh >> 2, h = bh & 3, t0 = b * SEQ + ch * CH;
        const bf16 *Kp, *Vp; int ldk;
        if (mixer == 0) {
            float iv = 0.f;
            if (t < 128) { lf[t] = logsigmoidf_(IFG[(size_t)(t0 + t) * 8 + 4 + h]); iv = IFG[(size_t)(t0 + t) * 8 + h]; nl[t] = 0.f; }
            __syncthreads();
            if (t < 128) { float s = 0.f; for (int j = 0; j <= t; ++j) s += lf[j]; bvl[t] = iv - s; AG[bh * SEQ + ch * CH + t] = s; if (t == 127) wsv[0] = s; }
            __syncthreads();
            float gm = -3.0e38f, cm = -3.0e38f; const float Aall = wsv[0];
            if (t < 128) { for (int j = 0; j < 128; ++j) { const float x = bvl[j]; gm = fmaxf(gm, x); cm = (j <= t) ? fmaxf(cm, x) : cm; } CMG[bh * SEQ + ch * CH + t] = cm; }
            __syncthreads();
            if (t < 128) wsv[t] = __expf(bvl[t] - gm);
            if (t == 0) { MLOC[bh * 32 + ch] = Aall + gm; ACH[bh * 32 + ch] = Aall; }
            Kp = (const bf16*)(C.ws + WS_QC) + (size_t)t0 * D + 512 + h * 128; ldk = D;
            Vp = (const bf16*)(C.ws + WS_MLV) + (size_t)t0 * D + h * 256;
        } else {
            const float lg = ret_lg(h);
            if (t < 128) wsv[t] = __expf(lg * (float)(127 - t));
            Kp = (const bf16*)(C.ws + WS_RETK) + (size_t)t0 * 512 + h * 128; ldk = 512;
            Vp = (const bf16*)(C.ws + WS_RETV) + (size_t)t0 * D + h * 256;
        }
        __syncthreads();
        if (mixer == 0) {
            const int c32 = t & 31, run = t >> 5, isk = c32 >> 4, chk = c32 & 15;
            const int col = isk * 512 + h * 128 + 8 * chk;
            const bf16* raw = (const bf16*)(C.ws + WS_QKRAW) + (size_t)t0 * D + col;
            bf16* qc = (bf16*)(C.ws + WS_QC) + (size_t)t0 * D + col;
            u32x4 rv[11];
#pragma unroll
            for (int i = 0; i < 11; ++i) { const int rr = 8 * run - 3 + i; rv[i] = (ch * CH + rr >= 0) ? *(const u32x4*)(raw + (ptrdiff_t)rr * D) : (u32x4){0u, 0u, 0u, 0u}; }
            float wgt[4][8], bias[8];
#pragma unroll
            for (int j = 0; j < 4; ++j) { const f32x4 a = *(const f32x4*)(C.conv_w + j * D + col), b2 = *(const f32x4*)(C.conv_w + j * D + col + 4);
                wgt[j][0] = a.x; wgt[j][1] = a.y; wgt[j][2] = a.z; wgt[j][3] = a.w; wgt[j][4] = b2.x; wgt[j][5] = b2.y; wgt[j][6] = b2.z; wgt[j][7] = b2.w; }
            { const f32x4 a = *(const f32x4*)(C.conv_b + col), b2 = *(const f32x4*)(C.conv_b + col + 4); bias[0] = a.x; bias[1] = a.y; bias[2] = a.z; bias[3] = a.w; bias[4] = b2.x; bias[5] = b2.y; bias[6] = b2.z; bias[7] = b2.w; }
            float ns[8];
#pragma unroll
            for (int e = 0; e < 8; ++e) ns[e] = 0.f;
            const float qsc = isk ? 1.0f : 0.08838834764831845f;
#pragma unroll
            for (int rr = 0; rr < 8; ++rr) {
                float o[8];
#pragma unroll
                for (int e = 0; e < 8; ++e) o[e] = bias[e];
#pragma unroll
                for (int j = 0; j < 4; ++j) { float f[8]; unpack8(rv[rr + j], f);
#pragma unroll
                    for (int e = 0; e < 8; ++e) o[e] += f[e] * wgt[j][e]; }
#pragma unroll
                for (int e = 0; e < 8; ++e) o[e] = siluf_(o[e]) * qsc;
                const u32x4 pk = pack8(o);
                *(u32x4*)(qc + (size_t)(8 * run + rr) * D) = pk;
                if (isk) { const int row = 8 * run + rr; float f[8]; unpack8(pk, f); const float wv = wsv[row];
#pragma unroll
                    for (int e = 0; e < 8; ++e) { f[e] *= wv; ns[e] += f[e]; }
                    *(LAS u32x4*)(Kimg + off_b(row, chk)) = pack8(f); }
            }
            if (isk) {
#pragma unroll
                for (int e = 0; e < 8; ++e) atomicAdd((float*)(nl + chk * 8 + e), ns[e]);
            }
        } else {
            const int chk = t & 15;
#pragma unroll
            for (int i = 0; i < 4; ++i) { const int row = (t >> 4) + 32 * i; float f[8]; unpack8(*(const u32x4*)(Kp + (size_t)row * ldk + chk * 8), f); const float wv = wsv[row];
#pragma unroll
                for (int e = 0; e < 8; ++e) f[e] *= wv;
                *(LAS u32x4*)(Kimg + off_b(row, chk)) = pack8(f); }
        }
        fill_image(Vimg, Vp, D, 128, t); fill_image(Vimg + 32768, Vp + 128, D, 128, t);
        __syncthreads();
        const int kh = w & 1, vq = w >> 1;
        f32x4 acc[2][2][4];
#pragma unroll
        for (int a = 0; a < 2; ++a)
#pragma unroll
            for (int x = 0; x < 2; ++x)
#pragma unroll
                for (int c = 0; c < 4; ++c) acc[a][x][c] = (f32x4){0.f, 0.f, 0.f, 0.f};
        unsigned ba[2][2], bb[4][2];
#pragma unroll
        for (int ul = 0; ul < 2; ++ul)
#pragma unroll
            for (int tt = 0; tt < 2; ++tt) ba[ul][tt] = off_b(8 * g + q + 4 * tt, 4 * (2 * kh + ul) + p);
#pragma unroll
        for (int cl = 0; cl < 4; ++cl)
#pragma unroll
            for (int tt = 0; tt < 2; ++tt) { const int c = 4 * vq + cl; bb[cl][tt] = 32768 + (c >> 3) * 32768 + off_b(8 * g + q + 4 * tt, 2 * (c & 7) + (p >> 1)) + 8 * (p & 1); }
#pragma unroll
        for (int ks = 0; ks < 4; ++ks) {
            bf16x8 af[2][2], bfr[4];
#pragma unroll
            for (int ul = 0; ul < 2; ++ul)
#pragma unroll
                for (int x = 0; x < 2; ++x) af[ul][x] = cat8(tr_read(C.lds + ba[ul][0] + (8192 * ks + 8 * x)), tr_read(C.lds + ba[ul][1] + (8192 * ks + 8 * x)));
#pragma unroll
            for (int cl = 0; cl < 4; ++cl) bfr[cl] = cat8(tr_read(C.lds + bb[cl][0] + 8192 * ks), tr_read(C.lds + bb[cl][1] + 8192 * ks));
#pragma unroll
            for (int ul = 0; ul < 2; ++ul)
#pragma unroll
                for (int x = 0; x < 2; ++x)
#pragma unroll
                    for (int cl = 0; cl < 4; ++cl) acc[ul][x][cl] = MFMA16(af[ul][x], bfr[cl], acc[ul][x][cl]);
            asm volatile("" ::: "memory");
        }
        bf16* cl_ = CLOC + ((size_t)(mixer * 16 + bh) * 32 + ch) * 32768;
#pragma unroll
        for (int ul = 0; ul < 2; ++ul)
#pragma unroll
            for (int cl = 0; cl < 4; ++cl) { const int v = 16 * (4 * vq + cl) + (lane & 15), k0 = 32 * (2 * kh + ul) + 8 * g;
                u32x4 o; o.x = pk2(acc[ul][0][cl][0], acc[ul][0][cl][1]); o.y = pk2(acc[ul][0][cl][2], acc[ul][0][cl][3]); o.z = pk2(acc[ul][1][cl][0], acc[ul][1][cl][1]); o.w = pk2(acc[ul][1][cl][2], acc[ul][1][cl][3]);
                *(u32x4*)(cl_ + (size_t)v * 128 + k0) = o; }
        if (mixer == 0 && t < 128) NLOC[(bh * 32 + ch) * 128 + t] = nl[t];
        __syncthreads();
    }
}

struct OutUnit { const bf16 *Qp, *Kp, *Vp, *cp; int ldq, mixer, bh, ch, h, t0; };
DI OutUnit out_unit(const Ctx& C, int u) {
    OutUnit U; U.mixer = u >> 9; U.bh = (u >> 5) & 15; U.ch = u & 31; const int b = U.bh >> 2; U.h = U.bh & 3; U.t0 = b * SEQ + U.ch * CH;
    U.cp = (const bf16*)(C.ws + WS_CPREV) + ((size_t)(U.mixer * 16 + U.bh) * 32 + U.ch) * 32768;
    if (U.mixer == 0) { U.Qp = (const bf16*)(C.ws + WS_QC) + (size_t)U.t0 * D + U.h * 128; U.Kp = U.Qp + 512; U.ldq = D; U.Vp = (const bf16*)(C.ws + WS_MLV) + (size_t)U.t0 * D + U.h * 256; }
    else { U.Qp = (const bf16*)(C.ws + WS_RETQ) + (size_t)U.t0 * 512 + U.h * 128; U.Kp = (const bf16*)(C.ws + WS_RETK) + (size_t)U.t0 * 512 + U.h * 128; U.ldq = 512; U.Vp = (const bf16*)(C.ws + WS_RETV) + (size_t)U.t0 * D + U.h * 256; }
    return U;
}
DI void phase_out_mfma(Ctx& C) {
    LAS unsigned char* Qimg = C.lds; LAS unsigned char* Kimg = C.lds + 32768; LAS unsigned char* R1 = C.lds + 65536;
    LAS float* ea = (LAS float*)(C.lds + 131072); LAS float* bs = ea + 128; LAS float* isc = bs + 128; LAS float* edn = isc + 128; LAS float* npv = edn + 128; LAS float* gnl = npv + 128;
    const float* IFG = (const float*)(C.ws + WS_IFG);
    const float* NPREV = (const float*)(C.ws + WS_SMALL + SM_NPREV); const float* MPREV = (const float*)(C.ws + WS_SMALL + SM_MPREV);
    const float* AG = (const float*)(C.ws + WS_SMALL + SM_AG); const float* CMG = (const float*)(C.ws + WS_SMALL + SM_CMG);
    const int w = C.wave;
    if (C.bid >= 1024) return;
    u32x4 pq[4], pk[4], pc[8]; float ga = 0.f, gcm = 0.f, giv = 0.f, gmp = 0.f, gnp = 0.f, ggn = 0.f;
#define P6_PREFETCH(U) do { \
        _Pragma("unroll") for (int i = 0; i < 4; ++i) { const int e = t + NTHR * i, row = e >> 4, chk = e & 15; pq[i] = *(const u32x4*)((U).Qp + (size_t)row * (U).ldq + chk * 8); pk[i] = *(const u32x4*)((U).Kp + (size_t)row * (U).ldq + chk * 8); } \
        _Pragma("unroll") for (int i = 0; i < 8; ++i) { const int e = t + NTHR * i; pc[i] = *(const u32x4*)((U).cp + (size_t)e * 8); } \
        if (t < 256) ggn = ((U).mixer == 0 ? C.ml_norm_g : C.ret_norm_g)[(U).h * 256 + t]; \
        if ((U).mixer == 0 && t < 128) { ga = AG[(U).bh * SEQ + (U).ch * CH + t]; gcm = CMG[(U).bh * SEQ + (U).ch * CH + t]; giv = IFG[(size_t)((U).t0 + t) * 8 + (U).h]; gmp = MPREV[(U).bh * 32 + (U).ch]; gnp = NPREV[((U).bh * 32 + (U).ch) * 128 + t]; } } while (0)
    OutUnit U = out_unit(C, C.bid);
    { const int t = C.tid; P6_PREFETCH(U); }
    const int t_ = C.tid;
    for (int u = C.bid; u < 1024; u += C.G) {
        const int mixer = U.mixer, h = U.h, t0 = U.t0;
        int t = t_; asm volatile("" : "+v"(t));
        const int lane = t & 63, g = lane >> 4, q = (lane & 15) >> 2, p = lane & 3, jl = lane & 15;
#pragma unroll
        for (int i = 0; i < 4; ++i) { const int e = t + NTHR * i, row = e >> 4, chk = e & 15; *(LAS u32x4*)(Qimg + off_b(row, chk)) = pq[i]; *(LAS u32x4*)(Kimg + off_b(row, chk)) = pk[i]; }
#pragma unroll
        for (int i = 0; i < 8; ++i) { const int e = t + NTHR * i, row = e >> 4, chk = e & 15; *(LAS u32x4*)(R1 + off_b(row, chk)) = pc[i]; }
        if (t < 256) gnl[t] = ggn;
        if (t < 128) {
            if (mixer == 0) { const float il = ga + gmp, m = fmaxf(il, ga + gcm);
                ea[t] = ga - m; bs[t] = giv - ga; isc[t] = __expf(il - m); edn[t] = __expf(-m); npv[t] = gnp; }
            else { const float lg = ret_lg(h); ea[t] = lg * (float)t; bs[t] = -lg * (float)t; isc[t] = __expf(lg * (float)(t + 1)); edn[t] = 1.0f; npv[t] = 0.f; }
        }
        __syncthreads();
        u32x4 vst[8];
#pragma unroll
        for (int i = 0; i < 8; ++i) { const int e = t + NTHR * i, half = e >> 11, row = (e >> 4) & 127, chk = e & 15; vst[i] = *(const u32x4*)(U.Vp + (size_t)row * D + half * 128 + chk * 8); }
        unsigned bk[4];
#pragma unroll
        for (int kk = 0; kk < 4; ++kk) bk[kk] = off_b(jl, 4 * kk + g);
        bf16x8 qf[4];
#pragma unroll
        for (int kk = 0; kk < 4; ++kk) qf[kk] = *(const LAS bf16x8*)(Qimg + 4096 * w + bk[kk]);
        f32x4 st[8];
#pragma unroll
        for (int sb = 0; sb < 8; ++sb) { st[sb] = (f32x4){0.f, 0.f, 0.f, 0.f};
            if (sb <= w) {
#pragma unroll
                for (int kk = 0; kk < 4; ++kk) st[sb] = MFMA16(*(const LAS bf16x8*)(Kimg + bk[kk] + 4096 * sb), qf[kk], st[sb]);
            } }
        const int j = 16 * w + jl; const float eaj = ea[j];
        float psum = 0.f;
#pragma unroll
        for (int sb = 0; sb < 8; ++sb) { const f32x4 b4 = *(const LAS f32x4*)(bs + 16 * sb + 4 * g);
#pragma unroll
            for (int r = 0; r < 4; ++r) { const int s = 16 * sb + 4 * g + r; const float pv = (s <= j) ? __expf(eaj + b4[r]) * st[sb][r] : 0.f; st[sb][r] = pv; psum += pv; } }
        float qn = 0.f;
#pragma unroll
        for (int kk = 0; kk < 4; ++kk) { const f32x4 n0 = *(const LAS f32x4*)(npv + 32 * kk + 8 * g), n1 = *(const LAS f32x4*)(npv + 32 * kk + 8 * g + 4);
            float f[8]; unpack8(__builtin_bit_cast(u32x4, qf[kk]), f);
            qn += f[0] * n0.x + f[1] * n0.y + f[2] * n0.z + f[3] * n0.w + f[4] * n1.x + f[5] * n1.y + f[6] * n1.z + f[7] * n1.w; }
        psum += __shfl_xor(psum, 16); psum += __shfl_xor(psum, 32); qn += __shfl_xor(qn, 16); qn += __shfl_xor(qn, 32);
        const float iscj = isc[j];
        const float dinv = (mixer == 0) ? 1.0f / fmaxf(fabsf(psum + iscj * qn), edn[j]) : 1.0f;
        bf16x8 pf[4];
#pragma unroll
        for (int ks = 0; ks < 4; ++ks) { u32x4 pw; pw.x = pk2(st[2 * ks][0], st[2 * ks][1]); pw.y = pk2(st[2 * ks][2], st[2 * ks][3]); pw.z = pk2(st[2 * ks + 1][0], st[2 * ks + 1][1]); pw.w = pk2(st[2 * ks + 1][2], st[2 * ks + 1][3]);
            pf[ks] = __builtin_bit_cast(bf16x8, pw); }
        f32x4 acc[2][4][2];
#pragma unroll
        for (int hv = 0; hv < 2; ++hv)
#pragma unroll
            for (int uu = 0; uu < 4; ++uu)
#pragma unroll
                for (int x = 0; x < 2; ++x) acc[hv][uu][x] = (f32x4){0.f, 0.f, 0.f, 0.f};
#pragma unroll
        for (int kk = 0; kk < 4; ++kk) {
            const unsigned bi0 = off_b(8 * (jl >> 2) + (jl & 3), 4 * kk + g), bi1 = off_b(8 * (jl >> 2) + 4 + (jl & 3), 4 * kk + g);
#pragma unroll
            for (int hv = 0; hv < 2; ++hv) {
#pragma unroll
                for (int uu = 0; uu < 4; ++uu) {
                    acc[hv][uu][0] = MFMA16(*(const LAS bf16x8*)(R1 + bi0 + (32768 * hv + 8192 * uu)), qf[kk], acc[hv][uu][0]);
                    acc[hv][uu][1] = MFMA16(*(const LAS bf16x8*)(R1 + bi1 + (32768 * hv + 8192 * uu)), qf[kk], acc[hv][uu][1]); }
                asm volatile("" ::: "memory"); }
        }
#pragma unroll
        for (int hv = 0; hv < 2; ++hv)
#pragma unroll
            for (int uu = 0; uu < 4; ++uu)
#pragma unroll
                for (int x = 0; x < 2; ++x) acc[hv][uu][x] *= iscj;
        __syncthreads();
#pragma unroll
        for (int i = 0; i < 8; ++i) { const int e = t + NTHR * i, half = e >> 11, row = (e >> 4) & 127, chk = e & 15; *(LAS u32x4*)(R1 + half * 32768 + off_b(row, chk)) = vst[i]; }
        __syncthreads();
        const bf16* gate = (const bf16*)(C.ws + (mixer == 0 ? WS_MLO : WS_RETG)) + (size_t)(t0 + j) * D + h * 256;
        bf16* outp = (bf16*)(C.ws + (mixer == 0 ? WS_HML : WS_HRET)) + (size_t)(t0 + j) * D + h * 256;

        unsigned bp[4];
#pragma unroll
        for (int uu = 0; uu < 4; ++uu) bp[uu] = off_b(4 * g + q, 4 * uu + p);
#pragma unroll
        for (int ks = 0; ks < 4; ++ks) {
            if (2 * ks <= w) {
#pragma unroll
                for (int hv = 0; hv < 2; ++hv)
#pragma unroll
                    for (int uu = 0; uu < 4; ++uu)
#pragma unroll
                        for (int x = 0; x < 2; ++x) {
                            const bf16x8 vf = cat8(tr_read(R1 + bp[uu] + (32768 * hv + 8192 * ks + 8 * x)), tr_read(R1 + bp[uu] + (32768 * hv + 8192 * ks + 4096 + 8 * x)));
                            acc[hv][uu][x] = MFMA16(vf, pf[ks], acc[hv][uu][x]); }
            }
            asm volatile("" ::: "memory"); }
        const bool has_next = (u + C.G) < 1024;
        U = out_unit(C, has_next ? u + C.G : u); P6_PREFETCH(U);
        float s1 = 0.f;
#pragma unroll
        for (int hv = 0; hv < 2; ++hv)
#pragma unroll
            for (int uu = 0; uu < 4; ++uu)
#pragma unroll
                for (int x = 0; x < 2; ++x) { acc[hv][uu][x] *= dinv; s1 += (acc[hv][uu][x][0] + acc[hv][uu][x][1]) + (acc[hv][uu][x][2] + acc[hv][uu][x][3]); }
        s1 += __shfl_xor(s1, 16); s1 += __shfl_xor(s1, 32);
        const float mu = s1 * (1.0f / 256.0f); float s2 = 0.f;
#pragma unroll
        for (int hv = 0; hv < 2; ++hv)
#pragma unroll
            for (int uu = 0; uu < 4; ++uu)
#pragma unroll
                for (int x = 0; x < 2; ++x) { acc[hv][uu][x] -= mu; const f32x4 d = acc[hv][uu][x]; s2 += (d[0] * d[0] + d[1] * d[1]) + (d[2] * d[2] + d[3] * d[3]); }
        s2 += __shfl_xor(s2, 16); s2 += __shfl_xor(s2, 32);
        const float rstd = 1.0f / sqrtf(s2 * (1.0f / 256.0f) + EPS);
#pragma unroll
        for (int hv = 0; hv < 2; ++hv) {
            u32x4 gt[4];
#pragma unroll
            for (int uu = 0; uu < 4; ++uu) gt[uu] = *(const u32x4*)(gate + 128 * hv + 32 * uu + 8 * g);
#pragma unroll
            for (int uu = 0; uu < 4; ++uu) { const int v0 = 128 * hv + 32 * uu + 8 * g;
                const f32x4 g0 = *(const LAS f32x4*)(gnl + v0), g1 = *(const LAS f32x4*)(gnl + v0 + 4); f32x4 t0v, t1v; unpack8v(gt[uu], t0v, t1v);
                *(u32x4*)(outp + v0) = pack8v(acc[hv][uu][0] * rstd * g0 * t0v, acc[hv][uu][1] * rstd * g1 * t1v); }
            asm volatile("" ::: "memory"); }
        __syncthreads();
    }
#undef P6_PREFETCH
}

DI void phase_norm2_route_mfma(Ctx& C) {
    LAS float* wr = (LAS float*)C.lds;
    LAS float* pg = wr + 32768;
    LAS float* ps = pg + 1024;
    LAS float* lgt = ps + 1024;
    const float* mod = (const float*)(C.ws + WS_MOD); const float* X1 = (const float*)(C.ws + WS_X1);
    bf16* H2 = (bf16*)(C.ws + WS_H1);
    int* TOPI = (int*)(C.ws + WS_ROUTE + RT_TOPI); float* TOPW = (float*)(C.ws + WS_ROUTE + RT_TOPW); int* RANK = (int*)(C.ws + WS_ROUTE + RT_RANK);
    unsigned* BLKCNT = (unsigned*)(C.ws + WS_ROUTE + RT_BLKCNT);
    LAS unsigned* cntL = (LAS unsigned*)(lgt + 2048);
    const int lane = C.lane, r = lane & 15, kq = lane >> 4;
    for (int i = C.tid; i < 32768 / 4; i += NTHR) *(LAS f32x4*)(wr + i * 4) = *(const f32x4*)(C.w_router + i * 4);
    int cur_b = -1;
    for (int sg = C.bid; sg < T / 64; sg += C.G) {
        const int b = (sg * 64) / SEQ;
        if (b != cur_b) { __syncthreads();
            for (int i = C.tid; i < 1024; i += NTHR) { pg[i] = C.norm_ffn_g[i] * (1.0f + mod[b * 6144 + 4096 + i]); ps[i] = mod[b * 6144 + 3072 + i]; }
            cur_b = b; }
        if (C.tid < 32) cntL[C.tid] = 0u;
        __syncthreads();
        if (C.wave < 4) {
            const int row0 = sg * 64 + C.wave * 16;
            const float* xr = X1 + (size_t)(row0 + r) * D + 4 * kq;
            float ss = 0.f;
#pragma unroll 8
            for (int i = 0; i < 64; ++i) { const f32x4 v = *(const f32x4*)(xr + 16 * i); ss += (v.x * v.x + v.y * v.y) + (v.z * v.z + v.w * v.w); }
            ss += __shfl_xor(ss, 16); ss += __shfl_xor(ss, 32);
            const float rstd = 1.0f / sqrtf(ss * (1.0f / D) + EPS);
            f32x4 acc0 = (f32x4){0.f, 0.f, 0.f, 0.f}, acc1 = acc0;
            bf16* hr = H2 + (size_t)(row0 + r) * D + 4 * kq;
            const LAS float* wb = wr + (4 * kq) * 32 + r;
#pragma unroll 4
            for (int i = 0; i < 64; ++i) {
                const f32x4 v = *(const f32x4*)(xr + 16 * i);
                const f32x4 g4 = *(const LAS f32x4*)(pg + 16 * i + 4 * kq), s4 = *(const LAS f32x4*)(ps + 16 * i + 4 * kq);
                const f32x4 h = v * rstd * g4 + s4;
                u32x2 w; w.x = pk2(h.x, h.y); w.y = pk2(h.z, h.w); *(u32x2*)(hr + 16 * i) = w;
                const LAS float* wi = wb + (16 * i) * 32;
                acc0 = __builtin_amdgcn_mfma_f32_16x16x4f32(h.x, wi[0], acc0, 0, 0, 0);       acc1 = __builtin_amdgcn_mfma_f32_16x16x4f32(h.x, wi[16], acc1, 0, 0, 0);
                acc0 = __builtin_amdgcn_mfma_f32_16x16x4f32(h.y, wi[32], acc0, 0, 0, 0);      acc1 = __builtin_amdgcn_mfma_f32_16x16x4f32(h.y, wi[32 + 16], acc1, 0, 0, 0);
                acc0 = __builtin_amdgcn_mfma_f32_16x16x4f32(h.z, wi[64], acc0, 0, 0, 0);      acc1 = __builtin_amdgcn_mfma_f32_16x16x4f32(h.z, wi[64 + 16], acc1, 0, 0, 0);
                acc0 = __builtin_amdgcn_mfma_f32_16x16x4f32(h.w, wi[96], acc0, 0, 0, 0);      acc1 = __builtin_amdgcn_mfma_f32_16x16x4f32(h.w, wi[96 + 16], acc1, 0, 0, 0);
            }
            LAS float* lw = lgt + C.wave * 512;
#pragma unroll
            for (int j = 0; j < 4; ++j) { lw[(4 * kq + j) * 32 + r] = acc0[j] + C.b_router[r]; lw[(4 * kq + j) * 32 + 16 + r] = acc1[j] + C.b_router[16 + r]; }
            asm volatile("s_waitcnt lgkmcnt(0)" ::: "memory");
            if (lane < 16) {
                float l[32];
#pragma unroll
                for (int e4 = 0; e4 < 8; ++e4) { const f32x4 t4 = *(const LAS f32x4*)(lw + lane * 32 + e4 * 4); l[e4 * 4] = t4.x; l[e4 * 4 + 1] = t4.y; l[e4 * 4 + 2] = t4.z; l[e4 * 4 + 3] = t4.w; }
                float tv[4]; int ti[4];
#pragma unroll
                for (int k = 0; k < 4; ++k) {
                    float bvv = -3.0e38f; int bi = 0;
#pragma unroll
                    for (int e = 0; e < 32; ++e) { const bool take = l[e] > bvv; bvv = take ? l[e] : bvv; bi = take ? e : bi; }
                    tv[k] = bvv; ti[k] = bi;
#pragma unroll
                    for (int e = 0; e < 32; ++e) l[e] = (e == bi) ? -3.0e38f : l[e];
                }
                const float e1 = __expf(tv[1] - tv[0]), e2 = __expf(tv[2] - tv[0]), e3 = __expf(tv[3] - tv[0]), inv = 1.0f / (1.0f + e1 + e2 + e3);
                const int m = row0 + lane;
                const float ww[4] = {inv, e1 * inv, e2 * inv, e3 * inv};
#pragma unroll
                for (int k = 0; k < 4; ++k) { TOPI[m * 4 + k] = ti[k]; TOPW[m * 4 + k] = ww[k]; RANK[m * 4 + k] = (int)__hip_atomic_fetch_add(cntL + ti[k], 1u, __ATOMIC_RELAXED, __HIP_MEMORY_SCOPE_WORKGROUP); }
            }
        }
        __syncthreads();
        if (C.tid < 32) BLKCNT[sg * 32 + C.tid] = cntL[C.tid];
    }
    int* SLOTTOK = (int*)(C.ws + WS_ROUTE + RT_SLOTTOK); float* SLOTW = (float*)(C.ws + WS_ROUTE + RT_SLOTW);
    for (int i = C.bid * NTHR + C.tid; i < NSLOTS; i += C.G * NTHR) { SLOTTOK[i] = T; SLOTW[i] = 0.f; }
    if (C.bid == 0) for (int i = C.tid; i < D / 2; i += NTHR) ((unsigned*)(H2 + (size_t)T * D))[i] = 0u;
    __syncthreads();
}

DI void phase_mod_convert(Ctx& C) {
    LAS float* sc = (LAS float*)C.lds;
    LAS float* red = sc + 1024;
    float* MODP = (float*)(C.ws + WS_MODP);
    for (int gI = C.bid; gI < 256; gI += C.G) {
        const int cg = gI & 63, kq = gI >> 6, t = C.tid;
        for (int i = t; i < 1024; i += NTHR) sc[i] = siluf_(C.c[(i >> 8) * D + kq * 256 + (i & 255)]);
        __syncthreads();
        if (t < 504) {
            const int c4 = t % 24, kr = t / 24;
            f32x4 a0 = (f32x4){0.f, 0.f, 0.f, 0.f}, a1 = a0, a2 = a0, a3 = a0;
            for (int k = kr; k < 256; k += 21) {
                const f32x4 w4 = *(const f32x4*)(C.w_ada + (size_t)(kq * 256 + k) * 6144 + cg * 96 + c4 * 4);
                a0 += w4 * sc[k]; a1 += w4 * sc[256 + k]; a2 += w4 * sc[512 + k]; a3 += w4 * sc[768 + k];
            }
            *(LAS f32x4*)(red + (kr * 4 + 0) * 96 + c4 * 4) = a0; *(LAS f32x4*)(red + (kr * 4 + 1) * 96 + c4 * 4) = a1;
            *(LAS f32x4*)(red + (kr * 4 + 2) * 96 + c4 * 4) = a2; *(LAS f32x4*)(red + (kr * 4 + 3) * 96 + c4 * 4) = a3;
        }
        __syncthreads();
        if (t < 384) { const int b = t / 96, col = t % 96; float sm = 0.f; for (int kr = 0; kr < 21; ++kr) sm += red[(kr * 4 + b) * 96 + col];
            MODP[(size_t)kq * 4 * 6144 + b * 6144 + cg * 96 + col] = sm; }
        __syncthreads();
    }
    convert_weights(C);
}
DI void phase_norm1_v2(Ctx& C) {
    LAS float* pg = (LAS float*)C.lds; LAS float* psh = pg + 1024;
    const float* MODP = (const float*)(C.ws + WS_MODP); float* MOD = (float*)(C.ws + WS_MOD);
    bf16* H1 = (bf16*)(C.ws + WS_H1);
    float* IFG = (float*)(C.ws + WS_IFG);
    const int lane = C.lane;
    for (int idx = C.bid * NTHR + C.tid; idx < 4 * 6144; idx += C.G * NTHR) MOD[idx] = C.b_ada[idx % 6144] + (MODP[idx] + MODP[24576 + idx]) + (MODP[2 * 24576 + idx] + MODP[3 * 24576 + idx]);
    float wif[4][4][8];
#pragma unroll
    for (int j = 0; j < 4; ++j)
#pragma unroll
        for (int i = 0; i < 4; ++i) {
            const float* wp = C.w_in + (size_t)(4 * (lane + 64 * j) + i) * DIN + 3072;
#pragma unroll
            for (int e = 0; e < 8; ++e) wif[j][i][e] = wp[e];
        }
    int cur_b = -1;
    for (int sg = C.bid; sg < T / 64; sg += C.G) {
        const int b = (sg * 64) / SEQ;
        if (b != cur_b) { __syncthreads();
            for (int i = C.tid; i < 1024; i += NTHR) { const int i0 = b * 6144 + i, i1 = b * 6144 + 1024 + i;
                const float shv = C.b_ada[i] + (MODP[i0] + MODP[24576 + i0]) + (MODP[2 * 24576 + i0] + MODP[3 * 24576 + i0]);
                const float scv = C.b_ada[1024 + i] + (MODP[i1] + MODP[24576 + i1]) + (MODP[2 * 24576 + i1] + MODP[3 * 24576 + i1]);
                pg[i] = C.norm_mix_g[i] * (1.0f + scv); psh[i] = shv; }
            cur_b = b; __syncthreads(); }
#pragma unroll 1
        for (int rr = 0; rr < 8; ++rr) {
            const int m = sg * 64 + C.wave * 8 + rr;
            const f32x4* xr = (const f32x4*)(C.x + (size_t)m * D) + lane;
            f32x4 v[4]; float ss = 0.f;
#pragma unroll
            for (int j = 0; j < 4; ++j) { v[j] = xr[64 * j]; ss += (v[j].x * v[j].x + v[j].y * v[j].y) + (v[j].z * v[j].z + v[j].w * v[j].w); }
            const float rstd = 1.0f / sqrtf(wave_sum(ss) * (1.0f / D) + EPS);
            float p[8];
#pragma unroll
            for (int e = 0; e < 8; ++e) p[e] = 0.f;
            u32x2* o8 = (u32x2*)(H1 + (size_t)m * D) + lane;
#pragma unroll
            for (int j = 0; j < 4; ++j) {
                const int col = 4 * (lane + 64 * j);
                const f32x4 h = v[j] * rstd * *(const LAS f32x4*)(pg + col) + *(const LAS f32x4*)(psh + col);
                u32x2 w; w.x = pk2(h.x, h.y); w.y = pk2(h.z, h.w); o8[64 * j] = w;
                const float hh[4] = {h.x, h.y, h.z, h.w};
#pragma unroll
                for (int i = 0; i < 4; ++i)
#pragma unroll
                    for (int e = 0; e < 8; ++e) p[e] += hh[i] * wif[j][i][e];
            }
#pragma unroll
            for (int e = 0; e < 8; ++e) p[e] = wave_sum(p[e]);
            if (lane < 8) { float r = p[0];
#pragma unroll
                for (int e = 1; e < 8; ++e) r = (lane == e) ? p[e] : r;
                IFG[(size_t)m * 8 + lane] = r + C.b_if[lane]; }
        }
    }
    float* COS = (float*)(C.ws + WS_COS); float* SIN = (float*)(C.ws + WS_SIN);
    for (int idx = C.bid * NTHR + C.tid; idx < T * 64; idx += C.G * NTHR) {
        const int t = idx >> 6, i = idx & 63;
        const float inv = (float)exp(-(double)i * (9.210340371976184 / 64.0));
        const double ang = (double)C.positions[t] * (double)inv;
        const double kq = rint(ang * 0.6366197723675814);
        double r = fma(-kq, 1.5707963267948966, ang); r = fma(-kq, 6.123233995736766e-17, r);
        const float rf = (float)r; const float s = sinf(rf), c = cosf(rf);
        const int q = ((int)kq) & 3;
        const float cs = (q == 0) ? c : (q == 1) ? -s : (q == 2) ? -c : s;
        const float sn = (q == 0) ? s : (q == 1) ? c : (q == 2) ? -s : -c;
        COS[idx] = cs; SIN[idx] = sn;
    }
    __syncthreads();
}

#define XB_TMO      128
#define XB_XCNT(j)  (256  + 64 * (j))
#define XB_XSUB(j)  (1280 + 64 * (j))
#define XB_XGEN(j)  (2304 + 64 * (j))
#define XB_TOP      3328
#define XB_TOPGEN   3392
#define XCD_BAR_WORDS 3456
#define XB_SPIN_CAP (1u << 22)
DI unsigned xb_ld(unsigned* p)              { return __hip_atomic_load(p, __ATOMIC_RELAXED, __HIP_MEMORY_SCOPE_AGENT); }
DI unsigned xb_add(unsigned* p, unsigned v) { return __hip_atomic_fetch_add(p, v, __ATOMIC_RELAXED, __HIP_MEMORY_SCOPE_AGENT); }
DI unsigned xb_xcc_id() { return (unsigned)__builtin_amdgcn_s_getreg((3 << 11) | 20) & 0xFu; }
#define XB_SPIN(cond, bar) do { unsigned _sp = 0; while (cond) { __builtin_amdgcn_s_sleep(1); \
    if ((++_sp & 255u) == 0u) { if (xb_ld(&(bar)[XB_TMO])) break; if (_sp > XB_SPIN_CAP) { atomicAdd(&(bar)[XB_TMO], 1u); break; } } } } while (0)
struct XcdBarrier { unsigned* bar; unsigned x; volatile LAS unsigned* st; };
DI XcdBarrier xcd_barrier_post(unsigned* bar, volatile LAS unsigned* st) {
    XcdBarrier b; b.bar = bar; b.x = xb_xcc_id(); b.st = st;
    if (threadIdx.x == 0) (void)xb_add(&bar[XB_XCNT(b.x)], 1u);
    return b;
}
DI void xcd_barrier_complete(unsigned* bar, unsigned x, unsigned& nloc, unsigned& nx) {
    const unsigned G = gridDim.x * gridDim.y * gridDim.z;
    unsigned sum, cnt, mine, sp = 0u;
    for (;;) {
        sum = 0u; cnt = 0u; mine = 0u;
#pragma unroll
        for (unsigned j = 0; j < 16; ++j) { const unsigned c = xb_ld(&bar[XB_XCNT(j)]); sum += c; cnt += (c > 0u) ? 1u : 0u; mine = (j == x) ? c : mine; }
        if (sum == G) break;
        __builtin_amdgcn_s_sleep(1);
        if ((++sp & 255u) == 0u) { if (xb_ld(&bar[XB_TMO])) break; if (sp > XB_SPIN_CAP) { atomicAdd(&bar[XB_TMO], 1u); break; } }
    }
    nloc = mine > 0u ? mine : 1u; nx = cnt > 0u ? cnt : 1u;
}
DI void xcd_barrier(const XcdBarrier& b) {
    asm volatile("s_waitcnt vmcnt(0)" ::: "memory");
    __syncthreads();
    if (threadIdx.x == 0) {
        unsigned* bar = b.bar;
        __builtin_amdgcn_s_waitcnt(0);
        unsigned nloc = b.st[0], nx = b.st[1];
        if (nloc == 0u) { xcd_barrier_complete(bar, b.x, nloc, nx); b.st[0] = nloc; b.st[1] = nx; }
        const unsigned old = xb_add(&bar[XB_XSUB(b.x)], 1u);
        const unsigned gen = old / nloc;
        if (old + 1u == (gen + 1u) * nloc) {
            __builtin_amdgcn_fence(__ATOMIC_RELEASE, "agent");
            asm volatile("s_waitcnt vmcnt(0)" ::: "memory");
            const unsigned og = xb_add(&bar[XB_TOP], 1u);
            const unsigned tg = og / nx;
            if (og + 1u == (tg + 1u) * nx) xb_add(&bar[XB_TOPGEN], 1u);
            else XB_SPIN(xb_ld(&bar[XB_TOPGEN]) == tg, bar);
            __builtin_amdgcn_fence(__ATOMIC_ACQUIRE, "agent");
            xb_add(&bar[XB_XGEN(b.x)], 1u);
            asm volatile("s_waitcnt vmcnt(0)" ::: "memory");
        } else {
            XB_SPIN(xb_ld(&bar[XB_XGEN(b.x)]) == gen, bar);
            __builtin_amdgcn_fence(__ATOMIC_ACQUIRE, "agent");
            asm volatile("s_waitcnt vmcnt(0)" ::: "memory");
        }
    }
    __syncthreads();
}

constexpr int NPHASES = 14;
__global__ void __launch_bounds__(NTHR, 2) fwd(Args a) {
    extern __shared__ __attribute__((aligned(16))) unsigned char lds[];
    Ctx C;
    C.lds = (LAS unsigned char*)lds; C.tid = threadIdx.x; C.lane = C.tid & 63; C.wave = __builtin_amdgcn_readfirstlane(C.tid >> 6); C.G = gridDim.x; C.bid = blockIdx.x;
    C.x = (const float*)a.in[0]; C.c = (const float*)a.in[1]; C.positions = (const int*)a.in[2]; C.w_ada = (const float*)a.in[3]; C.b_ada = (const float*)a.in[4];
    C.norm_mix_g = (const float*)a.in[5]; C.w_in = (const float*)a.in[6]; C.conv_w = (const float*)a.in[7]; C.conv_b = (const float*)a.in[8]; C.b_if = (const float*)a.in[9];
    C.ml_norm_g = (const float*)a.in[10]; C.ret_norm_g = (const float*)a.in[11]; C.w_bml = (const float*)a.in[12]; C.w_bret = (const float*)a.in[13]; C.w_out = (const float*)a.in[14];
    C.norm_ffn_g = (const float*)a.in[15]; C.w_router = (const float*)a.in[16]; C.b_router = (const float*)a.in[17]; C.w_gu = (const float*)a.in[18]; C.b_gu = (const float*)a.in[19];
    C.w_dn = (const float*)a.in[20]; C.b_dn = (const float*)a.in[21]; C.norm_final_g = (const float*)a.in[22];
    C.out = a.out; C.ws = a.ws;
    const int lo = a.ph_lo, hi = a.ph_hi;
    volatile LAS unsigned* bst = (volatile LAS unsigned*)(C.lds + LDS_BYTES - 16);
    if (C.tid < 4) bst[C.tid] = 0u;
    __syncthreads();
    XcdBarrier bar; bar.bar = (unsigned*)(C.ws + WS_CTL) + CW_BAR; bar.x = 0; bar.st = bst;
    if (hi - lo > 1) bar = xcd_barrier_post((unsigned*)(C.ws + WS_CTL) + CW_BAR, bst);
#define SEAM(k) do { if (IN(k) && IN((k) + 1)) xcd_barrier(bar); } while (0)
#ifdef ONLY_PHASE
#define IN(k) ((k) == ONLY_PHASE && lo <= (k) && (k) < hi)
#else
#define IN(k) (lo <= (k) && (k) < hi)
#endif
    if (IN(0)) phase_mod_convert(C); SEAM(0);
    if (IN(1)) phase_norm1_v2(C); SEAM(1);
#if OPT_INPROJ
    if (IN(2)) phase_inproj_mfma(C); SEAM(2);
#else
    if (IN(2)) phase_inproj(C); SEAM(2);
#endif
#if !(OPT_INPROJ && OPT_LOCAL)
    if (IN(3)) phase_conv_rope(C); SEAM(3);
#endif
#if OPT_LOCAL
    if (IN(4)) phase_local_mfma(C); SEAM(4);
#else
    if (IN(4)) phase_local(C); SEAM(4);
#endif
    if (IN(5)) phase_scan(C); SEAM(5);
#if OPT_OUTP
    if (IN(6)) phase_out_mfma(C); SEAM(6);
#else
    if (IN(6)) phase_out(C); SEAM(6);
#endif
#if OPT_BRANCH
    if (IN(7)) phase_branch_mfma(C); SEAM(7);
#else
    if (IN(7)) phase_branch(C); SEAM(7);
#endif
#if OPT_OUT
    if (IN(8)) phase_outproj_mfma(C); SEAM(8);
#else
    if (IN(8)) phase_outproj(C); SEAM(8);
#endif
#if OPT_ROUTE
    if (IN(9)) phase_norm2_route_mfma(C); SEAM(9);
#else
    if (IN(9)) phase_norm2_route(C); SEAM(9);
#endif
    if (IN(10)) phase_slots(C); SEAM(10);
#if OPT_MOE
    if (IN(11)) phase_gateup_mfma(C); SEAM(11);
#else
    if (IN(11)) phase_gateup(C); SEAM(11);
#endif
#if OPT_MOE
    if (IN(12)) phase_down_mfma(C); SEAM(12);
#else
    if (IN(12)) phase_down(C); SEAM(12);
#endif
    if (IN(13)) phase_final(C); SEAM(13);
#undef IN
}

extern "C" void kernel_launch(void* const* d_in, const int* in_sizes, int n_in, void* d_out, int out_size, void* d_ws, size_t ws_size, hipStream_t stream) {
    static int grid = 0;
    if (grid == 0) {
        if (n_in != 23 || out_size != T * D || ws_size < WS_END) { fprintf(stderr, "kernel_launch: unexpected shapes: n_in %d out %d ws %zu (need %zu)\n", n_in, out_size, ws_size, (size_t)WS_END); grid = -1; return; }
        int dev = 0, cus = 0;
        if (hipGetDevice(&dev) != hipSuccess || hipDeviceGetAttribute(&cus, hipDeviceAttributeMultiprocessorCount, dev) != hipSuccess) { grid = -1; return; }
        if (hipFuncSetAttribute((const void*)fwd, hipFuncAttributeMaxDynamicSharedMemorySize, LDS_BYTES) != hipSuccess) { fprintf(stderr, "kernel_launch: hipFuncSetAttribute failed\n"); grid = -1; return; }
        grid = cus > 0 ? cus : 256;
    }
    if (grid < 0) return;
    Args a{};
    for (int i = 0; i < 23; ++i) a.in[i] = d_in[i];
    a.out = (float*)d_out; a.ws = (unsigned char*)d_ws;
    (void)hipMemsetAsync((char*)d_ws + WS_CTL, 0, CTL_ZERO_BYTES, stream);
#ifdef MK_PER_PHASE
    for (int p = 0; p < NPHASES; ++p) { a.ph_lo = p; a.ph_hi = p + 1; hipLaunchKernelGGL(fwd, dim3(grid), dim3(NTHR), LDS_BYTES, stream, a); }
#else
    a.ph_lo = 0; a.ph_hi = NPHASES;
    hipLaunchKernelGGL(fwd, dim3(grid), dim3(NTHR), LDS_BYTES, stream, a);
#endif
#ifdef PROBE_PHASE
    for (int r = 0; r < PROBE_REPS; ++r) { a.ph_lo = PROBE_PHASE; a.ph_hi = PROBE_PHASE + 1; hipLaunchKernelGGL(fwd, dim3(grid), dim3(NTHR), LDS_BYTES, stream, a); }
#endif
}
```

```cpp
#include <hip/hip_runtime.h>
#include <cstdio>
#include <cstdint>

#ifndef OPT_INPROJ
#define OPT_INPROJ 1
#endif
#ifndef OPT_BRANCH
#define OPT_BRANCH 1
#endif
#ifndef OPT_OUT
#define OPT_OUT 1
#endif
#ifndef OPT_MOE
#define OPT_MOE 1
#endif
#ifndef OPT_LOCAL
#define OPT_LOCAL 1
#endif
#ifndef OPT_OUTP
#define OPT_OUTP 1
#endif
#ifndef OPT_ROUTE
#define OPT_ROUTE 1
#endif
#define OPT_ANY (OPT_INPROJ || OPT_BRANCH || OPT_OUT || OPT_MOE)
#define DI __device__ __forceinline__
#define LAS __attribute__((address_space(3)))
typedef unsigned short bf16;
typedef float f32x4 __attribute__((ext_vector_type(4)));
typedef unsigned u32x4 __attribute__((ext_vector_type(4)));
typedef unsigned u32x2 __attribute__((ext_vector_type(2)));

constexpr int D = 1024, NB = 4, SEQ = 4096, T = NB * SEQ;
constexpr int DIN = 8200, CH = 128, NCH = SEQ / CH;
constexpr int NE = 32, TOPK = 4, NSLOT_BLK = 288, NSLOTS = NSLOT_BLK * 256;
constexpr float EPS = 1e-5f;
constexpr int NTHR = 512, NWAVES = 8;

constexpr size_t MiB = 1u << 20;
constexpr size_t WS_CTL   = 0;
constexpr size_t WS_MOD   = 1 * MiB;
constexpr size_t WS_IFG   = 2 * MiB;
constexpr size_t WS_COS   = 3 * MiB;
constexpr size_t WS_SIN   = 7 * MiB;
constexpr size_t WS_ROUTE = 11 * MiB;
constexpr size_t WS_SMALL = 14 * MiB;
constexpr size_t WS_H1    = 16 * MiB;
constexpr size_t WS_X1    = 50 * MiB;
constexpr size_t WS_TMP   = 114 * MiB;
constexpr size_t WS_B     = 178 * MiB;
constexpr size_t WS_QKRAW = WS_B;
constexpr size_t WS_QC    = WS_B + 32 * MiB;
constexpr size_t WS_MLV   = WS_B + 64 * MiB;
constexpr size_t WS_MLO   = WS_B + 96 * MiB;
constexpr size_t WS_RETQ  = WS_B + 128 * MiB;
constexpr size_t WS_RETK  = WS_B + 144 * MiB;
constexpr size_t WS_RETV  = WS_B + 160 * MiB;
constexpr size_t WS_RETG  = WS_B + 192 * MiB;
constexpr size_t WS_GML   = WS_B + 224 * MiB;
constexpr size_t WS_GRET  = WS_B + 256 * MiB;
constexpr size_t WS_CLOC  = WS_B + 288 * MiB;
constexpr size_t WS_CPREV = WS_B + 352 * MiB;
constexpr size_t WS_HML   = WS_B + 416 * MiB;
constexpr size_t WS_HRET  = WS_B + 448 * MiB;
constexpr size_t WS_B_END = WS_B + 480 * MiB;
constexpr size_t WS_ACT   = WS_B;
constexpr size_t WS_YS    = WS_B + 160 * MiB;
constexpr size_t WS_WT_IN = WS_B_END;
constexpr size_t WS_WT_BR = WS_WT_IN + 16 * MiB;
constexpr size_t WS_WT_OUT = WS_WT_BR + 4 * MiB;
constexpr size_t WS_WT_GU = WS_WT_OUT + 2 * MiB;
constexpr size_t WS_WT_DN = WS_WT_GU + 128 * MiB;
constexpr size_t WS_MODP  = WS_WT_DN + 64 * MiB;
constexpr size_t WS_END   = WS_MODP + 1 * MiB;
static_assert(WS_YS + (size_t)NSLOTS * 2048 <= WS_B_END, "ws map");

constexpr int CW_CNT = 64;
constexpr int CW_NBLK = 128;
constexpr int CW_BLKE = 192;
constexpr int CW_BAR = 4096;
constexpr size_t CTL_ZERO_BYTES = 65536;
constexpr size_t RT_TOPI = 0;
constexpr size_t RT_TOPW = 256 * 1024;
constexpr size_t RT_RANK = 512 * 1024;
constexpr size_t RT_ASLOT = 768 * 1024;
constexpr size_t RT_SLOTTOK = 1024 * 1024;
constexpr size_t RT_SLOTW = 1024 * 1024 + 512 * 1024;
constexpr size_t RT_BLKCNT = 2048 * 1024;
constexpr size_t SM_NLOC = 0;
constexpr size_t SM_NPREV = 256 * 1024;
constexpr size_t SM_MLOC = 512 * 1024;
constexpr size_t SM_ACH = 512 * 1024 + 4096;
constexpr size_t SM_MPREV = 512 * 1024 + 8192;
constexpr size_t SM_AG = 1024 * 1024;
constexpr size_t SM_CMG = 1280 * 1024;

constexpr int LDS_BYTES = 163840;

DI float bf2f(bf16 v) { return __uint_as_float(((unsigned)v) << 16); }
DI unsigned f2bf(float f) { unsigned u = __float_as_uint(f); return (u + 0x7fffu + ((u >> 16) & 1u)) >> 16; }
DI unsigned pk2(float lo, float hi) { return f2bf(lo) | (f2bf(hi) << 16); }
DI float wave_sum(float v) {
#pragma unroll
    for (int o = 1; o < 64; o <<= 1) v += __shfl_xor(v, o);
    return v;
}
DI float sigmoidf_(float x) { return 1.0f / (1.0f + __expf(-x)); }
DI float siluf_(float x) { return x / (1.0f + __expf(-x)); }
DI float logsigmoidf_(float x) { return fminf(x, 0.f) - log1pf(__expf(-fabsf(x))); }
DI void unpack8(const u32x4 w, float (&f)[8]) {
    f[0] = __uint_as_float(w.x << 16); f[1] = __uint_as_float(w.x & 0xffff0000u);
    f[2] = __uint_as_float(w.y << 16); f[3] = __uint_as_float(w.y & 0xffff0000u);
    f[4] = __uint_as_float(w.z << 16); f[5] = __uint_as_float(w.z & 0xffff0000u);
    f[6] = __uint_as_float(w.w << 16); f[7] = __uint_as_float(w.w & 0xffff0000u);
}
DI u32x4 pack8(const float (&f)[8]) { u32x4 w; w.x = pk2(f[0], f[1]); w.y = pk2(f[2], f[3]); w.z = pk2(f[4], f[5]); w.w = pk2(f[6], f[7]); return w; }

struct Args { const void* in[23]; float* out; unsigned char* ws; int ph_lo, ph_hi; };

struct Ctx {
    LAS unsigned char* lds;
    int tid, lane, wave, G, bid;
    const float *x, *c, *w_ada, *b_ada, *norm_mix_g, *w_in, *conv_w, *conv_b, *b_if, *ml_norm_g, *ret_norm_g;
    const float *w_bml, *w_bret, *w_out, *norm_ffn_g, *w_router, *b_router, *w_gu, *b_gu, *w_dn, *b_dn, *norm_final_g;
    const int* positions;
    float* out; unsigned char* ws;
};

template <class AF, class BF, class EF>
DI void naive_gemm_tile(Ctx& C, int tm, int tn, int K, int ldb, const AF& af, const BF& bf, const EF& ef) {
    LAS float* As = (LAS float*)C.lds;
    LAS float* Bs = As + 16 * 132;
    const int t = C.tid, ty = t >> 5, tx = t & 31;
    float acc[8][4];
#pragma unroll
    for (int i = 0; i < 8; ++i)
#pragma unroll
        for (int j = 0; j < 4; ++j) acc[i][j] = 0.f;
    const int ar = t >> 2, ak = (t & 3) * 4;
    const bf16* arow = af.row(tm, ar);
    const int bk = t >> 5, bn = (t & 31) * 4;
    const float* bbase = bf.ptr(tm, tn) + bn;
    for (int k0 = 0; k0 < K; k0 += 16) {
        const u32x2 av = *(const u32x2*)(arow + k0 + ak);
        const f32x4 bv = *(const f32x4*)(bbase + (size_t)(k0 + bk) * ldb);
        __syncthreads();
        As[(ak + 0) * 132 + ar] = __uint_as_float(av.x << 16); As[(ak + 1) * 132 + ar] = __uint_as_float(av.x & 0xffff0000u);
        As[(ak + 2) * 132 + ar] = __uint_as_float(av.y << 16); As[(ak + 3) * 132 + ar] = __uint_as_float(av.y & 0xffff0000u);
        *(LAS f32x4*)(Bs + bk * 132 + bn) = bv;
        __syncthreads();
#pragma unroll 4
        for (int kk = 0; kk < 16; ++kk) {
            const f32x4 a0 = *(const LAS f32x4*)(As + kk * 132 + ty * 8), a1 = *(const LAS f32x4*)(As + kk * 132 + ty * 8 + 4);
            const f32x4 b = *(const LAS f32x4*)(Bs + kk * 132 + tx * 4);
            const float a[8] = {a0.x, a0.y, a0.z, a0.w, a1.x, a1.y, a1.z, a1.w};
#pragma unroll
            for (int i = 0; i < 8; ++i) { acc[i][0] += a[i] * b.x; acc[i][1] += a[i] * b.y; acc[i][2] += a[i] * b.z; acc[i][3] += a[i] * b.w; }
        }
    }
#pragma unroll
    for (int i = 0; i < 8; ++i) { ef.put(tm, tn, ty * 8 + i, tx * 4, acc[i]); asm volatile("" ::: "memory"); }
    __syncthreads();
}

DI void phase_mod(Ctx& C) {
    LAS float* red = (LAS float*)C.lds;
    float* mod = (float*)(C.ws + WS_MOD);
    for (int g = C.bid; g < 256; g += C.G) {
        const int n0 = g * 24, t = C.tid;
        if (t < 504) {
            const int col = t % 24, kg = t / 24;
            float a0 = 0.f, a1 = 0.f, a2 = 0.f, a3 = 0.f;
            for (int k = kg; k < D; k += 21) {
                const float w = C.w_ada[(size_t)k * 6144 + n0 + col];
                a0 += siluf_(C.c[k]) * w; a1 += siluf_(C.c[D + k]) * w; a2 += siluf_(C.c[2 * D + k]) * w; a3 += siluf_(C.c[3 * D + k]) * w;
            }
            red[(kg * 24 + col) * 4 + 0] = a0; red[(kg * 24 + col) * 4 + 1] = a1; red[(kg * 24 + col) * 4 + 2] = a2; red[(kg * 24 + col) * 4 + 3] = a3;
        }
        __syncthreads();
        if (t < 96) {
            const int col = t % 24, b = t / 24; float s = 0.f;
            for (int kg = 0; kg < 21; ++kg) s += red[(kg * 24 + col) * 4 + b];
            mod[b * 6144 + n0 + col] = s + C.b_ada[n0 + col];
        }
        __syncthreads();
    }
}

DI void phase_norm1(Ctx& C) {
    const float* mod = (const float*)(C.ws + WS_MOD);
    bf16* H1 = (bf16*)(C.ws + WS_H1);
    float* IFG = (float*)(C.ws + WS_IFG);
    const int lane = C.lane, gw = C.bid * NWAVES + C.wave, NGW = C.G * NWAVES;
    float wif[4][4][8];
#pragma unroll
    for (int j = 0; j < 4; ++j)
#pragma unroll
        for (int i = 0; i < 4; ++i) {
            const float* wp = C.w_in + (size_t)(4 * (lane + 64 * j) + i) * DIN + 3072;
#pragma unroll
            for (int e = 0; e < 8; ++e) wif[j][i][e] = wp[e];
        }
    for (int m = gw; m < T; m += NGW) {
        const int b = m / SEQ;
        const f32x4* xr = (const f32x4*)(C.x + (size_t)m * D) + lane;
        f32x4 v[4]; float ss = 0.f;
#pragma unroll
        for (int j = 0; j < 4; ++j) { v[j] = xr[64 * j]; ss += (v[j].x * v[j].x + v[j].y * v[j].y) + (v[j].z * v[j].z + v[j].w * v[j].w); }
        const float rstd = 1.0f / sqrtf(wave_sum(ss) * (1.0f / D) + EPS);
        float p[8];
#pragma unroll
        for (int e = 0; e < 8; ++e) p[e] = 0.f;
        u32x2* o8 = (u32x2*)(H1 + (size_t)m * D) + lane;
#pragma unroll
        for (int j = 0; j < 4; ++j) {
            const int col = 4 * (lane + 64 * j);
            const f32x4 g = *(const f32x4*)(C.norm_mix_g + col), sh = *(const f32x4*)(mod + b * 6144 + col), sc = *(const f32x4*)(mod + b * 6144 + 1024 + col);
            f32x4 h = (v[j] * rstd * g) * (sc + 1.0f) + sh;
            u32x2 w; w.x = pk2(h.x, h.y); w.y = pk2(h.z, h.w); o8[64 * j] = w;
            const float hh[4] = {h.x, h.y, h.z, h.w};
#pragma unroll
            for (int i = 0; i < 4; ++i)
#pragma unroll
                for (int e = 0; e < 8; ++e) p[e] += hh[i] * wif[j][i][e];
        }
#pragma unroll
        for (int e = 0; e < 8; ++e) p[e] = wave_sum(p[e]);
        if (lane < 8) { float r = p[0];
#pragma unroll
            for (int e = 1; e < 8; ++e) r = (lane == e) ? p[e] : r;
            IFG[(size_t)m * 8 + lane] = r + C.b_if[lane]; }
    }
    float* COS = (float*)(C.ws + WS_COS); float* SIN = (float*)(C.ws + WS_SIN);
    for (int idx = C.bid * NTHR + C.tid; idx < T * 64; idx += C.G * NTHR) {
        const int t = idx >> 6, i = idx & 63;
        const float inv = (float)exp(-(double)i * (9.210340371976184 / 64.0));
        const double ang = (double)C.positions[t] * (double)inv;
        const double kq = rint(ang * 0.6366197723675814);
        double r = fma(-kq, 1.5707963267948966, ang); r = fma(-kq, 6.123233995736766e-17, r);
        const float rf = (float)r; const float s = sinf(rf), c = cosf(rf);
        const int q = ((int)kq) & 3;
        const float cs = (q == 0) ? c : (q == 1) ? -s : (q == 2) ? -c : s;
        const float sn = (q == 0) ? s : (q == 1) ? c : (q == 2) ? -s : -c;
        COS[idx] = cs; SIN[idx] = sn;
    }
    if (C.bid == 0 && C.tid < 32) ((unsigned*)(C.ws + WS_CTL))[CW_CNT + C.tid] = 0u;
}

struct AF_rows { const bf16* base; int ld; DI const bf16* row(int tm, int r) const { return base + (size_t)(tm * 128 + r) * ld; } };
struct BF_inproj { const float* w; DI const float* ptr(int, int tn) const { return w + (tn < 24 ? tn * 128 : tn * 128 + 8); } };
struct EF_inproj { unsigned char* ws;
    DI void put(int tm, int tn, int r, int c, const float (&v)[4]) const {
        const int row = tm * 128 + r; const int seg = tn >> 3;
        bf16* dst; int ld = 1024, col = (tn & 7) * 128 + c; int act = 0;
        switch (seg) {
            case 0: dst = (bf16*)(ws + WS_QKRAW); break;
            case 1: dst = (bf16*)(ws + WS_MLV); break;
            case 2: dst = (bf16*)(ws + WS_MLO); act = 1; break;
            case 3: if ((tn & 7) < 4) dst = (bf16*)(ws + WS_RETQ); else { dst = (bf16*)(ws + WS_RETK); col -= 512; } ld = 512; break;
            case 4: dst = (bf16*)(ws + WS_RETV); break;
            case 5: dst = (bf16*)(ws + WS_RETG); act = 2; break;
            case 6: dst = (bf16*)(ws + WS_GML); act = 1; break;
            default: dst = (bf16*)(ws + WS_GRET); act = 1; break;
        }
        float o[4];
#pragma unroll
        for (int j = 0; j < 4; ++j) o[j] = act == 1 ? sigmoidf_(v[j]) : act == 2 ? siluf_(v[j]) : v[j];
        u32x2 w; w.x = pk2(o[0], o[1]); w.y = pk2(o[2], o[3]);
        *(u32x2*)(dst + (size_t)row * ld + col) = w;
    } };
DI void phase_inproj(Ctx& C) {
    AF_rows af{(const bf16*)(C.ws + WS_H1), D}; BF_inproj bf{C.w_in}; EF_inproj ef{C.ws};
    const int ntn = 64, nt = (T / 128) * ntn;
    for (int u = C.bid; u < nt; u += C.G) naive_gemm_tile(C, u / ntn, u % ntn, D, DIN, af, bf, ef);
}

DI void phase_conv_rope(Ctx& C) {
    const bf16* QKRAW = (const bf16*)(C.ws + WS_QKRAW); bf16* QC = (bf16*)(C.ws + WS_QC);
    for (int idx = C.bid * NTHR + C.tid; idx < T * 128; idx += C.G * NTHR) {
        const int t = idx >> 7, c0 = (idx & 127) * 8, s = t % SEQ;
        float acc[8];
#pragma unroll
        for (int e = 0; e < 8; ++e) acc[e] = C.conv_b[c0 + e];
#pragma unroll
        for (int j = 0; j < 4; ++j) {
            if (s - 3 + j >= 0) {
                float f[8]; unpack8(*(const u32x4*)(QKRAW + (size_t)(t - 3 + j) * D + c0), f);
#pragma unroll
                for (int e = 0; e < 8; ++e) acc[e] += f[e] * C.conv_w[j * D + c0 + e];
            }
        }
        const float sc = (c0 < 512) ? 0.08838834764831845f : 1.0f;
#pragma unroll
        for (int e = 0; e < 8; ++e) acc[e] = siluf_(acc[e]) * sc;
        *(u32x4*)(QC + (size_t)t * D + c0) = pack8(acc);
    }
#if !OPT_INPROJ
    const float* COS = (const float*)(C.ws + WS_COS); const float* SIN = (const float*)(C.ws + WS_SIN);
    for (int idx = C.bid * NTHR + C.tid; idx < T * 64; idx += C.G * NTHR) {
        const int t = idx >> 6, r = idx & 63, which = r >> 5, h = (r >> 3) & 3, i0 = (r & 7) * 8;
        bf16* base = (bf16*)(C.ws + (which ? WS_RETK : WS_RETQ)) + (size_t)t * 512 + h * 128;
        float x1[8], x2[8], o1[8], o2[8]; unpack8(*(const u32x4*)(base + i0), x1); unpack8(*(const u32x4*)(base + 64 + i0), x2);
        const float sc = which ? 0.08838834764831845f : 1.0f;
#pragma unroll
        for (int e = 0; e < 8; ++e) { const float cs = COS[t * 64 + i0 + e], sn = SIN[t * 64 + i0 + e]; o1[e] = (x1[e] * cs - x2[e] * sn) * sc; o2[e] = (x2[e] * cs + x1[e] * sn) * sc; }
        *(u32x4*)(base + i0) = pack8(o1); *(u32x4*)(base + 64 + i0) = pack8(o2);
    }
#endif
}

DI float ret_lg(int h) { return logf(1.0f - exp2f(-5.0f - (float)h)); }

DI void phase_local(Ctx& C) {
    LAS float* lf = (LAS float*)C.lds; LAS float* a = lf + 128; LAS float* ws = a + 128; LAS float* red = ws + 128;
    const float* IFG = (const float*)(C.ws + WS_IFG);
    bf16* CLOC = (bf16*)(C.ws + WS_CLOC);
    float* NLOC = (float*)(C.ws + WS_SMALL + SM_NLOC); float* MLOC = (float*)(C.ws + WS_SMALL + SM_MLOC); float* ACH = (float*)(C.ws + WS_SMALL + SM_ACH);
    const int t = C.tid;
    for (int u = C.bid; u < 1024; u += C.G) {
        const int mixer = u >> 9, bh = (u >> 5) & 15, ch = u & 31, b = bh >> 2, h = bh & 3, t0 = b * SEQ + ch * CH;
        const bf16 *Kp, *Vp; int ldk;
        if (mixer == 0) {
            if (t < 128) lf[t] = logsigmoidf_(IFG[(size_t)(t0 + t) * 8 + 4 + h]);
            __syncthreads();
            if (t < 128) { float s = 0.f; for (int j = 0; j <= t; ++j) s += lf[j]; a[t] = s; }
            __syncthreads();
            const float A = a[127];
            if (t < 128) ws[t] = A - a[t] + IFG[(size_t)(t0 + t) * 8 + h];
            __syncthreads();
            float mloc = -3.0e38f; for (int j = 0; j < 128; ++j) mloc = fmaxf(mloc, ws[j]);
            __syncthreads();
            if (t < 128) ws[t] = __expf(ws[t] - mloc);
            if (t == 0) { MLOC[bh * 32 + ch] = mloc; ACH[bh * 32 + ch] = A; }
            __syncthreads();
            Kp = (const bf16*)(C.ws + WS_QC) + (size_t)t0 * D + 512 + h * 128; ldk = D;
            Vp = (const bf16*)(C.ws + WS_MLV) + (size_t)t0 * D + h * 256;
        } else {
            const float lg = ret_lg(h);
            if (t < 128) ws[t] = __expf(lg * (float)(127 - t));
            __syncthreads();
            Kp = (const bf16*)(C.ws + WS_RETK) + (size_t)t0 * 512 + h * 128; ldk = 512;
            Vp = (const bf16*)(C.ws + WS_RETV) + (size_t)t0 * D + h * 256;
        }
        const int kh = t >> 8, v = t & 255;
        float acc[64];
#pragma unroll
        for (int i = 0; i < 64; ++i) acc[i] = 0.f;
        for (int s = 0; s < 128; ++s) {
            const float vv = ws[s] * bf2f(Vp[(size_t)s * D + v]);
            const bf16* kr = Kp + (size_t)s * ldk + kh * 64;
#pragma unroll
            for (int i8 = 0; i8 < 8; ++i8) { float f[8]; unpack8(*(const u32x4*)(kr + i8 * 8), f);
#pragma unroll
                for (int e = 0; e < 8; ++e) acc[i8 * 8 + e] += f[e] * vv; }
        }
        bf16* cl = CLOC + ((size_t)(mixer * 16 + bh) * 32 + ch) * 32768;
#pragma unroll
        for (int i = 0; i < 64; ++i) cl[(size_t)v * 128 + (kh * 64 + i)] = (bf16)f2bf(acc[i]);
        if (mixer == 0 && t < 128) { float s = 0.f; for (int j = 0; j < 128; ++j) s += ws[j] * bf2f(Kp[(size_t)j * ldk + t]); NLOC[(bh * 32 + ch) * 128 + t] = s; }
        __syncthreads();
    }
    (void)red;
}

DI void phase_scan(Ctx& C) {
    const bf16* CLOC = (const bf16*)(C.ws + WS_CLOC); bf16* CPREV = (bf16*)(C.ws + WS_CPREV);
    const float* NLOC = (const float*)(C.ws + WS_SMALL + SM_NLOC); float* NPREV = (float*)(C.ws + WS_SMALL + SM_NPREV);
    const float* MLOC = (const float*)(C.ws + WS_SMALL + SM_MLOC); const float* ACH = (const float*)(C.ws + WS_SMALL + SM_ACH); float* MPREV = (float*)(C.ws + WS_SMALL + SM_MPREV);
    for (int idx = C.bid * NTHR + C.tid; idx < 32 * 4096; idx += C.G * NTHR) {
        const int seq = idx >> 12, e8 = idx & 4095;
        float st[8];
#pragma unroll
        for (int e = 0; e < 8; ++e) st[e] = 0.f;
        if (seq < 16) {
            float m_st = 0.f; float nst[8];
#pragma unroll
            for (int e = 0; e < 8; ++e) nst[e] = 0.f;
            for (int ch = 0; ch < 32; ++ch) {
                const size_t o = ((size_t)seq * 32 + ch) * 32768 + (size_t)e8 * 8;
                *(u32x4*)(CPREV + o) = pack8(st);
                if (e8 < 16) { *(f32x4*)(NPREV + (seq * 32 + ch) * 128 + e8 * 8) = (f32x4){nst[0], nst[1], nst[2], nst[3]}; *(f32x4*)(NPREV + (seq * 32 + ch) * 128 + e8 * 8 + 4) = (f32x4){nst[4], nst[5], nst[6], nst[7]}; }
                if (e8 == 0) MPREV[seq * 32 + ch] = m_st;
                const float A = ACH[seq * 32 + ch], ml = MLOC[seq * 32 + ch];
                const float m_new = fmaxf(A + m_st, ml), sp = __expf(A + m_st - m_new), sl = __expf(ml - m_new);
                float f[8]; unpack8(*(const u32x4*)(CLOC + o), f);
#pragma unroll
                for (int e = 0; e < 8; ++e) st[e] = sp * st[e] + sl * f[e];
                if (e8 < 16) { const float* nl = NLOC + (seq * 32 + ch) * 128 + e8 * 8;
#pragma unroll
                    for (int e = 0; e < 8; ++e) nst[e] = sp * nst[e] + sl * nl[e]; }
                m_st = m_new;
            }
        } else {
            const float g = __expf(ret_lg(seq & 3) * 128.0f);
            for (int ch = 0; ch < 32; ++ch) {
                const size_t o = ((size_t)seq * 32 + ch) * 32768 + (size_t)e8 * 8;
                *(u32x4*)(CPREV + o) = pack8(st);
                float f[8]; unpack8(*(const u32x4*)(CLOC + o), f);
#pragma unroll
                for (int e = 0; e < 8; ++e) st[e] = g * st[e] + f[e];
            }
        }
    }
}

DI void phase_out(Ctx& C) {
    LAS float* av = (LAS float*)C.lds;
    LAS float* bv = av + 128;
    LAS float* mt = bv + 128;
    LAS float* isc = mt + 128;
    LAS float* den = isc + 128;
    LAS float* rs = den + 128;
    LAS float* P = rs + 1024;
    LAS float* Qs = P + 128 * 129;
    const float* IFG = (const float*)(C.ws + WS_IFG);
    const bf16* CPREV = (const bf16*)(C.ws + WS_CPREV);
    const float* NPREV = (const float*)(C.ws + WS_SMALL + SM_NPREV); const float* MPREV = (const float*)(C.ws + WS_SMALL + SM_MPREV);
    const int t = C.tid;
    for (int u = C.bid; u < 1024; u += C.G) {
        const int mixer = u >> 9, bh = (u >> 5) & 15, ch = u & 31, b = bh >> 2, h = bh & 3, t0 = b * SEQ + ch * CH;
        const bf16 *Qp, *Kp, *Vp; int ldq; const bf16* cp = CPREV + ((size_t)(mixer * 16 + bh) * 32 + ch) * 32768;
        float lg = 0.f;
        if (mixer == 0) {
            Qp = (const bf16*)(C.ws + WS_QC) + (size_t)t0 * D + h * 128; Kp = Qp + 512; ldq = D;
            Vp = (const bf16*)(C.ws + WS_MLV) + (size_t)t0 * D + h * 256;
            if (t < 128) mt[t] = logsigmoidf_(IFG[(size_t)(t0 + t) * 8 + 4 + h]);
            __syncthreads();
            if (t < 128) { float s = 0.f; for (int j = 0; j <= t; ++j) s += mt[j]; av[t] = s; bv[t] = IFG[(size_t)(t0 + t) * 8 + h] - s; }
            __syncthreads();
            if (t < 128) { float cm = -3.0e38f; for (int j = 0; j <= t; ++j) cm = fmaxf(cm, bv[j]);
                const float il = av[t] + MPREV[bh * 32 + ch], m = fmaxf(il, av[t] + cm); isc[t] = __expf(il - m); mt[t] = m; }
        } else {
            lg = ret_lg(h);
            Qp = (const bf16*)(C.ws + WS_RETQ) + (size_t)t0 * 512 + h * 128; Kp = (const bf16*)(C.ws + WS_RETK) + (size_t)t0 * 512 + h * 128; ldq = 512;
            Vp = (const bf16*)(C.ws + WS_RETV) + (size_t)t0 * D + h * 256;
            if (t < 128) isc[t] = __expf(lg * (float)(t + 1));
        }
        for (int e = t; e < 128 * 16; e += NTHR) { const int j = e >> 4, k8 = e & 15; float f[8]; unpack8(*(const u32x4*)(Qp + (size_t)j * ldq + k8 * 8), f);
#pragma unroll
            for (int i = 0; i < 8; ++i) Qs[j * 129 + k8 * 8 + i] = f[i]; }
        __syncthreads();
        for (int e = t; e < 128 * 128; e += NTHR) {
            const int j = e >> 7, s = e & 127; float p = 0.f;
            if (s <= j) {
                float d = 0.f;
#pragma unroll 4
                for (int k8 = 0; k8 < 16; ++k8) { float fk[8]; unpack8(*(const u32x4*)(Kp + (size_t)s * ldq + k8 * 8), fk);
#pragma unroll
                    for (int i = 0; i < 8; ++i) d += Qs[j * 129 + k8 * 8 + i] * fk[i]; }
                p = d * (mixer == 0 ? __expf(av[j] + bv[s] - mt[j]) : __expf(lg * (float)(j - s)));
            }
            P[j * 129 + s] = p;
        }
        __syncthreads();
        if (mixer == 0 && t < 128) { float s = 0.f; for (int i = 0; i < 128; ++i) s += P[t * 129 + i];
            float qn = 0.f; const float* np = NPREV + (bh * 32 + ch) * 128; for (int k = 0; k < 128; ++k) qn += Qs[t * 129 + k] * np[k];
            den[t] = fmaxf(fabsf(s + isc[t] * qn), __expf(-mt[t])); }
        __syncthreads();
        const float gain = (mixer == 0 ? C.ml_norm_g : C.ret_norm_g)[h * 256 + (t & 255)];
#pragma unroll 1
        for (int pass = 0; pass < 2; ++pass) {
            const int jh = t >> 8, v = t & 255, r0 = (pass * 2 + jh) * 32;
            float acc[32];
#pragma unroll
            for (int i = 0; i < 32; ++i) acc[i] = 0.f;
            const LAS float* qb = Qs + r0 * 129; const LAS float* pb = P + r0 * 129;
            for (int k = 0; k < 128; ++k) {
                const float cv = bf2f(cp[(size_t)v * 128 + k]);
#pragma unroll
                for (int i = 0; i < 32; ++i) acc[i] += qb[i * 129 + k] * cv;
            }
#pragma unroll
            for (int i = 0; i < 32; ++i) acc[i] *= isc[r0 + i];
            for (int s = 0; s < 128; ++s) {
                const float vv = bf2f(Vp[(size_t)s * D + v]);
#pragma unroll
                for (int i = 0; i < 32; ++i) acc[i] += pb[i * 129 + s] * vv;
            }
            if (mixer == 0) {
#pragma unroll
                for (int i = 0; i < 32; ++i) acc[i] = acc[i] / den[r0 + i];
            }
            const int wq = C.wave & 3;
#pragma unroll
            for (int i = 0; i < 32; ++i) { const float s1 = wave_sum(acc[i]); if (C.lane == 0) rs[wq * 128 + r0 + i] = s1; }
            __syncthreads();
#pragma unroll
            for (int i = 0; i < 32; ++i) { const int r = r0 + i; acc[i] -= (rs[r] + rs[128 + r] + rs[256 + r] + rs[384 + r]) * (1.0f / 256.0f); }
#pragma unroll
            for (int i = 0; i < 32; ++i) { const float s2 = wave_sum(acc[i] * acc[i]); if (C.lane == 0) rs[512 + wq * 128 + r0 + i] = s2; }
            __syncthreads();
            const bf16* gate = (const bf16*)(C.ws + (mixer == 0 ? WS_MLO : WS_RETG)) + (size_t)t0 * D + h * 256 + v;
            bf16* outp = (bf16*)(C.ws + (mixer == 0 ? WS_HML : WS_HRET)) + (size_t)t0 * D + h * 256 + v;
#pragma unroll
            for (int i = 0; i < 32; ++i) { const int r = r0 + i;
                const float var = (rs[512 + r] + rs[512 + 128 + r] + rs[512 + 256 + r] + rs[512 + 384 + r]) * (1.0f / 256.0f);
                const float y = acc[i] * (1.0f / sqrtf(var + EPS)) * gain * bf2f(gate[(size_t)r * D]);
                outp[(size_t)r * D] = (bf16)f2bf(y); }
            __syncthreads();
        }
    }
}

struct BF_plain { const float* w; DI const float* ptr(int, int tn) const { return w + tn * 128; } };
struct EF_f32 { float* dst; DI void put(int tm, int tn, int r, int c, const float (&v)[4]) const { *(f32x4*)(dst + (size_t)(tm * 128 + r) * D + tn * 128 + c) = (f32x4){v[0], v[1], v[2], v[3]}; } };
struct EF_merge { const float* t1; const bf16* g1; const bf16* g2; bf16* y;
    DI void put(int tm, int tn, int r, int c, const float (&v)[4]) const {
        const size_t o = (size_t)(tm * 128 + r) * D + tn * 128 + c; const f32x4 a = *(const f32x4*)(t1 + o);
        const u32x2 w1 = *(const u32x2*)(g1 + o), w2 = *(const u32x2*)(g2 + o);
        const float o0 = __uint_as_float(w1.x << 16) * a.x + __uint_as_float(w2.x << 16) * v[0], o1 = __uint_as_float(w1.x & 0xffff0000u) * a.y + __uint_as_float(w2.x & 0xffff0000u) * v[1];
        const float o2 = __uint_as_float(w1.y << 16) * a.z + __uint_as_float(w2.y << 16) * v[2], o3 = __uint_as_float(w1.y & 0xffff0000u) * a.w + __uint_as_float(w2.y & 0xffff0000u) * v[3];
        u32x2 w; w.x = pk2(o0, o1); w.y = pk2(o2, o3); *(u32x2*)(y + o) = w; } };
DI void phase_branch(Ctx& C) {
    AF_rows a1{(const bf16*)(C.ws + WS_HML), D}, a2{(const bf16*)(C.ws + WS_HRET), D}; BF_plain b1{C.w_bml}, b2{C.w_bret};
    EF_f32 e1{(float*)(C.ws + WS_TMP)}; EF_merge e2{(const float*)(C.ws + WS_TMP), (const bf16*)(C.ws + WS_GML), (const bf16*)(C.ws + WS_GRET), (bf16*)(C.ws + WS_H1)};
    const int nt = (T / 128) * 8;
    for (int u = C.bid; u < nt; u += C.G) { naive_gemm_tile(C, u / 8, u % 8, D, D, a1, b1, e1); naive_gemm_tile(C, u / 8, u % 8, D, D, a2, b2, e2); }
}
struct EF_resid { const float* x; const float* mod; float* x1;
    DI void put(int tm, int tn, int r, int c, const float (&v)[4]) const {
        const int row = tm * 128 + r, col = tn * 128 + c, b = row / SEQ; const size_t o = (size_t)row * D + col;
        const f32x4 xv = *(const f32x4*)(x + o), g = *(const f32x4*)(mod + b * 6144 + 2048 + col);
        *(f32x4*)(x1 + o) = xv + g * (f32x4){v[0], v[1], v[2], v[3]}; } };
DI void phase_outproj(Ctx& C) {
    AF_rows a{(const bf16*)(C.ws + WS_H1), D}; BF_plain b{C.w_out}; EF_resid e{C.x, (const float*)(C.ws + WS_MOD), (float*)(C.ws + WS_X1)};
    const int nt = (T / 128) * 8;
    for (int u = C.bid; u < nt; u += C.G) naive_gemm_tile(C, u / 8, u % 8, D, D, a, b, e);
}

DI void phase_norm2_route(Ctx& C) {
    LAS float* wr = (LAS float*)C.lds;
    LAS float* lg = wr + 32768;
    for (int i = C.tid; i < 32768 / 4; i += NTHR) *(LAS f32x4*)(wr + i * 4) = *(const f32x4*)(C.w_router + i * 4);
    __syncthreads();
    const float* mod = (const float*)(C.ws + WS_MOD); const float* X1 = (const float*)(C.ws + WS_X1);
    bf16* H2 = (bf16*)(C.ws + WS_H1);
    int* TOPI = (int*)(C.ws + WS_ROUTE + RT_TOPI); float* TOPW = (float*)(C.ws + WS_ROUTE + RT_TOPW); int* RANK = (int*)(C.ws + WS_ROUTE + RT_RANK);
    unsigned* CNT = (unsigned*)(C.ws + WS_CTL) + CW_CNT;
    const int lane = C.lane, gw = C.bid * NWAVES + C.wave, NGW = C.G * NWAVES;
    for (int m = gw; m < T; m += NGW) {
        const int b = m / SEQ;
        const f32x4* xr = (const f32x4*)(X1 + (size_t)m * D) + lane;
        f32x4 v[4]; float ss = 0.f;
#pragma unroll
        for (int j = 0; j < 4; ++j) { v[j] = xr[64 * j]; ss += (v[j].x * v[j].x + v[j].y * v[j].y) + (v[j].z * v[j].z + v[j].w * v[j].w); }
        const float rstd = 1.0f / sqrtf(wave_sum(ss) * (1.0f / D) + EPS);
        float acc[32];
#pragma unroll
        for (int e = 0; e < 32; ++e) acc[e] = 0.f;
        u32x2* o8 = (u32x2*)(H2 + (size_t)m * D) + lane;
#pragma unroll
        for (int j = 0; j < 4; ++j) {
            const int col = 4 * (lane + 64 * j);
            const f32x4 g = *(const f32x4*)(C.norm_ffn_g + col), sh = *(const f32x4*)(mod + b * 6144 + 3072 + col), sc = *(const f32x4*)(mod + b * 6144 + 4096 + col);
            const f32x4 h = (v[j] * rstd * g) * (sc + 1.0f) + sh;
            u32x2 w; w.x = pk2(h.x, h.y); w.y = pk2(h.z, h.w); o8[64 * j] = w;
            const float hh[4] = {h.x, h.y, h.z, h.w};
#pragma unroll
            for (int i = 0; i < 4; ++i) {
                const LAS f32x4* wp = (const LAS f32x4*)(wr + (col + i) * 32);
#pragma unroll
                for (int e4 = 0; e4 < 8; ++e4) { const f32x4 w4 = wp[e4]; acc[e4 * 4 + 0] += hh[i] * w4.x; acc[e4 * 4 + 1] += hh[i] * w4.y; acc[e4 * 4 + 2] += hh[i] * w4.z; acc[e4 * 4 + 3] += hh[i] * w4.w; }
                asm volatile("" ::: "memory");
            }
        }
#pragma unroll
        for (int e = 0; e < 32; ++e) acc[e] = wave_sum(acc[e]);
        float l[32];
#pragma unroll
        for (int e = 0; e < 32; ++e) l[e] = acc[e] + C.b_router[e];
        float tv[4]; int ti[4];
#pragma unroll
        for (int k = 0; k < 4; ++k) {
            float bvv = -3.0e38f; int bi = 0;
#pragma unroll
            for (int e = 0; e < 32; ++e) { const bool take = l[e] > bvv; bvv = take ? l[e] : bvv; bi = take ? e : bi; }
            tv[k] = bvv; ti[k] = bi;
#pragma unroll
            for (int e = 0; e < 32; ++e) l[e] = (e == bi) ? -3.0e38f : l[e];
        }
        const float e1 = __expf(tv[1] - tv[0]), e2 = __expf(tv[2] - tv[0]), e3 = __expf(tv[3] - tv[0]), inv = 1.0f / (1.0f + e1 + e2 + e3);
        if (lane < 4) {
            const int e = lane == 0 ? ti[0] : lane == 1 ? ti[1] : lane == 2 ? ti[2] : ti[3];
            const float w = (lane == 0 ? 1.0f : lane == 1 ? e1 : lane == 2 ? e2 : e3) * inv;
            TOPI[m * 4 + lane] = e; TOPW[m * 4 + lane] = w; RANK[m * 4 + lane] = (int)atomicAdd(CNT + e, 1u);
        }
    }
    (void)lg;
    int* SLOTTOK = (int*)(C.ws + WS_ROUTE + RT_SLOTTOK); float* SLOTW = (float*)(C.ws + WS_ROUTE + RT_SLOTW);
    for (int i = C.bid * NTHR + C.tid; i < NSLOTS; i += C.G * NTHR) { SLOTTOK[i] = T; SLOTW[i] = 0.f; }
    if (C.bid == 0) for (int i = C.tid; i < D / 2; i += NTHR) ((unsigned*)(H2 + (size_t)T * D))[i] = 0u;
    __syncthreads();
}

DI void phase_slots(Ctx& C) {
    LAS int* tot = (LAS int*)C.lds;
    LAS int* pstart = tot + 32;
    LAS int* base = pstart + 32;
    LAS int* part = base + 32;
    const unsigned* BLKCNT = (const unsigned*)(C.ws + WS_ROUTE + RT_BLKCNT);
    unsigned* ctl = (unsigned*)(C.ws + WS_CTL);
    const int* TOPI = (const int*)(C.ws + WS_ROUTE + RT_TOPI); const float* TOPW = (const float*)(C.ws + WS_ROUTE + RT_TOPW); const int* RANK = (const int*)(C.ws + WS_ROUTE + RT_RANK);
    int* ASLOT = (int*)(C.ws + WS_ROUTE + RT_ASLOT); int* SLOTTOK = (int*)(C.ws + WS_ROUTE + RT_SLOTTOK); float* SLOTW = (float*)(C.ws + WS_ROUTE + RT_SLOTW);
    for (int sg = C.bid; sg < T / 64; sg += C.G) {
        const int e = C.tid & 31, pt = C.tid >> 5;
        int sa = 0, sb = 0;
        for (int g2 = pt; g2 < T / 64; g2 += 16) { const int c = (int)BLKCNT[g2 * 32 + e]; sa += c; sb += (g2 < sg) ? c : 0; }
        part[(pt * 32 + e) * 2] = sa; part[(pt * 32 + e) * 2 + 1] = sb;
        __syncthreads();
        if (C.tid < 32) { int a = 0, b2 = 0; for (int p2 = 0; p2 < 16; ++p2) { a += part[(p2 * 32 + C.tid) * 2]; b2 += part[(p2 * 32 + C.tid) * 2 + 1]; } tot[C.tid] = a; base[C.tid] = b2; }
        __syncthreads();
        if (C.tid == 0) {
            int nb = 0;
            for (int e2 = 0; e2 < NE; ++e2) { pstart[e2] = nb * 256; const int bl = (tot[e2] + 255) >> 8;
                if (sg == 0) for (int i = 0; i < bl; ++i) ctl[CW_BLKE + nb + i] = (unsigned)e2;
                nb += bl; }
            if (sg == 0) ctl[CW_NBLK] = (unsigned)nb;
        }
        __syncthreads();
        if (C.tid < 256) { const int i = sg * 256 + C.tid, ex = TOPI[i];
            const int slot = pstart[ex] + base[ex] + RANK[i];
            ASLOT[i] = slot; SLOTTOK[slot] = i >> 2; SLOTW[slot] = TOPW[i]; }
        __syncthreads();
    }
}

struct AF_gather { const bf16* base; const int* slottok; DI const bf16* row(int tm, int r) const { return base + (size_t)slottok[tm * 128 + r] * D; } };
struct BF_expert { const float* w; const unsigned* blke; size_t estride; DI const float* ptr(int tm, int tn) const { return w + (size_t)blke[tm >> 1] * estride + tn * 128; } };
struct EF_swiglu { const float* bias; const unsigned* blke; bf16* act;
    DI void put(int tm, int tn, int r, int c, const float (&v)[4]) const {
        const int e = (int)blke[tm >> 1]; const float* bp = bias + (size_t)e * 2048 + tn * 128 + c;
        float o[2];
#pragma unroll
        for (int j = 0; j < 2; ++j) { const float xg = fminf(v[2 * j] + bp[2 * j], 7.0f), xl = fminf(fmaxf(v[2 * j + 1] + bp[2 * j + 1], -7.0f), 7.0f); o[j] = xg * sigmoidf_(1.702f * xg) * (xl + 1.0f); }
        *(unsigned*)(act + (size_t)(tm * 128 + r) * D + (tn * 128 + c) / 2) = pk2(o[0], o[1]); } };
DI void phase_gateup(Ctx& C) {
    const unsigned* ctl = (const unsigned*)(C.ws + WS_CTL); const int nblk = (int)ctl[CW_NBLK];
    AF_gather a{(const bf16*)(C.ws + WS_H1), (const int*)(C.ws + WS_ROUTE + RT_SLOTTOK)}; BF_expert b{C.w_gu, ctl + CW_BLKE, (size_t)D * 2048};
    EF_swiglu e{C.b_gu, ctl + CW_BLKE, (bf16*)(C.ws + WS_ACT)};
    const int nt = nblk * 2 * 16;
    for (int u = C.bid; u < nt; u += C.G) naive_gemm_tile(C, u / 16, u % 16, D, 2048, a, b, e);
}
struct EF_down { const float* bias; const unsigned* blke; const float* slotw; bf16* ys;
    DI void put(int tm, int tn, int r, int c, const float (&v)[4]) const {
        const int e = (int)blke[tm >> 1], slot = tm * 128 + r; const float w = slotw[slot]; const float* bp = bias + (size_t)e * D + tn * 128 + c;
        u32x2 o; o.x = pk2((v[0] + bp[0]) * w, (v[1] + bp[1]) * w); o.y = pk2((v[2] + bp[2]) * w, (v[3] + bp[3]) * w);
        *(u32x2*)(ys + (size_t)slot * D + tn * 128 + c) = o; } };
DI void phase_down(Ctx& C) {
    const unsigned* ctl = (const unsigned*)(C.ws + WS_CTL); const int nblk = (int)ctl[CW_NBLK];
    AF_rows a{(const bf16*)(C.ws + WS_ACT), D}; BF_expert b{C.w_dn, ctl + CW_BLKE, (size_t)D * D};
    EF_down e{C.b_dn, ctl + CW_BLKE, (const float*)(C.ws + WS_ROUTE + RT_SLOTW), (bf16*)(C.ws + WS_YS)};
    const int nt = nblk * 2 * 8;
    for (int u = C.bid; u < nt; u += C.G) naive_gemm_tile(C, u / 8, u % 8, D, D, a, b, e);
}
DI void phase_final(Ctx& C) {
    const float* mod = (const float*)(C.ws + WS_MOD); const float* X1 = (const float*)(C.ws + WS_X1); const bf16* YS = (const bf16*)(C.ws + WS_YS);
    const int* ASLOT = (const int*)(C.ws + WS_ROUTE + RT_ASLOT);
    const int lane = C.lane, gw = C.bid * NWAVES + C.wave, NGW = C.G * NWAVES;
    for (int m = gw; m < T; m += NGW) {
        const int b = m / SEQ;
        const int s0 = ASLOT[m * 4 + 0], s1 = ASLOT[m * 4 + 1], s2 = ASLOT[m * 4 + 2], s3 = ASLOT[m * 4 + 3];
        f32x4 v[4]; float ss = 0.f;
#pragma unroll
        for (int j = 0; j < 4; ++j) {
            const int col = 4 * (lane + 64 * j);
            f32x4 y = (f32x4){0.f, 0.f, 0.f, 0.f};
            const int sl[4] = {s0, s1, s2, s3};
#pragma unroll
            for (int k = 0; k < 4; ++k) { const u32x2 w = *(const u32x2*)(YS + (size_t)sl[k] * D + col);
                y += (f32x4){__uint_as_float(w.x << 16), __uint_as_float(w.x & 0xffff0000u), __uint_as_float(w.y << 16), __uint_as_float(w.y & 0xffff0000u)}; }
            const f32x4 g = *(const f32x4*)(mod + b * 6144 + 5120 + col);
            v[j] = *(const f32x4*)(X1 + (size_t)m * D + col) + g * y;
            ss += (v[j].x * v[j].x + v[j].y * v[j].y) + (v[j].z * v[j].z + v[j].w * v[j].w);
        }
        const float rstd = 1.0f / sqrtf(wave_sum(ss) * (1.0f / D) + EPS);
#pragma unroll
        for (int j = 0; j < 4; ++j) { const int col = 4 * (lane + 64 * j); *(f32x4*)(C.out + (size_t)m * D + col) = v[j] * rstd * *(const f32x4*)(C.norm_final_g + col); }
    }
}

namespace pg8 {
typedef short bf16x8 __attribute__((ext_vector_type(8)));
constexpr int BM = 256, BK = 64, HALF = 128, HTB = HALF * BK * 2, STAGE_BYTES = 8 * HTB, NXCD = 8, WGM = 8;
DI int lds_byte(int r, int c) { const int st = (r >> 4) * 2 + (c >> 5), rr = r & 15, cc = c & 31, ob = rr * 64 + cc * 2; return st * 1024 + (ob ^ (((ob >> 9) & 1) << 5)); }
DI void stage_rc(int b, int& R, int& C) { const int st = b / 1024, sb = b % 1024, swz = sb ^ (((sb >> 9) & 1) << 5); R = (st >> 1) * 16 + swz / 64; C = (st & 1) * 32 + (swz % 64) / 2; }
struct Unit { int pm, pn, aux; };
struct Gemm { const bf16* A; const bf16* Bt; int K; };
DI unsigned cvt_pk_bf16(float lo, float hi) { unsigned r; asm volatile("v_cvt_pk_bf16_f32 %0, %1, %2" : "=v"(r) : "v"(lo), "v"(hi)); return r; }

struct TileOrder {
    int nM, nN, nwg;
    DI void init(int nM_, int nN_) { nM = nM_; nN = nN_; nwg = nM * nN; }
    DI bool tile(long L, int& pm, int& pn) const {
        if (L >= nwg) return false;
        int wgid = (int)L; { const int q = nwg / NXCD, r = nwg % NXCD, xcd = wgid % NXCD, off = wgid / NXCD; wgid = (xcd < r ? xcd * (q + 1) : r * (q + 1) + (xcd - r) * q) + off; }
        const int nig = WGM * nN, gid = wgid / nig, fm = gid * WGM, gsz = (nM - fm) < WGM ? (nM - fm) : WGM;
        pm = fm + ((wgid % nig) % gsz); pn = (wgid % nig) / gsz; return true;
    }
};

template <class Epi, class Sched, bool ALIGN_EPI, bool SP2>
DI void gemm_phase(LAS unsigned char* lds, const Gemm g, const Sched& S, const Epi& E) {
    const int tid = threadIdx.x, wid = __builtin_amdgcn_readfirstlane(tid >> 6), lane = tid & 63, wr = wid >> 2, wc = wid & 3, fr = lane & 15, fq = lane >> 4;
    const int K = g.K, nt = K / BK;
    unsigned voffB[2]; int Rr[2]; unsigned cb[2];
#pragma unroll
    for (int i = 0; i < 2; ++i) { int R, C; stage_rc(tid * 16 + i * 8192, R, C); voffB[i] = (unsigned)(R * K + C) * 2u; Rr[i] = R; cb[i] = (unsigned)C * 2u; }
    const size_t kstep = (size_t)(BK * 2);
    const size_t hstep = (size_t)HALF * K * 2;
    const size_t tstep = 2 * hstep;
    const unsigned ldsw = (unsigned)wid * 1024u;
    const int aoff = lds_byte(wr * 64 + fr, fq * 8), boff = lds_byte(wc * 32 + fr, fq * 8);
    const unsigned rowb = (unsigned)K * 2u;
#define PG8_SA(b, h) (((b) * 2 + (h)) * HTB)
#define PG8_SB(b, h) ((4 + (b) * 2 + (h)) * HTB)
#define PG8_STAGE(bufoff, gbase, voff) do { _Pragma("unroll") for (int _i = 0; _i < 2; ++_i) \
        __builtin_amdgcn_global_load_lds((const unsigned*)((const char*)(gbase) + (voff)[_i]), (LAS unsigned*)(lds + (bufoff) + ldsw + _i * 8192), 16, 0, 0); } while (0)
#define PG8_LDA(dst, b, h) do { _Pragma("unroll") for (int m = 0; m < 4; ++m) _Pragma("unroll") for (int k = 0; k < 2; ++k) dst[m][k] = *(const LAS bf16x8*)(lds + PG8_SA(b, h) + aoff + m * 2048 + k * 1024); } while (0)
#define PG8_LDB(dst, b, h) do { _Pragma("unroll") for (int n = 0; n < 2; ++n) _Pragma("unroll") for (int k = 0; k < 2; ++k) dst[n][k] = *(const LAS bf16x8*)(lds + PG8_SB(b, h) + boff + n * 2048 + k * 1024); } while (0)
#define PG8_MMA(ai, bj, At, Bt) do { __builtin_amdgcn_s_setprio(1); _Pragma("unroll") for (int m = 0; m < 4; ++m) _Pragma("unroll") for (int n = 0; n < 2; ++n) _Pragma("unroll") for (int k = 0; k < 2; ++k) \
        acc[ai][bj][m][n] = __builtin_amdgcn_mfma_f32_16x16x32_bf16(Bt[n][k], At[m][k], acc[ai][bj][m][n], 0, 0, 0); __builtin_amdgcn_s_setprio(0); } while (0)
#define PG8_WAIT_V(n) asm volatile("s_waitcnt vmcnt(" #n ")" ::: "memory")
#define PG8_WAIT_L(n) asm volatile("s_waitcnt lgkmcnt(" #n ")" ::: "memory")
#define PG8_BAR __builtin_amdgcn_s_barrier()
#define PG8_SCHED __builtin_amdgcn_sched_barrier(0)
    Unit cur, nxt; int ui = 0;
    if (!S.next(0, cur)) return;
    f32x4 acc[2][2][4][2];
#pragma unroll
    for (int a = 0; a < 2; ++a)
#pragma unroll
        for (int b = 0; b < 2; ++b)
#pragma unroll
            for (int m = 0; m < 4; ++m)
#pragma unroll
                for (int n = 0; n < 2; ++n) acc[a][b][m][n] = (f32x4){0.f, 0.f, 0.f, 0.f};
    bf16x8 At[4][2], B0[2][2], B1[2][2];
    const char* Ab = (const char*)g.A;
    const char* cB = (const char*)g.Bt + (size_t)cur.pn * tstep;
    unsigned c0[2], c1[2], n0[2], n1[2];
#pragma unroll
    for (int i = 0; i < 2; ++i) { c0[i] = (unsigned)S.arow(cur, Rr[i]) * rowb + cb[i]; c1[i] = (unsigned)S.arow(cur, HALF + Rr[i]) * rowb + cb[i]; n0[i] = c0[i]; n1[i] = c1[i]; }
    if constexpr (SP2) {
        PG8_STAGE(PG8_SB(0, 0), cB, voffB); PG8_STAGE(PG8_SB(0, 1), cB + hstep, voffB); PG8_STAGE(PG8_SA(0, 0), Ab, c0); PG8_STAGE(PG8_SA(0, 1), Ab, c1);
        if (wr == 1) PG8_BAR;
        PG8_WAIT_V(2); PG8_BAR;
        PG8_STAGE(PG8_SB(1, 0), cB + kstep, voffB); PG8_STAGE(PG8_SA(1, 0), Ab + kstep, c0); PG8_STAGE(PG8_SB(1, 1), cB + hstep + kstep, voffB);
        PG8_WAIT_V(6); PG8_BAR;
    } else {
        PG8_STAGE(PG8_SB(0, 0), cB, voffB); PG8_STAGE(PG8_SA(0, 0), Ab, c0); PG8_STAGE(PG8_SB(0, 1), cB + hstep, voffB); PG8_STAGE(PG8_SA(0, 1), Ab, c1);
        if (wr == 1) PG8_BAR;
        PG8_WAIT_V(4); PG8_BAR;
        PG8_STAGE(PG8_SB(1, 0), cB + kstep, voffB); PG8_STAGE(PG8_SA(1, 0), Ab + kstep, c0); PG8_STAGE(PG8_SB(1, 1), cB + hstep + kstep, voffB);
        PG8_WAIT_V(6); PG8_BAR;
    }
    for (;;) {
        const bool has_next = S.next(ui + 1, nxt);
        const char* nB = has_next ? (const char*)g.Bt + (size_t)nxt.pn * tstep : cB;
        if (has_next) {
#pragma unroll
            for (int i = 0; i < 2; ++i) { n0[i] = (unsigned)S.arow(nxt, Rr[i]) * rowb + cb[i]; n1[i] = (unsigned)S.arow(nxt, HALF + Rr[i]) * rowb + cb[i]; }
        } else {
#pragma unroll
            for (int i = 0; i < 2; ++i) { n0[i] = c0[i]; n1[i] = c1[i]; }
        }
        for (int t = 0; t < nt; t += 2) {
            const bool last = (t == nt - 2);
            const char* a1 = Ab + (size_t)(t + 1) * kstep;
            const char* a2 = last ? Ab : Ab + (size_t)(t + 2) * kstep; const char* b2 = last ? nB : cB + (size_t)(t + 2) * kstep;
            const char* a3 = a2 + kstep; const char* b3 = b2 + kstep;
            unsigned x0[2], x1[2];
#pragma unroll
            for (int i = 0; i < 2; ++i) { x0[i] = last ? n0[i] : c0[i]; x1[i] = last ? n1[i] : c1[i]; }
            if constexpr (SP2) {
            PG8_LDB(B0, 0, 0); PG8_LDB(B1, 0, 1); PG8_SCHED; PG8_LDA(At, 0, 0); PG8_STAGE(PG8_SA(1, 1), a1, c1);
            PG8_WAIT_V(8); PG8_WAIT_L(0); PG8_BAR; PG8_MMA(0, 0, At, B0); PG8_MMA(0, 1, At, B1); PG8_BAR; PG8_SCHED;
            PG8_LDA(At, 0, 1); PG8_STAGE(PG8_SB(0, 0), b2, voffB); PG8_STAGE(PG8_SB(0, 1), b2 + hstep, voffB); PG8_STAGE(PG8_SA(0, 0), a2, x0);
            PG8_WAIT_V(8); PG8_WAIT_L(0); PG8_BAR; PG8_MMA(1, 0, At, B0); PG8_MMA(1, 1, At, B1); PG8_BAR; PG8_SCHED;
            PG8_LDB(B0, 1, 0); PG8_LDB(B1, 1, 1); PG8_SCHED; PG8_LDA(At, 1, 0); PG8_STAGE(PG8_SA(0, 1), a2, x1);
            PG8_WAIT_V(8); PG8_WAIT_L(0); PG8_BAR; PG8_MMA(0, 0, At, B0); PG8_MMA(0, 1, At, B1); PG8_BAR; PG8_SCHED;
            PG8_LDA(At, 1, 1); PG8_STAGE(PG8_SB(1, 0), b3, voffB); PG8_STAGE(PG8_SB(1, 1), b3 + hstep, voffB); PG8_STAGE(PG8_SA(1, 0), a3, x0);
            PG8_WAIT_V(8); PG8_WAIT_L(0); PG8_BAR; PG8_MMA(1, 0, At, B0); PG8_MMA(1, 1, At, B1); PG8_BAR; PG8_SCHED;
            } else {
            PG8_LDB(B0, 0, 0); PG8_SCHED; PG8_LDA(At, 0, 0); PG8_STAGE(PG8_SA(1, 1), a1, c1);
            PG8_WAIT_L(8); PG8_BAR; PG8_WAIT_L(0); PG8_MMA(0, 0, At, B0); PG8_BAR; PG8_SCHED;
            PG8_LDB(B1, 0, 1); PG8_STAGE(PG8_SB(0, 0), b2, voffB);
            PG8_BAR; PG8_WAIT_L(0); PG8_MMA(0, 1, At, B1); PG8_BAR;
            PG8_LDA(At, 0, 1); PG8_STAGE(PG8_SA(0, 0), a2, x0);
            PG8_BAR; PG8_WAIT_L(0); PG8_MMA(1, 0, At, B0); PG8_BAR; PG8_SCHED;
            PG8_STAGE(PG8_SB(0, 1), b2 + hstep, voffB);
            PG8_WAIT_V(6); PG8_BAR; PG8_MMA(1, 1, At, B1); PG8_BAR;
            PG8_LDB(B0, 1, 0); PG8_SCHED; PG8_LDA(At, 1, 0); PG8_STAGE(PG8_SA(0, 1), a2, x1);
            PG8_WAIT_L(8); PG8_BAR; PG8_WAIT_L(0); PG8_MMA(0, 0, At, B0); PG8_BAR; PG8_SCHED;
            PG8_LDB(B1, 1, 1); PG8_STAGE(PG8_SB(1, 0), b3, voffB);
            PG8_BAR; PG8_WAIT_L(0); PG8_MMA(0, 1, At, B1); PG8_BAR;
            PG8_LDA(At, 1, 1); PG8_STAGE(PG8_SA(1, 0), a3, x0);
            PG8_BAR; PG8_WAIT_L(0); PG8_MMA(1, 0, At, B0); PG8_BAR; PG8_SCHED;
            PG8_STAGE(PG8_SB(1, 1), b3 + hstep, voffB);
            PG8_WAIT_V(6); PG8_BAR; PG8_MMA(1, 1, At, B1); PG8_BAR;
            }
        }
        if constexpr (ALIGN_EPI) { if (wr == 0) PG8_BAR; }
        const bool keep = E(acc, cur, wr, wc, fr, fq);
        if (!has_next) break;
        if (!keep) {
#pragma unroll
            for (int a = 0; a < 2; ++a)
#pragma unroll
                for (int b = 0; b < 2; ++b)
#pragma unroll
                    for (int m = 0; m < 4; ++m)
#pragma unroll
                        for (int n = 0; n < 2; ++n) acc[a][b][m][n] = (f32x4){0.f, 0.f, 0.f, 0.f};
        }
        cur = nxt; cB = nB; ++ui;
#pragma unroll
        for (int i = 0; i < 2; ++i) { c0[i] = n0[i]; c1[i] = n1[i]; }
        if constexpr (ALIGN_EPI) { if (wr == 1) PG8_BAR; }
    }
    PG8_WAIT_V(0);
    if constexpr (!ALIGN_EPI) { if (wr == 0) PG8_BAR; }
    PG8_BAR;
#undef PG8_SA
#undef PG8_SB
#undef PG8_STAGE
#undef PG8_LDA
#undef PG8_LDB
#undef PG8_MMA
#undef PG8_WAIT_V
#undef PG8_WAIT_L
#undef PG8_BAR
#undef PG8_SCHED
}
}

DI int pos_bf8(int o) { const int o32 = o & 31; return (o & ~31) | (16 * ((o32 >> 2) & 1) + 4 * (o32 >> 3) + (o32 & 3)); }
DI int pos_rope(int o) { const int head = o >> 7, bj = (o >> 6) & 1, r = o & 63, w = r >> 5, fq = (r >> 3) & 3, n = (r >> 2) & 1, j = r & 3; return 128 * bj + 32 * (2 * head + w) + 16 * n + 4 * fq + j; }
DI int pos_swiglu(int o) { const int wc = o >> 6, fq = (o >> 4) & 3, bj = (o >> 3) & 1, n = (o >> 2) & 1, j = o & 3; return 128 * bj + 32 * wc + 16 * n + 4 * fq + j; }
template <int PT  >
DI void tr_item(const float* src, int ldw, int K, bf16* WT, int tile_row0, int o0  , int k0, LAS float* scr, int lane) {
    float v[32];
#pragma unroll
    for (int i = 0; i < 32; ++i) { const int kk = 2 * i + (lane >> 5); v[i] = src[(size_t)kk * ldw + (lane & 31)]; }
#pragma unroll
    for (int i = 0; i < 32; ++i) { const int kk = 2 * i + (lane >> 5); scr[kk * 33 + (lane & 31)] = v[i]; }
    asm volatile("s_waitcnt lgkmcnt(0)" ::: "memory");
    const int c = lane & 7;
#pragma unroll
    for (int j = 0; j < 4; ++j) { const int n = (lane >> 3) + 8 * j; const LAS float* s = scr + (8 * c) * 33 + n;
        u32x4 o; o.x = pk2(s[0 * 33], s[1 * 33]); o.y = pk2(s[2 * 33], s[3 * 33]); o.z = pk2(s[4 * 33], s[5 * 33]); o.w = pk2(s[6 * 33], s[7 * 33]);
        const int oc = o0 + n; const int p = PT == 0 ? oc : PT == 1 ? pos_bf8(oc) : PT == 2 ? pos_rope(oc) : pos_swiglu(oc);
        *(u32x4*)(WT + (size_t)(tile_row0 + p) * K + k0 + 8 * c) = o; }
    asm volatile("s_waitcnt lgkmcnt(0)" ::: "memory");
}
DI void convert_small(Ctx& C) {
    LAS float* scr = (LAS float*)(C.lds + C.wave * 16384);
    const int gw = C.bid * NWAVES + C.wave, NGW = C.G * NWAVES, lane = C.lane;
    bf16* WT_IN = (bf16*)(C.ws + WS_WT_IN); bf16* WT_BR = (bf16*)(C.ws + WS_WT_BR); bf16* WT_OUT = (bf16*)(C.ws + WS_WT_OUT);
    constexpr int I_IN = 16 * 256, I_SQ = 16 * 32;
    constexpr int NITEMS = I_IN + 3 * I_SQ;
    for (int it = gw; it < NITEMS; it += NGW) {
        int r = it;
        if (r < I_IN) { const int kb = r >> 8, nb = r & 255, n0 = nb * 32, sc = n0 < 3072 ? n0 : n0 + 8, tile = n0 >> 8;
            const float* src = C.w_in + (size_t)(kb * 64) * DIN + sc;
            if (tile >= 12 && tile < 16) tr_item<2>(src, DIN, D, WT_IN, tile * 256, n0 & 255, kb * 64, scr, lane); else tr_item<1>(src, DIN, D, WT_IN, tile * 256, n0 & 255, kb * 64, scr, lane);
            continue; } r -= I_IN;
        if (r < 2 * I_SQ) { const int which = r >> 9, q = r & 511, kb = q >> 5, nb = q & 31, n0 = nb * 32;
            const float* src = (which ? C.w_bret : C.w_bml) + (size_t)(kb * 64) * D + n0;
            tr_item<1>(src, D, D, WT_BR, which * 1024 + (n0 & ~255), n0 & 255, kb * 64, scr, lane); continue; } r -= 2 * I_SQ;
        { const int kb = r >> 5, nb = r & 31, n0 = nb * 32;
            tr_item<0>(C.w_out + (size_t)(kb * 64) * D + n0, D, D, WT_OUT, n0 & ~255, n0 & 255, kb * 64, scr, lane); }
    }
}
DI void convert_moe(Ctx& C, int i0, int i1) {
    LAS float* scr = (LAS float*)(C.lds + C.wave * 16384);
    const int gw = C.bid * NWAVES + C.wave, NGW = C.G * NWAVES, lane = C.lane;
    bf16* WT_GU = (bf16*)(C.ws + WS_WT_GU); bf16* WT_DN = (bf16*)(C.ws + WS_WT_DN);
    constexpr int I_GU = 32 * 16 * 64, I_DN = 32 * 16 * 32;
    for (int i = i0; i < i1; ++i) {
        int r = gw + NGW * i;
        if (r >= I_GU + I_DN) break;
        if (r < I_GU) { const int e = r >> 10, q = r & 1023, kb = q >> 6, nb = q & 63, n0 = nb * 32;
            tr_item<3>(C.w_gu + (size_t)e * D * 2048 + (size_t)(kb * 64) * 2048 + n0, 2048, D, WT_GU, e * 2048 + (n0 & ~255), n0 & 255, kb * 64, scr, lane); continue; } r -= I_GU;
        { const int e = r >> 9, q = r & 511, kb = q >> 5, nb = q & 31, n0 = nb * 32;
            tr_item<1>(C.w_dn + (size_t)e * D * D + (size_t)(kb * 64) * D + n0, D, D, WT_DN, e * 1024 + (n0 & ~255), n0 & 255, kb * 64, scr, lane); }
    }
}
constexpr int MOE_CONV_ITEMS = 32 * 16 * 64 + 32 * 16 * 32;

struct SchedDense { pg8::TileOrder o; int G, c;
    DI bool next(int i, pg8::Unit& u) const { int pm, pn; if (!o.tile((long)i * G + c, pm, pn)) return false; u.pm = pm; u.pn = pn; u.aux = 0; return true; }
    DI int arow(const pg8::Unit& u, int r) const { return u.pm * 256 + r; } };
DI u32x4 pack8v(const f32x4 a, const f32x4 b) { u32x4 w; w.x = pg8::cvt_pk_bf16(a.x, a.y); w.y = pg8::cvt_pk_bf16(a.z, a.w); w.z = pg8::cvt_pk_bf16(b.x, b.y); w.w = pg8::cvt_pk_bf16(b.z, b.w); return w; }
DI f32x4 sig4(const f32x4 v) { return (f32x4){sigmoidf_(v.x), sigmoidf_(v.y), sigmoidf_(v.z), sigmoidf_(v.w)}; }
DI f32x4 silu4(const f32x4 v) { return (f32x4){siluf_(v.x), siluf_(v.y), siluf_(v.z), siluf_(v.w)}; }
DI void unpack8v(const u32x4 w, f32x4& a, f32x4& b) { a = (f32x4){__uint_as_float(w.x << 16), __uint_as_float(w.x & 0xffff0000u), __uint_as_float(w.y << 16), __uint_as_float(w.y & 0xffff0000u)};
    b = (f32x4){__uint_as_float(w.z << 16), __uint_as_float(w.z & 0xffff0000u), __uint_as_float(w.w << 16), __uint_as_float(w.w & 0xffff0000u)}; }

struct EpiInproj { unsigned char* ws;
    DI bool operator()(f32x4 (&acc)[2][2][4][2], const pg8::Unit& u, int wr, int wc, int fr, int fq) const {
        const int seg = u.pn >> 2, row0 = u.pm * 256 + wr * 64 + fr;
        if (seg == 3) {
            const int which = (u.pn >> 1) & 1, head = 2 * (u.pn & 1) + (wc >> 1), i0 = 32 * (wc & 1) + 8 * fq;
            bf16* dst = (bf16*)(ws + (which ? WS_RETK : WS_RETQ)); const float sc = which ? 0.08838834764831845f : 1.0f;
            const float* COS = (const float*)(ws + WS_COS); const float* SIN = (const float*)(ws + WS_SIN);
#pragma unroll
            for (int ai = 0; ai < 2; ++ai)
#pragma unroll
                for (int m = 0; m < 4; ++m) { const int row = row0 + ai * 128 + m * 16;
                    const f32x4 c0 = *(const f32x4*)(COS + (size_t)row * 64 + i0) * sc, c1 = *(const f32x4*)(COS + (size_t)row * 64 + i0 + 4) * sc;
                    const f32x4 s0 = *(const f32x4*)(SIN + (size_t)row * 64 + i0) * sc, s1 = *(const f32x4*)(SIN + (size_t)row * 64 + i0 + 4) * sc;
                    const f32x4 x1a = acc[ai][0][m][0], x1b = acc[ai][0][m][1], x2a = acc[ai][1][m][0], x2b = acc[ai][1][m][1];
                    bf16* rp = dst + (size_t)row * 512 + head * 128 + i0;
                    *(u32x4*)rp = pack8v(x1a * c0 - x2a * s0, x1b * c1 - x2b * s1);
                    *(u32x4*)(rp + 64) = pack8v(x2a * c0 + x1a * s0, x2b * c1 + x1b * s1);
                    asm volatile("" ::: "memory"); }
            return false;
        }
        bf16* dst; int act = 0;
        switch (seg) { case 0: dst = (bf16*)(ws + WS_QKRAW); break; case 1: dst = (bf16*)(ws + WS_MLV); break; case 2: dst = (bf16*)(ws + WS_MLO); act = 1; break;
            case 4: dst = (bf16*)(ws + WS_RETV); break; case 5: dst = (bf16*)(ws + WS_RETG); act = 2; break; case 6: dst = (bf16*)(ws + WS_GML); act = 1; break; default: dst = (bf16*)(ws + WS_GRET); act = 1; break; }
        const int col0 = (u.pn & 3) * 256 + wc * 32 + 8 * fq;
#pragma unroll
        for (int ai = 0; ai < 2; ++ai)
#pragma unroll
            for (int m = 0; m < 4; ++m) { bf16* rp = dst + (size_t)(row0 + ai * 128 + m * 16) * D + col0;
#pragma unroll
                for (int bj = 0; bj < 2; ++bj) { f32x4 v0 = acc[ai][bj][m][0], v1 = acc[ai][bj][m][1];
                    if (act == 1) { v0 = sig4(v0); v1 = sig4(v1); } else if (act == 2) { v0 = silu4(v0); v1 = silu4(v1); }
                    *(u32x4*)(rp + bj * 128) = pack8v(v0, v1); } }
        return false;
    } };
DI void phase_inproj_mfma(Ctx& C) {
    pg8::Gemm g{(const bf16*)(C.ws + WS_H1), (const bf16*)(C.ws + WS_WT_IN), D};
    SchedDense S; S.o.init(T / 256, 32); S.G = C.G; S.c = C.bid;
    EpiInproj E{C.ws};
    const int rounds = (MOE_CONV_ITEMS + C.G * NWAVES - 1) / (C.G * NWAVES), cls = (C.bid >> 3) & 7, npre = (rounds * cls) / 7;
    convert_moe(C, 0, npre);
    __syncthreads();
    pg8::gemm_phase<EpiInproj, SchedDense, true, true>(C.lds, g, S, E);
    convert_moe(C, npre, rounds);
}

struct SchedBranch { pg8::TileOrder o; int G, c;
    DI bool next(int i, pg8::Unit& u) const { int pm, pn; if (!o.tile((long)(i >> 1) * G + c, pm, pn)) return false; const int seg = i & 1; u.pm = seg * 64 + pm; u.pn = seg * 4 + pn; u.aux = seg; return true; }
    DI int arow(const pg8::Unit& u, int r) const { return u.pm * 256 + r; } };
struct EpiBranch { const bf16* g1; const bf16* g2; bf16* y;
    DI bool operator()(f32x4 (&acc)[2][2][4][2], const pg8::Unit& u, int wr, int wc, int fr, int fq) const {
        const int seg = u.aux, row0 = (u.pm & 63) * 256 + wr * 64 + fr, col0 = (u.pn & 3) * 256 + wc * 32 + 8 * fq;
#pragma unroll
        for (int ai = 0; ai < 2; ++ai)
#pragma unroll
            for (int m = 0; m < 4; ++m) { const size_t o = (size_t)(row0 + ai * 128 + m * 16) * D + col0;
#pragma unroll
                for (int bj = 0; bj < 2; ++bj) {
                    f32x4 b0, b1; unpack8v(*(const u32x4*)(g2 + o + bj * 128), b0, b1);
                    if (seg == 0) { f32x4 a0, a1; unpack8v(*(const u32x4*)(g1 + o + bj * 128), a0, a1);
#pragma unroll
                        for (int j = 0; j < 4; ++j) { acc[ai][bj][m][0][j] *= a0[j] / fmaxf(b0[j], 1e-12f); acc[ai][bj][m][1][j] *= a1[j] / fmaxf(b1[j], 1e-12f); }
                    } else *(u32x4*)(y + o + bj * 128) = pack8v(acc[ai][bj][m][0] * b0, acc[ai][bj][m][1] * b1);
                }
                asm volatile("" ::: "memory"); }
        return seg == 0;
    } };
DI void phase_branch_mfma(Ctx& C) {
    pg8::Gemm g{(const bf16*)(C.ws + WS_HML), (const bf16*)(C.ws + WS_WT_BR), D};
    SchedBranch S; S.o.init(T / 256, 4); S.G = C.G; S.c = C.bid;
    EpiBranch E{(const bf16*)(C.ws + WS_GML), (const bf16*)(C.ws + WS_GRET), (bf16*)(C.ws + WS_H1)};
    pg8::gemm_phase<EpiBranch, SchedBranch, true, true>(C.lds, g, S, E);
}
struct EpiOut { const float* x; const float* mod; float* x1;
    DI bool operator()(f32x4 (&acc)[2][2][4][2], const pg8::Unit& u, int wr, int wc, int fr, int fq) const {
        const int row0 = u.pm * 256 + wr * 64 + fr, col0 = u.pn * 256 + wc * 32 + 4 * fq; const int b = (u.pm * 256) / SEQ;
        f32x4 gv[2][2];
#pragma unroll
        for (int bj = 0; bj < 2; ++bj)
#pragma unroll
            for (int n = 0; n < 2; ++n) gv[bj][n] = *(const f32x4*)(mod + b * 6144 + 2048 + col0 + bj * 128 + n * 16);
#pragma unroll
        for (int ai = 0; ai < 2; ++ai)
#pragma unroll
            for (int m = 0; m < 4; ++m) { const size_t o = (size_t)(row0 + ai * 128 + m * 16) * D + col0;
#pragma unroll
                for (int bj = 0; bj < 2; ++bj)
#pragma unroll
                    for (int n = 0; n < 2; ++n) *(f32x4*)(x1 + o + bj * 128 + n * 16) = *(const f32x4*)(x + o + bj * 128 + n * 16) + gv[bj][n] * acc[ai][bj][m][n];
                asm volatile("" ::: "memory"); }
        return false;
    } };
DI void phase_outproj_mfma(Ctx& C) {
    pg8::Gemm g{(const bf16*)(C.ws + WS_H1), (const bf16*)(C.ws + WS_WT_OUT), D};
    SchedDense S; S.o.init(T / 256, 4); S.G = C.G; S.c = C.bid;
    EpiOut E{C.x, (const float*)(C.ws + WS_MOD), (float*)(C.ws + WS_X1)};
    pg8::gemm_phase<EpiOut, SchedDense, false, true>(C.lds, g, S, E);
}
struct SchedMoe { const unsigned* blke; const int* slottok; int nunits, ntn, G, c;
    DI bool next(int i, pg8::Unit& u) const { const long L = (long)i * G + c; if (L >= nunits) return false; const int bi = (int)(L / ntn), pn = (int)(L % ntn);
        const int e = (int)__builtin_amdgcn_readfirstlane((int)blke[bi]); u.pm = bi; u.pn = e * ntn + pn; u.aux = e | (pn << 8); return true; }
    DI int arow(const pg8::Unit& u, int r) const { return slottok ? slottok[u.pm * 256 + r] : u.pm * 256 + r; } };
struct EpiSwiglu { const float* bias; bf16* act;
    DI bool operator()(f32x4 (&acc)[2][2][4][2], const pg8::Unit& u, int wr, int wc, int fr, int fq) const {
        const int e = u.aux & 255, pn = u.aux >> 8, slot0 = u.pm * 256 + wr * 64 + fr;
        const float* bp = bias + (size_t)e * 2048 + pn * 256 + 64 * wc + 16 * fq;
        f32x4 bv[2][2];
#pragma unroll
        for (int bj = 0; bj < 2; ++bj)
#pragma unroll
            for (int n = 0; n < 2; ++n) bv[bj][n] = *(const f32x4*)(bp + 8 * bj + 4 * n);
#pragma unroll
        for (int ai = 0; ai < 2; ++ai)
#pragma unroll
            for (int m = 0; m < 4; ++m) { float o[8];
#pragma unroll
                for (int bj = 0; bj < 2; ++bj)
#pragma unroll
                    for (int n = 0; n < 2; ++n) { const f32x4 v = acc[ai][bj][m][n] + bv[bj][n];
#pragma unroll
                        for (int p = 0; p < 2; ++p) { const float xg = fminf(v[2 * p], 7.0f), xl = fminf(fmaxf(v[2 * p + 1], -7.0f), 7.0f); o[4 * bj + 2 * n + p] = xg * sigmoidf_(1.702f * xg) * (xl + 1.0f); } }
                u32x4 w; w.x = pg8::cvt_pk_bf16(o[0], o[1]); w.y = pg8::cvt_pk_bf16(o[2], o[3]); w.z = pg8::cvt_pk_bf16(o[4], o[5]); w.w = pg8::cvt_pk_bf16(o[6], o[7]);
                *(u32x4*)(act + (size_t)(slot0 + ai * 128 + m * 16) * D + pn * 128 + 32 * wc + 8 * fq) = w; }
        return false;
    } };
struct EpiDown { const float* bias; const float* slotw; bf16* ys;
    DI bool operator()(f32x4 (&acc)[2][2][4][2], const pg8::Unit& u, int wr, int wc, int fr, int fq) const {
        const int e = u.aux & 255, pn = u.aux >> 8, slot0 = u.pm * 256 + wr * 64 + fr, col0 = pn * 256 + wc * 32 + 8 * fq;
        f32x4 bv[2][2];
#pragma unroll
        for (int bj = 0; bj < 2; ++bj)
#pragma unroll
            for (int n = 0; n < 2; ++n) bv[bj][n] = *(const f32x4*)(bias + (size_t)e * D + col0 + bj * 128 + 4 * n);
#pragma unroll
        for (int ai = 0; ai < 2; ++ai)
#pragma unroll
            for (int m = 0; m < 4; ++m) { const int slot = slot0 + ai * 128 + m * 16; const float w = slotw[slot];
#pragma unroll
                for (int bj = 0; bj < 2; ++bj) *(u32x4*)(ys + (size_t)slot * D + col0 + bj * 128) = pack8v((acc[ai][bj][m][0] + bv[bj][0]) * w, (acc[ai][bj][m][1] + bv[bj][1]) * w); }
        return false;
    } };
DI void phase_gateup_mfma(Ctx& C) {
    unsigned* ctl = (unsigned*)(C.ws + WS_CTL); const int nblk = (int)__builtin_amdgcn_readfirstlane((int)__hip_atomic_load(ctl + CW_NBLK, __ATOMIC_RELAXED, __HIP_MEMORY_SCOPE_AGENT));
    pg8::Gemm g{(const bf16*)(C.ws + WS_H1), (const bf16*)(C.ws + WS_WT_GU), D};
    SchedMoe S{ctl + CW_BLKE, (const int*)(C.ws + WS_ROUTE + RT_SLOTTOK), nblk * 8, 8, C.G, C.bid};
    EpiSwiglu E{C.b_gu, (bf16*)(C.ws + WS_ACT)};
    pg8::gemm_phase<EpiSwiglu, SchedMoe, true, true>(C.lds, g, S, E);
}
DI void phase_down_mfma(Ctx& C) {
    unsigned* ctl = (unsigned*)(C.ws + WS_CTL); const int nblk = (int)__builtin_amdgcn_readfirstlane((int)__hip_atomic_load(ctl + CW_NBLK, __ATOMIC_RELAXED, __HIP_MEMORY_SCOPE_AGENT));
    pg8::Gemm g{(const bf16*)(C.ws + WS_ACT), (const bf16*)(C.ws + WS_WT_DN), D};
    SchedMoe S{ctl + CW_BLKE, nullptr, nblk * 4, 4, C.G, C.bid};
    EpiDown E{C.b_dn, (const float*)(C.ws + WS_ROUTE + RT_SLOTW), (bf16*)(C.ws + WS_YS)};
    pg8::gemm_phase<EpiDown, SchedMoe, true, true>(C.lds, g, S, E);
}

typedef short s16x4 __attribute__((ext_vector_type(4)));
typedef short bf16x8 __attribute__((ext_vector_type(8)));
DI unsigned off_b(unsigned row, unsigned ch) { return 256u * row + 16u * (ch ^ (((row & 3u) << 2) | ((row >> 2) & 3u))); }
DI s16x4 tr_read(LAS unsigned char* p) { return __builtin_amdgcn_ds_read_tr16_b64_v4i16((LAS s16x4*)p); }
DI bf16x8 cat8(const s16x4 lo, const s16x4 hi) { return __builtin_shufflevector(lo, hi, 0, 1, 2, 3, 4, 5, 6, 7); }
DI bf16x8 row_read(LAS unsigned char* img, unsigned row, unsigned ch) { return *(const LAS bf16x8*)(img + off_b(row, ch)); }
#define MFMA16(a, b, c) __builtin_amdgcn_mfma_f32_16x16x32_bf16((a), (b), (c), 0, 0, 0)
DI void fill_image(LAS unsigned char* img, const bf16* src, int ld, int nrows, int tid) {
    for (int e = tid; e < nrows * 16; e += NTHR) { const int row = e >> 4, ch = e & 15; *(LAS u32x4*)(img + off_b(row, ch)) = *(const u32x4*)(src + (size_t)row * ld + ch * 8); }
}

DI void phase_local_mfma(Ctx& C) {
    LAS unsigned char* Kimg = C.lds; LAS unsigned char* Vimg = C.lds + 32768;
    LAS float* lf = (LAS float*)(C.lds + 98304); LAS float* bvl = lf + 128; LAS float* wsv = bvl + 128; LAS float* nl = wsv + 128;
    const float* IFG = (const float*)(C.ws + WS_IFG);
    bf16* CLOC = (bf16*)(C.ws + WS_CLOC);
    float* NLOC = (float*)(C.ws + WS_SMALL + SM_NLOC); float* MLOC = (float*)(C.ws + WS_SMALL + SM_MLOC); float* ACH = (float*)(C.ws + WS_SMALL + SM_ACH);
    float* AG = (float*)(C.ws + WS_SMALL + SM_AG); float* CMG = (float*)(C.ws + WS_SMALL + SM_CMG);
    const int t = C.tid, lane = C.lane, w = C.wave, g = lane >> 4, q = (lane & 15) >> 2, p = lane & 3;
    for (int u = C.bid; u < 1024; u += C.G) {
        const int mixer = u >> 9, bh = (u >> 5) & 15, ch = u & 31, b = bh >> 2, h = bh & 3, t0 = b * SEQ + ch * CH;
        const bf16 *Kp, *Vp; int ldk;
        if (mixer == 0) {
            float iv = 0.f;
            if (t < 128) { lf[t] = logsigmoidf_(IFG[(size_t)(t0 + t) * 8 + 4 + h]); iv = IFG[(size_t)(t0 + t) * 8 + h]; nl[t] = 0.f; }
            __syncthreads();
            if (t < 128) { float s = 0.f; for (int j = 0; j <= t; ++j) s += lf[j]; bvl[t] = iv - s; AG[bh * SEQ + ch * CH + t] = s; if (t == 127) wsv[0] = s; }
            __syncthreads();
            float gm = -3.0e38f, cm = -3.0e38f; const float Aall = wsv[0];
            if (t < 128) { for (int j = 0; j < 128; ++j) { const float x = bvl[j]; gm = fmaxf(gm, x); cm = (j <= t) ? fmaxf(cm, x) : cm; } CMG[bh * SEQ + ch * CH + t] = cm; }
            __syncthreads();
            if (t < 128) wsv[t] = __expf(bvl[t] - gm);
            if (t == 0) { MLOC[bh * 32 + ch] = Aall + gm; ACH[bh * 32 + ch] = Aall; }
            Kp = (const bf16*)(C.ws + WS_QC) + (size_t)t0 * D + 512 + h * 128; ldk = D;
            Vp = (const bf16*)(C.ws + WS_MLV) + (size_t)t0 * D + h * 256;
        } else {
            const float lg = ret_lg(h);
            if (t < 128) wsv[t] = __expf(lg * (float)(127 - t));
            Kp = (const bf16*)(C.ws + WS_RETK) + (size_t)t0 * 512 + h * 128; ldk = 512;
            Vp = (const bf16*)(C.ws + WS_RETV) + (size_t)t0 * D + h * 256;
        }
        __syncthreads();
        if (mixer == 0) {
            const int c32 = t & 31, run = t >> 5, isk = c32 >> 4, chk = c32 & 15;
            const int col = isk * 512 + h * 128 + 8 * chk;
            const bf16* raw = (const bf16*)(C.ws + WS_QKRAW) + (size_t)t0 * D + col;
            bf16* qc = (bf16*)(C.ws + WS_QC) + (size_t)t0 * D + col;
            u32x4 rv[11];
#pragma unroll
            for (int i = 0; i < 11; ++i) { const int rr = 8 * run - 3 + i; rv[i] = (ch * CH + rr >= 0) ? *(const u32x4*)(raw + (ptrdiff_t)rr * D) : (u32x4){0u, 0u, 0u, 0u}; }
            float wgt[4][8], bias[8];
#pragma unroll
            for (int j = 0; j < 4; ++j) { const f32x4 a = *(const f32x4*)(C.conv_w + j * D + col), b2 = *(const f32x4*)(C.conv_w + j * D + col + 4);
                wgt[j][0] = a.x; wgt[j][1] = a.y; wgt[j][2] = a.z; wgt[j][3] = a.w; wgt[j][4] = b2.x; wgt[j][5] = b2.y; wgt[j][6] = b2.z; wgt[j][7] = b2.w; }
            { const f32x4 a = *(const f32x4*)(C.conv_b + col), b2 = *(const f32x4*)(C.conv_b + col + 4); bias[0] = a.x; bias[1] = a.y; bias[2] = a.z; bias[3] = a.w; bias[4] = b2.x; bias[5] = b2.y; bias[6] = b2.z; bias[7] = b2.w; }
            float ns[8];
#pragma unroll
            for (int e = 0; e < 8; ++e) ns[e] = 0.f;
            const float qsc = isk ? 1.0f : 0.08838834764831845f;
#pragma unroll
            for (int rr = 0; rr < 8; ++rr) {
                float o[8];
#pragma unroll
                for (int e = 0; e < 8; ++e) o[e] = bias[e];
#pragma unroll
                for (int j = 0; j < 4; ++j) { float f[8]; unpack8(rv[rr + j], f);
#pragma unroll
                    for (int e = 0; e < 8; ++e) o[e] += f[e] * wgt[j][e]; }
#pragma unroll
                for (int e = 0; e < 8; ++e) o[e] = siluf_(o[e]) * qsc;
                const u32x4 pk = pack8(o);
                *(u32x4*)(qc + (size_t)(8 * run + rr) * D) = pk;
                if (isk) { const int row = 8 * run + rr; float f[8]; unpack8(pk, f); const float wv = wsv[row];
#pragma unroll
                    for (int e = 0; e < 8; ++e) { f[e] *= wv; ns[e] += f[e]; }
                    *(LAS u32x4*)(Kimg + off_b(row, chk)) = pack8(f); }
            }
            if (isk) {
#pragma unroll
                for (int e = 0; e < 8; ++e) atomicAdd((float*)(nl + chk * 8 + e), ns[e]);
            }
        } else {
            const int chk = t & 15;
#pragma unroll
            for (int i = 0; i < 4; ++i) { const int row = (t >> 4) + 32 * i; float f[8]; unpack8(*(const u32x4*)(Kp + (size_t)row * ldk + chk * 8), f); const float wv = wsv[row];
#pragma unroll
                for (int e = 0; e < 8; ++e) f[e] *= wv;
                *(LAS u32x4*)(Kimg + off_b(row, chk)) = pack8(f); }
        }
        fill_image(Vimg, Vp, D, 128, t); fill_image(Vimg + 32768, Vp + 128, D, 128, t);
        __syncthreads();
        const int kh = w & 1, vq = w >> 1;
        f32x4 acc[2][2][4];
#pragma unroll
        for (int a = 0; a < 2; ++a)
#pragma unroll
            for (int x = 0; x < 2; ++x)
#pragma unroll
                for (int c = 0; c < 4; ++c) acc[a][x][c] = (f32x4){0.f, 0.f, 0.f, 0.f};
        unsigned ba[2][2], bb[4][2];
#pragma unroll
        for (int ul = 0; ul < 2; ++ul)
#pragma unroll
            for (int tt = 0; tt < 2; ++tt) ba[ul][tt] = off_b(8 * g + q + 4 * tt, 4 * (2 * kh + ul) + p);
#pragma unroll
        for (int cl = 0; cl < 4; ++cl)
#pragma unroll
            for (int tt = 0; tt < 2; ++tt) { const int c = 4 * vq + cl; bb[cl][tt] = 32768 + (c >> 3) * 32768 + off_b(8 * g + q + 4 * tt, 2 * (c & 7) + (p >> 1)) + 8 * (p & 1); }
#pragma unroll
        for (int ks = 0; ks < 4; ++ks) {
            bf16x8 af[2][2], bfr[4];
#pragma unroll
            for (int ul = 0; ul < 2; ++ul)
#pragma unroll
                for (int x = 0; x < 2; ++x) af[ul][x] = cat8(tr_read(C.lds + ba[ul][0] + (8192 * ks + 8 * x)), tr_read(C.lds + ba[ul][1] + (8192 * ks + 8 * x)));
#pragma unroll
            for (int cl = 0; cl < 4; ++cl) bfr[cl] = cat8(tr_read(C.lds + bb[cl][0] + 8192 * ks), tr_read(C.lds + bb[cl][1] + 8192 * ks));
#pragma unroll
            for (int ul = 0; ul < 2; ++ul)
#pragma unroll
                for (int x = 0; x < 2; ++x)
#pragma unroll
                    for (int cl = 0; cl < 4; ++cl) acc[ul][x][cl] = MFMA16(af[ul][x], bfr[cl], acc[ul][x][cl]);
            asm volatile("" ::: "memory");
        }
        bf16* cl_ = CLOC + ((size_t)(mixer * 16 + bh) * 32 + ch) * 32768;
#pragma unroll
        for (int ul = 0; ul < 2; ++ul)
#pragma unroll
            for (int cl = 0; cl < 4; ++cl) { const int v = 16 * (4 * vq + cl) + (lane & 15), k0 = 32 * (2 * kh + ul) + 8 * g;
                u32x4 o; o.x = pk2(acc[ul][0][cl][0], acc[ul][0][cl][1]); o.y = pk2(acc[ul][0][cl][2], acc[ul][0][cl][3]); o.z = pk2(acc[ul][1][cl][0], acc[ul][1][cl][1]); o.w = pk2(acc[ul][1][cl][2], acc[ul][1][cl][3]);
                *(u32x4*)(cl_ + (size_t)v * 128 + k0) = o; }
        if (mixer == 0 && t < 128) NLOC[(bh * 32 + ch) * 128 + t] = nl[t];
        __syncthreads();
    }
}

struct OutUnit { const bf16 *Qp, *Kp, *Vp, *cp; int ldq, mixer, bh, ch, h, t0; };
DI OutUnit out_unit(const Ctx& C, int u) {
    OutUnit U; U.mixer = u >> 9; U.bh = (u >> 5) & 15; U.ch = u & 31; const int b = U.bh >> 2; U.h = U.bh & 3; U.t0 = b * SEQ + U.ch * CH;
    U.cp = (const bf16*)(C.ws + WS_CPREV) + ((size_t)(U.mixer * 16 + U.bh) * 32 + U.ch) * 32768;
    if (U.mixer == 0) { U.Qp = (const bf16*)(C.ws + WS_QC) + (size_t)U.t0 * D + U.h * 128; U.Kp = U.Qp + 512; U.ldq = D; U.Vp = (const bf16*)(C.ws + WS_MLV) + (size_t)U.t0 * D + U.h * 256; }
    else { U.Qp = (const bf16*)(C.ws + WS_RETQ) + (size_t)U.t0 * 512 + U.h * 128; U.Kp = (const bf16*)(C.ws + WS_RETK) + (size_t)U.t0 * 512 + U.h * 128; U.ldq = 512; U.Vp = (const bf16*)(C.ws + WS_RETV) + (size_t)U.t0 * D + U.h * 256; }
    return U;
}
DI void phase_out_mfma(Ctx& C) {
    LAS unsigned char* Qimg = C.lds; LAS unsigned char* Kimg = C.lds + 32768; LAS unsigned char* R1 = C.lds + 65536;
    LAS float* ea = (LAS float*)(C.lds + 131072); LAS float* bs = ea + 128; LAS float* isc = bs + 128; LAS float* edn = isc + 128; LAS float* npv = edn + 128; LAS float* gnl = npv + 128;
    const float* IFG = (const float*)(C.ws + WS_IFG);
    const float* NPREV = (const float*)(C.ws + WS_SMALL + SM_NPREV); const float* MPREV = (const float*)(C.ws + WS_SMALL + SM_MPREV);
    const float* AG = (const float*)(C.ws + WS_SMALL + SM_AG); const float* CMG = (const float*)(C.ws + WS_SMALL + SM_CMG);
    const int w = C.wave;
    if (C.bid >= 1024) return;
    u32x4 pq[4], pk[4], pc[8]; float ga = 0.f, gcm = 0.f, giv = 0.f, gmp = 0.f, gnp = 0.f, ggn = 0.f;
#define P6_PREFETCH(U) do { \
        _Pragma("unroll") for (int i = 0; i < 4; ++i) { const int e = t + NTHR * i, row = e >> 4, chk = e & 15; pq[i] = *(const u32x4*)((U).Qp + (size_t)row * (U).ldq + chk * 8); pk[i] = *(const u32x4*)((U).Kp + (size_t)row * (U).ldq + chk * 8); } \
        _Pragma("unroll") for (int i = 0; i < 8; ++i) { const int e = t + NTHR * i; pc[i] = *(const u32x4*)((U).cp + (size_t)e * 8); } \
        if (t < 256) ggn = ((U).mixer == 0 ? C.ml_norm_g : C.ret_norm_g)[(U).h * 256 + t]; \
        if ((U).mixer == 0 && t < 128) { ga = AG[(U).bh * SEQ + (U).ch * CH + t]; gcm = CMG[(U).bh * SEQ + (U).ch * CH + t]; giv = IFG[(size_t)((U).t0 + t) * 8 + (U).h]; gmp = MPREV[(U).bh * 32 + (U).ch]; gnp = NPREV[((U).bh * 32 + (U).ch) * 128 + t]; } } while (0)
    OutUnit U = out_unit(C, C.bid);
    { const int t = C.tid; P6_PREFETCH(U); }
    const int t_ = C.tid;
    for (int u = C.bid; u < 1024; u += C.G) {
        const int mixer = U.mixer, h = U.h, t0 = U.t0;
        int t = t_; asm volatile("" : "+v"(t));
        const int lane = t & 63, g = lane >> 4, q = (lane & 15) >> 2, p = lane & 3, jl = lane & 15;
#pragma unroll
        for (int i = 0; i < 4; ++i) { const int e = t + NTHR * i, row = e >> 4, chk = e & 15; *(LAS u32x4*)(Qimg + off_b(row, chk)) = pq[i]; *(LAS u32x4*)(Kimg + off_b(row, chk)) = pk[i]; }
#pragma unroll
        for (int i = 0; i < 8; ++i) { const int e = t + NTHR * i, row = e >> 4, chk = e & 15; *(LAS u32x4*)(R1 + off_b(row, chk)) = pc[i]; }
        if (t < 256) gnl[t] = ggn;
        if (t < 128) {
            if (mixer == 0) { const float il = ga + gmp, m = fmaxf(il, ga + gcm);
                ea[t] = ga - m; bs[t] = giv - ga; isc[t] = __expf(il - m); edn[t] = __expf(-m); npv[t] = gnp; }
            else { const float lg = ret_lg(h); ea[t] = lg * (float)t; bs[t] = -lg * (float)t; isc[t] = __expf(lg * (float)(t + 1)); edn[t] = 1.0f; npv[t] = 0.f; }
        }
        __syncthreads();
        u32x4 vst[8];
#pragma unroll
        for (int i = 0; i < 8; ++i) { const int e = t + NTHR * i, half = e >> 11, row = (e >> 4) & 127, chk = e & 15; vst[i] = *(const u32x4*)(U.Vp + (size_t)row * D + half * 128 + chk * 8); }
        unsigned bk[4];
#pragma unroll
        for (int kk = 0; kk < 4; ++kk) bk[kk] = off_b(jl, 4 * kk + g);
        bf16x8 qf[4];
#pragma unroll
        for (int kk = 0; kk < 4; ++kk) qf[kk] = *(const LAS bf16x8*)(Qimg + 4096 * w + bk[kk]);
        f32x4 st[8];
#pragma unroll
        for (int sb = 0; sb < 8; ++sb) { st[sb] = (f32x4){0.f, 0.f, 0.f, 0.f};
            if (sb <= w) {
#pragma unroll
                for (int kk = 0; kk < 4; ++kk) st[sb] = MFMA16(*(const LAS bf16x8*)(Kimg + bk[kk] + 4096 * sb), qf[kk], st[sb]);
            } }
        const int j = 16 * w + jl; const float eaj = ea[j];
        float psum = 0.f;
#pragma unroll
        for (int sb = 0; sb < 8; ++sb) { const f32x4 b4 = *(const LAS f32x4*)(bs + 16 * sb + 4 * g);
#pragma unroll
            for (int r = 0; r < 4; ++r) { const int s = 16 * sb + 4 * g + r; const float pv = (s <= j) ? __expf(eaj + b4[r]) * st[sb][r] : 0.f; st[sb][r] = pv; psum += pv; } }
        float qn = 0.f;
#pragma unroll
        for (int kk = 0; kk < 4; ++kk) { const f32x4 n0 = *(const LAS f32x4*)(npv + 32 * kk + 8 * g), n1 = *(const LAS f32x4*)(npv + 32 * kk + 8 * g + 4);
            float f[8]; unpack8(__builtin_bit_cast(u32x4, qf[kk]), f);
            qn += f[0] * n0.x + f[1] * n0.y + f[2] * n0.z + f[3] * n0.w + f[4] * n1.x + f[5] * n1.y + f[6] * n1.z + f[7] * n1.w; }
        psum += __shfl_xor(psum, 16); psum += __shfl_xor(psum, 32); qn += __shfl_xor(qn, 16); qn += __shfl_xor(qn, 32);
        const float iscj = isc[j];
        const float dinv = (mixer == 0) ? 1.0f / fmaxf(fabsf(psum + iscj * qn), edn[j]) : 1.0f;
        bf16x8 pf[4];
#pragma unroll
        for (int ks = 0; ks < 4; ++ks) { u32x4 pw; pw.x = pk2(st[2 * ks][0], st[2 * ks][1]); pw.y = pk2(st[2 * ks][2], st[2 * ks][3]); pw.z = pk2(st[2 * ks + 1][0], st[2 * ks + 1][1]); pw.w = pk2(st[2 * ks + 1][2], st[2 * ks + 1][3]);
            pf[ks] = __builtin_bit_cast(bf16x8, pw); }
        f32x4 acc[2][4][2];
#pragma unroll
        for (int hv = 0; hv < 2; ++hv)
#pragma unroll
            for (int uu = 0; uu < 4; ++uu)
#pragma unroll
                for (int x = 0; x < 2; ++x) acc[hv][uu][x] = (f32x4){0.f, 0.f, 0.f, 0.f};
#pragma unroll
        for (int kk = 0; kk < 4; ++kk) {
            const unsigned bi0 = off_b(8 * (jl >> 2) + (jl & 3), 4 * kk + g), bi1 = off_b(8 * (jl >> 2) + 4 + (jl & 3), 4 * kk + g);
#pragma unroll
            for (int hv = 0; hv < 2; ++hv) {
#pragma unroll
                for (int uu = 0; uu < 4; ++uu) {
                    acc[hv][uu][0] = MFMA16(*(const LAS bf16x8*)(R1 + bi0 + (32768 * hv + 8192 * uu)), qf[kk], acc[hv][uu][0]);
                    acc[hv][uu][1] = MFMA16(*(const LAS bf16x8*)(R1 + bi1 + (32768 * hv + 8192 * uu)), qf[kk], acc[hv][uu][1]); }
                asm volatile("" ::: "memory"); }
        }
#pragma unroll
        for (int hv = 0; hv < 2; ++hv)
#pragma unroll
            for (int uu = 0; uu < 4; ++uu)
#pragma unroll
                for (int x = 0; x < 2; ++x) acc[hv][uu][x] *= iscj;
        __syncthreads();
#pragma unroll
        for (int i = 0; i < 8; ++i) { const int e = t + NTHR * i, half = e >> 11, row = (e >> 4) & 127, chk = e & 15; *(LAS u32x4*)(R1 + half * 32768 + off_b(row, chk)) = vst[i]; }
        __syncthreads();
        const bf16* gate = (const bf16*)(C.ws + (mixer == 0 ? WS_MLO : WS_RETG)) + (size_t)(t0 + j) * D + h * 256;
        bf16* outp = (bf16*)(C.ws + (mixer == 0 ? WS_HML : WS_HRET)) + (size_t)(t0 + j) * D + h * 256;

        unsigned bp[4];
#pragma unroll
        for (int uu = 0; uu < 4; ++uu) bp[uu] = off_b(4 * g + q, 4 * uu + p);
#pragma unroll
        for (int ks = 0; ks < 4; ++ks) {
            if (2 * ks <= w) {
#pragma unroll
                for (int hv = 0; hv < 2; ++hv)
#pragma unroll
                    for (int uu = 0; uu < 4; ++uu)
#pragma unroll
                        for (int x = 0; x < 2; ++x) {
                            const bf16x8 vf = cat8(tr_read(R1 + bp[uu] + (32768 * hv + 8192 * ks + 8 * x)), tr_read(R1 + bp[uu] + (32768 * hv + 8192 * ks + 4096 + 8 * x)));
                            acc[hv][uu][x] = MFMA16(vf, pf[ks], acc[hv][uu][x]); }
            }
            asm volatile("" ::: "memory"); }
        const bool has_next = (u + C.G) < 1024;
        U = out_unit(C, has_next ? u + C.G : u); P6_PREFETCH(U);
        float s1 = 0.f;
#pragma unroll
        for (int hv = 0; hv < 2; ++hv)
#pragma unroll
            for (int uu = 0; uu < 4; ++uu)
#pragma unroll
                for (int x = 0; x < 2; ++x) { acc[hv][uu][x] *= dinv; s1 += (acc[hv][uu][x][0] + acc[hv][uu][x][1]) + (acc[hv][uu][x][2] + acc[hv][uu][x][3]); }
        s1 += __shfl_xor(s1, 16); s1 += __shfl_xor(s1, 32);
        const float mu = s1 * (1.0f / 256.0f); float s2 = 0.f;
#pragma unroll
        for (int hv = 0; hv < 2; ++hv)
#pragma unroll
            for (int uu = 0; uu < 4; ++uu)
#pragma unroll
                for (int x = 0; x < 2; ++x) { acc[hv][uu][x] -= mu; const f32x4 d = acc[hv][uu][x]; s2 += (d[0] * d[0] + d[1] * d[1]) + (d[2] * d[2] + d[3] * d[3]); }
        s2 += __shfl_xor(s2, 16); s2 += __shfl_xor(s2, 32);
        const float rstd = 1.0f / sqrtf(s2 * (1.0f / 256.0f) + EPS);
#pragma unroll
        for (int hv = 0; hv < 2; ++hv) {
            u32x4 gt[4];
#pragma unroll
            for (int uu = 0; uu < 4; ++uu) gt[uu] = *(const u32x4*)(gate + 128 * hv + 32 * uu + 8 * g);
#pragma unroll
            for (int uu = 0; uu < 4; ++uu) { const int v0 = 128 * hv + 32 * uu + 8 * g;
                const f32x4 g0 = *(const LAS f32x4*)(gnl + v0), g1 = *(const LAS f32x4*)(gnl + v0 + 4); f32x4 t0v, t1v; unpack8v(gt[uu], t0v, t1v);
                *(u32x4*)(outp + v0) = pack8v(acc[hv][uu][0] * rstd * g0 * t0v, acc[hv][uu][1] * rstd * g1 * t1v); }
            asm volatile("" ::: "memory"); }
        __syncthreads();
    }
#undef P6_PREFETCH
}

DI void phase_norm2_route_mfma(Ctx& C) {
    LAS float* wr = (LAS float*)C.lds;
    LAS float* pg = wr + 32768;
    LAS float* ps = pg + 1024;
    LAS float* lgt = ps + 1024;
    const float* mod = (const float*)(C.ws + WS_MOD); const float* X1 = (const float*)(C.ws + WS_X1);
    bf16* H2 = (bf16*)(C.ws + WS_H1);
    int* TOPI = (int*)(C.ws + WS_ROUTE + RT_TOPI); float* TOPW = (float*)(C.ws + WS_ROUTE + RT_TOPW); int* RANK = (int*)(C.ws + WS_ROUTE + RT_RANK);
    unsigned* BLKCNT = (unsigned*)(C.ws + WS_ROUTE + RT_BLKCNT);
    LAS unsigned* cntL = (LAS unsigned*)(lgt + 2048);
    const int lane = C.lane, r = lane & 15, kq = lane >> 4;
    for (int i = C.tid; i < 32768 / 4; i += NTHR) *(LAS f32x4*)(wr + i * 4) = *(const f32x4*)(C.w_router + i * 4);
    int cur_b = -1;
    for (int sg = C.bid; sg < T / 64; sg += C.G) {
        const int b = (sg * 64) / SEQ;
        if (b != cur_b) { __syncthreads();
            for (int i = C.tid; i < 1024; i += NTHR) { pg[i] = C.norm_ffn_g[i] * (1.0f + mod[b * 6144 + 4096 + i]); ps[i] = mod[b * 6144 + 3072 + i]; }
            cur_b = b; }
        if (C.tid < 32) cntL[C.tid] = 0u;
        __syncthreads();
        if (C.wave < 4) {
            const int row0 = sg * 64 + C.wave * 16;
            const float* xr = X1 + (size_t)(row0 + r) * D + 4 * kq;
            float ss = 0.f;
#pragma unroll 8
            for (int i = 0; i < 64; ++i) { const f32x4 v = *(const f32x4*)(xr + 16 * i); ss += (v.x * v.x + v.y * v.y) + (v.z * v.z + v.w * v.w); }
            ss += __shfl_xor(ss, 16); ss += __shfl_xor(ss, 32);
            const float rstd = 1.0f / sqrtf(ss * (1.0f / D) + EPS);
            f32x4 acc0 = (f32x4){0.f, 0.f, 0.f, 0.f}, acc1 = acc0;
            bf16* hr = H2 + (size_t)(row0 + r) * D + 4 * kq;
            const LAS float* wb = wr + (4 * kq) * 32 + r;
#pragma unroll 4
            for (int i = 0; i < 64; ++i) {
                const f32x4 v = *(const f32x4*)(xr + 16 * i);
                const f32x4 g4 = *(const LAS f32x4*)(pg + 16 * i + 4 * kq), s4 = *(const LAS f32x4*)(ps + 16 * i + 4 * kq);
                const f32x4 h = v * rstd * g4 + s4;
                u32x2 w; w.x = pk2(h.x, h.y); w.y = pk2(h.z, h.w); *(u32x2*)(hr + 16 * i) = w;
                const LAS float* wi = wb + (16 * i) * 32;
                acc0 = __builtin_amdgcn_mfma_f32_16x16x4f32(h.x, wi[0], acc0, 0, 0, 0);       acc1 = __builtin_amdgcn_mfma_f32_16x16x4f32(h.x, wi[16], acc1, 0, 0, 0);
                acc0 = __builtin_amdgcn_mfma_f32_16x16x4f32(h.y, wi[32], acc0, 0, 0, 0);      acc1 = __builtin_amdgcn_mfma_f32_16x16x4f32(h.y, wi[32 + 16], acc1, 0, 0, 0);
                acc0 = __builtin_amdgcn_mfma_f32_16x16x4f32(h.z, wi[64], acc0, 0, 0, 0);      acc1 = __builtin_amdgcn_mfma_f32_16x16x4f32(h.z, wi[64 + 16], acc1, 0, 0, 0);
                acc0 = __builtin_amdgcn_mfma_f32_16x16x4f32(h.w, wi[96], acc0, 0, 0, 0);      acc1 = __builtin_amdgcn_mfma_f32_16x16x4f32(h.w, wi[96 + 16], acc1, 0, 0, 0);
            }
            LAS float* lw = lgt + C.wave * 512;
#pragma unroll
            for (int j = 0; j < 4; ++j) { lw[(4 * kq + j) * 32 + r] = acc0[j] + C.b_router[r]; lw[(4 * kq + j) * 32 + 16 + r] = acc1[j] + C.b_router[16 + r]; }
            asm volatile("s_waitcnt lgkmcnt(0)" ::: "memory");
            if (lane < 16) {
                float l[32];
#pragma unroll
                for (int e4 = 0; e4 < 8; ++e4) { const f32x4 t4 = *(const LAS f32x4*)(lw + lane * 32 + e4 * 4); l[e4 * 4] = t4.x; l[e4 * 4 + 1] = t4.y; l[e4 * 4 + 2] = t4.z; l[e4 * 4 + 3] = t4.w; }
                float tv[4]; int ti[4];
#pragma unroll
                for (int k = 0; k < 4; ++k) {
                    float bvv = -3.0e38f; int bi = 0;
#pragma unroll
                    for (int e = 0; e < 32; ++e) { const bool take = l[e] > bvv; bvv = take ? l[e] : bvv; bi = take ? e : bi; }
                    tv[k] = bvv; ti[k] = bi;
#pragma unroll
                    for (int e = 0; e < 32; ++e) l[e] = (e == bi) ? -3.0e38f : l[e];
                }
                const float e1 = __expf(tv[1] - tv[0]), e2 = __expf(tv[2] - tv[0]), e3 = __expf(tv[3] - tv[0]), inv = 1.0f / (1.0f + e1 + e2 + e3);
                const int m = row0 + lane;
                const float ww[4] = {inv, e1 * inv, e2 * inv, e3 * inv};
#pragma unroll
                for (int k = 0; k < 4; ++k) { TOPI[m * 4 + k] = ti[k]; TOPW[m * 4 + k] = ww[k]; RANK[m * 4 + k] = (int)__hip_atomic_fetch_add(cntL + ti[k], 1u, __ATOMIC_RELAXED, __HIP_MEMORY_SCOPE_WORKGROUP); }
            }
        }
        __syncthreads();
        if (C.tid < 32) BLKCNT[sg * 32 + C.tid] = cntL[C.tid];
    }
    int* SLOTTOK = (int*)(C.ws + WS_ROUTE + RT_SLOTTOK); float* SLOTW = (float*)(C.ws + WS_ROUTE + RT_SLOTW);
    for (int i = C.bid * NTHR + C.tid; i < NSLOTS; i += C.G * NTHR) { SLOTTOK[i] = T; SLOTW[i] = 0.f; }
    if (C.bid == 0) for (int i = C.tid; i < D / 2; i += NTHR) ((unsigned*)(H2 + (size_t)T * D))[i] = 0u;
    __syncthreads();
}

DI void phase_mod_convert(Ctx& C) {
    LAS float* sc = (LAS float*)C.lds;
    LAS float* red = sc + 1024;
    float* MODP = (float*)(C.ws + WS_MODP);
    for (int gI = C.bid; gI < 256; gI += C.G) {
        const int cg = gI & 63, kq = gI >> 6, t = C.tid;
        for (int i = t; i < 1024; i += NTHR) sc[i] = siluf_(C.c[(i >> 8) * D + kq * 256 + (i & 255)]);
        __syncthreads();
        if (t < 504) {
            const int c4 = t % 24, kr = t / 24;
            f32x4 a0 = (f32x4){0.f, 0.f, 0.f, 0.f}, a1 = a0, a2 = a0, a3 = a0;
            for (int k = kr; k < 256; k += 21) {
                const f32x4 w4 = *(const f32x4*)(C.w_ada + (size_t)(kq * 256 + k) * 6144 + cg * 96 + c4 * 4);
                a0 += w4 * sc[k]; a1 += w4 * sc[256 + k]; a2 += w4 * sc[512 + k]; a3 += w4 * sc[768 + k];
            }
            *(LAS f32x4*)(red + (kr * 4 + 0) * 96 + c4 * 4) = a0; *(LAS f32x4*)(red + (kr * 4 + 1) * 96 + c4 * 4) = a1;
            *(LAS f32x4*)(red + (kr * 4 + 2) * 96 + c4 * 4) = a2; *(LAS f32x4*)(red + (kr * 4 + 3) * 96 + c4 * 4) = a3;
        }
        __syncthreads();
        if (t < 384) { const int b = t / 96, col = t % 96; float sm = 0.f; for (int kr = 0; kr < 21; ++kr) sm += red[(kr * 4 + b) * 96 + col];
            MODP[(size_t)kq * 4 * 6144 + b * 6144 + cg * 96 + col] = sm; }
        __syncthreads();
    }
    convert_small(C);
}
DI void phase_norm1_v2(Ctx& C) {
    LAS float* pg = (LAS float*)C.lds; LAS float* psh = pg + 1024;
    const float* MODP = (const float*)(C.ws + WS_MODP); float* MOD = (float*)(C.ws + WS_MOD);
    bf16* H1 = (bf16*)(C.ws + WS_H1);
    float* IFG = (float*)(C.ws + WS_IFG);
    const int lane = C.lane;
    for (int idx = C.bid * NTHR + C.tid; idx < 4 * 6144; idx += C.G * NTHR) MOD[idx] = C.b_ada[idx % 6144] + (MODP[idx] + MODP[24576 + idx]) + (MODP[2 * 24576 + idx] + MODP[3 * 24576 + idx]);
    float wif[4][4][8];
#pragma unroll
    for (int j = 0; j < 4; ++j)
#pragma unroll
        for (int i = 0; i < 4; ++i) {
            const float* wp = C.w_in + (size_t)(4 * (lane + 64 * j) + i) * DIN + 3072;
#pragma unroll
            for (int e = 0; e < 8; ++e) wif[j][i][e] = wp[e];
        }
    int cur_b = -1;
    for (int sg = C.bid; sg < T / 64; sg += C.G) {
        const int b = (sg * 64) / SEQ;
        if (b != cur_b) { __syncthreads();
            for (int i = C.tid; i < 1024; i += NTHR) { const int i0 = b * 6144 + i, i1 = b * 6144 + 1024 + i;
                const float shv = C.b_ada[i] + (MODP[i0] + MODP[24576 + i0]) + (MODP[2 * 24576 + i0] + MODP[3 * 24576 + i0]);
                const float scv = C.b_ada[1024 + i] + (MODP[i1] + MODP[24576 + i1]) + (MODP[2 * 24576 + i1] + MODP[3 * 24576 + i1]);
                pg[i] = C.norm_mix_g[i] * (1.0f + scv); psh[i] = shv; }
            cur_b = b; __syncthreads(); }
#pragma unroll 1
        for (int rr = 0; rr < 8; ++rr) {
            const int m = sg * 64 + C.wave * 8 + rr;
            const f32x4* xr = (const f32x4*)(C.x + (size_t)m * D) + lane;
            f32x4 v[4]; float ss = 0.f;
#pragma unroll
            for (int j = 0; j < 4; ++j) { v[j] = xr[64 * j]; ss += (v[j].x * v[j].x + v[j].y * v[j].y) + (v[j].z * v[j].z + v[j].w * v[j].w); }
            const float rstd = 1.0f / sqrtf(wave_sum(ss) * (1.0f / D) + EPS);
            float p[8];
#pragma unroll
            for (int e = 0; e < 8; ++e) p[e] = 0.f;
            u32x2* o8 = (u32x2*)(H1 + (size_t)m * D) + lane;
#pragma unroll
            for (int j = 0; j < 4; ++j) {
                const int col = 4 * (lane + 64 * j);
                const f32x4 h = v[j] * rstd * *(const LAS f32x4*)(pg + col) + *(const LAS f32x4*)(psh + col);
                u32x2 w; w.x = pk2(h.x, h.y); w.y = pk2(h.z, h.w); o8[64 * j] = w;
                const float hh[4] = {h.x, h.y, h.z, h.w};
#pragma unroll
                for (int i = 0; i < 4; ++i)
#pragma unroll
                    for (int e = 0; e < 8; ++e) p[e] += hh[i] * wif[j][i][e];
            }
#pragma unroll
            for (int e = 0; e < 8; ++e) p[e] = wave_sum(p[e]);
            if (lane < 8) { float r = p[0];
#pragma unroll
                for (int e = 1; e < 8; ++e) r = (lane == e) ? p[e] : r;
                IFG[(size_t)m * 8 + lane] = r + C.b_if[lane]; }
        }
    }
    float* COS = (float*)(C.ws + WS_COS); float* SIN = (float*)(C.ws + WS_SIN);
    for (int idx = C.bid * NTHR + C.tid; idx < T * 64; idx += C.G * NTHR) {
        const int t = idx >> 6, i = idx & 63;
        const float inv = (float)exp(-(double)i * (9.210340371976184 / 64.0));
        const double ang = (double)C.positions[t] * (double)inv;
        const double kq = rint(ang * 0.6366197723675814);
        double r = fma(-kq, 1.5707963267948966, ang); r = fma(-kq, 6.123233995736766e-17, r);
        const float rf = (float)r; const float s = sinf(rf), c = cosf(rf);
        const int q = ((int)kq) & 3;
        const float cs = (q == 0) ? c : (q == 1) ? -s : (q == 2) ? -c : s;
        const float sn = (q == 0) ? s : (q == 1) ? c : (q == 2) ? -s : -c;
        COS[idx] = cs; SIN[idx] = sn;
    }
    __syncthreads();
}

#define XB_TMO      128
#define XB_XCNT(j)  (256  + 64 * (j))
#define XB_XSUB(j)  (1280 + 64 * (j))
#define XB_XGEN(j)  (2304 + 64 * (j))
#define XB_TOP      3328
#define XB_TOPGEN   3392
#define XCD_BAR_WORDS 3456
#define XB_SPIN_CAP (1u << 22)
DI unsigned xb_ld(unsigned* p)              { return __hip_atomic_load(p, __ATOMIC_RELAXED, __HIP_MEMORY_SCOPE_AGENT); }
DI unsigned xb_add(unsigned* p, unsigned v) { return __hip_atomic_fetch_add(p, v, __ATOMIC_RELAXED, __HIP_MEMORY_SCOPE_AGENT); }
DI unsigned xb_xcc_id() { return (unsigned)__builtin_amdgcn_s_getreg((3 << 11) | 20) & 0xFu; }
#define XB_SPIN(cond, bar) do { unsigned _sp = 0; while (cond) { __builtin_amdgcn_s_sleep(1); \
    if ((++_sp & 255u) == 0u) { if (xb_ld(&(bar)[XB_TMO])) break; if (_sp > XB_SPIN_CAP) { atomicAdd(&(bar)[XB_TMO], 1u); break; } } } } while (0)
struct XcdBarrier { unsigned* bar; unsigned x; volatile LAS unsigned* st; };
DI XcdBarrier xcd_barrier_post(unsigned* bar, volatile LAS unsigned* st) {
    XcdBarrier b; b.bar = bar; b.x = xb_xcc_id(); b.st = st;
    if (threadIdx.x == 0) (void)xb_add(&bar[XB_XCNT(b.x)], 1u);
    return b;
}
DI void xcd_barrier_complete(unsigned* bar, unsigned x, unsigned& nloc, unsigned& nx) {
    const unsigned G = gridDim.x * gridDim.y * gridDim.z;
    unsigned sum, cnt, mine, sp = 0u;
    for (;;) {
        sum = 0u; cnt = 0u; mine = 0u;
#pragma unroll
        for (unsigned j = 0; j < 16; ++j) { const unsigned c = xb_ld(&bar[XB_XCNT(j)]); sum += c; cnt += (c > 0u) ? 1u : 0u; mine = (j == x) ? c : mine; }
        if (sum == G) break;
        __builtin_amdgcn_s_sleep(1);
        if ((++sp & 255u) == 0u) { if (xb_ld(&bar[XB_TMO])) break; if (sp > XB_SPIN_CAP) { atomicAdd(&bar[XB_TMO], 1u); break; } }
    }
    nloc = mine > 0u ? mine : 1u; nx = cnt > 0u ? cnt : 1u;
}
DI void xcd_barrier(const XcdBarrier& b) {
    asm volatile("s_waitcnt vmcnt(0)" ::: "memory");
    __syncthreads();
    if (threadIdx.x == 0) {
        unsigned* bar = b.bar;
        __builtin_amdgcn_s_waitcnt(0);
        unsigned nloc = b.st[0], nx = b.st[1];
        if (nloc == 0u) { xcd_barrier_complete(bar, b.x, nloc, nx); b.st[0] = nloc; b.st[1] = nx; }
        const unsigned old = xb_add(&bar[XB_XSUB(b.x)], 1u);
        const unsigned gen = old / nloc;
        if (old + 1u == (gen + 1u) * nloc) {
            __builtin_amdgcn_fence(__ATOMIC_RELEASE, "agent");
            asm volatile("s_waitcnt vmcnt(0)" ::: "memory");
            const unsigned og = xb_add(&bar[XB_TOP], 1u);
            const unsigned tg = og / nx;
            if (og + 1u == (tg + 1u) * nx) xb_add(&bar[XB_TOPGEN], 1u);
            else XB_SPIN(xb_ld(&bar[XB_TOPGEN]) == tg, bar);
            __builtin_amdgcn_fence(__ATOMIC_ACQUIRE, "agent");
            xb_add(&bar[XB_XGEN(b.x)], 1u);
            asm volatile("s_waitcnt vmcnt(0)" ::: "memory");
        } else {
            XB_SPIN(xb_ld(&bar[XB_XGEN(b.x)]) == gen, bar);
            __builtin_amdgcn_fence(__ATOMIC_ACQUIRE, "agent");
            asm volatile("s_waitcnt vmcnt(0)" ::: "memory");
        }
    }
    __syncthreads();
}

constexpr int NPHASES = 14;
__global__ void __launch_bounds__(NTHR, 2) fwd(Args a) {
    extern __shared__ __attribute__((aligned(16))) unsigned char lds[];
    Ctx C;
    C.lds = (LAS unsigned char*)lds; C.tid = threadIdx.x; C.lane = C.tid & 63; C.wave = __builtin_amdgcn_readfirstlane(C.tid >> 6); C.G = gridDim.x; C.bid = blockIdx.x;
    C.x = (const float*)a.in[0]; C.c = (const float*)a.in[1]; C.positions = (const int*)a.in[2]; C.w_ada = (const float*)a.in[3]; C.b_ada = (const float*)a.in[4];
    C.norm_mix_g = (const float*)a.in[5]; C.w_in = (const float*)a.in[6]; C.conv_w = (const float*)a.in[7]; C.conv_b = (const float*)a.in[8]; C.b_if = (const float*)a.in[9];
    C.ml_norm_g = (const float*)a.in[10]; C.ret_norm_g = (const float*)a.in[11]; C.w_bml = (const float*)a.in[12]; C.w_bret = (const float*)a.in[13]; C.w_out = (const float*)a.in[14];
    C.norm_ffn_g = (const float*)a.in[15]; C.w_router = (const float*)a.in[16]; C.b_router = (const float*)a.in[17]; C.w_gu = (const float*)a.in[18]; C.b_gu = (const float*)a.in[19];
    C.w_dn = (const float*)a.in[20]; C.b_dn = (const float*)a.in[21]; C.norm_final_g = (const float*)a.in[22];
    C.out = a.out; C.ws = a.ws;
    const int lo = a.ph_lo, hi = a.ph_hi;
    volatile LAS unsigned* bst = (volatile LAS unsigned*)(C.lds + LDS_BYTES - 16);
    if (C.tid < 4) bst[C.tid] = 0u;
    __syncthreads();
    XcdBarrier bar; bar.bar = (unsigned*)(C.ws + WS_CTL) + CW_BAR; bar.x = 0; bar.st = bst;
    if (hi - lo > 1) bar = xcd_barrier_post((unsigned*)(C.ws + WS_CTL) + CW_BAR, bst);
#define SEAM(k) do { if (IN(k) && IN((k) + 1)) xcd_barrier(bar); } while (0)
#ifdef ONLY_PHASE
#define IN(k) ((k) == ONLY_PHASE && lo <= (k) && (k) < hi)
#else
#define IN(k) (lo <= (k) && (k) < hi)
#endif
    if (IN(0)) phase_mod_convert(C); SEAM(0);
    if (IN(1)) phase_norm1_v2(C); SEAM(1);
#if OPT_INPROJ
    if (IN(2)) phase_inproj_mfma(C); SEAM(2);
#else
    if (IN(2)) phase_inproj(C); SEAM(2);
#endif
#if !(OPT_INPROJ && OPT_LOCAL)
    if (IN(3)) phase_conv_rope(C); SEAM(3);
#endif
#if OPT_LOCAL
    if (IN(4)) phase_local_mfma(C); SEAM(4);
#else
    if (IN(4)) phase_local(C); SEAM(4);
#endif
    if (IN(5)) phase_scan(C); SEAM(5);
#if OPT_OUTP
    if (IN(6)) phase_out_mfma(C); SEAM(6);
#else
    if (IN(6)) phase_out(C); SEAM(6);
#endif
#if OPT_BRANCH
    if (IN(7)) phase_branch_mfma(C); SEAM(7);
#else
    if (IN(7)) phase_branch(C); SEAM(7);
#endif
#if OPT_OUT
    if (IN(8)) phase_outproj_mfma(C); SEAM(8);
#else
    if (IN(8)) phase_outproj(C); SEAM(8);
#endif
#if OPT_ROUTE
    if (IN(9)) phase_norm2_route_mfma(C); SEAM(9);
#else
    if (IN(9)) phase_norm2_route(C); SEAM(9);
#endif
    if (IN(10)) phase_slots(C); SEAM(10);
#if OPT_MOE
    if (IN(11)) phase_gateup_mfma(C); SEAM(11);
#else
    if (IN(11)) phase_gateup(C); SEAM(11);
#endif
#if OPT_MOE
    if (IN(12)) phase_down_mfma(C); SEAM(12);
#else
    if (IN(12)) phase_down(C); SEAM(12);
#endif
    if (IN(13)) phase_final(C); SEAM(13);
#undef IN
}

extern "C" void kernel_launch(void* const* d_in, const int* in_sizes, int n_in, void* d_out, int out_size, void* d_ws, size_t ws_size, hipStream_t stream) {
    static int grid = 0;
    if (grid == 0) {
        if (n_in != 23 || out_size != T * D || ws_size < WS_END) { fprintf(stderr, "kernel_launch: unexpected shapes: n_in %d out %d ws %zu (need %zu)\n", n_in, out_size, ws_size, (size_t)WS_END); grid = -1; return; }
        int dev = 0, cus = 0;
        if (hipGetDevice(&dev) != hipSuccess || hipDeviceGetAttribute(&cus, hipDeviceAttributeMultiprocessorCount, dev) != hipSuccess) { grid = -1; return; }
        if (hipFuncSetAttribute((const void*)fwd, hipFuncAttributeMaxDynamicSharedMemorySize, LDS_BYTES) != hipSuccess) { fprintf(stderr, "kernel_launch: hipFuncSetAttribute failed\n"); grid = -1; return; }
        grid = cus > 0 ? cus : 256;
    }
    if (grid < 0) return;
    Args a{};
    for (int i = 0; i < 23; ++i) a.in[i] = d_in[i];
    a.out = (float*)d_out; a.ws = (unsigned char*)d_ws;
    (void)hipMemsetAsync((char*)d_ws + WS_CTL, 0, CTL_ZERO_BYTES, stream);
#ifdef MK_PER_PHASE
    for (int p = 0; p < NPHASES; ++p) { a.ph_lo = p; a.ph_hi = p + 1; hipLaunchKernelGGL(fwd, dim3(grid), dim3(NTHR), LDS_BYTES, stream, a); }
#else
    a.ph_lo = 0; a.ph_hi = NPHASES;
    hipLaunchKernelGGL(fwd, dim3(grid), dim3(NTHR), LDS_BYTES, stream, a);
#endif
#ifdef PROBE_PHASE
    for (int r = 0; r < PROBE_REPS; ++r) { a.ph_lo = PROBE_PHASE; a.ph_hi = PROBE_PHASE + 1; hipLaunchKernelGGL(fwd, dim3(grid), dim3(NTHR), LDS_BYTES, stream, a); }
#endif
}
```

```cpp
#include <hip/hip_runtime.h>
#include <cstdio>
#include <cstdint>

#ifndef OPT_INPROJ
#define OPT_INPROJ 1
#endif
#ifndef OPT_BRANCH
#define OPT_BRANCH 1
#endif
#ifndef OPT_OUT
#define OPT_OUT 1
#endif
#ifndef OPT_MOE
#define OPT_MOE 1
#endif
#ifndef OPT_LOCAL
#define OPT_LOCAL 1
#endif
#ifndef OPT_OUTP
#define OPT_OUTP 1
#endif
#ifndef OPT_ROUTE
#define OPT_ROUTE 1
#endif
#define OPT_ANY (OPT_INPROJ || OPT_BRANCH || OPT_OUT || OPT_MOE)
#define DI __device__ __forceinline__
#define LAS __attribute__((address_space(3)))
typedef unsigned short bf16;
typedef float f32x4 __attribute__((ext_vector_type(4)));
typedef unsigned u32x4 __attribute__((ext_vector_type(4)));
typedef unsigned u32x2 __attribute__((ext_vector_type(2)));

constexpr int D = 1024, NB = 4, SEQ = 4096, T = NB * SEQ;
constexpr int DIN = 8200, CH = 128, NCH = SEQ / CH;
constexpr int NE = 32, TOPK = 4, NSLOT_BLK = 288, NSLOTS = NSLOT_BLK * 256;
constexpr float EPS = 1e-5f;
constexpr int NTHR = 512, NWAVES = 8;

constexpr size_t MiB = 1u << 20;
constexpr size_t WS_CTL   = 0;
constexpr size_t WS_MOD   = 1 * MiB;
constexpr size_t WS_IFG   = 2 * MiB;
constexpr size_t WS_COS   = 3 * MiB;
constexpr size_t WS_SIN   = 7 * MiB;
constexpr size_t WS_ROUTE = 11 * MiB;
constexpr size_t WS_SMALL = 14 * MiB;
constexpr size_t WS_H1    = 16 * MiB;
constexpr size_t WS_X1    = 50 * MiB;
constexpr size_t WS_TMP   = 114 * MiB;
constexpr size_t WS_B     = 178 * MiB;
constexpr size_t WS_QKRAW = WS_B;
constexpr size_t WS_QC    = WS_B + 32 * MiB;
constexpr size_t WS_MLV   = WS_B + 64 * MiB;
constexpr size_t WS_MLO   = WS_B + 96 * MiB;
constexpr size_t WS_RETQ  = WS_B + 128 * MiB;
constexpr size_t WS_RETK  = WS_B + 144 * MiB;
constexpr size_t WS_RETV  = WS_B + 160 * MiB;
constexpr size_t WS_RETG  = WS_B + 192 * MiB;
constexpr size_t WS_GML   = WS_B + 224 * MiB;
constexpr size_t WS_GRET  = WS_B + 256 * MiB;
constexpr size_t WS_CLOC  = WS_B + 288 * MiB;
constexpr size_t WS_CPREV = WS_B + 352 * MiB;
constexpr size_t WS_HML   = WS_B + 416 * MiB;
constexpr size_t WS_HRET  = WS_B + 448 * MiB;
constexpr size_t WS_B_END = WS_B + 480 * MiB;
constexpr size_t WS_ACT   = WS_B;
constexpr size_t WS_YS    = WS_B + 160 * MiB;
constexpr size_t WS_WT_IN = WS_B_END;
constexpr size_t WS_WT_BR = WS_WT_IN + 16 * MiB;
constexpr size_t WS_WT_OUT = WS_WT_BR + 4 * MiB;
constexpr size_t WS_WT_GU = WS_WT_OUT + 2 * MiB;
constexpr size_t WS_WT_DN = WS_WT_GU + 128 * MiB;
constexpr size_t WS_MODP  = WS_WT_DN + 64 * MiB;
constexpr size_t WS_END   = WS_MODP + 1 * MiB;
static_assert(WS_YS + (size_t)NSLOTS * 2048 <= WS_B_END, "ws map");

constexpr int CW_CNT = 64;
constexpr int CW_NBLK = 128;
constexpr int CW_BLKE = 192;
constexpr int CW_BAR = 4096;
constexpr size_t CTL_ZERO_BYTES = 65536;
constexpr size_t RT_TOPI = 0;
constexpr size_t RT_TOPW = 256 * 1024;
constexpr size_t RT_RANK = 512 * 1024;
constexpr size_t RT_ASLOT = 768 * 1024;
constexpr size_t RT_SLOTTOK = 1024 * 1024;
constexpr size_t RT_SLOTW = 1024 * 1024 + 512 * 1024;
constexpr size_t RT_BLKCNT = 2048 * 1024;
constexpr size_t SM_NLOC = 0;
constexpr size_t SM_NPREV = 256 * 1024;
constexpr size_t SM_MLOC = 512 * 1024;
constexpr size_t SM_ACH = 512 * 1024 + 4096;
constexpr size_t SM_MPREV = 512 * 1024 + 8192;
constexpr size_t SM_AG = 1024 * 1024;
constexpr size_t SM_CMG = 1280 * 1024;

constexpr int LDS_BYTES = 163840;

DI float bf2f(bf16 v) { return __uint_as_float(((unsigned)v) << 16); }
DI unsigned f2bf(float f) { unsigned u = __float_as_uint(f); return (u + 0x7fffu + ((u >> 16) & 1u)) >> 16; }
DI unsigned pk2(float lo, float hi) { return f2bf(lo) | (f2bf(hi) << 16); }
DI float wave_sum(float v) {
#pragma unroll
    for (int o = 1; o < 64; o <<= 1) v += __shfl_xor(v, o);
    return v;
}
DI float sigmoidf_(float x) { return 1.0f / (1.0f + __expf(-x)); }
DI float siluf_(float x) { return x / (1.0f + __expf(-x)); }
DI float logsigmoidf_(float x) { return fminf(x, 0.f) - log1pf(__expf(-fabsf(x))); }
DI void unpack8(const u32x4 w, float (&f)[8]) {
    f[0] = __uint_as_float(w.x << 16); f[1] = __uint_as_float(w.x & 0xffff0000u);
    f[2] = __uint_as_float(w.y << 16); f[3] = __uint_as_float(w.y & 0xffff0000u);
    f[4] = __uint_as_float(w.z << 16); f[5] = __uint_as_float(w.z & 0xffff0000u);
    f[6] = __uint_as_float(w.w << 16); f[7] = __uint_as_float(w.w & 0xffff0000u);
}
DI u32x4 pack8(const float (&f)[8]) { u32x4 w; w.x = pk2(f[0], f[1]); w.y = pk2(f[2], f[3]); w.z = pk2(f[4], f[5]); w.w = pk2(f[6], f[7]); return w; }

struct Args { const void* in[23]; float* out; unsigned char* ws; int ph_lo, ph_hi; };

struct Ctx {
    LAS unsigned char* lds;
    int tid, lane, wave, G, bid;
    const float *x, *c, *w_ada, *b_ada, *norm_mix_g, *w_in, *conv_w, *conv_b, *b_if, *ml_norm_g, *ret_norm_g;
    const float *w_bml, *w_bret, *w_out, *norm_ffn_g, *w_router, *b_router, *w_gu, *b_gu, *w_dn, *b_dn, *norm_final_g;
    const int* positions;
    float* out; unsigned char* ws;
};

template <class AF, class BF, class EF>
DI void naive_gemm_tile(Ctx& C, int tm, int tn, int K, int ldb, const AF& af, const BF& bf, const EF& ef) {
    LAS float* As = (LAS float*)C.lds;
    LAS float* Bs = As + 16 * 132;
    const int t = C.tid, ty = t >> 5, tx = t & 31;
    float acc[8][4];
#pragma unroll
    for (int i = 0; i < 8; ++i)
#pragma unroll
        for (int j = 0; j < 4; ++j) acc[i][j] = 0.f;
    const int ar = t >> 2, ak = (t & 3) * 4;
    const bf16* arow = af.row(tm, ar);
    const int bk = t >> 5, bn = (t & 31) * 4;
    const float* bbase = bf.ptr(tm, tn) + bn;
    for (int k0 = 0; k0 < K; k0 += 16) {
        const u32x2 av = *(const u32x2*)(arow + k0 + ak);
        const f32x4 bv = *(const f32x4*)(bbase + (size_t)(k0 + bk) * ldb);
        __syncthreads();
        As[(ak + 0) * 132 + ar] = __uint_as_float(av.x << 16); As[(ak + 1) * 132 + ar] = __uint_as_float(av.x & 0xffff0000u);
        As[(ak + 2) * 132 + ar] = __uint_as_float(av.y << 16); As[(ak + 3) * 132 + ar] = __uint_as_float(av.y & 0xffff0000u);
        *(LAS f32x4*)(Bs + bk * 132 + bn) = bv;
        __syncthreads();
#pragma unroll 4
        for (int kk = 0; kk < 16; ++kk) {
            const f32x4 a0 = *(const LAS f32x4*)(As + kk * 132 + ty * 8), a1 = *(const LAS f32x4*)(As + kk * 132 + ty * 8 + 4);
            const f32x4 b = *(const LAS f32x4*)(Bs + kk * 132 + tx * 4);
            const float a[8] = {a0.x, a0.y, a0.z, a0.w, a1.x, a1.y, a1.z, a1.w};
#pragma unroll
            for (int i = 0; i < 8; ++i) { acc[i][0] += a[i] * b.x; acc[i][1] += a[i] * b.y; acc[i][2] += a[i] * b.z; acc[i][3] += a[i] * b.w; }
        }
    }
#pragma unroll
    for (int i = 0; i < 8; ++i) { ef.put(tm, tn, ty * 8 + i, tx * 4, acc[i]); asm volatile("" ::: "memory"); }
    __syncthreads();
}

DI void phase_mod(Ctx& C) {
    LAS float* red = (LAS float*)C.lds;
    float* mod = (float*)(C.ws + WS_MOD);
    for (int g = C.bid; g < 256; g += C.G) {
        const int n0 = g * 24, t = C.tid;
        if (t < 504) {
            const int col = t % 24, kg = t / 24;
            float a0 = 0.f, a1 = 0.f, a2 = 0.f, a3 = 0.f;
            for (int k = kg; k < D; k += 21) {
                const float w = C.w_ada[(size_t)k * 6144 + n0 + col];
                a0 += siluf_(C.c[k]) * w; a1 += siluf_(C.c[D + k]) * w; a2 += siluf_(C.c[2 * D + k]) * w; a3 += siluf_(C.c[3 * D + k]) * w;
            }
            red[(kg * 24 + col) * 4 + 0] = a0; red[(kg * 24 + col) * 4 + 1] = a1; red[(kg * 24 + col) * 4 + 2] = a2; red[(kg * 24 + col) * 4 + 3] = a3;
        }
        __syncthreads();
        if (t < 96) {
            const int col = t % 24, b = t / 24; float s = 0.f;
            for (int kg = 0; kg < 21; ++kg) s += red[(kg * 24 + col) * 4 + b];
            mod[b * 6144 + n0 + col] = s + C.b_ada[n0 + col];
        }
        __syncthreads();
    }
}

DI void phase_norm1(Ctx& C) {
    const float* mod = (const float*)(C.ws + WS_MOD);
    bf16* H1 = (bf16*)(C.ws + WS_H1);
    float* IFG = (float*)(C.ws + WS_IFG);
    const int lane = C.lane, gw = C.bid * NWAVES + C.wave, NGW = C.G * NWAVES;
    float wif[4][4][8];
#pragma unroll
    for (int j = 0; j < 4; ++j)
#pragma unroll
        for (int i = 0; i < 4; ++i) {
            const float* wp = C.w_in + (size_t)(4 * (lane + 64 * j) + i) * DIN + 3072;
#pragma unroll
            for (int e = 0; e < 8; ++e) wif[j][i][e] = wp[e];
        }
    for (int m = gw; m < T; m += NGW) {
        const int b = m / SEQ;
        const f32x4* xr = (const f32x4*)(C.x + (size_t)m * D) + lane;
        f32x4 v[4]; float ss = 0.f;
#pragma unroll
        for (int j = 0; j < 4; ++j) { v[j] = xr[64 * j]; ss += (v[j].x * v[j].x + v[j].y * v[j].y) + (v[j].z * v[j].z + v[j].w * v[j].w); }
        const float rstd = 1.0f / sqrtf(wave_sum(ss) * (1.0f / D) + EPS);
        float p[8];
#pragma unroll
        for (int e = 0; e < 8; ++e) p[e] = 0.f;
        u32x2* o8 = (u32x2*)(H1 + (size_t)m * D) + lane;
#pragma unroll
        for (int j = 0; j < 4; ++j) {
            const int col = 4 * (lane + 64 * j);
            const f32x4 g = *(const f32x4*)(C.norm_mix_g + col), sh = *(const f32x4*)(mod + b * 6144 + col), sc = *(const f32x4*)(mod + b * 6144 + 1024 + col);
            f32x4 h = (v[j] * rstd * g) * (sc + 1.0f) + sh;
            u32x2 w; w.x = pk2(h.x, h.y); w.y = pk2(h.z, h.w); o8[64 * j] = w;
            const float hh[4] = {h.x, h.y, h.z, h.w};
#pragma unroll
            for (int i = 0; i < 4; ++i)
#pragma unroll
                for (int e = 0; e < 8; ++e) p[e] += hh[i] * wif[j][i][e];
        }
#pragma unroll
        for (int e = 0; e < 8; ++e) p[e] = wave_sum(p[e]);
        if (lane < 8) { float r = p[0];
#pragma unroll
            for (int e = 1; e < 8; ++e) r = (lane == e) ? p[e] : r;
            IFG[(size_t)m * 8 + lane] = r + C.b_if[lane]; }
    }
    float* COS = (float*)(C.ws + WS_COS); float* SIN = (float*)(C.ws + WS_SIN);
    for (int idx = C.bid * NTHR + C.tid; idx < T * 64; idx += C.G * NTHR) {
        const int t = idx >> 6, i = idx & 63;
        const float inv = (float)exp(-(double)i * (9.210340371976184 / 64.0));
        const double ang = (double)C.positions[t] * (double)inv;
        const double kq = rint(ang * 0.6366197723675814);
        double r = fma(-kq, 1.5707963267948966, ang); r = fma(-kq, 6.123233995736766e-17, r);
        const float rf = (float)r; const float s = sinf(rf), c = cosf(rf);
        const int q = ((int)kq) & 3;
        const float cs = (q == 0) ? c : (q == 1) ? -s : (q == 2) ? -c : s;
        const float sn = (q == 0) ? s : (q == 1) ? c : (q == 2) ? -s : -c;
        COS[idx] = cs; SIN[idx] = sn;
    }
    if (C.bid == 0 && C.tid < 32) ((unsigned*)(C.ws + WS_CTL))[CW_CNT + C.tid] = 0u;
}

struct AF_rows { const bf16* base; int ld; DI const bf16* row(int tm, int r) const { return base + (size_t)(tm * 128 + r) * ld; } };
struct BF_inproj { const float* w; DI const float* ptr(int, int tn) const { return w + (tn < 24 ? tn * 128 : tn * 128 + 8); } };
struct EF_inproj { unsigned char* ws;
    DI void put(int tm, int tn, int r, int c, const float (&v)[4]) const {
        const int row = tm * 128 + r; const int seg = tn >> 3;
        bf16* dst; int ld = 1024, col = (tn & 7) * 128 + c; int act = 0;
        switch (seg) {
            case 0: dst = (bf16*)(ws + WS_QKRAW); break;
            case 1: dst = (bf16*)(ws + WS_MLV); break;
            case 2: dst = (bf16*)(ws + WS_MLO); act = 1; break;
            case 3: if ((tn & 7) < 4) dst = (bf16*)(ws + WS_RETQ); else { dst = (bf16*)(ws + WS_RETK); col -= 512; } ld = 512; break;
            case 4: dst = (bf16*)(ws + WS_RETV); break;
            case 5: dst = (bf16*)(ws + WS_RETG); act = 2; break;
            case 6: dst = (bf16*)(ws + WS_GML); act = 1; break;
            default: dst = (bf16*)(ws + WS_GRET); act = 1; break;
        }
        float o[4];
#pragma unroll
        for (int j = 0; j < 4; ++j) o[j] = act == 1 ? sigmoidf_(v[j]) : act == 2 ? siluf_(v[j]) : v[j];
        u32x2 w; w.x = pk2(o[0], o[1]); w.y = pk2(o[2], o[3]);
        *(u32x2*)(dst + (size_t)row * ld + col) = w;
    } };
DI void phase_inproj(Ctx& C) {
    AF_rows af{(const bf16*)(C.ws + WS_H1), D}; BF_inproj bf{C.w_in}; EF_inproj ef{C.ws};
    const int ntn = 64, nt = (T / 128) * ntn;
    for (int u = C.bid; u < nt; u += C.G) naive_gemm_tile(C, u / ntn, u % ntn, D, DIN, af, bf, ef);
}

DI void phase_conv_rope(Ctx& C) {
    const bf16* QKRAW = (const bf16*)(C.ws + WS_QKRAW); bf16* QC = (bf16*)(C.ws + WS_QC);
    for (int idx = C.bid * NTHR + C.tid; idx < T * 128; idx += C.G * NTHR) {
        const int t = idx >> 7, c0 = (idx & 127) * 8, s = t % SEQ;
        float acc[8];
#pragma unroll
        for (int e = 0; e < 8; ++e) acc[e] = C.conv_b[c0 + e];
#pragma unroll
        for (int j = 0; j < 4; ++j) {
            if (s - 3 + j >= 0) {
                float f[8]; unpack8(*(const u32x4*)(QKRAW + (size_t)(t - 3 + j) * D + c0), f);
#pragma unroll
                for (int e = 0; e < 8; ++e) acc[e] += f[e] * C.conv_w[j * D + c0 + e];
            }
        }
        const float sc = (c0 < 512) ? 0.08838834764831845f : 1.0f;
#pragma unroll
        for (int e = 0; e < 8; ++e) acc[e] = siluf_(acc[e]) * sc;
        *(u32x4*)(QC + (size_t)t * D + c0) = pack8(acc);
    }
#if !OPT_INPROJ
    const float* COS = (const float*)(C.ws + WS_COS); const float* SIN = (const float*)(C.ws + WS_SIN);
    for (int idx = C.bid * NTHR + C.tid; idx < T * 64; idx += C.G * NTHR) {
        const int t = idx >> 6, r = idx & 63, which = r >> 5, h = (r >> 3) & 3, i0 = (r & 7) * 8;
        bf16* base = (bf16*)(C.ws + (which ? WS_RETK : WS_RETQ)) + (size_t)t * 512 + h * 128;
        float x1[8], x2[8], o1[8], o2[8]; unpack8(*(const u32x4*)(base + i0), x1); unpack8(*(const u32x4*)(base + 64 + i0), x2);
        const float sc = which ? 0.08838834764831845f : 1.0f;
#pragma unroll
        for (int e = 0; e < 8; ++e) { const float cs = COS[t * 64 + i0 + e], sn = SIN[t * 64 + i0 + e]; o1[e] = (x1[e] * cs - x2[e] * sn) * sc; o2[e] = (x2[e] * cs + x1[e] * sn) * sc; }
        *(u32x4*)(base + i0) = pack8(o1); *(u32x4*)(base + 64 + i0) = pack8(o2);
    }
#endif
}

DI float ret_lg(int h) { return logf(1.0f - exp2f(-5.0f - (float)h)); }

DI void phase_local(Ctx& C) {
    LAS float* lf = (LAS float*)C.lds; LAS float* a = lf + 128; LAS float* ws = a + 128; LAS float* red = ws + 128;
    const float* IFG = (const float*)(C.ws + WS_IFG);
    bf16* CLOC = (bf16*)(C.ws + WS_CLOC);
    float* NLOC = (float*)(C.ws + WS_SMALL + SM_NLOC); float* MLOC = (float*)(C.ws + WS_SMALL + SM_MLOC); float* ACH = (float*)(C.ws + WS_SMALL + SM_ACH);
    const int t = C.tid;
    for (int u = C.bid; u < 1024; u += C.G) {
        const int mixer = u >> 9, bh = (u >> 5) & 15, ch = u & 31, b = bh >> 2, h = bh & 3, t0 = b * SEQ + ch * CH;
        const bf16 *Kp, *Vp; int ldk;
        if (mixer == 0) {
            if (t < 128) lf[t] = logsigmoidf_(IFG[(size_t)(t0 + t) * 8 + 4 + h]);
            __syncthreads();
            if (t < 128) { float s = 0.f; for (int j = 0; j <= t; ++j) s += lf[j]; a[t] = s; }
            __syncthreads();
            const float A = a[127];
            if (t < 128) ws[t] = A - a[t] + IFG[(size_t)(t0 + t) * 8 + h];
            __syncthreads();
            float mloc = -3.0e38f; for (int j = 0; j < 128; ++j) mloc = fmaxf(mloc, ws[j]);
            __syncthreads();
            if (t < 128) ws[t] = __expf(ws[t] - mloc);
            if (t == 0) { MLOC[bh * 32 + ch] = mloc; ACH[bh * 32 + ch] = A; }
            __syncthreads();
            Kp = (const bf16*)(C.ws + WS_QC) + (size_t)t0 * D + 512 + h * 128; ldk = D;
            Vp = (const bf16*)(C.ws + WS_MLV) + (size_t)t0 * D + h * 256;
        } else {
            const float lg = ret_lg(h);
            if (t < 128) ws[t] = __expf(lg * (float)(127 - t));
            __syncthreads();
            Kp = (const bf16*)(C.ws + WS_RETK) + (size_t)t0 * 512 + h * 128; ldk = 512;
            Vp = (const bf16*)(C.ws + WS_RETV) + (size_t)t0 * D + h * 256;
        }
        const int kh = t >> 8, v = t & 255;
        float acc[64];
#pragma unroll
        for (int i = 0; i < 64; ++i) acc[i] = 0.f;
        for (int s = 0; s < 128; ++s) {
            const float vv = ws[s] * bf2f(Vp[(size_t)s * D + v]);
            const bf16* kr = Kp + (size_t)s * ldk + kh * 64;
#pragma unroll
            for (int i8 = 0; i8 < 8; ++i8) { float f[8]; unpack8(*(const u32x4*)(kr + i8 * 8), f);
#pragma unroll
                for (int e = 0; e < 8; ++e) acc[i8 * 8 + e] += f[e] * vv; }
        }
        bf16* cl = CLOC + ((size_t)(mixer * 16 + bh) * 32 + ch) * 32768;
#pragma unroll
        for (int i = 0; i < 64; ++i) cl[(size_t)v * 128 + (kh * 64 + i)] = (bf16)f2bf(acc[i]);
        if (mixer == 0 && t < 128) { float s = 0.f; for (int j = 0; j < 128; ++j) s += ws[j] * bf2f(Kp[(size_t)j * ldk + t]); NLOC[(bh * 32 + ch) * 128 + t] = s; }
        __syncthreads();
    }
    (void)red;
}

DI void phase_scan(Ctx& C) {
    const bf16* CLOC = (const bf16*)(C.ws + WS_CLOC); bf16* CPREV = (bf16*)(C.ws + WS_CPREV);
    const float* NLOC = (const float*)(C.ws + WS_SMALL + SM_NLOC); float* NPREV = (float*)(C.ws + WS_SMALL + SM_NPREV);
    const float* MLOC = (const float*)(C.ws + WS_SMALL + SM_MLOC); const float* ACH = (const float*)(C.ws + WS_SMALL + SM_ACH); float* MPREV = (float*)(C.ws + WS_SMALL + SM_MPREV);
    for (int idx = C.bid * NTHR + C.tid; idx < 32 * 4096; idx += C.G * NTHR) {
        const int seq = idx >> 12, e8 = idx & 4095;
        float st[8];
#pragma unroll
        for (int e = 0; e < 8; ++e) st[e] = 0.f;
        if (seq < 16) {
            float m_st = 0.f; float nst[8];
#pragma unroll
            for (int e = 0; e < 8; ++e) nst[e] = 0.f;
            for (int ch = 0; ch < 32; ++ch) {
                const size_t o = ((size_t)seq * 32 + ch) * 32768 + (size_t)e8 * 8;
                *(u32x4*)(CPREV + o) = pack8(st);
                if (e8 < 16) { *(f32x4*)(NPREV + (seq * 32 + ch) * 128 + e8 * 8) = (f32x4){nst[0], nst[1], nst[2], nst[3]}; *(f32x4*)(NPREV + (seq * 32 + ch) * 128 + e8 * 8 + 4) = (f32x4){nst[4], nst[5], nst[6], nst[7]}; }
                if (e8 == 0) MPREV[seq * 32 + ch] = m_st;
                const float A = ACH[seq * 32 + ch], ml = MLOC[seq * 32 + ch];
                const float m_new = fmaxf(A + m_st, ml), sp = __expf(A + m_st - m_new), sl = __expf(ml - m_new);
                float f[8]; unpack8(*(const u32x4*)(CLOC + o), f);
#pragma unroll
                for (int e = 0; e < 8; ++e) st[e] = sp * st[e] + sl * f[e];
                if (e8 < 16) { const float* nl = NLOC + (seq * 32 + ch) * 128 + e8 * 8;
#pragma unroll
                    for (int e = 0; e < 8; ++e) nst[e] = sp * nst[e] + sl * nl[e]; }
                m_st = m_new;
            }
        } else {
            const float g = __expf(ret_lg(seq & 3) * 128.0f);
            for (int ch = 0; ch < 32; ++ch) {
                const size_t o = ((size_t)seq * 32 + ch) * 32768 + (size_t)e8 * 8;
                *(u32x4*)(CPREV + o) = pack8(st);
                float f[8]; unpack8(*(const u32x4*)(CLOC + o), f);
#pragma unroll
                for (int e = 0; e < 8; ++e) st[e] = g * st[e] + f[e];
            }
        }
    }
}

DI void phase_out(Ctx& C) {
    LAS float* av = (LAS float*)C.lds;
    LAS float* bv = av + 128;
    LAS float* mt = bv + 128;
    LAS float* isc = mt + 128;
    LAS float* den = isc + 128;
    LAS float* rs = den + 128;
    LAS float* P = rs + 1024;
    LAS float* Qs = P + 128 * 129;
    const float* IFG = (const float*)(C.ws + WS_IFG);
    const bf16* CPREV = (const bf16*)(C.ws + WS_CPREV);
    const float* NPREV = (const float*)(C.ws + WS_SMALL + SM_NPREV); const float* MPREV = (const float*)(C.ws + WS_SMALL + SM_MPREV);
    const int t = C.tid;
    for (int u = C.bid; u < 1024; u += C.G) {
        const int mixer = u >> 9, bh = (u >> 5) & 15, ch = u & 31, b = bh >> 2, h = bh & 3, t0 = b * SEQ + ch * CH;
        const bf16 *Qp, *Kp, *Vp; int ldq; const bf16* cp = CPREV + ((size_t)(mixer * 16 + bh) * 32 + ch) * 32768;
        float lg = 0.f;
        if (mixer == 0) {
            Qp = (const bf16*)(C.ws + WS_QC) + (size_t)t0 * D + h * 128; Kp = Qp + 512; ldq = D;
            Vp = (const bf16*)(C.ws + WS_MLV) + (size_t)t0 * D + h * 256;
            if (t < 128) mt[t] = logsigmoidf_(IFG[(size_t)(t0 + t) * 8 + 4 + h]);
            __syncthreads();
            if (t < 128) { float s = 0.f; for (int j = 0; j <= t; ++j) s += mt[j]; av[t] = s; bv[t] = IFG[(size_t)(t0 + t) * 8 + h] - s; }
            __syncthreads();
            if (t < 128) { float cm = -3.0e38f; for (int j = 0; j <= t; ++j) cm = fmaxf(cm, bv[j]);
                const float il = av[t] + MPREV[bh * 32 + ch], m = fmaxf(il, av[t] + cm); isc[t] = __expf(il - m); mt[t] = m; }
        } else {
            lg = ret_lg(h);
            Qp = (const bf16*)(C.ws + WS_RETQ) + (size_t)t0 * 512 + h * 128; Kp = (const bf16*)(C.ws + WS_RETK) + (size_t)t0 * 512 + h * 128; ldq = 512;
            Vp = (const bf16*)(C.ws + WS_RETV) + (size_t)t0 * D + h * 256;
            if (t < 128) isc[t] = __expf(lg * (float)(t + 1));
        }
        for (int e = t; e < 128 * 16; e += NTHR) { const int j = e >> 4, k8 = e & 15; float f[8]; unpack8(*(const u32x4*)(Qp + (size_t)j * ldq + k8 * 8), f);
#pragma unroll
            for (int i = 0; i < 8; ++i) Qs[j * 129 + k8 * 8 + i] = f[i]; }
        __syncthreads();
        for (int e = t; e < 128 * 128; e += NTHR) {
            const int j = e >> 7, s = e & 127; float p = 0.f;
            if (s <= j) {
                float d = 0.f;
#pragma unroll 4
                for (int k8 = 0; k8 < 16; ++k8) { float fk[8]; unpack8(*(const u32x4*)(Kp + (size_t)s * ldq + k8 * 8), fk);
#pragma unroll
                    for (int i = 0; i < 8; ++i) d += Qs[j * 129 + k8 * 8 + i] * fk[i]; }
                p = d * (mixer == 0 ? __expf(av[j] + bv[s] - mt[j]) : __expf(lg * (float)(j - s)));
            }
            P[j * 129 + s] = p;
        }
        __syncthreads();
        if (mixer == 0 && t < 128) { float s = 0.f; for (int i = 0; i < 128; ++i) s += P[t * 129 + i];
            float qn = 0.f; const float* np = NPREV + (bh * 32 + ch) * 128; for (int k = 0; k < 128; ++k) qn += Qs[t * 129 + k] * np[k];
            den[t] = fmaxf(fabsf(s + isc[t] * qn), __expf(-mt[t])); }
        __syncthreads();
        const float gain = (mixer == 0 ? C.ml_norm_g : C.ret_norm_g)[h * 256 + (t & 255)];
#pragma unroll 1
        for (int pass = 0; pass < 2; ++pass) {
            const int jh = t >> 8, v = t & 255, r0 = (pass * 2 + jh) * 32;
            float acc[32];
#pragma unroll
            for (int i = 0; i < 32; ++i) acc[i] = 0.f;
            const LAS float* qb = Qs + r0 * 129; const LAS float* pb = P + r0 * 129;
            for (int k = 0; k < 128; ++k) {
                const float cv = bf2f(cp[(size_t)v * 128 + k]);
#pragma unroll
                for (int i = 0; i < 32; ++i) acc[i] += qb[i * 129 + k] * cv;
            }
#pragma unroll
            for (int i = 0; i < 32; ++i) acc[i] *= isc[r0 + i];
            for (int s = 0; s < 128; ++s) {
                const float vv = bf2f(Vp[(size_t)s * D + v]);
#pragma unroll
                for (int i = 0; i < 32; ++i) acc[i] += pb[i * 129 + s] * vv;
            }
            if (mixer == 0) {
#pragma unroll
                for (int i = 0; i < 32; ++i) acc[i] = acc[i] / den[r0 + i];
            }
            const int wq = C.wave & 3;
#pragma unroll
            for (int i = 0; i < 32; ++i) { const float s1 = wave_sum(acc[i]); if (C.lane == 0) rs[wq * 128 + r0 + i] = s1; }
            __syncthreads();
#pragma unroll
            for (int i = 0; i < 32; ++i) { const int r = r0 + i; acc[i] -= (rs[r] + rs[128 + r] + rs[256 + r] + rs[384 + r]) * (1.0f / 256.0f); }
#pragma unroll
            for (int i = 0; i < 32; ++i) { const float s2 = wave_sum(acc[i] * acc[i]); if (C.lane == 0) rs[512 + wq * 128 + r0 + i] = s2; }
            __syncthreads();
            const bf16* gate = (const bf16*)(C.ws + (mixer == 0 ? WS_MLO : WS_RETG)) + (size_t)t0 * D + h * 256 + v;
            bf16* outp = (bf16*)(C.ws + (mixer == 0 ? WS_HML : WS_HRET)) + (size_t)t0 * D + h * 256 + v;
#pragma unroll
            for (int i = 0; i < 32; ++i) { const int r = r0 + i;
                const float var = (rs[512 + r] + rs[512 + 128 + r] + rs[512 + 256 + r] + rs[512 + 384 + r]) * (1.0f / 256.0f);
                const float y = acc[i] * (1.0f / sqrtf(var + EPS)) * gain * bf2f(gate[(size_t)r * D]);
                outp[(size_t)r * D] = (bf16)f2bf(y); }
            __syncthreads();
        }
    }
}

struct BF_plain { const float* w; DI const float* ptr(int, int tn) const { return w + tn * 128; } };
struct EF_f32 { float* dst; DI void put(int tm, int tn, int r, int c, const float (&v)[4]) const { *(f32x4*)(dst + (size_t)(tm * 128 + r) * D + tn * 128 + c) = (f32x4){v[0], v[1], v[2], v[3]}; } };
struct EF_merge { const float* t1; const bf16* g1; const bf16* g2; bf16* y;
    DI void put(int tm, int tn, int r, int c, const float (&v)[4]) const {
        const size_t o = (size_t)(tm * 128 + r) * D + tn * 128 + c; const f32x4 a = *(const f32x4*)(t1 + o);
        const u32x2 w1 = *(const u32x2*)(g1 + o), w2 = *(const u32x2*)(g2 + o);
        const float o0 = __uint_as_float(w1.x << 16) * a.x + __uint_as_float(w2.x << 16) * v[0], o1 = __uint_as_float(w1.x & 0xffff0000u) * a.y + __uint_as_float(w2.x & 0xffff0000u) * v[1];
        const float o2 = __uint_as_float(w1.y << 16) * a.z + __uint_as_float(w2.y << 16) * v[2], o3 = __uint_as_float(w1.y & 0xffff0000u) * a.w + __uint_as_float(w2.y & 0xffff0000u) * v[3];
        u32x2 w; w.x = pk2(o0, o1); w.y = pk2(o2, o3); *(u32x2*)(y + o) = w; } };
DI void phase_branch(Ctx& C) {
    AF_rows a1{(const bf16*)(C.ws + WS_HML), D}, a2{(const bf16*)(C.ws + WS_HRET), D}; BF_plain b1{C.w_bml}, b2{C.w_bret};
    EF_f32 e1{(float*)(C.ws + WS_TMP)}; EF_merge e2{(const float*)(C.ws + WS_TMP), (const bf16*)(C.ws + WS_GML), (const bf16*)(C.ws + WS_GRET), (bf16*)(C.ws + WS_H1)};
    const int nt = (T / 128) * 8;
    for (int u = C.bid; u < nt; u += C.G) { naive_gemm_tile(C, u / 8, u % 8, D, D, a1, b1, e1); naive_gemm_tile(C, u / 8, u % 8, D, D, a2, b2, e2); }
}
struct EF_resid { const float* x; const float* mod; float* x1;
    DI void put(int tm, int tn, int r, int c, const float (&v)[4]) const {
        const int row = tm * 128 + r, col = tn * 128 + c, b = row / SEQ; const size_t o = (size_t)row * D + col;
        const f32x4 xv = *(const f32x4*)(x + o), g = *(const f32x4*)(mod + b * 6144 + 2048 + col);
        *(f32x4*)(x1 + o) = xv + g * (f32x4){v[0], v[1], v[2], v[3]}; } };
DI void phase_outproj(Ctx& C) {
    AF_rows a{(const bf16*)(C.ws + WS_H1), D}; BF_plain b{C.w_out}; EF_resid e{C.x, (const float*)(C.ws + WS_MOD), (float*)(C.ws + WS_X1)};
    const int nt = (T / 128) * 8;
    for (int u = C.bid; u < nt; u += C.G) naive_gemm_tile(C, u / 8, u % 8, D, D, a, b, e);
}

DI void phase_norm2_route(Ctx& C) {
    LAS float* wr = (LAS float*)C.lds;
    LAS float* lg = wr + 32768;
    for (int i = C.tid; i < 32768 / 4; i += NTHR) *(LAS f32x4*)(wr + i * 4) = *(const f32x4*)(C.w_router + i * 4);
    __syncthreads();
    const float* mod = (const float*)(C.ws + WS_MOD); const float* X1 = (const float*)(C.ws + WS_X1);
    bf16* H2 = (bf16*)(C.ws + WS_H1);
    int* TOPI = (int*)(C.ws + WS_ROUTE + RT_TOPI); float* TOPW = (float*)(C.ws + WS_ROUTE + RT_TOPW); int* RANK = (int*)(C.ws + WS_ROUTE + RT_RANK);
    unsigned* CNT = (unsigned*)(C.ws + WS_CTL) + CW_CNT;
    const int lane = C.lane, gw = C.bid * NWAVES + C.wave, NGW = C.G * NWAVES;
    for (int m = gw; m < T; m += NGW) {
        const int b = m / SEQ;
        const f32x4* xr = (const f32x4*)(X1 + (size_t)m * D) + lane;
        f32x4 v[4]; float ss = 0.f;
#pragma unroll
        for (int j = 0; j < 4; ++j) { v[j] = xr[64 * j]; ss += (v[j].x * v[j].x + v[j].y * v[j].y) + (v[j].z * v[j].z + v[j].w * v[j].w); }
        const float rstd = 1.0f / sqrtf(wave_sum(ss) * (1.0f / D) + EPS);
        float acc[32];
#pragma unroll
        for (int e = 0; e < 32; ++e) acc[e] = 0.f;
        u32x2* o8 = (u32x2*)(H2 + (size_t)m * D) + lane;
#pragma unroll
        for (int j = 0; j < 4; ++j) {
            const int col = 4 * (lane + 64 * j);
            const f32x4 g = *(const f32x4*)(C.norm_ffn_g + col), sh = *(const f32x4*)(mod + b * 6144 + 3072 + col), sc = *(const f32x4*)(mod + b * 6144 + 4096 + col);
            const f32x4 h = (v[j] * rstd * g) * (sc + 1.0f) + sh;
            u32x2 w; w.x = pk2(h.x, h.y); w.y = pk2(h.z, h.w); o8[64 * j] = w;
            const float hh[4] = {h.x, h.y, h.z, h.w};
#pragma unroll
            for (int i = 0; i < 4; ++i) {
                const LAS f32x4* wp = (const LAS f32x4*)(wr + (col + i) * 32);
#pragma unroll
                for (int e4 = 0; e4 < 8; ++e4) { const f32x4 w4 = wp[e4]; acc[e4 * 4 + 0] += hh[i] * w4.x; acc[e4 * 4 + 1] += hh[i] * w4.y; acc[e4 * 4 + 2] += hh[i] * w4.z; acc[e4 * 4 + 3] += hh[i] * w4.w; }
                asm volatile("" ::: "memory");
            }
        }
#pragma unroll
        for (int e = 0; e < 32; ++e) acc[e] = wave_sum(acc[e]);
        float l[32];
#pragma unroll
        for (int e = 0; e < 32; ++e) l[e] = acc[e] + C.b_router[e];
        float tv[4]; int ti[4];
#pragma unroll
        for (int k = 0; k < 4; ++k) {
            float bvv = -3.0e38f; int bi = 0;
#pragma unroll
            for (int e = 0; e < 32; ++e) { const bool take = l[e] > bvv; bvv = take ? l[e] : bvv; bi = take ? e : bi; }
            tv[k] = bvv; ti[k] = bi;
#pragma unroll
            for (int e = 0; e < 32; ++e) l[e] = (e == bi) ? -3.0e38f : l[e];
        }
        const float e1 = __expf(tv[1] - tv[0]), e2 = __expf(tv[2] - tv[0]), e3 = __expf(tv[3] - tv[0]), inv = 1.0f / (1.0f + e1 + e2 + e3);
        if (lane < 4) {
            const int e = lane == 0 ? ti[0] : lane == 1 ? ti[1] : lane == 2 ? ti[2] : ti[3];
            const float w = (lane == 0 ? 1.0f : lane == 1 ? e1 : lane == 2 ? e2 : e3) * inv;
            TOPI[m * 4 + lane] = e; TOPW[m * 4 + lane] = w; RANK[m * 4 + lane] = (int)atomicAdd(CNT + e, 1u);
        }
    }
    (void)lg;
    int* SLOTTOK = (int*)(C.ws + WS_ROUTE + RT_SLOTTOK); float* SLOTW = (float*)(C.ws + WS_ROUTE + RT_SLOTW);
    for (int i = C.bid * NTHR + C.tid; i < NSLOTS; i += C.G * NTHR) { SLOTTOK[i] = T; SLOTW[i] = 0.f; }
    if (C.bid == 0) for (int i = C.tid; i < D / 2; i += NTHR) ((unsigned*)(H2 + (size_t)T * D))[i] = 0u;
    __syncthreads();
}

DI void phase_slots(Ctx& C) {
    LAS int* tot = (LAS int*)C.lds;
    LAS int* pstart = tot + 32;
    LAS int* base = pstart + 32;
    LAS int* part = base + 32;
    const unsigned* BLKCNT = (const unsigned*)(C.ws + WS_ROUTE + RT_BLKCNT);
    unsigned* ctl = (unsigned*)(C.ws + WS_CTL);
    const int* TOPI = (const int*)(C.ws + WS_ROUTE + RT_TOPI); const float* TOPW = (const float*)(C.ws + WS_ROUTE + RT_TOPW); const int* RANK = (const int*)(C.ws + WS_ROUTE + RT_RANK);
    int* ASLOT = (int*)(C.ws + WS_ROUTE + RT_ASLOT); int* SLOTTOK = (int*)(C.ws + WS_ROUTE + RT_SLOTTOK); float* SLOTW = (float*)(C.ws + WS_ROUTE + RT_SLOTW);
    for (int sg = C.bid; sg < T / 64; sg += C.G) {
        const int e = C.tid & 31, pt = C.tid >> 5;
        int sa = 0, sb = 0;
        for (int g2 = pt; g2 < T / 64; g2 += 16) { const int c = (int)BLKCNT[g2 * 32 + e]; sa += c; sb += (g2 < sg) ? c : 0; }
        part[(pt * 32 + e) * 2] = sa; part[(pt * 32 + e) * 2 + 1] = sb;
        __syncthreads();
        if (C.tid < 32) { int a = 0, b2 = 0; for (int p2 = 0; p2 < 16; ++p2) { a += part[(p2 * 32 + C.tid) * 2]; b2 += part[(p2 * 32 + C.tid) * 2 + 1]; } tot[C.tid] = a; base[C.tid] = b2; }
        __syncthreads();
        if (C.tid == 0) {
            int nb = 0;
            for (int e2 = 0; e2 < NE; ++e2) { pstart[e2] = nb * 256; const int bl = (tot[e2] + 255) >> 8;
                if (sg == 0) for (int i = 0; i < bl; ++i) ctl[CW_BLKE + nb + i] = (unsigned)e2;
                nb += bl; }
            if (sg == 0) ctl[CW_NBLK] = (unsigned)nb;
        }
        __syncthreads();
        if (C.tid < 256) { const int i = sg * 256 + C.tid, ex = TOPI[i];
            const int slot = pstart[ex] + base[ex] + RANK[i];
            ASLOT[i] = slot; SLOTTOK[slot] = i >> 2; SLOTW[slot] = TOPW[i]; }
        __syncthreads();
    }
}

struct AF_gather { const bf16* base; const int* slottok; DI const bf16* row(int tm, int r) const { return base + (size_t)slottok[tm * 128 + r] * D; } };
struct BF_expert { const float* w; const unsigned* blke; size_t estride; DI const float* ptr(int tm, int tn) const { return w + (size_t)blke[tm >> 1] * estride + tn * 128; } };
struct EF_swiglu { const float* bias; const unsigned* blke; bf16* act;
    DI void put(int tm, int tn, int r, int c, const float (&v)[4]) const {
        const int e = (int)blke[tm >> 1]; const float* bp = bias + (size_t)e * 2048 + tn * 128 + c;
        float o[2];
#pragma unroll
        for (int j = 0; j < 2; ++j) { const float xg = fminf(v[2 * j] + bp[2 * j], 7.0f), xl = fminf(fmaxf(v[2 * j + 1] + bp[2 * j + 1], -7.0f), 7.0f); o[j] = xg * sigmoidf_(1.702f * xg) * (xl + 1.0f); }
        *(unsigned*)(act + (size_t)(tm * 128 + r) * D + (tn * 128 + c) / 2) = pk2(o[0], o[1]); } };
DI void phase_gateup(Ctx& C) {
    const unsigned* ctl = (const unsigned*)(C.ws + WS_CTL); const int nblk = (int)ctl[CW_NBLK];
    AF_gather a{(const bf16*)(C.ws + WS_H1), (const int*)(C.ws + WS_ROUTE + RT_SLOTTOK)}; BF_expert b{C.w_gu, ctl + CW_BLKE, (size_t)D * 2048};
    EF_swiglu e{C.b_gu, ctl + CW_BLKE, (bf16*)(C.ws + WS_ACT)};
    const int nt = nblk * 2 * 16;
    for (int u = C.bid; u < nt; u += C.G) naive_gemm_tile(C, u / 16, u % 16, D, 2048, a, b, e);
}
struct EF_down { const float* bias; const unsigned* blke; const float* slotw; bf16* ys;
    DI void put(int tm, int tn, int r, int c, const float (&v)[4]) const {
        const int e = (int)blke[tm >> 1], slot = tm * 128 + r; const float w = slotw[slot]; const float* bp = bias + (size_t)e * D + tn * 128 + c;
        u32x2 o; o.x = pk2((v[0] + bp[0]) * w, (v[1] + bp[1]) * w); o.y = pk2((v[2] + bp[2]) * w, (v[3] + bp[3]) * w);
        *(u32x2*)(ys + (size_t)slot * D + tn * 128 + c) = o; } };
DI void phase_down(Ctx& C) {
    const unsigned* ctl = (const unsigned*)(C.ws + WS_CTL); const int nblk = (int)ctl[CW_NBLK];
    AF_rows a{(const bf16*)(C.ws + WS_ACT), D}; BF_expert b{C.w_dn, ctl + CW_BLKE, (size_t)D * D};
    EF_down e{C.b_dn, ctl + CW_BLKE, (const float*)(C.ws + WS_ROUTE + RT_SLOTW), (bf16*)(C.ws + WS_YS)};
    const int nt = nblk * 2 * 8;
    for (int u = C.bid; u < nt; u += C.G) naive_gemm_tile(C, u / 8, u % 8, D, D, a, b, e);
}
DI void phase_final(Ctx& C) {
    const float* mod = (const float*)(C.ws + WS_MOD); const float* X1 = (const float*)(C.ws + WS_X1); const bf16* YS = (const bf16*)(C.ws + WS_YS);
    const int* ASLOT = (const int*)(C.ws + WS_ROUTE + RT_ASLOT);
    const int lane = C.lane, gw = C.bid * NWAVES + C.wave, NGW = C.G * NWAVES;
    for (int m = gw; m < T; m += NGW) {
        const int b = m / SEQ;
        const int s0 = ASLOT[m * 4 + 0], s1 = ASLOT[m * 4 + 1], s2 = ASLOT[m * 4 + 2], s3 = ASLOT[m * 4 + 3];
        f32x4 v[4]; float ss = 0.f;
#pragma unroll
        for (int j = 0; j < 4; ++j) {
            const int col = 4 * (lane + 64 * j);
            f32x4 y = (f32x4){0.f, 0.f, 0.f, 0.f};
            const int sl[4] = {s0, s1, s2, s3};
#pragma unroll
            for (int k = 0; k < 4; ++k) { const u32x2 w = *(const u32x2*)(YS + (size_t)sl[k] * D + col);
                y += (f32x4){__uint_as_float(w.x << 16), __uint_as_float(w.x & 0xffff0000u), __uint_as_float(w.y << 16), __uint_as_float(w.y & 0xffff0000u)}; }
            const f32x4 g = *(const f32x4*)(mod + b * 6144 + 5120 + col);
            v[j] = *(const f32x4*)(X1 + (size_t)m * D + col) + g * y;
            ss += (v[j].x * v[j].x + v[j].y * v[j].y) + (v[j].z * v[j].z + v[j].w * v[j].w);
        }
        const float rstd = 1.0f / sqrtf(wave_sum(ss) * (1.0f / D) + EPS);
#pragma unroll
        for (int j = 0; j < 4; ++j) { const int col = 4 * (lane + 64 * j); *(f32x4*)(C.out + (size_t)m * D + col) = v[j] * rstd * *(const f32x4*)(C.norm_final_g + col); }
    }
}

namespace pg8 {
typedef short bf16x8 __attribute__((ext_vector_type(8)));
constexpr int BM = 256, BK = 64, HALF = 128, HTB = HALF * BK * 2, STAGE_BYTES = 8 * HTB, NXCD = 8, WGM = 8;
DI int lds_byte(int r, int c) { const int st = (r >> 4) * 2 + (c >> 5), rr = r & 15, cc = c & 31, ob = rr * 64 + cc * 2; return st * 1024 + (ob ^ (((ob >> 9) & 1) << 5)); }
DI void stage_rc(int b, int& R, int& C) { const int st = b / 1024, sb = b % 1024, swz = sb ^ (((sb >> 9) & 1) << 5); R = (st >> 1) * 16 + swz / 64; C = (st & 1) * 32 + (swz % 64) / 2; }
struct Unit { int pm, pn, aux; };
struct Gemm { const bf16* A; const bf16* Bt; int K; };
DI unsigned cvt_pk_bf16(float lo, float hi) { unsigned r; asm volatile("v_cvt_pk_bf16_f32 %0, %1, %2" : "=v"(r) : "v"(lo), "v"(hi)); return r; }

struct TileOrder {
    int nM, nN, nwg;
    DI void init(int nM_, int nN_) { nM = nM_; nN = nN_; nwg = nM * nN; }
    DI bool tile(long L, int& pm, int& pn) const {
        if (L >= nwg) return false;
        int wgid = (int)L; { const int q = nwg / NXCD, r = nwg % NXCD, xcd = wgid % NXCD, off = wgid / NXCD; wgid = (xcd < r ? xcd * (q + 1) : r * (q + 1) + (xcd - r) * q) + off; }
        const int nig = WGM * nN, gid = wgid / nig, fm = gid * WGM, gsz = (nM - fm) < WGM ? (nM - fm) : WGM;
        pm = fm + ((wgid % nig) % gsz); pn = (wgid % nig) / gsz; return true;
    }
};

template <class Epi, class Sched, bool ALIGN_EPI, bool SP2>
DI void gemm_phase(LAS unsigned char* lds, const Gemm g, const Sched& S, const Epi& E) {
    const int tid = threadIdx.x, wid = __builtin_amdgcn_readfirstlane(tid >> 6), lane = tid & 63, wr = wid >> 2, wc = wid & 3, fr = lane & 15, fq = lane >> 4;
    const int K = g.K, nt = K / BK;
    unsigned voffB[2]; int Rr[2]; unsigned cb[2];
#pragma unroll
    for (int i = 0; i < 2; ++i) { int R, C; stage_rc(tid * 16 + i * 8192, R, C); voffB[i] = (unsigned)(R * K + C) * 2u; Rr[i] = R; cb[i] = (unsigned)C * 2u; }
    const size_t kstep = (size_t)(BK * 2);
    const size_t hstep = (size_t)HALF * K * 2;
    const size_t tstep = 2 * hstep;
    const unsigned ldsw = (unsigned)wid * 1024u;
    const int aoff = lds_byte(wr * 64 + fr, fq * 8), boff = lds_byte(wc * 32 + fr, fq * 8);
    const unsigned rowb = (unsigned)K * 2u;
#define PG8_SA(b, h) (((b) * 2 + (h)) * HTB)
#define PG8_SB(b, h) ((4 + (b) * 2 + (h)) * HTB)
#define PG8_STAGE(bufoff, gbase, voff) do { _Pragma("unroll") for (int _i = 0; _i < 2; ++_i) \
        __builtin_amdgcn_global_load_lds((const unsigned*)((const char*)(gbase) + (voff)[_i]), (LAS unsigned*)(lds + (bufoff) + ldsw + _i * 8192), 16, 0, 0); } while (0)
#define PG8_LDA(dst, b, h) do { _Pragma("unroll") for (int m = 0; m < 4; ++m) _Pragma("unroll") for (int k = 0; k < 2; ++k) dst[m][k] = *(const LAS bf16x8*)(lds + PG8_SA(b, h) + aoff + m * 2048 + k * 1024); } while (0)
#define PG8_LDB(dst, b, h) do { _Pragma("unroll") for (int n = 0; n < 2; ++n) _Pragma("unroll") for (int k = 0; k < 2; ++k) dst[n][k] = *(const LAS bf16x8*)(lds + PG8_SB(b, h) + boff + n * 2048 + k * 1024); } while (0)
#define PG8_MMA(ai, bj, At, Bt) do { __builtin_amdgcn_s_setprio(1); _Pragma("unroll") for (int m = 0; m < 4; ++m) _Pragma("unroll") for (int n = 0; n < 2; ++n) _Pragma("unroll") for (int k = 0; k < 2; ++k) \
        acc[ai][bj][m][n] = __builtin_amdgcn_mfma_f32_16x16x32_bf16(Bt[n][k], At[m][k], acc[ai][bj][m][n], 0, 0, 0); __builtin_amdgcn_s_setprio(0); } while (0)
#define PG8_WAIT_V(n) asm volatile("s_waitcnt vmcnt(" #n ")" ::: "memory")
#define PG8_WAIT_L(n) asm volatile("s_waitcnt lgkmcnt(" #n ")" ::: "memory")
#define PG8_BAR __builtin_amdgcn_s_barrier()
#define PG8_SCHED __builtin_amdgcn_sched_barrier(0)
    Unit cur, nxt; int ui = 0;
    if (!S.next(0, cur)) return;
    f32x4 acc[2][2][4][2];
#pragma unroll
    for (int a = 0; a < 2; ++a)
#pragma unroll
        for (int b = 0; b < 2; ++b)
#pragma unroll
            for (int m = 0; m < 4; ++m)
#pragma unroll
                for (int n = 0; n < 2; ++n) acc[a][b][m][n] = (f32x4){0.f, 0.f, 0.f, 0.f};
    bf16x8 At[4][2], B0[2][2], B1[2][2];
    const char* Ab = (const char*)g.A;
    const char* cB = (const char*)g.Bt + (size_t)cur.pn * tstep;
    unsigned c0[2], c1[2], n0[2], n1[2];
#pragma unroll
    for (int i = 0; i < 2; ++i) { c0[i] = (unsigned)S.arow(cur, Rr[i]) * rowb + cb[i]; c1[i] = (unsigned)S.arow(cur, HALF + Rr[i]) * rowb + cb[i]; n0[i] = c0[i]; n1[i] = c1[i]; }
    if constexpr (SP2) {
        PG8_STAGE(PG8_SB(0, 0), cB, voffB); PG8_STAGE(PG8_SB(0, 1), cB + hstep, voffB); PG8_STAGE(PG8_SA(0, 0), Ab, c0); PG8_STAGE(PG8_SA(0, 1), Ab, c1);
        if (wr == 1) PG8_BAR;
        PG8_WAIT_V(2); PG8_BAR;
        PG8_STAGE(PG8_SB(1, 0), cB + kstep, voffB); PG8_STAGE(PG8_SA(1, 0), Ab + kstep, c0); PG8_STAGE(PG8_SB(1, 1), cB + hstep + kstep, voffB);
        PG8_WAIT_V(6); PG8_BAR;
    } else {
        PG8_STAGE(PG8_SB(0, 0), cB, voffB); PG8_STAGE(PG8_SA(0, 0), Ab, c0); PG8_STAGE(PG8_SB(0, 1), cB + hstep, voffB); PG8_STAGE(PG8_SA(0, 1), Ab, c1);
        if (wr == 1) PG8_BAR;
        PG8_WAIT_V(4); PG8_BAR;
        PG8_STAGE(PG8_SB(1, 0), cB + kstep, voffB); PG8_STAGE(PG8_SA(1, 0), Ab + kstep, c0); PG8_STAGE(PG8_SB(1, 1), cB + hstep + kstep, voffB);
        PG8_WAIT_V(6); PG8_BAR;
    }
    for (;;) {
        const bool has_next = S.next(ui + 1, nxt);
        const char* nB = has_next ? (const char*)g.Bt + (size_t)nxt.pn * tstep : cB;
        if (has_next) {
#pragma unroll
            for (int i = 0; i < 2; ++i) { n0[i] = (unsigned)S.arow(nxt, Rr[i]) * rowb + cb[i]; n1[i] = (unsigned)S.arow(nxt, HALF + Rr[i]) * rowb + cb[i]; }
        } else {
#pragma unroll
            for (int i = 0; i < 2; ++i) { n0[i] = c0[i]; n1[i] = c1[i]; }
        }
        for (int t = 0; t < nt; t += 2) {
            const bool last = (t == nt - 2);
            const char* a1 = Ab + (size_t)(t + 1) * kstep;
            const char* a2 = last ? Ab : Ab + (size_t)(t + 2) * kstep; const char* b2 = last ? nB : cB + (size_t)(t + 2) * kstep;
            const char* a3 = a2 + kstep; const char* b3 = b2 + kstep;
            unsigned x0[2], x1[2];
#pragma unroll
            for (int i = 0; i < 2; ++i) { x0[i] = last ? n0[i] : c0[i]; x1[i] = last ? n1[i] : c1[i]; }
            if constexpr (SP2) {
            PG8_LDB(B0, 0, 0); PG8_LDB(B1, 0, 1); PG8_SCHED; PG8_LDA(At, 0, 0); PG8_STAGE(PG8_SA(1, 1), a1, c1);
            PG8_WAIT_V(8); PG8_WAIT_L(0); PG8_BAR; PG8_MMA(0, 0, At, B0); PG8_MMA(0, 1, At, B1); PG8_BAR; PG8_SCHED;
            PG8_LDA(At, 0, 1); PG8_STAGE(PG8_SB(0, 0), b2, voffB); PG8_STAGE(PG8_SB(0, 1), b2 + hstep, voffB); PG8_STAGE(PG8_SA(0, 0), a2, x0);
            PG8_WAIT_V(8); PG8_WAIT_L(0); PG8_BAR; PG8_MMA(1, 0, At, B0); PG8_MMA(1, 1, At, B1); PG8_BAR; PG8_SCHED;
            PG8_LDB(B0, 1, 0); PG8_LDB(B1, 1, 1); PG8_SCHED; PG8_LDA(At, 1, 0); PG8_STAGE(PG8_SA(0, 1), a2, x1);
            PG8_WAIT_V(8); PG8_WAIT_L(0); PG8_BAR; PG8_MMA(0, 0, At, B0); PG8_MMA(0, 1, At, B1); PG8_BAR; PG8_SCHED;
            PG8_LDA(At, 1, 1); PG8_STAGE(PG8_SB(1, 0), b3, voffB); PG8_STAGE(PG8_SB(1, 1), b3 + hstep, voffB); PG8_STAGE(PG8_SA(1, 0), a3, x0);
            PG8_WAIT_V(8); PG8_WAIT_L(0); PG8_BAR; PG8_MMA(1, 0, At, B0); PG8_MMA(1, 1, At, B1); PG8_BAR; PG8_SCHED;
            } else {
            PG8_LDB(B0, 0, 0); PG8_SCHED; PG8_LDA(At, 0, 0); PG8_STAGE(PG8_SA(1, 1), a1, c1);
            PG8_WAIT_L(8); PG8_BAR; PG8_WAIT_L(0); PG8_MMA(0, 0, At, B0); PG8_BAR; PG8_SCHED;
            PG8_LDB(B1, 0, 1); PG8_STAGE(PG8_SB(0, 0), b2, voffB);
            PG8_BAR; PG8_WAIT_L(0); PG8_MMA(0, 1, At, B1); PG8_BAR;
            PG8_LDA(At, 0, 1); PG8_STAGE(PG8_SA(0, 0), a2, x0);
            PG8_BAR; PG8_WAIT_L(0); PG8_MMA(1, 0, At, B0); PG8_BAR; PG8_SCHED;
            PG8_STAGE(PG8_SB(0, 1), b2 + hstep, voffB);
            PG8_WAIT_V(6); PG8_BAR; PG8_MMA(1, 1, At, B1); PG8_BAR;
            PG8_LDB(B0, 1, 0); PG8_SCHED; PG8_LDA(At, 1, 0); PG8_STAGE(PG8_SA(0, 1), a2, x1);
            PG8_WAIT_L(8); PG8_BAR; PG8_WAIT_L(0); PG8_MMA(0, 0, At, B0); PG8_BAR; PG8_SCHED;
            PG8_LDB(B1, 1, 1); PG8_STAGE(PG8_SB(1, 0), b3, voffB);
            PG8_BAR; PG8_WAIT_L(0); PG8_MMA(0, 1, At, B1); PG8_BAR;
            PG8_LDA(At, 1, 1); PG8_STAGE(PG8_SA(1, 0), a3, x0);
            PG8_BAR; PG8_WAIT_L(0); PG8_MMA(1, 0, At, B0); PG8_BAR; PG8_SCHED;
            PG8_STAGE(PG8_SB(1, 1), b3 + hstep, voffB);
            PG8_WAIT_V(6); PG8_BAR; PG8_MMA(1, 1, At, B1); PG8_BAR;
            }
        }
        if constexpr (ALIGN_EPI) { if (wr == 0) PG8_BAR; }
        const bool keep = E(acc, cur, wr, wc, fr, fq);
        if (!has_next) break;
        if (!keep) {
#pragma unroll
            for (int a = 0; a < 2; ++a)
#pragma unroll
                for (int b = 0; b < 2; ++b)
#pragma unroll
                    for (int m = 0; m < 4; ++m)
#pragma unroll
                        for (int n = 0; n < 2; ++n) acc[a][b][m][n] = (f32x4){0.f, 0.f, 0.f, 0.f};
        }
        cur = nxt; cB = nB; ++ui;
#pragma unroll
        for (int i = 0; i < 2; ++i) { c0[i] = n0[i]; c1[i] = n1[i]; }
        if constexpr (ALIGN_EPI) { if (wr == 1) PG8_BAR; }
    }
    PG8_WAIT_V(0);
    if constexpr (!ALIGN_EPI) { if (wr == 0) PG8_BAR; }
    PG8_BAR;
#undef PG8_SA
#undef PG8_SB
#undef PG8_STAGE
#undef PG8_LDA
#undef PG8_LDB
#undef PG8_MMA
#undef PG8_WAIT_V
#undef PG8_WAIT_L
#undef PG8_BAR
#undef PG8_SCHED
}
}

DI int pos_bf8(int o) { const int o32 = o & 31; return (o & ~31) | (16 * ((o32 >> 2) & 1) + 4 * (o32 >> 3) + (o32 & 3)); }
DI int pos_rope(int o) { const int head = o >> 7, bj = (o >> 6) & 1, r = o & 63, w = r >> 5, fq = (r >> 3) & 3, n = (r >> 2) & 1, j = r & 3; return 128 * bj + 32 * (2 * head + w) + 16 * n + 4 * fq + j; }
DI int pos_swiglu(int o) { const int wc = o >> 6, fq = (o >> 4) & 3, bj = (o >> 3) & 1, n = (o >> 2) & 1, j = o & 3; return 128 * bj + 32 * wc + 16 * n + 4 * fq + j; }
DI void tr_load(const float* src, int ldw, int lane, float (&v)[32]) {
#pragma unroll
    for (int i = 0; i < 32; ++i) { const int kk = 2 * i + (lane >> 5); v[i] = src[(size_t)kk * ldw + (lane & 31)]; }
}
template <int PT  >
DI void tr_store(const float (&v)[32], int K, bf16* WT, int tile_row0, int o0  , int k0, LAS float* scr, int lane) {
#pragma unroll
    for (int i = 0; i < 32; ++i) { const int kk = 2 * i + (lane >> 5); scr[kk * 33 + (lane & 31)] = v[i]; }
    asm volatile("s_waitcnt lgkmcnt(0)" ::: "memory");
    const int c = lane & 7;
#pragma unroll
    for (int j = 0; j < 4; ++j) { const int n = (lane >> 3) + 8 * j; const LAS float* s = scr + (8 * c) * 33 + n;
        u32x4 o; o.x = pk2(s[0 * 33], s[1 * 33]); o.y = pk2(s[2 * 33], s[3 * 33]); o.z = pk2(s[4 * 33], s[5 * 33]); o.w = pk2(s[6 * 33], s[7 * 33]);
        const int oc = o0 + n; const int p = PT == 0 ? oc : PT == 1 ? pos_bf8(oc) : PT == 2 ? pos_rope(oc) : pos_swiglu(oc);
        *(u32x4*)(WT + (size_t)(tile_row0 + p) * K + k0 + 8 * c) = o; }
    asm volatile("s_waitcnt lgkmcnt(0)" ::: "memory");
}
template <int PT>
DI void tr_item(const float* src, int ldw, int K, bf16* WT, int tile_row0, int o0, int k0, LAS float* scr, int lane) {
    float v[32]; tr_load(src, ldw, lane, v); tr_store<PT>(v, K, WT, tile_row0, o0, k0, scr, lane);
}
DI void convert_small(Ctx& C) {
    LAS float* scr = (LAS float*)(C.lds + C.wave * 16384);
    const int gw = C.bid * NWAVES + C.wave, NGW = C.G * NWAVES, lane = C.lane;
    bf16* WT_IN = (bf16*)(C.ws + WS_WT_IN); bf16* WT_BR = (bf16*)(C.ws + WS_WT_BR); bf16* WT_OUT = (bf16*)(C.ws + WS_WT_OUT);
    constexpr int I_IN = 16 * 256, I_SQ = 16 * 32;
    constexpr int NITEMS = I_IN + 3 * I_SQ;
    for (int it = gw; it < NITEMS; it += NGW) {
        int r = it;
        if (r < I_IN) { const int kb = r >> 8, nb = r & 255, n0 = nb * 32, sc = n0 < 3072 ? n0 : n0 + 8, tile = n0 >> 8;
            const float* src = C.w_in + (size_t)(kb * 64) * DIN + sc;
            if (tile >= 12 && tile < 16) tr_item<2>(src, DIN, D, WT_IN, tile * 256, n0 & 255, kb * 64, scr, lane); else tr_item<1>(src, DIN, D, WT_IN, tile * 256, n0 & 255, kb * 64, scr, lane);
            continue; } r -= I_IN;
        if (r < 2 * I_SQ) { const int which = r >> 9, q = r & 511, kb = q >> 5, nb = q & 31, n0 = nb * 32;
            const float* src = (which ? C.w_bret : C.w_bml) + (size_t)(kb * 64) * D + n0;
            tr_item<1>(src, D, D, WT_BR, which * 1024 + (n0 & ~255), n0 & 255, kb * 64, scr, lane); continue; } r -= 2 * I_SQ;
        { const int kb = r >> 5, nb = r & 31, n0 = nb * 32;
            tr_item<0>(C.w_out + (size_t)(kb * 64) * D + n0, D, D, WT_OUT, n0 & ~255, n0 & 255, kb * 64, scr, lane); }
    }
}
struct MoeItem { const float* src; bf16* wt; int ldw, row0, o0, k0, pt; };
DI MoeItem moe_item(const Ctx& C, int r) {
    constexpr int I_GU = 32 * 16 * 64;
    MoeItem m;
    if (r < I_GU) { const int e = r >> 10, q = r & 1023, kb = q >> 6, nb = q & 63, n0 = nb * 32;
        m.src = C.w_gu + (size_t)e * D * 2048 + (size_t)(kb * 64) * 2048 + n0; m.ldw = 2048; m.wt = (bf16*)(C.ws + WS_WT_GU); m.row0 = e * 2048 + (n0 & ~255); m.o0 = n0 & 255; m.k0 = kb * 64; m.pt = 3; }
    else { r -= I_GU; const int e = r >> 9, q = r & 511, kb = q >> 5, nb = q & 31, n0 = nb * 32;
        m.src = C.w_dn + (size_t)e * D * D + (size_t)(kb * 64) * D + n0; m.ldw = D; m.wt = (bf16*)(C.ws + WS_WT_DN); m.row0 = e * 1024 + (n0 & ~255); m.o0 = n0 & 255; m.k0 = kb * 64; m.pt = 1; }
    return m;
}
DI void convert_moe(Ctx& C, int i0, int i1) {
    LAS float* scr = (LAS float*)(C.lds + C.wave * 16384);
    const int gw = C.bid * NWAVES + C.wave, NGW = C.G * NWAVES, lane = C.lane;
    constexpr int NIT = 32 * 16 * 64 + 32 * 16 * 32;
    for (int i = i0; i < i1; i += 2) {
        const int ra = gw + NGW * i, rb = gw + NGW * (i + 1);
        const bool hb = (i + 1 < i1) && rb < NIT;
        if (ra >= NIT) break;
        const MoeItem A = moe_item(C, ra), B = moe_item(C, hb ? rb : ra);
        float va[32], vb[32];
        tr_load(A.src, A.ldw, lane, va);
        if (hb) tr_load(B.src, B.ldw, lane, vb);
        if (A.pt == 3) tr_store<3>(va, D, A.wt, A.row0, A.o0, A.k0, scr, lane); else tr_store<1>(va, D, A.wt, A.row0, A.o0, A.k0, scr, lane);
        if (hb) { if (B.pt == 3) tr_store<3>(vb, D, B.wt, B.row0, B.o0, B.k0, scr, lane); else tr_store<1>(vb, D, B.wt, B.row0, B.o0, B.k0, scr, lane); }
    }
}
constexpr int MOE_CONV_ITEMS = 32 * 16 * 64 + 32 * 16 * 32;

struct SchedDense { pg8::TileOrder o; int G, c;
    DI bool next(int i, pg8::Unit& u) const { int pm, pn; if (!o.tile((long)i * G + c, pm, pn)) return false; u.pm = pm; u.pn = pn; u.aux = 0; return true; }
    DI int arow(const pg8::Unit& u, int r) const { return u.pm * 256 + r; } };
DI u32x4 pack8v(const f32x4 a, const f32x4 b) { u32x4 w; w.x = pg8::cvt_pk_bf16(a.x, a.y); w.y = pg8::cvt_pk_bf16(a.z, a.w); w.z = pg8::cvt_pk_bf16(b.x, b.y); w.w = pg8::cvt_pk_bf16(b.z, b.w); return w; }
DI f32x4 sig4(const f32x4 v) { return (f32x4){sigmoidf_(v.x), sigmoidf_(v.y), sigmoidf_(v.z), sigmoidf_(v.w)}; }
DI f32x4 silu4(const f32x4 v) { return (f32x4){siluf_(v.x), siluf_(v.y), siluf_(v.z), siluf_(v.w)}; }
DI void unpack8v(const u32x4 w, f32x4& a, f32x4& b) { a = (f32x4){__uint_as_float(w.x << 16), __uint_as_float(w.x & 0xffff0000u), __uint_as_float(w.y << 16), __uint_as_float(w.y & 0xffff0000u)};
    b = (f32x4){__uint_as_float(w.z << 16), __uint_as_float(w.z & 0xffff0000u), __uint_as_float(w.w << 16), __uint_as_float(w.w & 0xffff0000u)}; }

struct EpiInproj { unsigned char* ws;
    DI bool operator()(f32x4 (&acc)[2][2][4][2], const pg8::Unit& u, int wr, int wc, int fr, int fq) const {
        const int seg = u.pn >> 2, row0 = u.pm * 256 + wr * 64 + fr;
        if (seg == 3) {
            const int which = (u.pn >> 1) & 1, head = 2 * (u.pn & 1) + (wc >> 1), i0 = 32 * (wc & 1) + 8 * fq;
            bf16* dst = (bf16*)(ws + (which ? WS_RETK : WS_RETQ)); const float sc = which ? 0.08838834764831845f : 1.0f;
            const float* COS = (const float*)(ws + WS_COS); const float* SIN = (const float*)(ws + WS_SIN);
#pragma unroll
            for (int ai = 0; ai < 2; ++ai)
#pragma unroll
                for (int m = 0; m < 4; ++m) { const int row = row0 + ai * 128 + m * 16;
                    const f32x4 c0 = *(const f32x4*)(COS + (size_t)row * 64 + i0) * sc, c1 = *(const f32x4*)(COS + (size_t)row * 64 + i0 + 4) * sc;
                    const f32x4 s0 = *(const f32x4*)(SIN + (size_t)row * 64 + i0) * sc, s1 = *(const f32x4*)(SIN + (size_t)row * 64 + i0 + 4) * sc;
                    const f32x4 x1a = acc[ai][0][m][0], x1b = acc[ai][0][m][1], x2a = acc[ai][1][m][0], x2b = acc[ai][1][m][1];
                    bf16* rp = dst + (size_t)row * 512 + head * 128 + i0;
                    *(u32x4*)rp = pack8v(x1a * c0 - x2a * s0, x1b * c1 - x2b * s1);
                    *(u32x4*)(rp + 64) = pack8v(x2a * c0 + x1a * s0, x2b * c1 + x1b * s1);
                    asm volatile("" ::: "memory"); }
            return false;
        }
        bf16* dst; int act = 0;
        switch (seg) { case 0: dst = (bf16*)(ws + WS_QKRAW); break; case 1: dst = (bf16*)(ws + WS_MLV); break; case 2: dst = (bf16*)(ws + WS_MLO); act = 1; break;
            case 4: dst = (bf16*)(ws + WS_RETV); break; case 5: dst = (bf16*)(ws + WS_RETG); act = 2; break; case 6: dst = (bf16*)(ws + WS_GML); act = 1; break; default: dst = (bf16*)(ws + WS_GRET); act = 1; break; }
        const int col0 = (u.pn & 3) * 256 + wc * 32 + 8 * fq;
#pragma unroll
        for (int ai = 0; ai < 2; ++ai)
#pragma unroll
            for (int m = 0; m < 4; ++m) { bf16* rp = dst + (size_t)(row0 + ai * 128 + m * 16) * D + col0;
#pragma unroll
                for (int bj = 0; bj < 2; ++bj) { f32x4 v0 = acc[ai][bj][m][0], v1 = acc[ai][bj][m][1];
                    if (act == 1) { v0 = sig4(v0); v1 = sig4(v1); } else if (act == 2) { v0 = silu4(v0); v1 = silu4(v1); }
                    *(u32x4*)(rp + bj * 128) = pack8v(v0, v1); } }
        return false;
    } };
DI void phase_inproj_mfma(Ctx& C) {
    pg8::Gemm g{(const bf16*)(C.ws + WS_H1), (const bf16*)(C.ws + WS_WT_IN), D};
    SchedDense S; S.o.init(T / 256, 32); S.G = C.G; S.c = C.bid;
    EpiInproj E{C.ws};
    const int rounds = (MOE_CONV_ITEMS + C.G * NWAVES - 1) / (C.G * NWAVES), cls = (C.bid >> 3) & 7, npre = (rounds * cls) / 7;
    convert_moe(C, 0, npre);
    __syncthreads();
    pg8::gemm_phase<EpiInproj, SchedDense, true, true>(C.lds, g, S, E);
    convert_moe(C, npre, rounds);
}

struct SchedBranch { pg8::TileOrder o; int G, c;
    DI bool next(int i, pg8::Unit& u) const { int pm, pn; if (!o.tile((long)(i >> 1) * G + c, pm, pn)) return false; const int seg = i & 1; u.pm = seg * 64 + pm; u.pn = seg * 4 + pn; u.aux = seg; return true; }
    DI int arow(const pg8::Unit& u, int r) const { return u.pm * 256 + r; } };
struct EpiBranch { const bf16* g1; const bf16* g2; bf16* y;
    DI bool operator()(f32x4 (&acc)[2][2][4][2], const pg8::Unit& u, int wr, int wc, int fr, int fq) const {
        const int seg = u.aux, row0 = (u.pm & 63) * 256 + wr * 64 + fr, col0 = (u.pn & 3) * 256 + wc * 32 + 8 * fq;
#pragma unroll
        for (int ai = 0; ai < 2; ++ai)
#pragma unroll
            for (int m = 0; m < 4; ++m) { const size_t o = (size_t)(row0 + ai * 128 + m * 16) * D + col0;
#pragma unroll
                for (int bj = 0; bj < 2; ++bj) {
                    f32x4 b0, b1; unpack8v(*(const u32x4*)(g2 + o + bj * 128), b0, b1);
                    if (seg == 0) { f32x4 a0, a1; unpack8v(*(const u32x4*)(g1 + o + bj * 128), a0, a1);
#pragma unroll
                        for (int j = 0; j < 4; ++j) { acc[ai][bj][m][0][j] *= a0[j] / fmaxf(b0[j], 1e-12f); acc[ai][bj][m][1][j] *= a1[j] / fmaxf(b1[j], 1e-12f); }
                    } else *(u32x4*)(y + o + bj * 128) = pack8v(acc[ai][bj][m][0] * b0, acc[ai][bj][m][1] * b1);
                }
                asm volatile("" ::: "memory"); }
        return seg == 0;
    } };
DI void phase_branch_mfma(Ctx& C) {
    pg8::Gemm g{(const bf16*)(C.ws + WS_HML), (const bf16*)(C.ws + WS_WT_BR), D};
    SchedBranch S; S.o.init(T / 256, 4); S.G = C.G; S.c = C.bid;
    EpiBranch E{(const bf16*)(C.ws + WS_GML), (const bf16*)(C.ws + WS_GRET), (bf16*)(C.ws + WS_H1)};
    pg8::gemm_phase<EpiBranch, SchedBranch, true, true>(C.lds, g, S, E);
}
struct EpiOut { const float* x; const float* mod; float* x1;
    DI bool operator()(f32x4 (&acc)[2][2][4][2], const pg8::Unit& u, int wr, int wc, int fr, int fq) const {
        const int row0 = u.pm * 256 + wr * 64 + fr, col0 = u.pn * 256 + wc * 32 + 4 * fq; const int b = (u.pm * 256) / SEQ;
        f32x4 gv[2][2];
#pragma unroll
        for (int bj = 0; bj < 2; ++bj)
#pragma unroll
            for (int n = 0; n < 2; ++n) gv[bj][n] = *(const f32x4*)(mod + b * 6144 + 2048 + col0 + bj * 128 + n * 16);
#pragma unroll
        for (int ai = 0; ai < 2; ++ai)
#pragma unroll
            for (int m = 0; m < 4; ++m) { const size_t o = (size_t)(row0 + ai * 128 + m * 16) * D + col0;
#pragma unroll
                for (int bj = 0; bj < 2; ++bj)
#pragma unroll
                    for (int n = 0; n < 2; ++n) *(f32x4*)(x1 + o + bj * 128 + n * 16) = *(const f32x4*)(x + o + bj * 128 + n * 16) + gv[bj][n] * acc[ai][bj][m][n];
                asm volatile("" ::: "memory"); }
        return false;
    } };
DI void phase_outproj_mfma(Ctx& C) {
    pg8::Gemm g{(const bf16*)(C.ws + WS_H1), (const bf16*)(C.ws + WS_WT_OUT), D};
    SchedDense S; S.o.init(T / 256, 4); S.G = C.G; S.c = C.bid;
    EpiOut E{C.x, (const float*)(C.ws + WS_MOD), (float*)(C.ws + WS_X1)};
    pg8::gemm_phase<EpiOut, SchedDense, false, true>(C.lds, g, S, E);
}
struct SchedMoe { const unsigned* blke; const int* slottok; int nunits, ntn, G, c;
    DI bool next(int i, pg8::Unit& u) const { const long L = (long)i * G + c; if (L >= nunits) return false; const int bi = (int)(L / ntn), pn = (int)(L % ntn);
        const int e = (int)__builtin_amdgcn_readfirstlane((int)blke[bi]); u.pm = bi; u.pn = e * ntn + pn; u.aux = e | (pn << 8); return true; }
    DI int arow(const pg8::Unit& u, int r) const { return slottok ? slottok[u.pm * 256 + r] : u.pm * 256 + r; } };
struct EpiSwiglu { const float* bias; bf16* act;
    DI bool operator()(f32x4 (&acc)[2][2][4][2], const pg8::Unit& u, int wr, int wc, int fr, int fq) const {
        const int e = u.aux & 255, pn = u.aux >> 8, slot0 = u.pm * 256 + wr * 64 + fr;
        const float* bp = bias + (size_t)e * 2048 + pn * 256 + 64 * wc + 16 * fq;
        f32x4 bv[2][2];
#pragma unroll
        for (int bj = 0; bj < 2; ++bj)
#pragma unroll
            for (int n = 0; n < 2; ++n) bv[bj][n] = *(const f32x4*)(bp + 8 * bj + 4 * n);
#pragma unroll
        for (int ai = 0; ai < 2; ++ai)
#pragma unroll
            for (int m = 0; m < 4; ++m) { float o[8];
#pragma unroll
                for (int bj = 0; bj < 2; ++bj)
#pragma unroll
                    for (int n = 0; n < 2; ++n) { const f32x4 v = acc[ai][bj][m][n] + bv[bj][n];
#pragma unroll
                        for (int p = 0; p < 2; ++p) { const float xg = fminf(v[2 * p], 7.0f), xl = fminf(fmaxf(v[2 * p + 1], -7.0f), 7.0f); o[4 * bj + 2 * n + p] = xg * sigmoidf_(1.702f * xg) * (xl + 1.0f); } }
                u32x4 w; w.x = pg8::cvt_pk_bf16(o[0], o[1]); w.y = pg8::cvt_pk_bf16(o[2], o[3]); w.z = pg8::cvt_pk_bf16(o[4], o[5]); w.w = pg8::cvt_pk_bf16(o[6], o[7]);
                *(u32x4*)(act + (size_t)(slot0 + ai * 128 + m * 16) * D + pn * 128 + 32 * wc + 8 * fq) = w; }
        return false;
    } };
struct EpiDown { const float* bias; const float* slotw; bf16* ys;
    DI bool operator()(f32x4 (&acc)[2][2][4][2], const pg8::Unit& u, int wr, int wc, int fr, int fq) const {
        const int e = u.aux & 255, pn = u.aux >> 8, slot0 = u.pm * 256 + wr * 64 + fr, col0 = pn * 256 + wc * 32 + 8 * fq;
        f32x4 bv[2][2];
#pragma unroll
        for (int bj = 0; bj < 2; ++bj)
#pragma unroll
            for (int n = 0; n < 2; ++n) bv[bj][n] = *(const f32x4*)(bias + (size_t)e * D + col0 + bj * 128 + 4 * n);
#pragma unroll
        for (int ai = 0; ai < 2; ++ai)
#pragma unroll
            for (int m = 0; m < 4; ++m) { const int slot = slot0 + ai * 128 + m * 16; const float w = slotw[slot];
#pragma unroll
                for (int bj = 0; bj < 2; ++bj) *(u32x4*)(ys + (size_t)slot * D + col0 + bj * 128) = pack8v((acc[ai][bj][m][0] + bv[bj][0]) * w, (acc[ai][bj][m][1] + bv[bj][1]) * w); }
        return false;
    } };
DI void phase_gateup_mfma(Ctx& C) {
    unsigned* ctl = (unsigned*)(C.ws + WS_CTL); const int nblk = (int)__builtin_amdgcn_readfirstlane((int)__hip_atomic_load(ctl + CW_NBLK, __ATOMIC_RELAXED, __HIP_MEMORY_SCOPE_AGENT));
    pg8::Gemm g{(const bf16*)(C.ws + WS_H1), (const bf16*)(C.ws + WS_WT_GU), D};
    SchedMoe S{ctl + CW_BLKE, (const int*)(C.ws + WS_ROUTE + RT_SLOTTOK), nblk * 8, 8, C.G, C.bid};
    EpiSwiglu E{C.b_gu, (bf16*)(C.ws + WS_ACT)};
    pg8::gemm_phase<EpiSwiglu, SchedMoe, true, true>(C.lds, g, S, E);
}
DI void phase_down_mfma(Ctx& C) {
    unsigned* ctl = (unsigned*)(C.ws + WS_CTL); const int nblk = (int)__builtin_amdgcn_readfirstlane((int)__hip_atomic_load(ctl + CW_NBLK, __ATOMIC_RELAXED, __HIP_MEMORY_SCOPE_AGENT));
    pg8::Gemm g{(const bf16*)(C.ws + WS_ACT), (const bf16*)(C.ws + WS_WT_DN), D};
    SchedMoe S{ctl + CW_BLKE, nullptr, nblk * 4, 4, C.G, C.bid};
    EpiDown E{C.b_dn, (const float*)(C.ws + WS_ROUTE + RT_SLOTW), (bf16*)(C.ws + WS_YS)};
    pg8::gemm_phase<EpiDown, SchedMoe, true, true>(C.lds, g, S, E);
}

typedef short s16x4 __attribute__((ext_vector_type(4)));
typedef short bf16x8 __attribute__((ext_vector_type(8)));
DI unsigned off_b(unsigned row, unsigned ch) { return 256u * row + 16u * (ch ^ (((row & 3u) << 2) | ((row >> 2) & 3u))); }
DI s16x4 tr_read(LAS unsigned char* p) { return __builtin_amdgcn_ds_read_tr16_b64_v4i16((LAS s16x4*)p); }
DI bf16x8 cat8(const s16x4 lo, const s16x4 hi) { return __builtin_shufflevector(lo, hi, 0, 1, 2, 3, 4, 5, 6, 7); }
DI bf16x8 row_read(LAS unsigned char* img, unsigned row, unsigned ch) { return *(const LAS bf16x8*)(img + off_b(row, ch)); }
#define MFMA16(a, b, c) __builtin_amdgcn_mfma_f32_16x16x32_bf16((a), (b), (c), 0, 0, 0)
DI void fill_image(LAS unsigned char* img, const bf16* src, int ld, int nrows, int tid) {
    for (int e = tid; e < nrows * 16; e += NTHR) { const int row = e >> 4, ch = e & 15; *(LAS u32x4*)(img + off_b(row, ch)) = *(const u32x4*)(src + (size_t)row * ld + ch * 8); }
}

DI void phase_local_mfma(Ctx& C) {
    LAS unsigned char* Kimg = C.lds; LAS unsigned char* Vimg = C.lds + 32768;
    LAS float* lf = (LAS float*)(C.lds + 98304); LAS float* bvl = lf + 128; LAS float* wsv = bvl + 128; LAS float* nl = wsv + 128;
    const float* IFG = (const float*)(C.ws + WS_IFG);
    bf16* CLOC = (bf16*)(C.ws + WS_CLOC);
    float* NLOC = (float*)(C.ws + WS_SMALL + SM_NLOC); float* MLOC = (float*)(C.ws + WS_SMALL + SM_MLOC); float* ACH = (float*)(C.ws + WS_SMALL + SM_ACH);
    float* AG = (float*)(C.ws + WS_SMALL + SM_AG); float* CMG = (float*)(C.ws + WS_SMALL + SM_CMG);
    const int t = C.tid, lane = C.lane, w = C.wave, g = lane >> 4, q = (lane & 15) >> 2, p = lane & 3;
    for (int u = C.bid; u < 1024; u += C.G) {
        const int mixer = u >> 9, bh = (u >> 5) & 15, ch = u & 31, b = bh >> 2, h = bh & 3, t0 = b * SEQ + ch * CH;
        const bf16 *Kp, *Vp; int ldk;
        if (mixer == 0) {
            float iv = 0.f;
            if (t < 128) { lf[t] = logsigmoidf_(IFG[(size_t)(t0 + t) * 8 + 4 + h]); iv = IFG[(size_t)(t0 + t) * 8 + h]; nl[t] = 0.f; }
            __syncthreads();
            if (t < 128) { float s = 0.f; for (int j = 0; j <= t; ++j) s += lf[j]; bvl[t] = iv - s; AG[bh * SEQ + ch * CH + t] = s; if (t == 127) wsv[0] = s; }
            __syncthreads();
            float gm = -3.0e38f, cm = -3.0e38f; const float Aall = wsv[0];
            if (t < 128) { for (int j = 0; j < 128; ++j) { const float x = bvl[j]; gm = fmaxf(gm, x); cm = (j <= t) ? fmaxf(cm, x) : cm; } CMG[bh * SEQ + ch * CH + t] = cm; }
            __syncthreads();
            if (t < 128) wsv[t] = __expf(bvl[t] - gm);
            if (t == 0) { MLOC[bh * 32 + ch] = Aall + gm; ACH[bh * 32 + ch] = Aall; }
            Kp = (const bf16*)(C.ws + WS_QC) + (size_t)t0 * D + 512 + h * 128; ldk = D;
            Vp = (const bf16*)(C.ws + WS_MLV) + (size_t)t0 * D + h * 256;
        } else {
            const float lg = ret_lg(h);
            if (t < 128) wsv[t] = __expf(lg * (float)(127 - t));
            Kp = (const bf16*)(C.ws + WS_RETK) + (size_t)t0 * 512 + h * 128; ldk = 512;
            Vp = (const bf16*)(C.ws + WS_RETV) + (size_t)t0 * D + h * 256;
        }
        __syncthreads();
        if (mixer == 0) {
            const int c32 = t & 31, run = t >> 5, isk = c32 >> 4, chk = c32 & 15;
            const int col = isk * 512 + h * 128 + 8 * chk;
            const bf16* raw = (const bf16*)(C.ws + WS_QKRAW) + (size_t)t0 * D + col;
            bf16* qc = (bf16*)(C.ws + WS_QC) + (size_t)t0 * D + col;
            u32x4 rv[11];
#pragma unroll
            for (int i = 0; i < 11; ++i) { const int rr = 8 * run - 3 + i; rv[i] = (ch * CH + rr >= 0) ? *(const u32x4*)(raw + (ptrdiff_t)rr * D) : (u32x4){0u, 0u, 0u, 0u}; }
            float wgt[4][8], bias[8];
#pragma unroll
            for (int j = 0; j < 4; ++j) { const f32x4 a = *(const f32x4*)(C.conv_w + j * D + col), b2 = *(const f32x4*)(C.conv_w + j * D + col + 4);
                wgt[j][0] = a.x; wgt[j][1] = a.y; wgt[j][2] = a.z; wgt[j][3] = a.w; wgt[j][4] = b2.x; wgt[j][5] = b2.y; wgt[j][6] = b2.z; wgt[j][7] = b2.w; }
            { const f32x4 a = *(const f32x4*)(C.conv_b + col), b2 = *(const f32x4*)(C.conv_b + col + 4); bias[0] = a.x; bias[1] = a.y; bias[2] = a.z; bias[3] = a.w; bias[4] = b2.x; bias[5] = b2.y; bias[6] = b2.z; bias[7] = b2.w; }
            float ns[8];
#pragma unroll
            for (int e = 0; e < 8; ++e) ns[e] = 0.f;
            const float qsc = isk ? 1.0f : 0.08838834764831845f;
#pragma unroll
            for (int rr = 0; rr < 8; ++rr) {
                float o[8];
#pragma unroll
                for (int e = 0; e < 8; ++e) o[e] = bias[e];
#pragma unroll
                for (int j = 0; j < 4; ++j) { float f[8]; unpack8(rv[rr + j], f);
#pragma unroll
                    for (int e = 0; e < 8; ++e) o[e] += f[e] * wgt[j][e]; }
#pragma unroll
                for (int e = 0; e < 8; ++e) o[e] = siluf_(o[e]) * qsc;
                const u32x4 pk = pack8(o);
                *(u32x4*)(qc + (size_t)(8 * run + rr) * D) = pk;
                if (isk) { const int row = 8 * run + rr; float f[8]; unpack8(pk, f); const float wv = wsv[row];
#pragma unroll
                    for (int e = 0; e < 8; ++e) { f[e] *= wv; ns[e] += f[e]; }
                    *(LAS u32x4*)(Kimg + off_b(row, chk)) = pack8(f); }
            }
            if (isk) {
#pragma unroll
                for (int e = 0; e < 8; ++e) atomicAdd((float*)(nl + chk * 8 + e), ns[e]);
            }
        } else {
            const int chk = t & 15;
#pragma unroll
            for (int i = 0; i < 4; ++i) { const int row = (t >> 4) + 32 * i; float f[8]; unpack8(*(const u32x4*)(Kp + (size_t)row * ldk + chk * 8), f); const float wv = wsv[row];
#pragma unroll
                for (int e = 0; e < 8; ++e) f[e] *= wv;
                *(LAS u32x4*)(Kimg + off_b(row, chk)) = pack8(f); }
        }
        fill_image(Vimg, Vp, D, 128, t); fill_image(Vimg + 32768, Vp + 128, D, 128, t);
        __syncthreads();
        const int kh = w & 1, vq = w >> 1;
        f32x4 acc[2][2][4];
#pragma unroll
        for (int a = 0; a < 2; ++a)
#pragma unroll
            for (int x = 0; x < 2; ++x)
#pragma unroll
                for (int c = 0; c < 4; ++c) acc[a][x][c] = (f32x4){0.f, 0.f, 0.f, 0.f};
        unsigned ba[2][2], bb[4][2];
#pragma unroll
        for (int ul = 0; ul < 2; ++ul)
#pragma unroll
            for (int tt = 0; tt < 2; ++tt) ba[ul][tt] = off_b(8 * g + q + 4 * tt, 4 * (2 * kh + ul) + p);
#pragma unroll
        for (int cl = 0; cl < 4; ++cl)
#pragma unroll
            for (int tt = 0; tt < 2; ++tt) { const int c = 4 * vq + cl; bb[cl][tt] = 32768 + (c >> 3) * 32768 + off_b(8 * g + q + 4 * tt, 2 * (c & 7) + (p >> 1)) + 8 * (p & 1); }
#pragma unroll
        for (int ks = 0; ks < 4; ++ks) {
            bf16x8 af[2][2], bfr[4];
#pragma unroll
            for (int ul = 0; ul < 2; ++ul)
#pragma unroll
                for (int x = 0; x < 2; ++x) af[ul][x] = cat8(tr_read(C.lds + ba[ul][0] + (8192 * ks + 8 * x)), tr_read(C.lds + ba[ul][1] + (8192 * ks + 8 * x)));
#pragma unroll
            for (int cl = 0; cl < 4; ++cl) bfr[cl] = cat8(tr_read(C.lds + bb[cl][0] + 8192 * ks), tr_read(C.lds + bb[cl][1] + 8192 * ks));
#pragma unroll
            for (int ul = 0; ul < 2; ++ul)
#pragma unroll
                for (int x = 0; x < 2; ++x)
#pragma unroll
                    for (int cl = 0; cl < 4; ++cl) acc[ul][x][cl] = MFMA16(af[ul][x], bfr[cl], acc[ul][x][cl]);
            asm volatile("" ::: "memory");
        }
        bf16* cl_ = CLOC + ((size_t)(mixer * 16 + bh) * 32 + ch) * 32768;
#pragma unroll
        for (int ul = 0; ul < 2; ++ul)
#pragma unroll
            for (int cl = 0; cl < 4; ++cl) { const int v = 16 * (4 * vq + cl) + (lane & 15), k0 = 32 * (2 * kh + ul) + 8 * g;
                u32x4 o; o.x = pk2(acc[ul][0][cl][0], acc[ul][0][cl][1]); o.y = pk2(acc[ul][0][cl][2], acc[ul][0][cl][3]); o.z = pk2(acc[ul][1][cl][0], acc[ul][1][cl][1]); o.w = pk2(acc[ul][1][cl][2], acc[ul][1][cl][3]);
                *(u32x4*)(cl_ + (size_t)v * 128 + k0) = o; }
        if (mixer == 0 && t < 128) NLOC[(bh * 32 + ch) * 128 + t] = nl[t];
        __syncthreads();
    }
}

struct OutUnit { const bf16 *Qp, *Kp, *Vp, *cp; int ldq, mixer, bh, ch, h, t0; };
DI OutUnit out_unit(const Ctx& C, int u) {
    OutUnit U; U.mixer = u >> 9; U.bh = (u >> 5) & 15; U.ch = u & 31; const int b = U.bh >> 2; U.h = U.bh & 3; U.t0 = b * SEQ + U.ch * CH;
    U.cp = (const bf16*)(C.ws + WS_CPREV) + ((size_t)(U.mixer * 16 + U.bh) * 32 + U.ch) * 32768;
    if (U.mixer == 0) { U.Qp = (const bf16*)(C.ws + WS_QC) + (size_t)U.t0 * D + U.h * 128; U.Kp = U.Qp + 512; U.ldq = D; U.Vp = (const bf16*)(C.ws + WS_MLV) + (size_t)U.t0 * D + U.h * 256; }
    else { U.Qp = (const bf16*)(C.ws + WS_RETQ) + (size_t)U.t0 * 512 + U.h * 128; U.Kp = (const bf16*)(C.ws + WS_RETK) + (size_t)U.t0 * 512 + U.h * 128; U.ldq = 512; U.Vp = (const bf16*)(C.ws + WS_RETV) + (size_t)U.t0 * D + U.h * 256; }
    return U;
}
DI void phase_out_mfma(Ctx& C) {
    LAS unsigned char* Qimg = C.lds; LAS unsigned char* Kimg = C.lds + 32768; LAS unsigned char* R1 = C.lds + 65536;
    LAS float* ea = (LAS float*)(C.lds + 131072); LAS float* bs = ea + 128; LAS float* isc = bs + 128; LAS float* edn = isc + 128; LAS float* npv = edn + 128; LAS float* gnl = npv + 128;
    const float* IFG = (const float*)(C.ws + WS_IFG);
    const float* NPREV = (const float*)(C.ws + WS_SMALL + SM_NPREV); const float* MPREV = (const float*)(C.ws + WS_SMALL + SM_MPREV);
    const float* AG = (const float*)(C.ws + WS_SMALL + SM_AG); const float* CMG = (const float*)(C.ws + WS_SMALL + SM_CMG);
    const int w = C.wave;
    if (C.bid >= 1024) return;
    u32x4 pq[4], pk[4], pc[8]; float ga = 0.f, gcm = 0.f, giv = 0.f, gmp = 0.f, gnp = 0.f, ggn = 0.f;
#define P6_PREFETCH(U) do { \
        _Pragma("unroll") for (int i = 0; i < 4; ++i) { const int e = t + NTHR * i, row = e >> 4, chk = e & 15; pq[i] = *(const u32x4*)((U).Qp + (size_t)row * (U).ldq + chk * 8); pk[i] = *(const u32x4*)((U).Kp + (size_t)row * (U).ldq + chk * 8); } \
        _Pragma("unroll") for (int i = 0; i < 8; ++i) { const int e = t + NTHR * i; pc[i] = *(const u32x4*)((U).cp + (size_t)e * 8); } \
        if (t < 256) ggn = ((U).mixer == 0 ? C.ml_norm_g : C.ret_norm_g)[(U).h * 256 + t]; \
        if ((U).mixer == 0 && t < 128) { ga = AG[(U).bh * SEQ + (U).ch * CH + t]; gcm = CMG[(U).bh * SEQ + (U).ch * CH + t]; giv = IFG[(size_t)((U).t0 + t) * 8 + (U).h]; gmp = MPREV[(U).bh * 32 + (U).ch]; gnp = NPREV[((U).bh * 32 + (U).ch) * 128 + t]; } } while (0)
    OutUnit U = out_unit(C, C.bid);
    { const int t = C.tid; P6_PREFETCH(U); }
    const int t_ = C.tid;
    for (int u = C.bid; u < 1024; u += C.G) {
        const int mixer = U.mixer, h = U.h, t0 = U.t0;
        int t = t_; asm volatile("" : "+v"(t));
        const int lane = t & 63, g = lane >> 4, q = (lane & 15) >> 2, p = lane & 3, jl = lane & 15;
#pragma unroll
        for (int i = 0; i < 4; ++i) { const int e = t + NTHR * i, row = e >> 4, chk = e & 15; *(LAS u32x4*)(Qimg + off_b(row, chk)) = pq[i]; *(LAS u32x4*)(Kimg + off_b(row, chk)) = pk[i]; }
#pragma unroll
        for (int i = 0; i < 8; ++i) { const int e = t + NTHR * i, row = e >> 4, chk = e & 15; *(LAS u32x4*)(R1 + off_b(row, chk)) = pc[i]; }
        if (t < 256) gnl[t] = ggn;
        if (t < 128) {
            if (mixer == 0) { const float il = ga + gmp, m = fmaxf(il, ga + gcm);
                ea[t] = ga - m; bs[t] = giv - ga; isc[t] = __expf(il - m); edn[t] = __expf(-m); npv[t] = gnp; }
            else { const float lg = ret_lg(h); ea[t] = lg * (float)t; bs[t] = -lg * (float)t; isc[t] = __expf(lg * (float)(t + 1)); edn[t] = 1.0f; npv[t] = 0.f; }
        }
        __syncthreads();
        u32x4 vst[8];
#pragma unroll
        for (int i = 0; i < 8; ++i) { const int e = t + NTHR * i, half = e >> 11, row = (e >> 4) & 127, chk = e & 15; vst[i] = *(const u32x4*)(U.Vp + (size_t)row * D + half * 128 + chk * 8); }
        unsigned bk[4];
#pragma unroll
        for (int kk = 0; kk < 4; ++kk) bk[kk] = off_b(jl, 4 * kk + g);
        bf16x8 qf[4];
#pragma unroll
        for (int kk = 0; kk < 4; ++kk) qf[kk] = *(const LAS bf16x8*)(Qimg + 4096 * w + bk[kk]);
        f32x4 st[8];
#pragma unroll
        for (int sb = 0; sb < 8; ++sb) { st[sb] = (f32x4){0.f, 0.f, 0.f, 0.f};
            if (sb <= w) {
#pragma unroll
                for (int kk = 0; kk < 4; ++kk) st[sb] = MFMA16(*(const LAS bf16x8*)(Kimg + bk[kk] + 4096 * sb), qf[kk], st[sb]);
            } }
        const int j = 16 * w + jl; const float eaj = ea[j];
        float psum = 0.f;
#pragma unroll
        for (int sb = 0; sb < 8; ++sb) { const f32x4 b4 = *(const LAS f32x4*)(bs + 16 * sb + 4 * g);
#pragma unroll
            for (int r = 0; r < 4; ++r) { const int s = 16 * sb + 4 * g + r; const float pv = (s <= j) ? __expf(eaj + b4[r]) * st[sb][r] : 0.f; st[sb][r] = pv; psum += pv; } }
        float qn = 0.f;
#pragma unroll
        for (int kk = 0; kk < 4; ++kk) { const f32x4 n0 = *(const LAS f32x4*)(npv + 32 * kk + 8 * g), n1 = *(const LAS f32x4*)(npv + 32 * kk + 8 * g + 4);
            float f[8]; unpack8(__builtin_bit_cast(u32x4, qf[kk]), f);
            qn += f[0] * n0.x + f[1] * n0.y + f[2] * n0.z + f[3] * n0.w + f[4] * n1.x + f[5] * n1.y + f[6] * n1.z + f[7] * n1.w; }
        psum += __shfl_xor(psum, 16); psum += __shfl_xor(psum, 32); qn += __shfl_xor(qn, 16); qn += __shfl_xor(qn, 32);
        const float iscj = isc[j];
        const float dinv = (mixer == 0) ? 1.0f / fmaxf(fabsf(psum + iscj * qn), edn[j]) : 1.0f;
        bf16x8 pf[4];
#pragma unroll
        for (int ks = 0; ks < 4; ++ks) { u32x4 pw; pw.x = pk2(st[2 * ks][0], st[2 * ks][1]); pw.y = pk2(st[2 * ks][2], st[2 * ks][3]); pw.z = pk2(st[2 * ks + 1][0], st[2 * ks + 1][1]); pw.w = pk2(st[2 * ks + 1][2], st[2 * ks + 1][3]);
            pf[ks] = __builtin_bit_cast(bf16x8, pw); }
        f32x4 acc[2][4][2];
#pragma unroll
        for (int hv = 0; hv < 2; ++hv)
#pragma unroll
            for (int uu = 0; uu < 4; ++uu)
#pragma unroll
                for (int x = 0; x < 2; ++x) acc[hv][uu][x] = (f32x4){0.f, 0.f, 0.f, 0.f};
#pragma unroll
        for (int kk = 0; kk < 4; ++kk) {
            const unsigned bi0 = off_b(8 * (jl >> 2) + (jl & 3), 4 * kk + g), bi1 = off_b(8 * (jl >> 2) + 4 + (jl & 3), 4 * kk + g);
#pragma unroll
            for (int hv = 0; hv < 2; ++hv) {
#pragma unroll
                for (int uu = 0; uu < 4; ++uu) {
                    acc[hv][uu][0] = MFMA16(*(const LAS bf16x8*)(R1 + bi0 + (32768 * hv + 8192 * uu)), qf[kk], acc[hv][uu][0]);
                    acc[hv][uu][1] = MFMA16(*(const LAS bf16x8*)(R1 + bi1 + (32768 * hv + 8192 * uu)), qf[kk], acc[hv][uu][1]); }
                asm volatile("" ::: "memory"); }
        }
#pragma unroll
        for (int hv = 0; hv < 2; ++hv)
#pragma unroll
            for (int uu = 0; uu < 4; ++uu)
#pragma unroll
                for (int x = 0; x < 2; ++x) acc[hv][uu][x] *= iscj;
        __syncthreads();
#pragma unroll
        for (int i = 0; i < 8; ++i) { const int e = t + NTHR * i, half = e >> 11, row = (e >> 4) & 127, chk = e & 15; *(LAS u32x4*)(R1 + half * 32768 + off_b(row, chk)) = vst[i]; }
        __syncthreads();
        const bf16* gate = (const bf16*)(C.ws + (mixer == 0 ? WS_MLO : WS_RETG)) + (size_t)(t0 + j) * D + h * 256;
        bf16* outp = (bf16*)(C.ws + (mixer == 0 ? WS_HML : WS_HRET)) + (size_t)(t0 + j) * D + h * 256;

        unsigned bp[4];
#pragma unroll
        for (int uu = 0; uu < 4; ++uu) bp[uu] = off_b(4 * g + q, 4 * uu + p);
#pragma unroll
        for (int ks = 0; ks < 4; ++ks) {
            if (2 * ks <= w) {
#pragma unroll
                for (int hv = 0; hv < 2; ++hv)
#pragma unroll
                    for (int uu = 0; uu < 4; ++uu)
#pragma unroll
                        for (int x = 0; x < 2; ++x) {
                            const bf16x8 vf = cat8(tr_read(R1 + bp[uu] + (32768 * hv + 8192 * ks + 8 * x)), tr_read(R1 + bp[uu] + (32768 * hv + 8192 * ks + 4096 + 8 * x)));
                            acc[hv][uu][x] = MFMA16(vf, pf[ks], acc[hv][uu][x]); }
            }
            asm volatile("" ::: "memory"); }
        const bool has_next = (u + C.G) < 1024;
        U = out_unit(C, has_next ? u + C.G : u); P6_PREFETCH(U);
        float s1 = 0.f;
#pragma unroll
        for (int hv = 0; hv < 2; ++hv)
#pragma unroll
            for (int uu = 0; uu < 4; ++uu)
#pragma unroll
                for (int x = 0; x < 2; ++x) { acc[hv][uu][x] *= dinv; s1 += (acc[hv][uu][x][0] + acc[hv][uu][x][1]) + (acc[hv][uu][x][2] + acc[hv][uu][x][3]); }
        s1 += __shfl_xor(s1, 16); s1 += __shfl_xor(s1, 32);
        const float mu = s1 * (1.0f / 256.0f); float s2 = 0.f;
#pragma unroll
        for (int hv = 0; hv < 2; ++hv)
#pragma unroll
            for (int uu = 0; uu < 4; ++uu)
#pragma unroll
                for (int x = 0; x < 2; ++x) { acc[hv][uu][x] -= mu; const f32x4 d = acc[hv][uu][x]; s2 += (d[0] * d[0] + d[1] * d[1]) + (d[2] * d[2] + d[3] * d[3]); }
        s2 += __shfl_xor(s2, 16); s2 += __shfl_xor(s2, 32);
        const float rstd = 1.0f / sqrtf(s2 * (1.0f / 256.0f) + EPS);
#pragma unroll
        for (int hv = 0; hv < 2; ++hv) {
            u32x4 gt[4];
#pragma unroll
            for (int uu = 0; uu < 4; ++uu) gt[uu] = *(const u32x4*)(gate + 128 * hv + 32 * uu + 8 * g);
#pragma unroll
            for (int uu = 0; uu < 4; ++uu) { const int v0 = 128 * hv + 32 * uu + 8 * g;
                const f32x4 g0 = *(const LAS f32x4*)(gnl + v0), g1 = *(const LAS f32x4*)(gnl + v0 + 4); f32x4 t0v, t1v; unpack8v(gt[uu], t0v, t1v);
                *(u32x4*)(outp + v0) = pack8v(acc[hv][uu][0] * rstd * g0 * t0v, acc[hv][uu][1] * rstd * g1 * t1v); }
            asm volatile("" ::: "memory"); }
        __syncthreads();
    }
#undef P6_PREFETCH
}

DI void phase_norm2_route_mfma(Ctx& C) {
    LAS float* wr = (LAS float*)C.lds;
    LAS float* pg = wr + 32768;
    LAS float* ps = pg + 1024;
    LAS float* lgt = ps + 1024;
    LAS unsigned* cntL = (LAS unsigned*)(lgt + 2048);
    LAS float* ssq = (LAS float*)(cntL + 32);
    const float* mod = (const float*)(C.ws + WS_MOD); const float* X1 = (const float*)(C.ws + WS_X1);
    bf16* H2 = (bf16*)(C.ws + WS_H1);
    int* TOPI = (int*)(C.ws + WS_ROUTE + RT_TOPI); float* TOPW = (float*)(C.ws + WS_ROUTE + RT_TOPW); int* RANK = (int*)(C.ws + WS_ROUTE + RT_RANK);
    unsigned* BLKCNT = (unsigned*)(C.ws + WS_ROUTE + RT_BLKCNT);
    const int lane = C.lane, r = lane & 15, kq = lane >> 4, wq = C.wave & 3, kh = C.wave >> 2;
    for (int i = C.tid; i < 32768 / 4; i += NTHR) *(LAS f32x4*)(wr + i * 4) = *(const f32x4*)(C.w_router + i * 4);
    int cur_b = -1;
    for (int sg = C.bid; sg < T / 64; sg += C.G) {
        const int b = (sg * 64) / SEQ;
        if (b != cur_b) { __syncthreads();
            for (int i = C.tid; i < 1024; i += NTHR) { pg[i] = C.norm_ffn_g[i] * (1.0f + mod[b * 6144 + 4096 + i]); ps[i] = mod[b * 6144 + 3072 + i]; }
            cur_b = b; }
        if (C.tid < 32) cntL[C.tid] = 0u;
        const int row0 = sg * 64 + wq * 16;
        const float* xr = X1 + (size_t)(row0 + r) * D + 4 * kq + 512 * kh;
        f32x4 xv[32]; float ss = 0.f;
#pragma unroll
        for (int i = 0; i < 32; ++i) { xv[i] = *(const f32x4*)(xr + 16 * i); }
#pragma unroll
        for (int i = 0; i < 32; ++i) ss += (xv[i].x * xv[i].x + xv[i].y * xv[i].y) + (xv[i].z * xv[i].z + xv[i].w * xv[i].w);
        ss += __shfl_xor(ss, 16); ss += __shfl_xor(ss, 32);
        if (kq == 0) ssq[C.wave * 16 + r] = ss;
        __syncthreads();
        const float rstd = 1.0f / sqrtf((ssq[wq * 16 + r] + ssq[(wq + 4) * 16 + r]) * (1.0f / D) + EPS);
        f32x4 acc0 = (f32x4){0.f, 0.f, 0.f, 0.f}, acc1 = acc0;
        bf16* hr = H2 + (size_t)(row0 + r) * D + 4 * kq + 512 * kh;
        const LAS float* wb = wr + (512 * kh + 4 * kq) * 32 + r;
        const LAS float* pgh = pg + 512 * kh + 4 * kq; const LAS float* psh = ps + 512 * kh + 4 * kq;
#pragma unroll
        for (int i = 0; i < 32; ++i) {
            const f32x4 h = xv[i] * rstd * *(const LAS f32x4*)(pgh + 16 * i) + *(const LAS f32x4*)(psh + 16 * i);
            u32x2 w; w.x = pk2(h.x, h.y); w.y = pk2(h.z, h.w); *(u32x2*)(hr + 16 * i) = w;
            const LAS float* wi = wb + (16 * i) * 32;
            acc0 = __builtin_amdgcn_mfma_f32_16x16x4f32(h.x, wi[0], acc0, 0, 0, 0);       acc1 = __builtin_amdgcn_mfma_f32_16x16x4f32(h.x, wi[16], acc1, 0, 0, 0);
            acc0 = __builtin_amdgcn_mfma_f32_16x16x4f32(h.y, wi[32], acc0, 0, 0, 0);      acc1 = __builtin_amdgcn_mfma_f32_16x16x4f32(h.y, wi[32 + 16], acc1, 0, 0, 0);
            acc0 = __builtin_amdgcn_mfma_f32_16x16x4f32(h.z, wi[64], acc0, 0, 0, 0);      acc1 = __builtin_amdgcn_mfma_f32_16x16x4f32(h.z, wi[64 + 16], acc1, 0, 0, 0);
            acc0 = __builtin_amdgcn_mfma_f32_16x16x4f32(h.w, wi[96], acc0, 0, 0, 0);      acc1 = __builtin_amdgcn_mfma_f32_16x16x4f32(h.w, wi[96 + 16], acc1, 0, 0, 0);
        }
        LAS float* lw = lgt + wq * 512;
        if (kh == 1) {
#pragma unroll
            for (int j = 0; j < 4; ++j) { lw[(4 * kq + j) * 32 + r] = acc0[j]; lw[(4 * kq + j) * 32 + 16 + r] = acc1[j]; }
        }
        __syncthreads();
        if (kh == 0) {
#pragma unroll
            for (int j = 0; j < 4; ++j) { lw[(4 * kq + j) * 32 + r] += acc0[j] + C.b_router[r]; lw[(4 * kq + j) * 32 + 16 + r] += acc1[j] + C.b_router[16 + r]; }
            asm volatile("s_waitcnt lgkmcnt(0)" ::: "memory");
            if (lane < 16) {
                float l[32];
#pragma unroll
                for (int e4 = 0; e4 < 8; ++e4) { const f32x4 t4 = *(const LAS f32x4*)(lw + lane * 32 + e4 * 4); l[e4 * 4] = t4.x; l[e4 * 4 + 1] = t4.y; l[e4 * 4 + 2] = t4.z; l[e4 * 4 + 3] = t4.w; }
                float tv[4]; int ti[4];
#pragma unroll
                for (int k = 0; k < 4; ++k) {
                    float bvv = -3.0e38f; int bi = 0;
#pragma unroll
                    for (int e = 0; e < 32; ++e) { const bool take = l[e] > bvv; bvv = take ? l[e] : bvv; bi = take ? e : bi; }
                    tv[k] = bvv; ti[k] = bi;
#pragma unroll
                    for (int e = 0; e < 32; ++e) l[e] = (e == bi) ? -3.0e38f : l[e];
                }
                const float e1 = __expf(tv[1] - tv[0]), e2 = __expf(tv[2] - tv[0]), e3 = __expf(tv[3] - tv[0]), inv = 1.0f / (1.0f + e1 + e2 + e3);
                const int m = row0 + lane;
                const float ww[4] = {inv, e1 * inv, e2 * inv, e3 * inv};
#pragma unroll
                for (int k = 0; k < 4; ++k) { TOPI[m * 4 + k] = ti[k]; TOPW[m * 4 + k] = ww[k]; RANK[m * 4 + k] = (int)__hip_atomic_fetch_add(cntL + ti[k], 1u, __ATOMIC_RELAXED, __HIP_MEMORY_SCOPE_WORKGROUP); }
            }
        }
        __syncthreads();
        if (C.tid < 32) BLKCNT[sg * 32 + C.tid] = cntL[C.tid];
    }
    int* SLOTTOK = (int*)(C.ws + WS_ROUTE + RT_SLOTTOK); float* SLOTW = (float*)(C.ws + WS_ROUTE + RT_SLOTW);
    for (int i = C.bid * NTHR + C.tid; i < NSLOTS; i += C.G * NTHR) { SLOTTOK[i] = T; SLOTW[i] = 0.f; }
    if (C.bid == 0) for (int i = C.tid; i < D / 2; i += NTHR) ((unsigned*)(H2 + (size_t)T * D))[i] = 0u;
    __syncthreads();
}

DI void phase_mod_convert(Ctx& C) {
    LAS float* sc = (LAS float*)C.lds;
    LAS float* red = sc + 1024;
    float* MODP = (float*)(C.ws + WS_MODP);
    for (int gI = C.bid; gI < 256; gI += C.G) {
        const int cg = gI & 63, kq = gI >> 6, t = C.tid;
        for (int i = t; i < 1024; i += NTHR) sc[i] = siluf_(C.c[(i >> 8) * D + kq * 256 + (i & 255)]);
        __syncthreads();
        if (t < 504) {
            const int c4 = t % 24, kr = t / 24;
            f32x4 a0 = (f32x4){0.f, 0.f, 0.f, 0.f}, a1 = a0, a2 = a0, a3 = a0;
            for (int k = kr; k < 256; k += 21) {
                const f32x4 w4 = *(const f32x4*)(C.w_ada + (size_t)(kq * 256 + k) * 6144 + cg * 96 + c4 * 4);
                a0 += w4 * sc[k]; a1 += w4 * sc[256 + k]; a2 += w4 * sc[512 + k]; a3 += w4 * sc[768 + k];
            }
            *(LAS f32x4*)(red + (kr * 4 + 0) * 96 + c4 * 4) = a0; *(LAS f32x4*)(red + (kr * 4 + 1) * 96 + c4 * 4) = a1;
            *(LAS f32x4*)(red + (kr * 4 + 2) * 96 + c4 * 4) = a2; *(LAS f32x4*)(red + (kr * 4 + 3) * 96 + c4 * 4) = a3;
        }
        __syncthreads();
        if (t < 384) { const int b = t / 96, col = t % 96; float sm = 0.f; for (int kr = 0; kr < 21; ++kr) sm += red[(kr * 4 + b) * 96 + col];
            MODP[(size_t)kq * 4 * 6144 + b * 6144 + cg * 96 + col] = sm; }
        __syncthreads();
    }
    convert_small(C);
}
DI void phase_norm1_v2(Ctx& C) {
    LAS float* pg = (LAS float*)C.lds; LAS float* psh = pg + 1024;
    const float* MODP = (const float*)(C.ws + WS_MODP); float* MOD = (float*)(C.ws + WS_MOD);
    bf16* H1 = (bf16*)(C.ws + WS_H1);
    float* IFG = (float*)(C.ws + WS_IFG);
    const int lane = C.lane;
    for (int idx = C.bid * NTHR + C.tid; idx < 4 * 6144; idx += C.G * NTHR) MOD[idx] = C.b_ada[idx % 6144] + (MODP[idx] + MODP[24576 + idx]) + (MODP[2 * 24576 + idx] + MODP[3 * 24576 + idx]);
    float wif[4][4][8];
#pragma unroll
    for (int j = 0; j < 4; ++j)
#pragma unroll
        for (int i = 0; i < 4; ++i) {
            const float* wp = C.w_in + (size_t)(4 * (lane + 64 * j) + i) * DIN + 3072;
#pragma unroll
            for (int e = 0; e < 8; ++e) wif[j][i][e] = wp[e];
        }
    int cur_b = -1;
    for (int sg = C.bid; sg < T / 64; sg += C.G) {
        const int b = (sg * 64) / SEQ;
        if (b != cur_b) { __syncthreads();
            for (int i = C.tid; i < 1024; i += NTHR) { const int i0 = b * 6144 + i, i1 = b * 6144 + 1024 + i;
                const float shv = C.b_ada[i] + (MODP[i0] + MODP[24576 + i0]) + (MODP[2 * 24576 + i0] + MODP[3 * 24576 + i0]);
                const float scv = C.b_ada[1024 + i] + (MODP[i1] + MODP[24576 + i1]) + (MODP[2 * 24576 + i1] + MODP[3 * 24576 + i1]);
                pg[i] = C.norm_mix_g[i] * (1.0f + scv); psh[i] = shv; }
            cur_b = b; __syncthreads(); }
#pragma unroll 1
        for (int rr = 0; rr < 8; ++rr) {
            const int m = sg * 64 + C.wave * 8 + rr;
            const f32x4* xr = (const f32x4*)(C.x + (size_t)m * D) + lane;
            f32x4 v[4]; float ss = 0.f;
#pragma unroll
            for (int j = 0; j < 4; ++j) { v[j] = xr[64 * j]; ss += (v[j].x * v[j].x + v[j].y * v[j].y) + (v[j].z * v[j].z + v[j].w * v[j].w); }
            const float rstd = 1.0f / sqrtf(wave_sum(ss) * (1.0f / D) + EPS);
            float p[8];
#pragma unroll
            for (int e = 0; e < 8; ++e) p[e] = 0.f;
            u32x2* o8 = (u32x2*)(H1 + (size_t)m * D) + lane;
#pragma unroll
            for (int j = 0; j < 4; ++j) {
                const int col = 4 * (lane + 64 * j);
                const f32x4 h = v[j] * rstd * *(const LAS f32x4*)(pg + col) + *(const LAS f32x4*)(psh + col);
                u32x2 w; w.x = pk2(h.x, h.y); w.y = pk2(h.z, h.w); o8[64 * j] = w;
                const float hh[4] = {h.x, h.y, h.z, h.w};
#pragma unroll
                for (int i = 0; i < 4; ++i)
#pragma unroll
                    for (int e = 0; e < 8; ++e) p[e] += hh[i] * wif[j][i][e];
            }
#pragma unroll
            for (int e = 0; e < 8; ++e) p[e] = wave_sum(p[e]);
            if (lane < 8) { float r = p[0];
#pragma unroll
                for (int e = 1; e < 8; ++e) r = (lane == e) ? p[e] : r;
                IFG[(size_t)m * 8 + lane] = r + C.b_if[lane]; }
        }
    }
    float* COS = (float*)(C.ws + WS_COS); float* SIN = (float*)(C.ws + WS_SIN);
    for (int idx = C.bid * NTHR + C.tid; idx < T * 64; idx += C.G * NTHR) {
        const int t = idx >> 6, i = idx & 63;
        const float inv = (float)exp(-(double)i * (9.210340371976184 / 64.0));
        const double ang = (double)C.positions[t] * (double)inv;
        const double kq = rint(ang * 0.6366197723675814);
        double r = fma(-kq, 1.5707963267948966, ang); r = fma(-kq, 6.123233995736766e-17, r);
        const float rf = (float)r; const float s = sinf(rf), c = cosf(rf);
        const int q = ((int)kq) & 3;
        const float cs = (q == 0) ? c : (q == 1) ? -s : (q == 2) ? -c : s;
        const float sn = (q == 0) ? s : (q == 1) ? c : (q == 2) ? -s : -c;
        COS[idx] = cs; SIN[idx] = sn;
    }
    __syncthreads();
}

#define XB_TMO      128
#define XB_XCNT(j)  (256  + 64 * (j))
#define XB_XSUB(j)  (1280 + 64 * (j))
#define XB_XGEN(j)  (2304 + 64 * (j))
#define XB_TOP      3328
#define XB_TOPGEN   3392
#define XCD_BAR_WORDS 3456
#define XB_SPIN_CAP (1u << 22)
DI unsigned xb_ld(unsigned* p)              { return __hip_atomic_load(p, __ATOMIC_RELAXED, __HIP_MEMORY_SCOPE_AGENT); }
DI unsigned xb_add(unsigned* p, unsigned v) { return __hip_atomic_fetch_add(p, v, __ATOMIC_RELAXED, __HIP_MEMORY_SCOPE_AGENT); }
DI unsigned xb_xcc_id() { return (unsigned)__builtin_amdgcn_s_getreg((3 << 11) | 20) & 0xFu; }
#define XB_SPIN(cond, bar) do { unsigned _sp = 0; while (cond) { __builtin_amdgcn_s_sleep(1); \
    if ((++_sp & 255u) == 0u) { if (xb_ld(&(bar)[XB_TMO])) break; if (_sp > XB_SPIN_CAP) { atomicAdd(&(bar)[XB_TMO], 1u); break; } } } } while (0)
struct XcdBarrier { unsigned* bar; unsigned x; volatile LAS unsigned* st; };
DI XcdBarrier xcd_barrier_post(unsigned* bar, volatile LAS unsigned* st) {
    XcdBarrier b; b.bar = bar; b.x = xb_xcc_id(); b.st = st;
    if (threadIdx.x == 0) (void)xb_add(&bar[XB_XCNT(b.x)], 1u);
    return b;
}
DI void xcd_barrier_complete(unsigned* bar, unsigned x, unsigned& nloc, unsigned& nx) {
    const unsigned G = gridDim.x * gridDim.y * gridDim.z;
    unsigned sum, cnt, mine, sp = 0u;
    for (;;) {
        sum = 0u; cnt = 0u; mine = 0u;
#pragma unroll
        for (unsigned j = 0; j < 16; ++j) { const unsigned c = xb_ld(&bar[XB_XCNT(j)]); sum += c; cnt += (c > 0u) ? 1u : 0u; mine = (j == x) ? c : mine; }
        if (sum == G) break;
        __builtin_amdgcn_s_sleep(1);
        if ((++sp & 255u) == 0u) { if (xb_ld(&bar[XB_TMO])) break; if (sp > XB_SPIN_CAP) { atomicAdd(&bar[XB_TMO], 1u); break; } }
    }
    nloc = mine > 0u ? mine : 1u; nx = cnt > 0u ? cnt : 1u;
}
DI void xcd_barrier(const XcdBarrier& b) {
    asm volatile("s_waitcnt vmcnt(0)" ::: "memory");
    __syncthreads();
    if (threadIdx.x == 0) {
        unsigned* bar = b.bar;
        __builtin_amdgcn_s_waitcnt(0);
        unsigned nloc = b.st[0], nx = b.st[1];
        if (nloc == 0u) { xcd_barrier_complete(bar, b.x, nloc, nx); b.st[0] = nloc; b.st[1] = nx; }
        const unsigned old = xb_add(&bar[XB_XSUB(b.x)], 1u);
        const unsigned gen = old / nloc;
        if (old + 1u == (gen + 1u) * nloc) {
            __builtin_amdgcn_fence(__ATOMIC_RELEASE, "agent");
            asm volatile("s_waitcnt vmcnt(0)" ::: "memory");
            const unsigned og = xb_add(&bar[XB_TOP], 1u);
            const unsigned tg = og / nx;
            if (og + 1u == (tg + 1u) * nx) xb_add(&bar[XB_TOPGEN], 1u);
            else XB_SPIN(xb_ld(&bar[XB_TOPGEN]) == tg, bar);
            __builtin_amdgcn_fence(__ATOMIC_ACQUIRE, "agent");
            xb_add(&bar[XB_XGEN(b.x)], 1u);
            asm volatile("s_waitcnt vmcnt(0)" ::: "memory");
        } else {
            XB_SPIN(xb_ld(&bar[XB_XGEN(b.x)]) == gen, bar);
            __builtin_amdgcn_fence(__ATOMIC_ACQUIRE, "agent");
            asm volatile("s_waitcnt vmcnt(0)" ::: "memory");
        }
    }
    __syncthreads();
}

constexpr int NPHASES = 14;
__global__ void __launch_bounds__(NTHR, 2) fwd(Args a) {
    extern __shared__ __attribute__((aligned(16))) unsigned char lds[];
    Ctx C;
    C.lds = (LAS unsigned char*)lds; C.tid = threadIdx.x; C.lane = C.tid & 63; C.wave = __builtin_amdgcn_readfirstlane(C.tid >> 6); C.G = gridDim.x; C.bid = blockIdx.x;
    C.x = (const float*)a.in[0]; C.c = (const float*)a.in[1]; C.positions = (const int*)a.in[2]; C.w_ada = (const float*)a.in[3]; C.b_ada = (const float*)a.in[4];
    C.norm_mix_g = (const float*)a.in[5]; C.w_in = (const float*)a.in[6]; C.conv_w = (const float*)a.in[7]; C.conv_b = (const float*)a.in[8]; C.b_if = (const float*)a.in[9];
    C.ml_norm_g = (const float*)a.in[10]; C.ret_norm_g = (const float*)a.in[11]; C.w_bml = (const float*)a.in[12]; C.w_bret = (const float*)a.in[13]; C.w_out = (const float*)a.in[14];
    C.norm_ffn_g = (const float*)a.in[15]; C.w_router = (const float*)a.in[16]; C.b_router = (const float*)a.in[17]; C.w_gu = (const float*)a.in[18]; C.b_gu = (const float*)a.in[19];
    C.w_dn = (const float*)a.in[20]; C.b_dn = (const float*)a.in[21]; C.norm_final_g = (const float*)a.in[22];
    C.out = a.out; C.ws = a.ws;
    const int lo = a.ph_lo, hi = a.ph_hi;
    volatile LAS unsigned* bst = (volatile LAS unsigned*)(C.lds + LDS_BYTES - 16);
    if (C.tid < 4) bst[C.tid] = 0u;
    __syncthreads();
    XcdBarrier bar; bar.bar = (unsigned*)(C.ws + WS_CTL) + CW_BAR; bar.x = 0; bar.st = bst;
    if (hi - lo > 1) bar = xcd_barrier_post((unsigned*)(C.ws + WS_CTL) + CW_BAR, bst);
#define SEAM(k) do { if (IN(k) && IN((k) + 1)) xcd_barrier(bar); } while (0)
#ifdef ONLY_PHASE
#define IN(k) ((k) == ONLY_PHASE && lo <= (k) && (k) < hi)
#else
#define IN(k) (lo <= (k) && (k) < hi)
#endif
    if (IN(0)) phase_mod_convert(C); SEAM(0);
    if (IN(1)) phase_norm1_v2(C); SEAM(1);
#if OPT_INPROJ
    if (IN(2)) phase_inproj_mfma(C); SEAM(2);
#else
    if (IN(2)) phase_inproj(C); SEAM(2);
#endif
#if !(OPT_INPROJ && OPT_LOCAL)
    if (IN(3)) phase_conv_rope(C); SEAM(3);
#endif
#if OPT_LOCAL
    if (IN(4)) phase_local_mfma(C); SEAM(4);
#else
    if (IN(4)) phase_local(C); SEAM(4);
#endif
    if (IN(5)) phase_scan(C); SEAM(5);
#if OPT_OUTP
    if (IN(6)) phase_out_mfma(C); SEAM(6);
#else
    if (IN(6)) phase_out(C); SEAM(6);
#endif
#if OPT_BRANCH
    if (IN(7)) phase_branch_mfma(C); SEAM(7);
#else
    if (IN(7)) phase_branch(C); SEAM(7);
#endif
#if OPT_OUT
    if (IN(8)) phase_outproj_mfma(C); SEAM(8);
#else
    if (IN(8)) phase_outproj(C); SEAM(8);
#endif
#if OPT_ROUTE
    if (IN(9)) phase_norm2_route_mfma(C); SEAM(9);
#else
    if (IN(9)) phase_norm2_route(C); SEAM(9);
#endif
    if (IN(10)) phase_slots(C); SEAM(10);
#if OPT_MOE
    if (IN(11)) phase_gateup_mfma(C); SEAM(11);
#else
    if (IN(11)) phase_gateup(C); SEAM(11);
#endif
#if OPT_MOE
    if (IN(12)) phase_down_mfma(C); SEAM(12);
#else
    if (IN(12)) phase_down(C); SEAM(12);
#endif
    if (IN(13)) phase_final(C); SEAM(13);
#undef IN
}

extern "C" void kernel_launch(void* const* d_in, const int* in_sizes, int n_in, void* d_out, int out_size, void* d_ws, size_t ws_size, hipStream_t stream) {
    static int grid = 0;
    if (grid == 0) {
        if (n_in != 23 || out_size != T * D || ws_size < WS_END) { fprintf(stderr, "kernel_launch: unexpected shapes: n_in %d out %d ws %zu (need %zu)\n", n_in, out_size, ws_size, (size_t)WS_END); grid = -1; return; }
        int dev = 0, cus = 0;
        if (hipGetDevice(&dev) != hipSuccess || hipDeviceGetAttribute(&cus, hipDeviceAttributeMultiprocessorCount, dev) != hipSuccess) { grid = -1; return; }
        if (hipFuncSetAttribute((const void*)fwd, hipFuncAttributeMaxDynamicSharedMemorySize, LDS_BYTES) != hipSuccess) { fprintf(stderr, "kernel_launch: hipFuncSetAttribute failed\n"); grid = -1; return; }
        grid = cus > 0 ? cus : 256;
    }
    if (grid < 0) return;
    Args a{};
    for (int i = 0; i < 23; ++i) a.in[i] = d_in[i];
    a.out = (float*)d_out; a.ws = (unsigned char*)d_ws;
    (void)hipMemsetAsync((char*)d_ws + WS_CTL, 0, CTL_ZERO_BYTES, stream);
#ifdef MK_PER_PHASE
    for (int p = 0; p < NPHASES; ++p) { a.ph_lo = p; a.ph_hi = p + 1; hipLaunchKernelGGL(fwd, dim3(grid), dim3(NTHR), LDS_BYTES, stream, a); }
#else
    a.ph_lo = 0; a.ph_hi = NPHASES;
    hipLaunchKernelGGL(fwd, dim3(grid), dim3(NTHR), LDS_BYTES, stream, a);
#endif
#ifdef PROBE_PHASE
    for (int r = 0; r < PROBE_REPS; ++r) { a.ph_lo = PROBE_PHASE; a.ph_hi = PROBE_PHASE + 1; hipLaunchKernelGGL(fwd, dim3(grid), dim3(NTHR), LDS_BYTES, stream, a); }
#endif
}
```
